# Optimizing an MI355X kernel written in HIP

```python
import jax, jax.numpy as jnp
from jax import lax
import numpy as np

D_MODEL = 4096
BATCH = 4
SEQ = 2048
DEPTH = 1

GRID_W = 64
CTX_LEN = 256
HEAD_DIM = 128
N_HEADS_TOTAL = D_MODEL // HEAD_DIM
NA_HEADS = N_HEADS_TOTAL // 2
NA_WIDTH = NA_HEADS * HEAD_DIM
CONV_WIDTH = D_MODEL - NA_WIDTH
MIX_WIDTH = NA_WIDTH + CONV_WIDTH
CONV_K = 3
NA_KH = 8
NA_KW = 16
FFN_HIDDEN = -(-8 * D_MODEL // (3 * 256)) * 256
ROPE_THETA = 10000.0
EPS = 1e-6
N_MOD = 6
Q0 = 0
K0 = NA_WIDTH
V0 = 2 * NA_WIDTH
CIN0 = 3 * NA_WIDTH
GB0 = CIN0 + CONV_WIDTH
GC0 = GB0 + CONV_WIDTH
IN_COLS = GC0 + CONV_WIDTH

kernel_name = "hybrid_na_shortconv_dit_layer"


def rmsnorm(x, g):
    xf = x.astype(jnp.float32)
    y = xf * lax.rsqrt(jnp.mean(xf * xf, axis=-1, keepdims=True) + EPS)
    return (y * g.astype(jnp.float32)).astype(x.dtype)


def modulate(xn, shift, scale):
    return xn * (1 + scale) + shift


def split_heads(t):
    b, s, _ = t.shape
    return t.reshape(b, s, -1, HEAD_DIM).transpose(0, 2, 1, 3)


def merge_heads(t):
    b, h, s, d = t.shape
    return t.transpose(0, 2, 1, 3).reshape(b, s, h * d)


def rope_1d(u, pos):
    half = u.shape[-1] // 2
    freqs = ROPE_THETA ** (-jnp.arange(half, dtype=jnp.float32) / half)
    ang = pos[:, None] * freqs[None, :]
    cos, sin = jnp.cos(ang), jnp.sin(ang)
    uf = u.astype(jnp.float32)
    u1, u2 = uf[..., :half], uf[..., half:]
    return jnp.concatenate([u1 * cos - u2 * sin, u1 * sin + u2 * cos], axis=-1)


def axial_rope(t, row_pos, col_pos):
    d = t.shape[-1] // 2
    out = jnp.concatenate([rope_1d(t[..., :d], row_pos), rope_1d(t[..., d:], col_pos)], axis=-1)
    return out.astype(t.dtype)


def neighbourhood_attention(q, k, v, k_ctx, v_ctx, rpb):
    b, h, s, dh = q.shape
    rows = s // GRID_W
    kh = min(NA_KH, rows)
    kw = NA_KW
    scale = dh ** -0.5
    qg = q.reshape(b, h, rows, GRID_W, dh)
    kg = k.reshape(b, h, rows, GRID_W, dh)
    vg = v.reshape(b, h, rows, GRID_W, dh)
    row_start = jnp.clip(jnp.arange(rows) - kh // 2, 0, rows - kh)
    col = jnp.arange(GRID_W)
    col_start = jnp.clip(col - kw // 2, 0, GRID_W - kw)
    col_mask = (col[None, :] >= col_start[:, None]) & (col[None, :] < col_start[:, None] + kw)
    dc_idx = jnp.clip(col[None, :] - col[:, None] + kw - 1, 0, 2 * kw - 2)
    rpb_c = rpb[:, :, dc_idx]

    def row_block(args):
        r, rs = args
        q_r = lax.dynamic_index_in_dim(qg, r, axis=2, keepdims=False)
        k_r = lax.dynamic_slice_in_dim(kg, rs, kh, axis=2)
        v_r = lax.dynamic_slice_in_dim(vg, rs, kh, axis=2)
        s_lat = jnp.einsum('bhqd,bhrkd->bhqrk', q_r, k_r).astype(jnp.float32) * scale
        dr_idx = rs + jnp.arange(kh) - r + (NA_KH - 1)
        bias = jnp.take(rpb_c, dr_idx, axis=1).transpose(0, 2, 1, 3)
        s_lat = jnp.where(col_mask[None, None, :, None, :], s_lat + bias[None].astype(jnp.float32), -jnp.inf)
        s_ctx = jnp.einsum('bhqd,bhld->bhql', q_r, k_ctx).astype(jnp.float32) * scale
        sc = jnp.concatenate([s_lat.reshape(b, h, GRID_W, kh * GRID_W), s_ctx], axis=-1)
        p = jax.nn.softmax(sc, axis=-1).astype(v.dtype)
        p_lat = p[..., :kh * GRID_W].reshape(b, h, GRID_W, kh, GRID_W)
        return (jnp.einsum('bhqrk,bhrkd->bhqd', p_lat, v_r)
                + jnp.einsum('bhql,bhld->bhqd', p[..., kh * GRID_W:], v_ctx))

    out = lax.map(row_block, (jnp.arange(rows), row_start))
    return out.transpose(1, 2, 0, 3, 4).reshape(b, h, s, dh)


def context_attention(q, k, v):
    sc = jnp.einsum('bhqd,bhkd->bhqk', q, k).astype(jnp.float32) * (q.shape[-1] ** -0.5)
    p = jax.nn.softmax(sc, axis=-1).astype(v.dtype)
    return jnp.einsum('bhqk,bhkd->bhqd', p, v)


def short_conv(u, w):
    up = jnp.pad(u, ((0, 0), (1, 1), (0, 0)))
    return w[0] * up[:, :-2] + w[1] * up[:, 1:-1] + w[2] * up[:, 2:]


def gated_short_conv(u, gate_b, gate_c, w):
    return gate_b * short_conv(gate_c * u, w)


def mix_output(attn_o, conv_o, g_grp, w_out):
    y = jnp.concatenate([rmsnorm(attn_o, g_grp[:NA_WIDTH]), rmsnorm(conv_o, g_grp[NA_WIDTH:])], axis=-1)
    return y @ w_out


def swiglu(hn, w_gate_up, w_down):
    gu = hn @ w_gate_up
    return (jax.nn.silu(gu[..., :FFN_HIDDEN]) * gu[..., FFN_HIDDEN:]) @ w_down


def setup_inputs(seed: int = 0) -> dict:
    key = jax.random.key(seed)
    ks = jax.random.split(key, 16)
    f32 = jnp.float32

    def nrm(k, shape, scale):
        return jax.random.normal(k, shape, f32) * scale

    def gain(k, shape):
        return 1.0 + 0.02 * jax.random.normal(k, shape, f32)

    return {
        "x": nrm(ks[0], (BATCH, SEQ, D_MODEL), 1.0),
        "c": nrm(ks[1], (BATCH, D_MODEL), 1.0),
        "ctx": nrm(ks[2], (BATCH, CTX_LEN, D_MODEL), 1.0),
        "c_ctx": nrm(ks[3], (D_MODEL,), 1.0),
        "ada_w": nrm(ks[4], (DEPTH, D_MODEL, N_MOD * D_MODEL), 0.5 * D_MODEL ** -0.5),
        "ada_b": nrm(ks[5], (DEPTH, N_MOD * D_MODEL), 0.02),
        "norm1_g": gain(ks[6], (DEPTH, D_MODEL)),
        "w_in": nrm(ks[7], (DEPTH, D_MODEL, IN_COLS), D_MODEL ** -0.5),
        "conv_w": nrm(ks[8], (DEPTH, CONV_K, CONV_WIDTH), CONV_K ** -0.5),
        "rpb": nrm(ks[9], (DEPTH, NA_HEADS, 2 * NA_KH - 1, 2 * NA_KW - 1), 0.1),
        "group_norm_g": gain(ks[10], (DEPTH, MIX_WIDTH)),
        "w_out": nrm(ks[11], (DEPTH, MIX_WIDTH, D_MODEL), MIX_WIDTH ** -0.5),
        "norm2_g": gain(ks[12], (DEPTH, D_MODEL)),
        "w_gate_up": nrm(ks[13], (DEPTH, D_MODEL, 2 * FFN_HIDDEN), D_MODEL ** -0.5),
        "w_down": nrm(ks[14], (DEPTH, FFN_HIDDEN, D_MODEL), FFN_HIDDEN ** -0.5),
        "final_norm_g": gain(ks[15], (D_MODEL,)),
    }


def reference(x, c, ctx, c_ctx, ada_w, ada_b, norm1_g, w_in, conv_w, rpb, group_norm_g, w_out,
              norm2_g, w_gate_up, w_down, final_norm_g):
    b, s, _ = x.shape
    t = jnp.arange(s)
    row_pos = (t // GRID_W).astype(jnp.float32)
    col_pos = (t % GRID_W).astype(jnp.float32)
    for l in range(DEPTH):
        update_ctx = l < DEPTH - 1
        mod = (jax.nn.silu(c) @ ada_w[l] + ada_b[l]).reshape(b, N_MOD, D_MODEL)
        mod_c = (jax.nn.silu(c_ctx) @ ada_w[l] + ada_b[l]).reshape(N_MOD, D_MODEL)
        sh1, sc1, g1, sh2, sc2, g2 = [mod[:, i, None, :] for i in range(N_MOD)]
        csh1, csc1, cg1, csh2, csc2, cg2 = [mod_c[i] for i in range(N_MOD)]

        h = modulate(rmsnorm(x, norm1_g[l]), sh1, sc1)
        hc = modulate(rmsnorm(ctx, norm1_g[l]), csh1, csc1)
        p = h @ w_in[l]
        q = axial_rope(split_heads(p[..., Q0:K0]), row_pos, col_pos)
        k = axial_rope(split_heads(p[..., K0:V0]), row_pos, col_pos)
        v = split_heads(p[..., V0:CIN0])
        if update_ctx:
            pc = hc @ w_in[l]
            kv_c = pc[..., K0:CIN0]
        else:
            kv_c = hc @ w_in[l][:, K0:CIN0]
        k_c = split_heads(kv_c[..., :NA_WIDTH])
        v_c = split_heads(kv_c[..., NA_WIDTH:])
        attn_o = merge_heads(neighbourhood_attention(q, k, v, k_c, v_c, rpb[l]))
        conv_o = gated_short_conv(p[..., CIN0:GB0], p[..., GB0:GC0], p[..., GC0:], conv_w[l])
        x = x + g1 * mix_output(attn_o, conv_o, group_norm_g[l], w_out[l])

        if update_ctx:
            q_c = split_heads(pc[..., Q0:K0])
            attn_c = merge_heads(context_attention(q_c, k_c, v_c))
            conv_c = gated_short_conv(pc[..., CIN0:GB0], pc[..., GB0:GC0], pc[..., GC0:], conv_w[l])
            ctx = ctx + cg1 * mix_output(attn_c, conv_c, group_norm_g[l], w_out[l])
            ctx = ctx + cg2 * swiglu(modulate(rmsnorm(ctx, norm2_g[l]), csh2, csc2), w_gate_up[l], w_down[l])

        x = x + g2 * swiglu(modulate(rmsnorm(x, norm2_g[l]), sh2, sc2), w_gate_up[l], w_down[l])
    return rmsnorm(x, final_norm_g)
```

```cpp
#include <hip/hip_runtime.h>
#include <cstdio>
#include <cstdint>
namespace pg8 {
#define PG8_LAS __attribute__((address_space(3)))
typedef unsigned short bf16_t;
typedef short bf16x8 __attribute__((ext_vector_type(8)));
typedef float f32x4 __attribute__((ext_vector_type(4)));
typedef unsigned u32x4 __attribute__((ext_vector_type(4)));
constexpr int BM = 256, BK = 64, HALF = 128, HTB = HALF * BK * 2  , STAGE_BYTES = 8 * HTB, NXCD = 8, WGM = 8;

__host__ __device__ __forceinline__ int lds_byte(int r, int c) { const int st = (r >> 4) * 2 + (c >> 5), rr = r & 15, cc = c & 31, ob = rr * 64 + cc * 2; return st * 1024 + (ob ^ (((ob >> 9) & 1) << 5)); }
__host__ __device__ __forceinline__ void stage_rc(int b, int& R, int& C) { const int st = b / 1024, sb = b % 1024, swz = sb ^ (((sb >> 9) & 1) << 5); R = (st >> 1) * 16 + swz / 64; C = (st & 1) * 32 + (swz % 64) / 2; }
__host__ __device__ __forceinline__ int perm32(int rho) { const int n = rho >> 4, i = rho & 15; return 8 * (i >> 2) + 4 * n + (i & 3); }

struct Unit { int pm, pn; };
struct Gemm { const bf16_t* A; const bf16_t* Bt; int M, N, K; };

struct StaticOrder {
    int nM, nN, nwg, G, c;
    __host__ __device__ void init(int M, int N, int G_, int c_) { nM = M / BM; nN = N / BM; nwg = nM * nN; G = G_; c = c_; }
    __host__ __device__ bool next(int i, Unit& u) const {
        const long L = (long)i * G + c; if (L >= nwg) return false;
        int wgid = (int)L; { const int q = nwg / NXCD, r = nwg % NXCD, xcd = wgid % NXCD, off = wgid / NXCD; wgid = (xcd < r ? xcd * (q + 1) : r * (q + 1) + (xcd - r) * q) + off; }
        const int nig = WGM * nN, gid = wgid / nig, fm = gid * WGM, gsz = (nM - fm) < WGM ? (nM - fm) : WGM;
        u.pm = fm + ((wgid % nig) % gsz); u.pn = (wgid % nig) / gsz; return true;
    }
    __device__ __forceinline__ void a_ready(const Unit&) const {}
    __device__ __forceinline__ void done(const Unit&) const {}
};

__device__ __forceinline__ unsigned cvt_pk_bf16(float lo, float hi) { unsigned r; asm volatile("v_cvt_pk_bf16_f32 %0, %1, %2" : "=v"(r) : "v"(lo), "v"(hi)); return r; }
typedef float f32x2 __attribute__((ext_vector_type(2)));
typedef __bf16 bf16v2 __attribute__((ext_vector_type(2)));
__device__ __forceinline__ unsigned pkbf(float lo, float hi) { f32x2 v = {lo, hi}; bf16v2 r = __builtin_convertvector(v, bf16v2); return __builtin_bit_cast(unsigned, r); }

struct EpiIn {
    static constexpr bool PERM = true, AFTER_DRAIN = false;
    bf16_t *Q, *Kd, *Vd, *Cd; const float* rope; float qscale;
    __device__ __forceinline__ void operator()(const f32x4 (&acc)[2][2][4][2], const Unit& u, int wr, int wc, int fr, int fq) const {
        const int reg = u.pn >> 3;
        bf16_t* base; int ldc, colt; bool rot = false; float sc = 1.f;
        if (reg == 0) { base = Q; ldc = 2048; colt = u.pn * BM; rot = true; sc = qscale; }
        else if (reg == 1) { base = Kd; ldc = 2048; colt = (u.pn - 8) * BM; rot = (u.pm < 32); }
        else if (reg == 2) { base = Vd; ldc = 2048; colt = (u.pn - 16) * BM; }
        else { base = Cd; ldc = 6144; colt = (u.pn - 24) * BM; }
        const int row0 = u.pm * BM + wr * 64 + fr, col0 = colt + wc * 32 + 8 * fq;
        const int blk = wc >> 1, i0 = 4 * ((4 * wc + fq) & 7);
#pragma unroll
        for (int ai = 0; ai < 2; ++ai)
#pragma unroll
            for (int m = 0; m < 4; ++m) { const int r = row0 + ai * HALF + m * 16; bf16_t* rowp = base + (size_t)r * ldc + col0;
                f32x4 cs4 = {1.f, 1.f, 1.f, 1.f}, sn4 = {0.f, 0.f, 0.f, 0.f};
                if (rot) { const int t = r & 2047, pos = blk ? (t & 63) : (t >> 6); cs4 = *(const f32x4*)(rope + pos * 32 + i0); sn4 = *(const f32x4*)(rope + 2048 + pos * 32 + i0); }
#pragma unroll
                for (int bj = 0; bj < 2; ++bj) { const f32x4 a = acc[ai][bj][m][0], b = acc[ai][bj][m][1];
                    const f32x4 v0 = (a * cs4 - b * sn4) * sc, v1 = (a * sn4 + b * cs4) * sc;
                    u32x4 w; w.x = pkbf(v0[0], v0[1]); w.y = pkbf(v0[2], v0[3]); w.z = pkbf(v1[0], v1[1]); w.w = pkbf(v1[2], v1[3]);
                    *(u32x4*)(rowp + bj * HALF) = w; } }
    }
};
struct EpiRes {
    static constexpr bool PERM = false, AFTER_DRAIN = false;
    const float* resid; float* out; int ldc; const float* gate;
    __device__ __forceinline__ void operator()(const f32x4 (&acc)[2][2][4][2], const Unit& u, int wr, int wc, int fr, int fq) const {
        const int row0 = u.pm * BM + wr * 64 + fr, col0 = u.pn * BM + wc * 32 + 4 * fq;
        const float* gp = gate + (size_t)(u.pm >> 3) * 24576 + col0;
        f32x4 gv[2][2];
#pragma unroll
        for (int bj = 0; bj < 2; ++bj)
#pragma unroll
            for (int n = 0; n < 2; ++n) gv[bj][n] = *(const f32x4*)(gp + bj * HALF + n * 16);
#pragma unroll
        for (int ai = 0; ai < 2; ++ai)
#pragma unroll
            for (int m = 0; m < 4; ++m) { const size_t off = (size_t)(row0 + ai * HALF + m * 16) * ldc + col0;
#pragma unroll
                for (int bj = 0; bj < 2; ++bj)
#pragma unroll
                    for (int n = 0; n < 2; ++n) { const f32x4 rs = *(const f32x4*)(resid + off + bj * HALF + n * 16);
                        *(f32x4*)(out + off + bj * HALF + n * 16) = rs + gv[bj][n] * acc[ai][bj][m][n]; }
                asm volatile("" ::: "memory"); }
    }
};
struct EpiSwiglu {
    static constexpr bool PERM = true, AFTER_DRAIN = false;
    bf16_t* O; int ldc;
    __device__ __forceinline__ void operator()(const f32x4 (&acc)[2][2][4][2], const Unit& u, int wr, int wc, int fr, int fq) const {
        const int row0 = u.pm * BM + wr * 64 + fr, col0 = u.pn * HALF + wc * 32 + 8 * fq;
#pragma unroll
        for (int ai = 0; ai < 2; ++ai)
#pragma unroll
            for (int m = 0; m < 4; ++m) { bf16_t* rowp = O + (size_t)(row0 + ai * HALF + m * 16) * ldc + col0;
                float o[8];
#pragma unroll
                for (int n = 0; n < 2; ++n)
#pragma unroll
                    for (int j = 0; j < 4; ++j) { const float gt = acc[ai][0][m][n][j], up = acc[ai][1][m][n][j];
                        o[4 * n + j] = gt * __builtin_amdgcn_rcpf(1.0f + __builtin_amdgcn_exp2f(-1.44269504089f * gt)) * up; }
                u32x4 w; w.x = pkbf(o[0], o[1]); w.y = pkbf(o[2], o[3]); w.z = pkbf(o[4], o[5]); w.w = pkbf(o[6], o[7]);
                *(u32x4*)rowp = w; }
    }
};
struct InOrder {
    StaticOrder so; int G, c;
    __host__ __device__ void init(int G_, int c_) { so.init(8192, 12288, G_, c_); G = G_; c = c_; }
    __host__ __device__ bool next(int i, Unit& u) const {
        const long L = (long)i * G + c; if (L >= 1600) return false;
        if (L < 1536) return so.next(i, u);
        const int e = (int)L - 1536; u.pm = 32 + (e & 3); u.pn = 8 + (e >> 2); return true;
    }
    __device__ __forceinline__ void a_ready(const Unit&) const {}
    __device__ __forceinline__ void done(const Unit&) const {}
};
template <class Epi, class Sched, bool ALIGN_EPI = false, bool SP2 = false>
__device__ __forceinline__ void gemm_phase(PG8_LAS unsigned char* lds, const Gemm g, const Sched& S, const Epi& E) {
    const int tid = threadIdx.x, wid = __builtin_amdgcn_readfirstlane(tid >> 6), lane = tid & 63, wr = wid >> 2, wc = wid & 3, fr = lane & 15, fq = lane >> 4;
    const int K = g.K, nt = K / BK;
    unsigned voffA[2], voffB[2];
#pragma unroll
    for (int i = 0; i < 2; ++i) { int R, C; stage_rc(tid * 16 + i * 8192, R, C); const int Rb = Epi::PERM ? ((R & ~31) + perm32(R & 31)) : R;
        voffA[i] = (unsigned)(R * K + C) * 2u; voffB[i] = (unsigned)(Rb * K + C) * 2u; }
    const size_t kstep = (size_t)(BK * 2);
    const size_t hstep = (size_t)HALF * K * 2;
    const size_t tstep = 2 * hstep;
    const unsigned ldsw = (unsigned)wid * 1024u;
    const int aoff = lds_byte(wr * 64 + fr, fq * 8), boff = lds_byte(wc * 32 + fr, fq * 8);
#define PG8_SA(b, h) (((b) * 2 + (h)) * HTB)
#define PG8_SB(b, h) ((4 + (b) * 2 + (h)) * HTB)
#define PG8_STAGE(bufoff, gbase, voff) do { _Pragma("unroll") for (int _i = 0; _i < 2; ++_i) \
        __builtin_amdgcn_global_load_lds((const unsigned*)((const char*)(gbase) + (voff)[_i]), (PG8_LAS unsigned*)(lds + (bufoff) + ldsw + _i * 8192), 16, 0, 0); } while (0)
#define PG8_LDA(dst, b, h) do { _Pragma("unroll") for (int m = 0; m < 4; ++m) _Pragma("unroll") for (int k = 0; k < 2; ++k) dst[m][k] = *(const PG8_LAS bf16x8*)(lds + PG8_SA(b, h) + aoff + m * 2048 + k * 1024); } while (0)
#define PG8_LDB(dst, b, h) do { _Pragma("unroll") for (int n = 0; n < 2; ++n) _Pragma("unroll") for (int k = 0; k < 2; ++k) dst[n][k] = *(const PG8_LAS bf16x8*)(lds + PG8_SB(b, h) + boff + n * 2048 + k * 1024); } while (0)
#define PG8_MMA(ai, bj, At, Bt) do { __builtin_amdgcn_s_setprio(1); _Pragma("unroll") for (int m = 0; m < 4; ++m) _Pragma("unroll") for (int n = 0; n < 2; ++n) _Pragma("unroll") for (int k = 0; k < 2; ++k) \
        acc[ai][bj][m][n] = __builtin_amdgcn_mfma_f32_16x16x32_bf16(Bt[n][k], At[m][k], acc[ai][bj][m][n], 0, 0, 0); __builtin_amdgcn_s_setprio(0); } while (0)
#define PG8_WAIT_V(n) asm volatile("s_waitcnt vmcnt(" #n ")" ::: "memory")
#define PG8_WAIT_L(n) asm volatile("s_waitcnt lgkmcnt(" #n ")" ::: "memory")
#define PG8_BAR __builtin_amdgcn_s_barrier()
#define PG8_SCHED __builtin_amdgcn_sched_barrier(0)
    Unit cur, nxt; int ui = 0;
    if (!S.next(0, cur)) return;
    f32x4 acc[2][2][4][2];
#pragma unroll
    for (int a = 0; a < 2; ++a)
#pragma unroll
        for (int b = 0; b < 2; ++b)
#pragma unroll
            for (int m = 0; m < 4; ++m)
#pragma unroll
                for (int n = 0; n < 2; ++n) acc[a][b][m][n] = (f32x4){0.f, 0.f, 0.f, 0.f};
    bf16x8 At[4][2], B0[2][2], B1[2][2];
    const char* cA = (const char*)g.A + (size_t)cur.pm * tstep; const char* cB = (const char*)g.Bt + (size_t)cur.pn * tstep;
    S.a_ready(cur);
    if constexpr (SP2) {
        PG8_STAGE(PG8_SB(0, 0), cB, voffB); PG8_STAGE(PG8_SB(0, 1), cB + hstep, voffB); PG8_STAGE(PG8_SA(0, 0), cA, voffA); PG8_STAGE(PG8_SA(0, 1), cA + hstep, voffA);
        if (wr == 1) PG8_BAR;
        PG8_WAIT_V(2); PG8_BAR;
        PG8_STAGE(PG8_SB(1, 0), cB + kstep, voffB); PG8_STAGE(PG8_SA(1, 0), cA + kstep, voffA); PG8_STAGE(PG8_SB(1, 1), cB + hstep + kstep, voffB);
        PG8_WAIT_V(6); PG8_BAR;
    } else {
        PG8_STAGE(PG8_SB(0, 0), cB, voffB); PG8_STAGE(PG8_SA(0, 0), cA, voffA); PG8_STAGE(PG8_SB(0, 1), cB + hstep, voffB); PG8_STAGE(PG8_SA(0, 1), cA + hstep, voffA);
        if (wr == 1) PG8_BAR;
        PG8_WAIT_V(4); PG8_BAR;
        PG8_STAGE(PG8_SB(1, 0), cB + kstep, voffB); PG8_STAGE(PG8_SA(1, 0), cA + kstep, voffA); PG8_STAGE(PG8_SB(1, 1), cB + hstep + kstep, voffB);
        PG8_WAIT_V(6); PG8_BAR;
    }
    for (;;) {
        const bool has_next = S.next(ui + 1, nxt);
        const char* nA = has_next ? (const char*)g.A + (size_t)nxt.pm * tstep : cA; const char* nB = has_next ? (const char*)g.Bt + (size_t)nxt.pn * tstep : cB;
        for (int t = 0; t < nt; t += 2) {
            const bool last = (t == nt - 2);
            const char* a1 = cA + (size_t)(t + 1) * kstep;
            const char* a2 = last ? nA : cA + (size_t)(t + 2) * kstep; const char* b2 = last ? nB : cB + (size_t)(t + 2) * kstep;
            const char* a3 = a2 + kstep; const char* b3 = b2 + kstep;
            if (last && has_next) S.a_ready(nxt);
            if constexpr (SP2) {
            PG8_LDB(B0, 0, 0); PG8_LDB(B1, 0, 1); PG8_SCHED; PG8_LDA(At, 0, 0); PG8_STAGE(PG8_SA(1, 1), a1 + hstep, voffA);
            PG8_WAIT_V(8); PG8_WAIT_L(0); PG8_BAR; PG8_MMA(0, 0, At, B0); PG8_MMA(0, 1, At, B1); PG8_BAR; PG8_SCHED;
            PG8_LDA(At, 0, 1); PG8_STAGE(PG8_SB(0, 0), b2, voffB); PG8_STAGE(PG8_SB(0, 1), b2 + hstep, voffB); PG8_STAGE(PG8_SA(0, 0), a2, voffA);
            PG8_WAIT_V(8); PG8_WAIT_L(0); PG8_BAR; PG8_MMA(1, 0, At, B0); PG8_MMA(1, 1, At, B1); PG8_BAR; PG8_SCHED;
            PG8_LDB(B0, 1, 0); PG8_LDB(B1, 1, 1); PG8_SCHED; PG8_LDA(At, 1, 0); PG8_STAGE(PG8_SA(0, 1), a2 + hstep, voffA);
            PG8_WAIT_V(8); PG8_WAIT_L(0); PG8_BAR; PG8_MMA(0, 0, At, B0); PG8_MMA(0, 1, At, B1); PG8_BAR; PG8_SCHED;
            PG8_LDA(At, 1, 1); PG8_STAGE(PG8_SB(1, 0), b3, voffB); PG8_STAGE(PG8_SB(1, 1), b3 + hstep, voffB); PG8_STAGE(PG8_SA(1, 0), a3, voffA);
            PG8_WAIT_V(8); PG8_WAIT_L(0); PG8_BAR; PG8_MMA(1, 0, At, B0); PG8_MMA(1, 1, At, B1); PG8_BAR; PG8_SCHED;
            } else {
            PG8_LDB(B0, 0, 0); PG8_SCHED; PG8_LDA(At, 0, 0); PG8_STAGE(PG8_SA(1, 1), a1 + hstep, voffA);
            PG8_WAIT_L(8); PG8_BAR; PG8_WAIT_L(0); PG8_MMA(0, 0, At, B0); PG8_BAR; PG8_SCHED;
            PG8_LDB(B1, 0, 1); PG8_STAGE(PG8_SB(0, 0), b2, voffB);
            PG8_BAR; PG8_WAIT_L(0); PG8_MMA(0, 1, At, B1); PG8_BAR;
            PG8_LDA(At, 0, 1); PG8_STAGE(PG8_SA(0, 0), a2, voffA);
            PG8_BAR; PG8_WAIT_L(0); PG8_MMA(1, 0, At, B0); PG8_BAR; PG8_SCHED;
            PG8_STAGE(PG8_SB(0, 1), b2 + hstep, voffB);
            PG8_WAIT_V(6); PG8_BAR; PG8_MMA(1, 1, At, B1); PG8_BAR;
            PG8_LDB(B0, 1, 0); PG8_SCHED; PG8_LDA(At, 1, 0); PG8_STAGE(PG8_SA(0, 1), a2 + hstep, voffA);
            PG8_WAIT_L(8); PG8_BAR; PG8_WAIT_L(0); PG8_MMA(0, 0, At, B0); PG8_BAR; PG8_SCHED;
            PG8_LDB(B1, 1, 1); PG8_STAGE(PG8_SB(1, 0), b3, voffB);
            PG8_BAR; PG8_WAIT_L(0); PG8_MMA(0, 1, At, B1); PG8_BAR;
            PG8_LDA(At, 1, 1); PG8_STAGE(PG8_SA(1, 0), a3, voffA);
            PG8_BAR; PG8_WAIT_L(0); PG8_MMA(1, 0, At, B0); PG8_BAR; PG8_SCHED;
            PG8_STAGE(PG8_SB(1, 1), b3 + hstep, voffB);
            PG8_WAIT_V(6); PG8_BAR; PG8_MMA(1, 1, At, B1); PG8_BAR;
            }
        }
        if constexpr (ALIGN_EPI) { if (wr == 0) PG8_BAR; }
        if constexpr (!Epi::AFTER_DRAIN) { E(acc, cur, wr, wc, fr, fq); S.done(cur); }
        if (!has_next) break;
#pragma unroll
        for (int a = 0; a < 2; ++a)
#pragma unroll
            for (int b = 0; b < 2; ++b)
#pragma unroll
                for (int m = 0; m < 4; ++m)
#pragma unroll
                    for (int n = 0; n < 2; ++n) acc[a][b][m][n] = (f32x4){0.f, 0.f, 0.f, 0.f};
        cur = nxt; cA = nA; cB = nB; ++ui;
        if constexpr (ALIGN_EPI) { if (wr == 1) PG8_BAR; }
    }
    PG8_WAIT_V(0);
    if constexpr (!ALIGN_EPI) { if (wr == 0) PG8_BAR; }
    PG8_BAR;
    if constexpr (Epi::AFTER_DRAIN) { E.fused(acc, cur, wr, wc, fr, fq, lds, wid, lane); S.done(cur); }
#undef PG8_SA
#undef PG8_SB
#undef PG8_STAGE
#undef PG8_LDA
#undef PG8_LDB
#undef PG8_MMA
#undef PG8_WAIT_V
#undef PG8_WAIT_L
#undef PG8_BAR
#undef PG8_SCHED
}
}
#ifndef PG8_SP2
#define PG8_SP2 true
#endif
#ifndef PG8_ALIGN
#define PG8_ALIGN true
#endif
constexpr int NWAVES = 8;
#ifndef MK_N_LAUNCHES
#define MK_N_LAUNCHES 10
#endif
constexpr int N_PHASES = 10;
constexpr int N_LAUNCHES = MK_N_LAUNCHES;

constexpr int D = 4096, NB = 4, SEQ = 2048, M = NB * SEQ, CTXL = 256, MC = NB * CTXL, MT = M + MC;
constexpr int HD = 128, NAH = 16, NAW = 2048, CVW = 2048, INC = 12288, FF = 11008, NMODC = 6 * D;
constexpr int GRIDW = 64, ROWS = 32, NAKH = 8, NAKW = 16;
constexpr float EPS = 1e-6f, LOG2E = 1.44269504089f;
enum { I_X = 0, I_C, I_CTX, I_CCTX, I_ADAW, I_ADAB, I_N1G, I_WIN, I_CONVW, I_RPB, I_GNG, I_WOUT, I_N2G, I_WGU, I_WDN, I_FNG, N_IN };

constexpr size_t MiB = 1u << 20;
constexpr size_t WS_CTL = 0, WS_MOD = 1 * MiB, CTL_ZERO_BYTES = 2 * MiB;
constexpr size_t WS_ROPE = 2 * MiB;
constexpr size_t WS_WIN = 4 * MiB, WS_WOUT = 100 * MiB, WS_WGU = 132 * MiB, WS_WDN = 304 * MiB;
constexpr size_t WS_H = 390 * MiB;
constexpr size_t WS_Q = 462 * MiB;
constexpr size_t WS_K = 494 * MiB;
constexpr size_t WS_V = 530 * MiB;
constexpr size_t WS_C = 566 * MiB;
constexpr size_t WS_AO = 662 * MiB;
constexpr size_t WS_Y = 694 * MiB;
constexpr size_t WS_X1 = 758 * MiB;
constexpr size_t WS_ACT = 886 * MiB;
constexpr size_t WS_END = 1058 * MiB;
static_assert(WS_WIN + (size_t)INC * D * 2 <= WS_WOUT && WS_WOUT + (size_t)D * D * 2 <= WS_WGU && WS_WGU + (size_t)2 * FF * D * 2 <= WS_WDN && WS_WDN + (size_t)D * FF * 2 <= WS_H, "ws map (weights)");
static_assert(WS_H + (size_t)MT * D * 2 <= WS_Q && WS_Q + (size_t)M * NAW * 2 <= WS_K && WS_K + (size_t)MT * NAW * 2 <= WS_V && WS_V + (size_t)MT * NAW * 2 <= WS_C && WS_C + (size_t)M * 6144 * 2 <= WS_AO, "ws map (acts 1)");
static_assert(WS_AO + (size_t)M * NAW * 2 <= WS_Y && WS_Y + (size_t)M * D * 2 <= WS_X1 && WS_X1 + (size_t)M * D * 4 <= WS_ACT && WS_ACT + (size_t)M * FF * 2 <= WS_END, "ws map (acts 2)");
constexpr int CW_BAR = 4096;

constexpr int RING_OFF = 0, RING_BYTES = 131072;
constexpr int LDSCTL_OFF = RING_BYTES, MISC_OFF = LDSCTL_OFF + 320;
constexpr int LDS_BYTES = 147456;
static_assert(MISC_OFF + 128 <= LDS_BYTES, "LDS map");

#define GAS __attribute__((address_space(1)))
#define LAS __attribute__((address_space(3)))
typedef unsigned short bf16;
typedef unsigned v4u __attribute__((ext_vector_type(4)));
typedef float f32x4 __attribute__((ext_vector_type(4)));
typedef short bf16x8 __attribute__((ext_vector_type(8)));
typedef GAS unsigned gu32;
typedef GAS unsigned long long gu64;
#define RLX_AGENT __ATOMIC_RELAXED, __HIP_MEMORY_SCOPE_AGENT
#define LDS_WAIT() asm volatile("s_waitcnt lgkmcnt(0)" ::: "memory")
#define VM_WAIT() asm volatile("s_waitcnt vmcnt(0)" ::: "memory")
__device__ __forceinline__ unsigned long long rt() { return __builtin_amdgcn_s_memrealtime(); }
__device__ __forceinline__ unsigned f2bf(float f) { unsigned u = __builtin_bit_cast(unsigned, f); return (u + 0x7fffu + ((u >> 16) & 1u)) >> 16; }
__device__ __forceinline__ unsigned pk2(float lo, float hi) { return f2bf(lo) | (f2bf(hi) << 16); }

#define XB_TMO      128
#define XB_XCNT(j)  (256  + 64 * (j))
#define XB_XSUB(j)  (1280 + 64 * (j))
#define XB_XGEN(j)  (2304 + 64 * (j))
#define XB_TOP      3328
#define XB_TOPGEN   3392
#define XCD_BAR_WORDS 3456
#define XB_SPIN_CAP (1u << 18)

__device__ __forceinline__ unsigned xb_ld(unsigned* p)              { return __hip_atomic_load(p, __ATOMIC_RELAXED, __HIP_MEMORY_SCOPE_AGENT); }
__device__ __forceinline__ unsigned xb_add(unsigned* p, unsigned v) { return __hip_atomic_fetch_add(p, v, __ATOMIC_RELAXED, __HIP_MEMORY_SCOPE_AGENT); }
__device__ __forceinline__ unsigned xb_xcc_id() { return (unsigned)__builtin_amdgcn_s_getreg((3 << 11) | 20) & 0xFu; }
#define XB_SPIN(cond, bar) do { unsigned _sp = 0; while (cond) { __builtin_amdgcn_s_sleep(1); \
    if ((++_sp & 255u) == 0u) { if (xb_ld(&(bar)[XB_TMO])) break; if (_sp > XB_SPIN_CAP) { atomicAdd(&(bar)[XB_TMO], 1u); break; } } } } while (0)

struct XcdBarrier {
    unsigned* bar; unsigned x;
    volatile LAS unsigned* st;
};

__device__ __forceinline__ XcdBarrier xcd_barrier_post(unsigned* bar, volatile LAS unsigned* st) {
    XcdBarrier b; b.bar = bar; b.x = xb_xcc_id(); b.st = st;
    if (threadIdx.x == 0) (void)xb_add(&bar[XB_XCNT(b.x)], 1u);
    return b;
}
__device__ __forceinline__ void xcd_barrier_complete(unsigned* bar, unsigned x, unsigned& nloc, unsigned& nx) {
    const unsigned G = gridDim.x * gridDim.y * gridDim.z;
    unsigned sum, cnt, mine, sp = 0u;
    for (;;) {
        sum = 0u; cnt = 0u; mine = 0u;
#pragma unroll
        for (unsigned j = 0; j < 16; ++j) { const unsigned c = xb_ld(&bar[XB_XCNT(j)]); sum += c; cnt += (c > 0u) ? 1u : 0u; mine = (j == x) ? c : mine; }
        if (sum == G) break;
        __builtin_amdgcn_s_sleep(1);
        if ((++sp & 255u) == 0u) { if (xb_ld(&bar[XB_TMO])) break; if (sp > XB_SPIN_CAP) { atomicAdd(&bar[XB_TMO], 1u); break; } }
    }
    nloc = mine > 0u ? mine : 1u; nx = cnt > 0u ? cnt : 1u;
}

__device__ __forceinline__ void xcd_barrier(const XcdBarrier& b) {
    asm volatile("s_waitcnt vmcnt(0)" ::: "memory");
    __syncthreads();
    if (threadIdx.x == 0) {
        unsigned* bar = b.bar;
        __builtin_amdgcn_s_waitcnt(0);
        unsigned nloc = b.st[0], nx = b.st[1];
        if (nloc == 0u) { xcd_barrier_complete(bar, b.x, nloc, nx); b.st[0] = nloc; b.st[1] = nx; }
        const unsigned old = xb_add(&bar[XB_XSUB(b.x)], 1u);
        const unsigned gen = old / nloc;
        if (old + 1u == (gen + 1u) * nloc) {
            __builtin_amdgcn_fence(__ATOMIC_RELEASE, "agent");
            asm volatile("s_waitcnt vmcnt(0)" ::: "memory");
            const unsigned og = xb_add(&bar[XB_TOP], 1u);
            const unsigned tg = og / nx;
            if (og + 1u == (tg + 1u) * nx) xb_add(&bar[XB_TOPGEN], 1u);
            else XB_SPIN(xb_ld(&bar[XB_TOPGEN]) == tg, bar);
            __builtin_amdgcn_fence(__ATOMIC_ACQUIRE, "agent");
            xb_add(&bar[XB_XGEN(b.x)], 1u);
            asm volatile("s_waitcnt vmcnt(0)" ::: "memory");
        } else {
            XB_SPIN(xb_ld(&bar[XB_XGEN(b.x)]) == gen, bar);
            __builtin_amdgcn_fence(__ATOMIC_ACQUIRE, "agent");
            asm volatile("s_waitcnt vmcnt(0)" ::: "memory");
        }
    }
    __syncthreads();
}

typedef float f32x16 __attribute__((ext_vector_type(16)));
typedef unsigned v2u __attribute__((ext_vector_type(2)));
struct Frame {
    LAS unsigned char* lds;
    volatile LAS unsigned* MISC;
    gu32* ctl;
    int tid, lane, wave, vcu, G;
    const float* in[N_IN]; float* out;
    float* mod; float* rope;
    bf16 *Win_t, *Wout_t, *Wgu_t, *Wdn_t;
    bf16 *HB, *QB, *KB, *VB, *CB, *AO, *YB, *ACT; float* X1;
};
template <int CTRL> __device__ __forceinline__ float dpp_add(float v) { return v + __builtin_bit_cast(float, __builtin_amdgcn_update_dpp(0, __builtin_bit_cast(int, v), CTRL, 0xf, 0xf, true)); }
__device__ __forceinline__ float wave_sum(float v) {
    v = dpp_add<0xB1>(v); v = dpp_add<0x4E>(v); v = dpp_add<0x141>(v); v = dpp_add<0x140>(v);
    v += __builtin_bit_cast(float, __builtin_amdgcn_ds_swizzle(__builtin_bit_cast(int, v), 0x401F));
    return __builtin_bit_cast(float, __builtin_amdgcn_readlane(__builtin_bit_cast(int, v), 0)) + __builtin_bit_cast(float, __builtin_amdgcn_readlane(__builtin_bit_cast(int, v), 32));
}
__device__ __forceinline__ unsigned pkbf(float lo, float hi) { return pg8::pkbf(lo, hi); }
__device__ __forceinline__ float bflo(unsigned w) { return __builtin_bit_cast(float, w << 16); }
__device__ __forceinline__ float bfhi(unsigned w) { return __builtin_bit_cast(float, w & 0xffff0000u); }

__device__ __forceinline__ int map_in(int n) {
    if (n < 4096) { const int hd = n & ~127, d = n & 127, blk = d >> 6, e4 = (d >> 5) & 1, i = d & 31; return hd + 64 * blk + 8 * (i >> 2) + 4 * e4 + (i & 3); }
    return n;
}
__device__ __forceinline__ int map_gu(int n) { const int up = n >= FF ? 1 : 0, jx = up ? n - FF : n; return 256 * (jx >> 7) + 128 * up + (jx & 127); }
template <int MAP> __device__ __forceinline__ void p0_transpose_item(const float* W, int K, int N, bf16* WT, LAS float* scr, int item, int lane) {
    const int nblk = N / 32, kb = item / nblk, nb = item % nblk, k0 = 64 * kb, n0 = 32 * nb;
    const GAS float* Wg = (const GAS float*)W;
#pragma unroll 8
    for (int i = 0; i < 32; ++i) { const int kk = 2 * i + (lane >> 5); scr[kk * 33 + (lane & 31)] = Wg[(size_t)(k0 + kk) * N + n0 + (lane & 31)]; }
    LDS_WAIT(); asm volatile("" ::: "memory");
    const int c = lane & 7;
#pragma unroll
    for (int j = 0; j < 4; ++j) { const int n = (lane >> 3) + 8 * j; const LAS float* s = scr + (8 * c) * 33 + n;
        v4u o; o.x = pkbf(s[0 * 33], s[1 * 33]); o.y = pkbf(s[2 * 33], s[3 * 33]); o.z = pkbf(s[4 * 33], s[5 * 33]); o.w = pkbf(s[6 * 33], s[7 * 33]);
        const int nsrc = n0 + n, nd = MAP == 1 ? map_in(nsrc) : (MAP == 2 ? map_gu(nsrc) : nsrc);
        *(GAS v4u*)(WT + (size_t)nd * K + k0 + 8 * c) = o; }
    LDS_WAIT(); asm volatile("" ::: "memory");
}
__device__ __forceinline__ void p0_prologue(Frame& F) {
    { const int gi = blockIdx.x * (NWAVES * 64) + F.tid;
      if (gi < 2048) { const int pos = gi >> 5, i = gi & 31; const float fr = exp2f(-(float)i * (13.287712379549449f / 32.0f)); const float ang = (float)pos * fr;
          F.rope[gi] = cosf(ang); F.rope[2048 + gi] = sinf(ang); } }
    { LAS float* sil = (LAS float*)(F.lds + RING_OFF);
      LAS float* red = (LAS float*)(F.lds + RING_OFF + 16384);
      const GAS float* aw = (const GAS float*)F.in[I_ADAW];
      for (int it = blockIdx.x; it < 768; it += F.G) {
          const int cs = it % 96, ks = it / 96, k0 = 512 * ks;
          for (int idx = F.tid; idx < 5 * 512; idx += NWAVES * 64) { const int bb = idx >> 9, kk = idx & 511;
              const float v = bb < 4 ? F.in[I_C][bb * D + k0 + kk] : F.in[I_CCTX][k0 + kk]; sil[idx] = v / (1.0f + __expf(-v)); }
          __syncthreads();
          f32x4 a0 = {0.f, 0.f, 0.f, 0.f}, a1 = a0, a2 = a0, a3 = a0, a4 = a0;
          const GAS float* wp = aw + (size_t)(k0 + F.wave) * NMODC + 256 * cs + 4 * F.lane;
#pragma unroll 8
          for (int i = 0; i < 64; ++i) { const f32x4 w = *(const GAS f32x4*)(wp + (size_t)(8 * i) * NMODC); const int k = F.wave + 8 * i;
              a0 += sil[k] * w; a1 += sil[512 + k] * w; a2 += sil[1024 + k] * w; a3 += sil[1536 + k] * w; a4 += sil[2048 + k] * w; }
          LAS f32x4* rw = (LAS f32x4*)(red + F.wave * 1280) + F.lane;
          rw[0] = a0; rw[64] = a1; rw[128] = a2; rw[192] = a3; rw[256] = a4;
          __syncthreads();
          for (int idx = F.tid; idx < 1280; idx += NWAVES * 64) { float s = 0.f;
#pragma unroll
              for (int w = 0; w < 8; ++w) s += red[w * 1280 + idx];
              const int bb = idx >> 8, cc = idx & 255, n = 256 * cs + cc;
              if (ks == 0) s += F.in[I_ADAB][n];
              atomicAdd(F.mod + bb * NMODC + n, s); }
          __syncthreads();
      } }
    LAS float* scr = (LAS float*)(F.lds + RING_OFF + F.wave * 16384);
    const int gw = F.vcu * NWAVES + F.wave, NGW = F.G * NWAVES;
    constexpr int IT_IN = (D / 64) * (INC / 32), IT_OUT = (D / 64) * (D / 32), IT_GU = (D / 64) * (2 * FF / 32), IT_DN = (FF / 64) * (D / 32);
    for (int it = gw; it < IT_IN; it += NGW) p0_transpose_item<1>(F.in[I_WIN], D, INC, F.Win_t, scr, it, F.lane);
    for (int it = gw; it < IT_OUT; it += NGW) p0_transpose_item<0>(F.in[I_WOUT], D, D, F.Wout_t, scr, it, F.lane);
    for (int it = gw; it < IT_GU; it += NGW) p0_transpose_item<2>(F.in[I_WGU], D, 2 * FF, F.Wgu_t, scr, it, F.lane);
    for (int it = gw; it < IT_DN; it += NGW) p0_transpose_item<0>(F.in[I_WDN], FF, D, F.Wdn_t, scr, it, F.lane);
}

__device__ __forceinline__ void norm_mod_row(const float* xrow, bf16* orow, const float* gain, const float* shift, const float* scale, int lane) {
    const GAS f32x4* xr = (const GAS f32x4*)xrow + lane;
    f32x4 v[16]; float ss = 0.f;
#pragma unroll
    for (int j = 0; j < 16; ++j) { v[j] = xr[64 * j]; ss += (v[j].x * v[j].x + v[j].y * v[j].y) + (v[j].z * v[j].z + v[j].w * v[j].w); }
    const float rstd = 1.0f / sqrtf(wave_sum(ss) * (1.0f / D) + EPS);
    const GAS f32x4* g4 = (const GAS f32x4*)gain + lane; const GAS f32x4* sh4 = (const GAS f32x4*)shift + lane; const GAS f32x4* sc4 = (const GAS f32x4*)scale + lane;
    GAS v2u* o8 = (GAS v2u*)orow + lane;
#pragma unroll
    for (int j = 0; j < 16; ++j) { const f32x4 g = g4[64 * j], sh = sh4[64 * j], sc = sc4[64 * j];
        const f32x4 y = v[j] * rstd * g * (1.0f + sc) + sh; v2u w; w.x = pkbf(y.x, y.y); w.y = pkbf(y.z, y.w); o8[64 * j] = w; }
}

#define MFMA32(a, b, c) __builtin_amdgcn_mfma_f32_32x32x16_bf16((a), (b), (c), 0, 0, 0)
__device__ __forceinline__ void attn_unit(const bf16* Qb, const bf16* Kb, const bf16* Vb, bf16* AO, const LAS float* rp, int b, int h, int r, int qblk, int lane) {
    const int j = lane & 31, g = lane >> 5;
    const int kap = (j & 19) | ((j & 4) << 1) | ((j & 8) >> 1);
    const size_t qtok = (size_t)b * SEQ + r * GRIDW + 32 * qblk + j;
    const GAS bf16x8* qp = (const GAS bf16x8*)(Qb + qtok * NAW + HD * h + 8 * g);
    bf16x8 qf[8];
#pragma unroll
    for (int kd = 0; kd < 8; ++kd) qf[kd] = qp[2 * kd];
    f32x16 o0, o1, o2, o3;
#pragma unroll
    for (int v = 0; v < 16; ++v) { o0[v] = 0.f; o1[v] = 0.f; o2[v] = 0.f; o3[v] = 0.f; }
    float m_run = -__builtin_inff(), l_run = 0.f;
    const int rs = min(max(r - NAKH / 2, 0), ROWS - NAKH);
    const int qc = 32 * qblk + j, cs = min(max(qc - NAKW / 2, 0), GRIDW - NAKW);
    for (int tile = 0; tile < 24; ++tile) {
        const bool lat = tile >= 8; const int lt = tile - 8, kr = rs + (lt >> 1), kblk = lt & 1;
        const int keybase = lat ? (b * SEQ + kr * GRIDW + 32 * kblk) : (M + b * CTXL + 32 * tile);
        const GAS bf16x8* kp = (const GAS bf16x8*)(Kb + (size_t)(keybase + kap) * NAW + HD * h + 8 * g);
        bf16x8 kf[8];
#pragma unroll
        for (int kd = 0; kd < 8; ++kd) kf[kd] = kp[2 * kd];
        const GAS v2u* vp = (const GAS v2u*)(Vb + (size_t)(keybase + 8 * g) * NAW + HD * h + 4 * j);
        v2u w0[8], w1[8];
#pragma unroll
        for (int jj = 0; jj < 8; ++jj) { w0[jj] = vp[(size_t)jj * (NAW / 4)]; w1[jj] = vp[(size_t)(16 + jj) * (NAW / 4)]; }
        f32x16 s;
#pragma unroll
        for (int v = 0; v < 16; ++v) s[v] = 0.f;
#pragma unroll
        for (int kd = 0; kd < 8; ++kd) s = MFMA32(kf[kd], qf[kd], s);
        if (lat) {
            const LAS float* brow = rp + (h * 15 + (kr - r + NAKH - 1)) * 31;
#pragma unroll
            for (int v = 0; v < 16; ++v) { const int kc = 32 * kblk + (v & 7) + 8 * g + 16 * (v >> 3), rel = kc - qc + NAKW - 1;
                const bool valid = (kc >= cs) && (kc < cs + NAKW); const float bias = brow[min(max(rel, 0), 30)];
                s[v] = valid ? s[v] + bias : -__builtin_inff(); }
        }
        float mx = s[0];
#pragma unroll
        for (int v = 1; v < 16; ++v) mx = fmaxf(mx, s[v]);
        mx = fmaxf(mx, __shfl_xor(mx, 32));
        const float m_new = fmaxf(m_run, mx);
        const float alpha = __builtin_amdgcn_exp2f(m_run - m_new);
        float ps = 0.f;
#pragma unroll
        for (int v = 0; v < 16; ++v) { s[v] = __builtin_amdgcn_exp2f(s[v] - m_new); ps += s[v]; }
        l_run = l_run * alpha + ps; m_run = m_new;
#pragma unroll
        for (int v = 0; v < 16; ++v) { o0[v] *= alpha; o1[v] *= alpha; o2[v] *= alpha; o3[v] *= alpha; }
        bf16x8 pf0, pf1;
        { v4u t0, t1; t0.x = pkbf(s[0], s[1]); t0.y = pkbf(s[2], s[3]); t0.z = pkbf(s[4], s[5]); t0.w = pkbf(s[6], s[7]);
          t1.x = pkbf(s[8], s[9]); t1.y = pkbf(s[10], s[11]); t1.z = pkbf(s[12], s[13]); t1.w = pkbf(s[14], s[15]);
          pf0 = __builtin_bit_cast(bf16x8, t0); pf1 = __builtin_bit_cast(bf16x8, t1); }
#define VFRAG(W, SEL, XY) ({ v4u _t; _t.x = __builtin_amdgcn_perm(W[1].XY, W[0].XY, SEL); _t.y = __builtin_amdgcn_perm(W[3].XY, W[2].XY, SEL); \
        _t.z = __builtin_amdgcn_perm(W[5].XY, W[4].XY, SEL); _t.w = __builtin_amdgcn_perm(W[7].XY, W[6].XY, SEL); __builtin_bit_cast(bf16x8, _t); })
        o0 = MFMA32(VFRAG(w0, 0x05040100u, x), pf0, o0); o1 = MFMA32(VFRAG(w0, 0x07060302u, x), pf0, o1);
        o2 = MFMA32(VFRAG(w0, 0x05040100u, y), pf0, o2); o3 = MFMA32(VFRAG(w0, 0x07060302u, y), pf0, o3);
        o0 = MFMA32(VFRAG(w1, 0x05040100u, x), pf1, o0); o1 = MFMA32(VFRAG(w1, 0x07060302u, x), pf1, o1);
        o2 = MFMA32(VFRAG(w1, 0x05040100u, y), pf1, o2); o3 = MFMA32(VFRAG(w1, 0x07060302u, y), pf1, o3);
#undef VFRAG
    }
    const float l = l_run + __shfl_xor(l_run, 32), inv = 1.0f / l;
    GAS v2u* op = (GAS v2u*)(AO + qtok * NAW + HD * h);
#pragma unroll
    for (int v = 0; v < 16; ++v) { const int i = (v & 3) + 8 * (v >> 2) + 4 * g;
        v2u w; w.x = pkbf(o0[v] * inv, o1[v] * inv); w.y = pkbf(o2[v] * inv, o3[v] * inv); op[i] = w; }
}
__device__ __forceinline__ void attn_phase(Frame& F) {
    LAS float* rp = (LAS float*)(F.lds + RING_OFF);
    for (int i = F.tid; i < NAH * 15 * 31; i += NWAVES * 64) rp[i] = F.in[I_RPB][i] * LOG2E;
    __syncthreads();
    for (int wu = F.vcu; wu < NB * NAH * 8; wu += F.G) { const int bh = wu >> 3, rg = wu & 7;
        attn_unit(F.QB, F.KB, F.VB, F.AO, rp, bh >> 4, bh & 15, rg * 4 + (F.wave >> 1), F.wave & 1, F.lane); }
}

__device__ __forceinline__ void mix_row(Frame& F, int row) {
    unsigned lane = (unsigned)F.lane; const int t = row & (SEQ - 1);
    const GAS char* gg = (const GAS char*)F.in[I_GNG];
    asm volatile("" : "+v"(lane) :: "memory");
    { const GAS char* ap = (const GAS char*)(F.AO + (size_t)row * NAW); v4u a[4]; float ss = 0.f;
#pragma unroll
      for (int q = 0; q < 4; ++q) { a[q] = *(const GAS v4u*)(ap + (lane * 16u + q * 1024u));
#pragma unroll
          for (int e = 0; e < 4; ++e) { const float lo = bflo(a[q][e]), hi = bfhi(a[q][e]); ss += lo * lo + hi * hi; } }
      const float rstd = 1.0f / sqrtf(wave_sum(ss) * (1.0f / NAW) + EPS);
      GAS char* yp = (GAS char*)(F.YB + (size_t)row * D);
#pragma unroll
      for (int q = 0; q < 4; ++q) { const f32x4 g0 = *(const GAS f32x4*)(gg + (lane * 32u + q * 2048u)), g1 = *(const GAS f32x4*)(gg + (lane * 32u + q * 2048u + 16u)); v4u w;
          w.x = pkbf(bflo(a[q].x) * rstd * g0.x, bfhi(a[q].x) * rstd * g0.y); w.y = pkbf(bflo(a[q].y) * rstd * g0.z, bfhi(a[q].y) * rstd * g0.w);
          w.z = pkbf(bflo(a[q].z) * rstd * g1.x, bfhi(a[q].z) * rstd * g1.y); w.w = pkbf(bflo(a[q].w) * rstd * g1.z, bfhi(a[q].w) * rstd * g1.w);
          *(GAS v4u*)(yp + (lane * 16u + q * 1024u)) = w; } }
    { const GAS char* cw = (const GAS char*)F.in[I_CONVW];
      const GAS char* r0 = (const GAS char*)(F.CB + (size_t)row * 6144);
      const GAS char* rm = t > 0 ? r0 - 12288 : r0; const GAS char* rp = t < SEQ - 1 ? r0 + 12288 : r0;
      const float fm = t > 0 ? 1.f : 0.f, fp = t < SEQ - 1 ? 1.f : 0.f;
      float co[4][8]; float ss = 0.f;
#pragma unroll
      for (int q = 0; q < 4; ++q) { const unsigned vo = lane * 16u + q * 1024u, wo = lane * 32u + q * 2048u;
          if (q == 2) __builtin_amdgcn_sched_barrier(0);
          const v4u u0 = *(const GAS v4u*)(r0 + vo), gb = *(const GAS v4u*)(r0 + (vo + 4096u)), c0v = *(const GAS v4u*)(r0 + (vo + 8192u));
          const v4u um = *(const GAS v4u*)(rm + vo), cm = *(const GAS v4u*)(rm + (vo + 8192u)), upl = *(const GAS v4u*)(rp + vo), cpl = *(const GAS v4u*)(rp + (vo + 8192u));
          const f32x4 wa0 = *(const GAS f32x4*)(cw + wo), wa1 = *(const GAS f32x4*)(cw + (wo + 16u)), wb0 = *(const GAS f32x4*)(cw + (wo + 8192u)), wb1 = *(const GAS f32x4*)(cw + (wo + 8208u)),
                      wc0 = *(const GAS f32x4*)(cw + (wo + 16384u)), wc1 = *(const GAS f32x4*)(cw + (wo + 16400u));
#pragma unroll
          for (int e = 0; e < 4; ++e) {
              const float k0l = (e < 2 ? wa0[(2 * e) & 3] : wa1[(2 * e) & 3]) * fm, k0h = (e < 2 ? wa0[(2 * e + 1) & 3] : wa1[(2 * e + 1) & 3]) * fm;
              const float k1l = e < 2 ? wb0[(2 * e) & 3] : wb1[(2 * e) & 3], k1h = e < 2 ? wb0[(2 * e + 1) & 3] : wb1[(2 * e + 1) & 3];
              const float k2l = (e < 2 ? wc0[(2 * e) & 3] : wc1[(2 * e) & 3]) * fp, k2h = (e < 2 ? wc0[(2 * e + 1) & 3] : wc1[(2 * e + 1) & 3]) * fp;
              const float vl = bflo(gb[e]) * (k0l * (bflo(cm[e]) * bflo(um[e])) + k1l * (bflo(c0v[e]) * bflo(u0[e])) + k2l * (bflo(cpl[e]) * bflo(upl[e])));
              const float vh = bfhi(gb[e]) * (k0h * (bfhi(cm[e]) * bfhi(um[e])) + k1h * (bfhi(c0v[e]) * bfhi(u0[e])) + k2h * (bfhi(cpl[e]) * bfhi(upl[e])));
              co[q][2 * e] = vl; co[q][2 * e + 1] = vh; ss += vl * vl + vh * vh; } }
      const float rstd = 1.0f / sqrtf(wave_sum(ss) * (1.0f / CVW) + EPS);
      GAS char* yp = (GAS char*)(F.YB + (size_t)row * D + NAW);
#pragma unroll
      for (int q = 0; q < 4; ++q) { const unsigned wo = lane * 32u + q * 2048u; const f32x4 g0 = *(const GAS f32x4*)(gg + (8192u + wo)), g1 = *(const GAS f32x4*)(gg + (8192u + 16u + wo)); v4u w;
          w.x = pkbf(co[q][0] * rstd * g0.x, co[q][1] * rstd * g0.y); w.y = pkbf(co[q][2] * rstd * g0.z, co[q][3] * rstd * g0.w);
          w.z = pkbf(co[q][4] * rstd * g1.x, co[q][5] * rstd * g1.y); w.w = pkbf(co[q][6] * rstd * g1.z, co[q][7] * rstd * g1.w);
          *(GAS v4u*)(yp + (lane * 16u + q * 1024u)) = w; } }
}
__device__ __forceinline__ void final_norm_row(float* xrow, const float* gain, int lane) {
    GAS f32x4* xr = (GAS f32x4*)xrow + lane; const GAS f32x4* g4 = (const GAS f32x4*)gain + lane;
    f32x4 v[16]; float ss = 0.f;
#pragma unroll
    for (int j = 0; j < 16; ++j) { v[j] = xr[64 * j]; ss += (v[j].x * v[j].x + v[j].y * v[j].y) + (v[j].z * v[j].z + v[j].w * v[j].w); }
    const float rstd = 1.0f / sqrtf(wave_sum(ss) * (1.0f / D) + EPS);
#pragma unroll
    for (int j = 0; j < 16; ++j) xr[64 * j] = v[j] * rstd * g4[64 * j];
}

struct Args { const float* in[N_IN]; float* out; unsigned char* ws; int ph_lo, ph_hi; };
__global__ void __launch_bounds__(NWAVES * 64, 2) fwd_kernel(Args args) {
    extern __shared__ __attribute__((aligned(16))) unsigned char lds[];
    Frame F;
    F.lds = (LAS unsigned char*)lds;
    F.MISC = (volatile LAS unsigned*)(F.lds + MISC_OFF);
    F.tid = threadIdx.x; F.lane = F.tid & 63; F.wave = __builtin_amdgcn_readfirstlane(F.tid >> 6);
    F.G = gridDim.x; { const int bx = blockIdx.x; F.vcu = (F.G % 8 == 0) ? (bx % 8) * (F.G / 8) + bx / 8 : bx; }
    unsigned char* ws = args.ws;
    F.ctl = (gu32*)(ws + WS_CTL);
#pragma unroll
    for (int i = 0; i < N_IN; ++i) F.in[i] = args.in[i];
    F.out = args.out; F.mod = (float*)(ws + WS_MOD); F.rope = (float*)(ws + WS_ROPE);
    F.Win_t = (bf16*)(ws + WS_WIN); F.Wout_t = (bf16*)(ws + WS_WOUT); F.Wgu_t = (bf16*)(ws + WS_WGU); F.Wdn_t = (bf16*)(ws + WS_WDN);
    F.HB = (bf16*)(ws + WS_H); F.QB = (bf16*)(ws + WS_Q); F.KB = (bf16*)(ws + WS_K); F.VB = (bf16*)(ws + WS_V); F.CB = (bf16*)(ws + WS_C);
    F.AO = (bf16*)(ws + WS_AO); F.YB = (bf16*)(ws + WS_Y); F.ACT = (bf16*)(ws + WS_ACT); F.X1 = (float*)(ws + WS_X1);
    for (int u = F.tid; u < (LDS_BYTES - LDSCTL_OFF) / 4; u += NWAVES * 64) ((LAS unsigned*)(F.lds + LDSCTL_OFF))[u] = 0u;
    __syncthreads();
    XcdBarrier bar; bar.bar = (unsigned*)(F.ctl + CW_BAR); bar.x = 0; bar.st = nullptr;
    if (N_LAUNCHES == 1) bar = xcd_barrier_post((unsigned*)(F.ctl + CW_BAR), F.MISC + 8);
    const int lo = args.ph_lo, hi = args.ph_hi;
#define IN(k) (lo <= (k) && (k) < hi)
#define SEAM(k) do { if (IN(k) && IN((k) + 1)) xcd_barrier(bar); } while (0)
    const int gw = F.vcu * NWAVES + F.wave, NGW = F.G * NWAVES;

    if (IN(0)) { p0_prologue(F); SEAM(0); }
    if (IN(1)) {
        for (int m = gw; m < MT; m += NGW) {
            const bool isctx = m >= M; const float* xrow = isctx ? F.in[I_CTX] + (size_t)(m - M) * D : F.in[I_X] + (size_t)m * D;
            const float* mrow = F.mod + (size_t)(isctx ? 4 : (m >> 11)) * NMODC;
            norm_mod_row(xrow, F.HB + (size_t)m * D, F.in[I_N1G], mrow, mrow + D, F.lane); }
        SEAM(1);
    }
    if (IN(2)) {
        pg8::Gemm g{F.HB, F.Win_t, MT, INC, D}; pg8::InOrder S; S.init(F.G, (int)blockIdx.x);
        pg8::EpiIn E{F.QB, F.KB, F.VB, F.CB, F.rope, 0.08838834764831845f * LOG2E};
        pg8::gemm_phase<pg8::EpiIn, pg8::InOrder, PG8_ALIGN, PG8_SP2>(F.lds + RING_OFF, g, S, E);
        SEAM(2);
    }
    if (IN(3)) { attn_phase(F); SEAM(3); }
    if (IN(4)) { for (int m = gw; m < M; m += NGW) mix_row(F, m); SEAM(4); }
    if (IN(5)) {
        pg8::Gemm g{F.YB, F.Wout_t, M, D, D}; pg8::StaticOrder S; S.init(M, D, F.G, (int)blockIdx.x);
        pg8::EpiRes E{F.in[I_X], F.X1, D, F.mod + 2 * D};
        pg8::gemm_phase<pg8::EpiRes, pg8::StaticOrder, PG8_ALIGN, PG8_SP2>(F.lds + RING_OFF, g, S, E);
        SEAM(5);
    }
    if (IN(6)) {
        for (int m = gw; m < M; m += NGW) { const float* mrow = F.mod + (size_t)(m >> 11) * NMODC;
            norm_mod_row(F.X1 + (size_t)m * D, F.HB + (size_t)m * D, F.in[I_N2G], mrow + 3 * D, mrow + 4 * D, F.lane); }
        SEAM(6);
    }
    if (IN(7)) {
        pg8::Gemm g{F.HB, F.Wgu_t, M, 2 * FF, D}; pg8::StaticOrder S; S.init(M, 2 * FF, F.G, (int)blockIdx.x);
        pg8::EpiSwiglu E{F.ACT, FF};
        pg8::gemm_phase<pg8::EpiSwiglu, pg8::StaticOrder, PG8_ALIGN, PG8_SP2>(F.lds + RING_OFF, g, S, E);
        SEAM(7);
    }
    if (IN(8)) {
        pg8::Gemm g{F.ACT, F.Wdn_t, M, D, FF}; pg8::StaticOrder S; S.init(M, D, F.G, (int)blockIdx.x);
        pg8::EpiRes E{F.X1, F.out, D, F.mod + 5 * D};
        pg8::gemm_phase<pg8::EpiRes, pg8::StaticOrder, PG8_ALIGN, PG8_SP2>(F.lds + RING_OFF, g, S, E);
        SEAM(8);
    }
    if (IN(9)) { for (int m = gw; m < M; m += NGW) final_norm_row(F.out + (size_t)m * D, F.in[I_FNG], F.lane); }
#undef IN
#undef SEAM
}

extern "C" void kernel_launch(void* const* d_in, const int* in_sizes, int n_in, void* d_out, int out_size, void* d_ws, size_t ws_size, hipStream_t stream) {
    static int grid = 0;
    if (grid == 0) {
        if (n_in != N_IN || in_sizes[I_X] != M * D || out_size != M * D || ws_size < WS_END) { fprintf(stderr, "kernel_launch: shape / workspace mismatch (n_in %d, x %d, out %d, ws %zu); nothing launched\n", n_in, n_in > 0 ? in_sizes[0] : -1, out_size, ws_size); grid = -1; return; }
        int dev = 0, cus = 0, per_cu = 0;
        if (hipGetDevice(&dev) != hipSuccess || hipDeviceGetAttribute(&cus, hipDeviceAttributeMultiprocessorCount, dev) != hipSuccess) { fprintf(stderr, "kernel_launch: device query failed\n"); grid = -1; return; }
        if (hipFuncSetAttribute((const void*)fwd_kernel, hipFuncAttributeMaxDynamicSharedMemorySize, LDS_BYTES) != hipSuccess) { fprintf(stderr, "kernel_launch: hipFuncSetAttribute failed\n"); grid = -1; return; }
        if (hipOccupancyMaxActiveBlocksPerMultiprocessor(&per_cu, (const void*)fwd_kernel, NWAVES * 64, LDS_BYTES) != hipSuccess || per_cu < 1)
            fprintf(stderr, "kernel_launch: note: occupancy query reports %d workgroups per CU\n", per_cu);
        (void)hipGetLastError();
        grid = cus;
    }
    if (grid < 0) return;
    if (hipMemsetAsync((char*)d_ws + WS_CTL, 0, CTL_ZERO_BYTES, stream) != hipSuccess) { fprintf(stderr, "kernel_launch: memset failed\n"); return; }
    Args a{};
    for (int i = 0; i < N_IN; ++i) a.in[i] = (const float*)d_in[i];
    a.out = (float*)d_out; a.ws = (unsigned char*)d_ws;
    for (int li = 0; li < N_LAUNCHES; ++li) {
        a.ph_lo = (N_LAUNCHES == 1) ? 0 : li; a.ph_hi = (N_LAUNCHES == 1) ? N_PHASES : li + 1;
        hipLaunchKernelGGL(fwd_kernel, dim3(grid), dim3(NWAVES * 64), LDS_BYTES, stream, a);
        const hipError_t le = hipPeekAtLastError();
        if (le != hipSuccess) { fprintf(stderr, "kernel_launch: launch %d failed: %s\n", li, hipGetErrorName(le)); break; }
    }
}
```

```cpp
#include <hip/hip_runtime.h>
#include <cstdio>
#include <cstdint>
namespace pg8 {
#define PG8_LAS __attribute__((address_space(3)))
typedef unsigned short bf16_t;
typedef short bf16x8 __attribute__((ext_vector_type(8)));
typedef float f32x4 __attribute__((ext_vector_type(4)));
typedef unsigned u32x4 __attribute__((ext_vector_type(4)));
constexpr int BM = 256, BK = 64, HALF = 128, HTB = HALF * BK * 2  , STAGE_BYTES = 8 * HTB, NXCD = 8, WGM = 8;

__host__ __device__ __forceinline__ int lds_byte(int r, int c) { const int st = (r >> 4) * 2 + (c >> 5), rr = r & 15, cc = c & 31, ob = rr * 64 + cc * 2; return st * 1024 + (ob ^ (((ob >> 9) & 1) << 5)); }
__host__ __device__ __forceinline__ void stage_rc(int b, int& R, int& C) { const int st = b / 1024, sb = b % 1024, swz = sb ^ (((sb >> 9) & 1) << 5); R = (st >> 1) * 16 + swz / 64; C = (st & 1) * 32 + (swz % 64) / 2; }
__host__ __device__ __forceinline__ int perm32(int rho) { const int n = rho >> 4, i = rho & 15; return 8 * (i >> 2) + 4 * n + (i & 3); }

struct Unit { int pm, pn; };
struct Gemm { const bf16_t* A; const bf16_t* Bt; int M, N, K; };

struct StaticOrder {
    int nM, nN, nwg, G, c;
    __host__ __device__ void init(int M, int N, int G_, int c_) { nM = M / BM; nN = N / BM; nwg = nM * nN; G = G_; c = c_; }
    __host__ __device__ bool next(int i, Unit& u) const {
        const long L = (long)i * G + c; if (L >= nwg) return false;
        int wgid = (int)L; { const int q = nwg / NXCD, r = nwg % NXCD, xcd = wgid % NXCD, off = wgid / NXCD; wgid = (xcd < r ? xcd * (q + 1) : r * (q + 1) + (xcd - r) * q) + off; }
        const int nig = WGM * nN, gid = wgid / nig, fm = gid * WGM, gsz = (nM - fm) < WGM ? (nM - fm) : WGM;
        u.pm = fm + ((wgid % nig) % gsz); u.pn = (wgid % nig) / gsz; return true;
    }
    __device__ __forceinline__ void a_ready(const Unit&) const {}
    __device__ __forceinline__ void done(const Unit&) const {}
};

__device__ __forceinline__ unsigned cvt_pk_bf16(float lo, float hi) { unsigned r; asm volatile("v_cvt_pk_bf16_f32 %0, %1, %2" : "=v"(r) : "v"(lo), "v"(hi)); return r; }
typedef float f32x2 __attribute__((ext_vector_type(2)));
typedef __bf16 bf16v2 __attribute__((ext_vector_type(2)));
__device__ __forceinline__ unsigned pkbf(float lo, float hi) { f32x2 v = {lo, hi}; bf16v2 r = __builtin_convertvector(v, bf16v2); return __builtin_bit_cast(unsigned, r); }

struct EpiIn {
    static constexpr bool PERM = true, AFTER_DRAIN = false;
    bf16_t *Q, *Kd, *Vd, *Cd; const float* rope; float qscale;
    __device__ __forceinline__ void operator()(const f32x4 (&acc)[2][2][4][2], const Unit& u, int wr, int wc, int fr, int fq) const {
        const int reg = u.pn >> 3;
        bf16_t* base; int ldc, colt; bool rot = false; float sc = 1.f;
        if (reg == 0) { base = Q; ldc = 2048; colt = u.pn * BM; rot = true; sc = qscale; }
        else if (reg == 1) { base = Kd; ldc = 2048; colt = (u.pn - 8) * BM; rot = (u.pm < 32); }
        else if (reg == 2) { base = Vd; ldc = 2048; colt = (u.pn - 16) * BM; }
        else { base = Cd; ldc = 6144; colt = (u.pn - 24) * BM; }
        const int row0 = u.pm * BM + wr * 64 + fr, col0 = colt + wc * 32 + 8 * fq;
        const int blk = wc >> 1, i0 = 4 * ((4 * wc + fq) & 7);
#pragma unroll
        for (int ai = 0; ai < 2; ++ai)
#pragma unroll
            for (int m = 0; m < 4; ++m) { const int r = row0 + ai * HALF + m * 16; bf16_t* rowp = base + (size_t)r * ldc + col0;
                f32x4 cs4 = {1.f, 1.f, 1.f, 1.f}, sn4 = {0.f, 0.f, 0.f, 0.f};
                if (rot) { const int t = r & 2047, pos = blk ? (t & 63) : (t >> 6); cs4 = *(const f32x4*)(rope + pos * 32 + i0); sn4 = *(const f32x4*)(rope + 2048 + pos * 32 + i0); }
#pragma unroll
                for (int bj = 0; bj < 2; ++bj) { const f32x4 a = acc[ai][bj][m][0], b = acc[ai][bj][m][1];
                    const f32x4 v0 = (a * cs4 - b * sn4) * sc, v1 = (a * sn4 + b * cs4) * sc;
                    u32x4 w; w.x = pkbf(v0[0], v0[1]); w.y = pkbf(v0[2], v0[3]); w.z = pkbf(v1[0], v1[1]); w.w = pkbf(v1[2], v1[3]);
                    *(u32x4*)(rowp + bj * HALF) = w; } }
    }
};
struct EpiRes {
    static constexpr bool PERM = false, AFTER_DRAIN = false;
    const float* resid; float* out; int ldc; const float* gate;
    __device__ __forceinline__ void operator()(const f32x4 (&acc)[2][2][4][2], const Unit& u, int wr, int wc, int fr, int fq) const {
        const int row0 = u.pm * BM + wr * 64 + fr, col0 = u.pn * BM + wc * 32 + 4 * fq;
        const float* gp = gate + (size_t)(u.pm >> 3) * 24576 + col0;
        f32x4 gv[2][2];
#pragma unroll
        for (int bj = 0; bj < 2; ++bj)
#pragma unroll
            for (int n = 0; n < 2; ++n) gv[bj][n] = *(const f32x4*)(gp + bj * HALF + n * 16);
#pragma unroll
        for (int ai = 0; ai < 2; ++ai)
#pragma unroll
            for (int m = 0; m < 4; ++m) { const size_t off = (size_t)(row0 + ai * HALF + m * 16) * ldc + col0;
#pragma unroll
                for (int bj = 0; bj < 2; ++bj)
#pragma unroll
                    for (int n = 0; n < 2; ++n) { const f32x4 rs = *(const f32x4*)(resid + off + bj * HALF + n * 16);
                        *(f32x4*)(out + off + bj * HALF + n * 16) = rs + gv[bj][n] * acc[ai][bj][m][n]; }
                asm volatile("" ::: "memory"); }
    }
};
struct EpiSwiglu {
    static constexpr bool PERM = true, AFTER_DRAIN = false;
    bf16_t* O; int ldc;
    __device__ __forceinline__ void operator()(const f32x4 (&acc)[2][2][4][2], const Unit& u, int wr, int wc, int fr, int fq) const {
        const int row0 = u.pm * BM + wr * 64 + fr, col0 = u.pn * HALF + wc * 32 + 8 * fq;
#pragma unroll
        for (int ai = 0; ai < 2; ++ai)
#pragma unroll
            for (int m = 0; m < 4; ++m) { bf16_t* rowp = O + (size_t)(row0 + ai * HALF + m * 16) * ldc + col0;
                float o[8];
#pragma unroll
                for (int n = 0; n < 2; ++n)
#pragma unroll
                    for (int j = 0; j < 4; ++j) { const float gt = acc[ai][0][m][n][j], up = acc[ai][1][m][n][j];
                        o[4 * n + j] = gt * __builtin_amdgcn_rcpf(1.0f + __builtin_amdgcn_exp2f(-1.44269504089f * gt)) * up; }
                u32x4 w; w.x = pkbf(o[0], o[1]); w.y = pkbf(o[2], o[3]); w.z = pkbf(o[4], o[5]); w.w = pkbf(o[6], o[7]);
                *(u32x4*)rowp = w; }
    }
};
struct InOrder {
    StaticOrder so; int G, c;
    __host__ __device__ void init(int G_, int c_) { so.init(8192, 12288, G_, c_); G = G_; c = c_; }
    __host__ __device__ bool next(int i, Unit& u) const {
        const long L = (long)i * G + c; if (L >= 1600) return false;
        if (L < 1536) return so.next(i, u);
        const int e = (int)L - 1536; u.pm = 32 + (e & 3); u.pn = 8 + (e >> 2); return true;
    }
    __device__ __forceinline__ void a_ready(const Unit&) const {}
    __device__ __forceinline__ void done(const Unit&) const {}
};
template <class Epi, class Sched, bool ALIGN_EPI = false, bool SP2 = false>
__device__ __forceinline__ void gemm_phase(PG8_LAS unsigned char* lds, const Gemm g, const Sched& S, const Epi& E) {
    const int tid = threadIdx.x, wid = __builtin_amdgcn_readfirstlane(tid >> 6), lane = tid & 63, wr = wid >> 2, wc = wid & 3, fr = lane & 15, fq = lane >> 4;
    const int K = g.K, nt = K / BK;
    unsigned voffA[2], voffB[2];
#pragma unroll
    for (int i = 0; i < 2; ++i) { int R, C; stage_rc(tid * 16 + i * 8192, R, C); const int Rb = Epi::PERM ? ((R & ~31) + perm32(R & 31)) : R;
        voffA[i] = (unsigned)(R * K + C) * 2u; voffB[i] = (unsigned)(Rb * K + C) * 2u; }
    const size_t kstep = (size_t)(BK * 2);
    const size_t hstep = (size_t)HALF * K * 2;
    const size_t tstep = 2 * hstep;
    const unsigned ldsw = (unsigned)wid * 1024u;
    const int aoff = lds_byte(wr * 64 + fr, fq * 8), boff = lds_byte(wc * 32 + fr, fq * 8);
#define PG8_SA(b, h) (((b) * 2 + (h)) * HTB)
#define PG8_SB(b, h) ((4 + (b) * 2 + (h)) * HTB)
#define PG8_STAGE(bufoff, gbase, voff) do { _Pragma("unroll") for (int _i = 0; _i < 2; ++_i) \
        __builtin_amdgcn_global_load_lds((const unsigned*)((const char*)(gbase) + (voff)[_i]), (PG8_LAS unsigned*)(lds + (bufoff) + ldsw + _i * 8192), 16, 0, 0); } while (0)
#define PG8_LDA(dst, b, h) do { _Pragma("unroll") for (int m = 0; m < 4; ++m) _Pragma("unroll") for (int k = 0; k < 2; ++k) dst[m][k] = *(const PG8_LAS bf16x8*)(lds + PG8_SA(b, h) + aoff + m * 2048 + k * 1024); } while (0)
#define PG8_LDB(dst, b, h) do { _Pragma("unroll") for (int n = 0; n < 2; ++n) _Pragma("unroll") for (int k = 0; k < 2; ++k) dst[n][k] = *(const PG8_LAS bf16x8*)(lds + PG8_SB(b, h) + boff + n * 2048 + k * 1024); } while (0)
#define PG8_MMA(ai, bj, At, Bt) do { __builtin_amdgcn_s_setprio(1); _Pragma("unroll") for (int m = 0; m < 4; ++m) _Pragma("unroll") for (int n = 0; n < 2; ++n) _Pragma("unroll") for (int k = 0; k < 2; ++k) \
        acc[ai][bj][m][n] = __builtin_amdgcn_mfma_f32_16x16x32_bf16(Bt[n][k], At[m][k], acc[ai][bj][m][n], 0, 0, 0); __builtin_amdgcn_s_setprio(0); } while (0)
#define PG8_WAIT_V(n) asm volatile("s_waitcnt vmcnt(" #n ")" ::: "memory")
#define PG8_WAIT_L(n) asm volatile("s_waitcnt lgkmcnt(" #n ")" ::: "memory")
#define PG8_BAR __builtin_amdgcn_s_barrier()
#define PG8_SCHED __builtin_amdgcn_sched_barrier(0)
    Unit cur, nxt; int ui = 0;
    if (!S.next(0, cur)) return;
    f32x4 acc[2][2][4][2];
#pragma unroll
    for (int a = 0; a < 2; ++a)
#pragma unroll
        for (int b = 0; b < 2; ++b)
#pragma unroll
            for (int m = 0; m < 4; ++m)
#pragma unroll
                for (int n = 0; n < 2; ++n) acc[a][b][m][n] = (f32x4){0.f, 0.f, 0.f, 0.f};
    bf16x8 At[4][2], B0[2][2], B1[2][2];
    const char* cA = (const char*)g.A + (size_t)cur.pm * tstep; const char* cB = (const char*)g.Bt + (size_t)cur.pn * tstep;
    S.a_ready(cur);
    if constexpr (SP2) {
        PG8_STAGE(PG8_SB(0, 0), cB, voffB); PG8_STAGE(PG8_SB(0, 1), cB + hstep, voffB); PG8_STAGE(PG8_SA(0, 0), cA, voffA); PG8_STAGE(PG8_SA(0, 1), cA + hstep, voffA);
        if (wr == 1) PG8_BAR;
        PG8_WAIT_V(2); PG8_BAR;
        PG8_STAGE(PG8_SB(1, 0), cB + kstep, voffB); PG8_STAGE(PG8_SA(1, 0), cA + kstep, voffA); PG8_STAGE(PG8_SB(1, 1), cB + hstep + kstep, voffB);
        PG8_WAIT_V(6); PG8_BAR;
    } else {
        PG8_STAGE(PG8_SB(0, 0), cB, voffB); PG8_STAGE(PG8_SA(0, 0), cA, voffA); PG8_STAGE(PG8_SB(0, 1), cB + hstep, voffB); PG8_STAGE(PG8_SA(0, 1), cA + hstep, voffA);
        if (wr == 1) PG8_BAR;
        PG8_WAIT_V(4); PG8_BAR;
        PG8_STAGE(PG8_SB(1, 0), cB + kstep, voffB); PG8_STAGE(PG8_SA(1, 0), cA + kstep, voffA); PG8_STAGE(PG8_SB(1, 1), cB + hstep + kstep, voffB);
        PG8_WAIT_V(6); PG8_BAR;
    }
    for (;;) {
        const bool has_next = S.next(ui + 1, nxt);
        const char* nA = has_next ? (const char*)g.A + (size_t)nxt.pm * tstep : cA; const char* nB = has_next ? (const char*)g.Bt + (size_t)nxt.pn * tstep : cB;
        for (int t = 0; t < nt; t += 2) {
            const bool last = (t == nt - 2);
            const char* a1 = cA + (size_t)(t + 1) * kstep;
            const char* a2 = last ? nA : cA + (size_t)(t + 2) * kstep; const char* b2 = last ? nB : cB + (size_t)(t + 2) * kstep;
            const char* a3 = a2 + kstep; const char* b3 = b2 + kstep;
            if (last && has_next) S.a_ready(nxt);
            if constexpr (SP2) {
            PG8_LDB(B0, 0, 0); PG8_LDB(B1, 0, 1); PG8_SCHED; PG8_LDA(At, 0, 0); PG8_STAGE(PG8_SA(1, 1), a1 + hstep, voffA);
            PG8_WAIT_V(8); PG8_WAIT_L(0); PG8_BAR; PG8_MMA(0, 0, At, B0); PG8_MMA(0, 1, At, B1); PG8_BAR; PG8_SCHED;
            PG8_LDA(At, 0, 1); PG8_STAGE(PG8_SB(0, 0), b2, voffB); PG8_STAGE(PG8_SB(0, 1), b2 + hstep, voffB); PG8_STAGE(PG8_SA(0, 0), a2, voffA);
            PG8_WAIT_V(8); PG8_WAIT_L(0); PG8_BAR; PG8_MMA(1, 0, At, B0); PG8_MMA(1, 1, At, B1); PG8_BAR; PG8_SCHED;
            PG8_LDB(B0, 1, 0); PG8_LDB(B1, 1, 1); PG8_SCHED; PG8_LDA(At, 1, 0); PG8_STAGE(PG8_SA(0, 1), a2 + hstep, voffA);
            PG8_WAIT_V(8); PG8_WAIT_L(0); PG8_BAR; PG8_MMA(0, 0, At, B0); PG8_MMA(0, 1, At, B1); PG8_BAR; PG8_SCHED;
            PG8_LDA(At, 1, 1); PG8_STAGE(PG8_SB(1, 0), b3, voffB); PG8_STAGE(PG8_SB(1, 1), b3 + hstep, voffB); PG8_STAGE(PG8_SA(1, 0), a3, voffA);
            PG8_WAIT_V(8); PG8_WAIT_L(0); PG8_BAR; PG8_MMA(1, 0, At, B0); PG8_MMA(1, 1, At, B1); PG8_BAR; PG8_SCHED;
            } else {
            PG8_LDB(B0, 0, 0); PG8_SCHED; PG8_LDA(At, 0, 0); PG8_STAGE(PG8_SA(1, 1), a1 + hstep, voffA);
            PG8_WAIT_L(8); PG8_BAR; PG8_WAIT_L(0); PG8_MMA(0, 0, At, B0); PG8_BAR; PG8_SCHED;
            PG8_LDB(B1, 0, 1); PG8_STAGE(PG8_SB(0, 0), b2, voffB);
            PG8_BAR; PG8_WAIT_L(0); PG8_MMA(0, 1, At, B1); PG8_BAR;
            PG8_LDA(At, 0, 1); PG8_STAGE(PG8_SA(0, 0), a2, voffA);
            PG8_BAR; PG8_WAIT_L(0); PG8_MMA(1, 0, At, B0); PG8_BAR; PG8_SCHED;
            PG8_STAGE(PG8_SB(0, 1), b2 + hstep, voffB);
            PG8_WAIT_V(6); PG8_BAR; PG8_MMA(1, 1, At, B1); PG8_BAR;
            PG8_LDB(B0, 1, 0); PG8_SCHED; PG8_LDA(At, 1, 0); PG8_STAGE(PG8_SA(0, 1), a2 + hstep, voffA);
            PG8_WAIT_L(8); PG8_BAR; PG8_WAIT_L(0); PG8_MMA(0, 0, At, B0); PG8_BAR; PG8_SCHED;
            PG8_LDB(B1, 1, 1); PG8_STAGE(PG8_SB(1, 0), b3, voffB);
            PG8_BAR; PG8_WAIT_L(0); PG8_MMA(0, 1, At, B1); PG8_BAR;
            PG8_LDA(At, 1, 1); PG8_STAGE(PG8_SA(1, 0), a3, voffA);
            PG8_BAR; PG8_WAIT_L(0); PG8_MMA(1, 0, At, B0); PG8_BAR; PG8_SCHED;
            PG8_STAGE(PG8_SB(1, 1), b3 + hstep, voffB);
            PG8_WAIT_V(6); PG8_BAR; PG8_MMA(1, 1, At, B1); PG8_BAR;
            }
        }
        if constexpr (ALIGN_EPI) { if (wr == 0) PG8_BAR; }
        if constexpr (!Epi::AFTER_DRAIN) { E(acc, cur, wr, wc, fr, fq); S.done(cur); }
        if (!has_next) break;
#pragma unroll
        for (int a = 0; a < 2; ++a)
#pragma unroll
            for (int b = 0; b < 2; ++b)
#pragma unroll
                for (int m = 0; m < 4; ++m)
#pragma unroll
                    for (int n = 0; n < 2; ++n) acc[a][b][m][n] = (f32x4){0.f, 0.f, 0.f, 0.f};
        cur = nxt; cA = nA; cB = nB; ++ui;
        if constexpr (ALIGN_EPI) { if (wr == 1) PG8_BAR; }
    }
    PG8_WAIT_V(0);
    if constexpr (!ALIGN_EPI) { if (wr == 0) PG8_BAR; }
    PG8_BAR;
    if constexpr (Epi::AFTER_DRAIN) { E.fused(acc, cur, wr, wc, fr, fq, lds, wid, lane); S.done(cur); }
#undef PG8_SA
#undef PG8_SB
#undef PG8_STAGE
#undef PG8_LDA
#undef PG8_LDB
#undef PG8_MMA
#undef PG8_WAIT_V
#undef PG8_WAIT_L
#undef PG8_BAR
#undef PG8_SCHED
}
}
#ifndef PG8_SP2
#define PG8_SP2 true
#endif
#ifndef PG8_ALIGN
#define PG8_ALIGN true
#endif
constexpr int NWAVES = 8;
#ifndef MK_N_LAUNCHES
#define MK_N_LAUNCHES 1
#endif
constexpr int N_PHASES = 10;
constexpr int N_LAUNCHES = MK_N_LAUNCHES;

constexpr int D = 4096, NB = 4, SEQ = 2048, M = NB * SEQ, CTXL = 256, MC = NB * CTXL, MT = M + MC;
constexpr int HD = 128, NAH = 16, NAW = 2048, CVW = 2048, INC = 12288, FF = 11008, NMODC = 6 * D;
constexpr int GRIDW = 64, ROWS = 32, NAKH = 8, NAKW = 16;
constexpr float EPS = 1e-6f, LOG2E = 1.44269504089f;
enum { I_X = 0, I_C, I_CTX, I_CCTX, I_ADAW, I_ADAB, I_N1G, I_WIN, I_CONVW, I_RPB, I_GNG, I_WOUT, I_N2G, I_WGU, I_WDN, I_FNG, N_IN };

constexpr size_t MiB = 1u << 20;
constexpr size_t WS_CTL = 0, WS_MOD = 1 * MiB, CTL_ZERO_BYTES = 2 * MiB;
constexpr size_t WS_ROPE = 2 * MiB;
constexpr size_t WS_WIN = 4 * MiB, WS_WOUT = 100 * MiB, WS_WGU = 132 * MiB, WS_WDN = 304 * MiB;
constexpr size_t WS_H = 390 * MiB;
constexpr size_t WS_Q = 462 * MiB;
constexpr size_t WS_K = 494 * MiB;
constexpr size_t WS_V = 530 * MiB;
constexpr size_t WS_C = 566 * MiB;
constexpr size_t WS_AO = 662 * MiB;
constexpr size_t WS_Y = 694 * MiB;
constexpr size_t WS_X1 = 758 * MiB;
constexpr size_t WS_ACT = 886 * MiB;
constexpr size_t WS_END = 1058 * MiB;
static_assert(WS_WIN + (size_t)INC * D * 2 <= WS_WOUT && WS_WOUT + (size_t)D * D * 2 <= WS_WGU && WS_WGU + (size_t)2 * FF * D * 2 <= WS_WDN && WS_WDN + (size_t)D * FF * 2 <= WS_H, "ws map (weights)");
static_assert(WS_H + (size_t)MT * D * 2 <= WS_Q && WS_Q + (size_t)M * NAW * 2 <= WS_K && WS_K + (size_t)MT * NAW * 2 <= WS_V && WS_V + (size_t)MT * NAW * 2 <= WS_C && WS_C + (size_t)M * 6144 * 2 <= WS_AO, "ws map (acts 1)");
static_assert(WS_AO + (size_t)M * NAW * 2 <= WS_Y && WS_Y + (size_t)M * D * 2 <= WS_X1 && WS_X1 + (size_t)M * D * 4 <= WS_ACT && WS_ACT + (size_t)M * FF * 2 <= WS_END, "ws map (acts 2)");
constexpr int CW_BAR = 4096;

constexpr int RING_OFF = 0, RING_BYTES = 131072;
constexpr int LDSCTL_OFF = RING_BYTES, MISC_OFF = LDSCTL_OFF + 320;
constexpr int LDS_BYTES = 147456;
static_assert(MISC_OFF + 128 <= LDS_BYTES, "LDS map");

#define GAS __attribute__((address_space(1)))
#define LAS __attribute__((address_space(3)))
typedef unsigned short bf16;
typedef unsigned v4u __attribute__((ext_vector_type(4)));
typedef float f32x4 __attribute__((ext_vector_type(4)));
typedef short bf16x8 __attribute__((ext_vector_type(8)));
typedef GAS unsigned gu32;
typedef GAS unsigned long long gu64;
#define RLX_AGENT __ATOMIC_RELAXED, __HIP_MEMORY_SCOPE_AGENT
#define LDS_WAIT() asm volatile("s_waitcnt lgkmcnt(0)" ::: "memory")
#define VM_WAIT() asm volatile("s_waitcnt vmcnt(0)" ::: "memory")
__device__ __forceinline__ unsigned long long rt() { return __builtin_amdgcn_s_memrealtime(); }
__device__ __forceinline__ unsigned f2bf(float f) { unsigned u = __builtin_bit_cast(unsigned, f); return (u + 0x7fffu + ((u >> 16) & 1u)) >> 16; }
__device__ __forceinline__ unsigned pk2(float lo, float hi) { return f2bf(lo) | (f2bf(hi) << 16); }

#define XB_TMO      128
#define XB_XCNT(j)  (256  + 64 * (j))
#define XB_XSUB(j)  (1280 + 64 * (j))
#define XB_XGEN(j)  (2304 + 64 * (j))
#define XB_TOP      3328
#define XB_TOPGEN   3392
#define XCD_BAR_WORDS 3456
#define XB_SPIN_CAP (1u << 18)

__device__ __forceinline__ unsigned xb_ld(unsigned* p)              { return __hip_atomic_load(p, __ATOMIC_RELAXED, __HIP_MEMORY_SCOPE_AGENT); }
__device__ __forceinline__ unsigned xb_add(unsigned* p, unsigned v) { return __hip_atomic_fetch_add(p, v, __ATOMIC_RELAXED, __HIP_MEMORY_SCOPE_AGENT); }
__device__ __forceinline__ unsigned xb_xcc_id() { return (unsigned)__builtin_amdgcn_s_getreg((3 << 11) | 20) & 0xFu; }
#define XB_SPIN(cond, bar) do { unsigned _sp = 0; while (cond) { __builtin_amdgcn_s_sleep(1); \
    if ((++_sp & 255u) == 0u) { if (xb_ld(&(bar)[XB_TMO])) break; if (_sp > XB_SPIN_CAP) { atomicAdd(&(bar)[XB_TMO], 1u); break; } } } } while (0)

struct XcdBarrier {
    unsigned* bar; unsigned x;
    volatile LAS unsigned* st;
};

__device__ __forceinline__ XcdBarrier xcd_barrier_post(unsigned* bar, volatile LAS unsigned* st) {
    XcdBarrier b; b.bar = bar; b.x = xb_xcc_id(); b.st = st;
    if (threadIdx.x == 0) (void)xb_add(&bar[XB_XCNT(b.x)], 1u);
    return b;
}
__device__ __forceinline__ void xcd_barrier_complete(unsigned* bar, unsigned x, unsigned& nloc, unsigned& nx) {
    const unsigned G = gridDim.x * gridDim.y * gridDim.z;
    unsigned sum, cnt, mine, sp = 0u;
    for (;;) {
        sum = 0u; cnt = 0u; mine = 0u;
#pragma unroll
        for (unsigned j = 0; j < 16; ++j) { const unsigned c = xb_ld(&bar[XB_XCNT(j)]); sum += c; cnt += (c > 0u) ? 1u : 0u; mine = (j == x) ? c : mine; }
        if (sum == G) break;
        __builtin_amdgcn_s_sleep(1);
        if ((++sp & 255u) == 0u) { if (xb_ld(&bar[XB_TMO])) break; if (sp > XB_SPIN_CAP) { atomicAdd(&bar[XB_TMO], 1u); break; } }
    }
    nloc = mine > 0u ? mine : 1u; nx = cnt > 0u ? cnt : 1u;
}

__device__ __forceinline__ void xcd_barrier(const XcdBarrier& b) {
    asm volatile("s_waitcnt vmcnt(0)" ::: "memory");
    __syncthreads();
    if (threadIdx.x == 0) {
        unsigned* bar = b.bar;
        __builtin_amdgcn_s_waitcnt(0);
        unsigned nloc = b.st[0], nx = b.st[1];
        if (nloc == 0u) { xcd_barrier_complete(bar, b.x, nloc, nx); b.st[0] = nloc; b.st[1] = nx; }
        const unsigned old = xb_add(&bar[XB_XSUB(b.x)], 1u);
        const unsigned gen = old / nloc;
        if (old + 1u == (gen + 1u) * nloc) {
            __builtin_amdgcn_fence(__ATOMIC_RELEASE, "agent");
            asm volatile("s_waitcnt vmcnt(0)" ::: "memory");
            const unsigned og = xb_add(&bar[XB_TOP], 1u);
            const unsigned tg = og / nx;
            if (og + 1u == (tg + 1u) * nx) xb_add(&bar[XB_TOPGEN], 1u);
            else XB_SPIN(xb_ld(&bar[XB_TOPGEN]) == tg, bar);
            __builtin_amdgcn_fence(__ATOMIC_ACQUIRE, "agent");
            xb_add(&bar[XB_XGEN(b.x)], 1u);
            asm volatile("s_waitcnt vmcnt(0)" ::: "memory");
        } else {
            XB_SPIN(xb_ld(&bar[XB_XGEN(b.x)]) == gen, bar);
            __builtin_amdgcn_fence(__ATOMIC_ACQUIRE, "agent");
            asm volatile("s_waitcnt vmcnt(0)" ::: "memory");
        }
    }
    __syncthreads();
}

typedef float f32x16 __attribute__((ext_vector_type(16)));
typedef unsigned v2u __attribute__((ext_vector_type(2)));
struct Frame {
    LAS unsigned char* lds;
    volatile LAS unsigned* MISC;
    gu32* ctl;
    int tid, lane, wave, vcu, G;
    const float* in[N_IN]; float* out;
    float* mod; float* rope;
    bf16 *Win_t, *Wout_t, *Wgu_t, *Wdn_t;
    bf16 *HB, *QB, *KB, *VB, *CB, *AO, *YB, *ACT; float* X1;
};
template <int CTRL> __device__ __forceinline__ float dpp_add(float v) { return v + __builtin_bit_cast(float, __builtin_amdgcn_update_dpp(0, __builtin_bit_cast(int, v), CTRL, 0xf, 0xf, true)); }
__device__ __forceinline__ float wave_sum(float v) {
    v = dpp_add<0xB1>(v); v = dpp_add<0x4E>(v); v = dpp_add<0x141>(v); v = dpp_add<0x140>(v);
    v += __builtin_bit_cast(float, __builtin_amdgcn_ds_swizzle(__builtin_bit_cast(int, v), 0x401F));
    return __builtin_bit_cast(float, __builtin_amdgcn_readlane(__builtin_bit_cast(int, v), 0)) + __builtin_bit_cast(float, __builtin_amdgcn_readlane(__builtin_bit_cast(int, v), 32));
}
__device__ __forceinline__ unsigned pkbf(float lo, float hi) { return pg8::pkbf(lo, hi); }
__device__ __forceinline__ float bflo(unsigned w) { return __builtin_bit_cast(float, w << 16); }
__device__ __forceinline__ float bfhi(unsigned w) { return __builtin_bit_cast(float, w & 0xffff0000u); }

__device__ __forceinline__ int map_in(int n) {
    if (n < 4096) { const int hd = n & ~127, d = n & 127, blk = d >> 6, e4 = (d >> 5) & 1, i = d & 31; return hd + 64 * blk + 8 * (i >> 2) + 4 * e4 + (i & 3); }
    return n;
}
__device__ __forceinline__ int map_gu(int n) { const int up = n >= FF ? 1 : 0, jx = up ? n - FF : n; return 256 * (jx >> 7) + 128 * up + (jx & 127); }
template <int MAP> __device__ __forceinline__ void p0_transpose_item(const float* W, int K, int N, bf16* WT, LAS float* scr, int item, int lane) {
    const int nblk = N / 32, kb = item / nblk, nb = item % nblk, k0 = 64 * kb, n0 = 32 * nb;
    const GAS float* Wg = (const GAS float*)W;
#pragma unroll 8
    for (int i = 0; i < 32; ++i) { const int kk = 2 * i + (lane >> 5); scr[kk * 33 + (lane & 31)] = Wg[(size_t)(k0 + kk) * N + n0 + (lane & 31)]; }
    LDS_WAIT(); asm volatile("" ::: "memory");
    const int c = lane & 7;
#pragma unroll
    for (int j = 0; j < 4; ++j) { const int n = (lane >> 3) + 8 * j; const LAS float* s = scr + (8 * c) * 33 + n;
        v4u o; o.x = pkbf(s[0 * 33], s[1 * 33]); o.y = pkbf(s[2 * 33], s[3 * 33]); o.z = pkbf(s[4 * 33], s[5 * 33]); o.w = pkbf(s[6 * 33], s[7 * 33]);
        const int nsrc = n0 + n, nd = MAP == 1 ? map_in(nsrc) : (MAP == 2 ? map_gu(nsrc) : nsrc);
        *(GAS v4u*)(WT + (size_t)nd * K + k0 + 8 * c) = o; }
    LDS_WAIT(); asm volatile("" ::: "memory");
}
__device__ __forceinline__ void p0_prologue(Frame& F) {
    { const int gi = blockIdx.x * (NWAVES * 64) + F.tid;
      if (gi < 2048) { const int pos = gi >> 5, i = gi & 31; const float fr = exp2f(-(float)i * (13.287712379549449f / 32.0f)); const float ang = (float)pos * fr;
          F.rope[gi] = cosf(ang); F.rope[2048 + gi] = sinf(ang); } }
    { LAS float* sil = (LAS float*)(F.lds + RING_OFF);
      LAS float* red = (LAS float*)(F.lds + RING_OFF + 16384);
      const GAS float* aw = (const GAS float*)F.in[I_ADAW];
      for (int it = blockIdx.x; it < 768; it += F.G) {
          const int cs = it % 96, ks = it / 96, k0 = 512 * ks;
          for (int idx = F.tid; idx < 5 * 512; idx += NWAVES * 64) { const int bb = idx >> 9, kk = idx & 511;
              const float v = bb < 4 ? F.in[I_C][bb * D + k0 + kk] : F.in[I_CCTX][k0 + kk]; sil[idx] = v / (1.0f + __expf(-v)); }
          __syncthreads();
          f32x4 a0 = {0.f, 0.f, 0.f, 0.f}, a1 = a0, a2 = a0, a3 = a0, a4 = a0;
          const GAS float* wp = aw + (size_t)(k0 + F.wave) * NMODC + 256 * cs + 4 * F.lane;
#pragma unroll 8
          for (int i = 0; i < 64; ++i) { const f32x4 w = *(const GAS f32x4*)(wp + (size_t)(8 * i) * NMODC); const int k = F.wave + 8 * i;
              a0 += sil[k] * w; a1 += sil[512 + k] * w; a2 += sil[1024 + k] * w; a3 += sil[1536 + k] * w; a4 += sil[2048 + k] * w; }
          LAS f32x4* rw = (LAS f32x4*)(red + F.wave * 1280) + F.lane;
          rw[0] = a0; rw[64] = a1; rw[128] = a2; rw[192] = a3; rw[256] = a4;
          __syncthreads();
          for (int idx = F.tid; idx < 1280; idx += NWAVES * 64) { float s = 0.f;
#pragma unroll
              for (int w = 0; w < 8; ++w) s += red[w * 1280 + idx];
              const int bb = idx >> 8, cc = idx & 255, n = 256 * cs + cc;
              if (ks == 0) s += F.in[I_ADAB][n];
              atomicAdd(F.mod + bb * NMODC + n, s); }
          __syncthreads();
      } }
    LAS float* scr = (LAS float*)(F.lds + RING_OFF + F.wave * 16384);
    const int gw = F.vcu * NWAVES + F.wave, NGW = F.G * NWAVES;
    constexpr int IT_IN = (D / 64) * (INC / 32), IT_OUT = (D / 64) * (D / 32), IT_GU = (D / 64) * (2 * FF / 32), IT_DN = (FF / 64) * (D / 32);
    for (int it = gw; it < IT_IN; it += NGW) p0_transpose_item<1>(F.in[I_WIN], D, INC, F.Win_t, scr, it, F.lane);
    for (int it = gw; it < IT_OUT; it += NGW) p0_transpose_item<0>(F.in[I_WOUT], D, D, F.Wout_t, scr, it, F.lane);
    for (int it = gw; it < IT_GU; it += NGW) p0_transpose_item<2>(F.in[I_WGU], D, 2 * FF, F.Wgu_t, scr, it, F.lane);
    for (int it = gw; it < IT_DN; it += NGW) p0_transpose_item<0>(F.in[I_WDN], FF, D, F.Wdn_t, scr, it, F.lane);
}

__device__ __forceinline__ void norm_mod_row(const float* xrow, bf16* orow, const float* gain, const float* shift, const float* scale, int lane) {
    const GAS f32x4* xr = (const GAS f32x4*)xrow + lane;
    f32x4 v[16]; float ss = 0.f;
#pragma unroll
    for (int j = 0; j < 16; ++j) { v[j] = xr[64 * j]; ss += (v[j].x * v[j].x + v[j].y * v[j].y) + (v[j].z * v[j].z + v[j].w * v[j].w); }
    const float rstd = 1.0f / sqrtf(wave_sum(ss) * (1.0f / D) + EPS);
    const GAS f32x4* g4 = (const GAS f32x4*)gain + lane; const GAS f32x4* sh4 = (const GAS f32x4*)shift + lane; const GAS f32x4* sc4 = (const GAS f32x4*)scale + lane;
    GAS v2u* o8 = (GAS v2u*)orow + lane;
#pragma unroll
    for (int j = 0; j < 16; ++j) { const f32x4 g = g4[64 * j], sh = sh4[64 * j], sc = sc4[64 * j];
        const f32x4 y = v[j] * rstd * g * (1.0f + sc) + sh; v2u w; w.x = pkbf(y.x, y.y); w.y = pkbf(y.z, y.w); o8[64 * j] = w; }
}

#define MFMA32(a, b, c) __builtin_amdgcn_mfma_f32_32x32x16_bf16((a), (b), (c), 0, 0, 0)
__device__ __forceinline__ void attn_unit(const bf16* Qb, const bf16* Kb, const bf16* Vb, bf16* AO, const LAS float* rp, int b, int h, int r, int qblk, int lane) {
    const int j = lane & 31, g = lane >> 5;
    const int kap = (j & 19) | ((j & 4) << 1) | ((j & 8) >> 1);
    const size_t qtok = (size_t)b * SEQ + r * GRIDW + 32 * qblk + j;
    const GAS bf16x8* qp = (const GAS bf16x8*)(Qb + qtok * NAW + HD * h + 8 * g);
    bf16x8 qf[8];
#pragma unroll
    for (int kd = 0; kd < 8; ++kd) qf[kd] = qp[2 * kd];
    f32x16 o0, o1, o2, o3;
#pragma unroll
    for (int v = 0; v < 16; ++v) { o0[v] = 0.f; o1[v] = 0.f; o2[v] = 0.f; o3[v] = 0.f; }
    float m_run = -__builtin_inff(), l_run = 0.f;
    const int rs = min(max(r - NAKH / 2, 0), ROWS - NAKH);
    const int qc = 32 * qblk + j, cs = min(max(qc - NAKW / 2, 0), GRIDW - NAKW);
    for (int tile = 0; tile < 24; ++tile) {
        const bool lat = tile >= 8; const int lt = tile - 8, kr = rs + (lt >> 1), kblk = lt & 1;
        const int keybase = lat ? (b * SEQ + kr * GRIDW + 32 * kblk) : (M + b * CTXL + 32 * tile);
        const GAS bf16x8* kp = (const GAS bf16x8*)(Kb + (size_t)(keybase + kap) * NAW + HD * h + 8 * g);
        bf16x8 kf[8];
#pragma unroll
        for (int kd = 0; kd < 8; ++kd) kf[kd] = kp[2 * kd];
        const GAS v2u* vp = (const GAS v2u*)(Vb + (size_t)(keybase + 8 * g) * NAW + HD * h + 4 * j);
        v2u w0[8], w1[8];
#pragma unroll
        for (int jj = 0; jj < 8; ++jj) { w0[jj] = vp[(size_t)jj * (NAW / 4)]; w1[jj] = vp[(size_t)(16 + jj) * (NAW / 4)]; }
        f32x16 s;
#pragma unroll
        for (int v = 0; v < 16; ++v) s[v] = 0.f;
#pragma unroll
        for (int kd = 0; kd < 8; ++kd) s = MFMA32(kf[kd], qf[kd], s);
        if (lat) {
            const LAS float* brow = rp + (h * 15 + (kr - r + NAKH - 1)) * 31;
#pragma unroll
            for (int v = 0; v < 16; ++v) { const int kc = 32 * kblk + (v & 7) + 8 * g + 16 * (v >> 3), rel = kc - qc + NAKW - 1;
                const bool valid = (kc >= cs) && (kc < cs + NAKW); const float bias = brow[min(max(rel, 0), 30)];
                s[v] = valid ? s[v] + bias : -__builtin_inff(); }
        }
        float mx = s[0];
#pragma unroll
        for (int v = 1; v < 16; ++v) mx = fmaxf(mx, s[v]);
        mx = fmaxf(mx, __shfl_xor(mx, 32));
        const float m_new = fmaxf(m_run, mx);
        const float alpha = __builtin_amdgcn_exp2f(m_run - m_new);
        float ps = 0.f;
#pragma unroll
        for (int v = 0; v < 16; ++v) { s[v] = __builtin_amdgcn_exp2f(s[v] - m_new); ps += s[v]; }
        l_run = l_run * alpha + ps; m_run = m_new;
#pragma unroll
        for (int v = 0; v < 16; ++v) { o0[v] *= alpha; o1[v] *= alpha; o2[v] *= alpha; o3[v] *= alpha; }
        bf16x8 pf0, pf1;
        { v4u t0, t1; t0.x = pkbf(s[0], s[1]); t0.y = pkbf(s[2], s[3]); t0.z = pkbf(s[4], s[5]); t0.w = pkbf(s[6], s[7]);
          t1.x = pkbf(s[8], s[9]); t1.y = pkbf(s[10], s[11]); t1.z = pkbf(s[12], s[13]); t1.w = pkbf(s[14], s[15]);
          pf0 = __builtin_bit_cast(bf16x8, t0); pf1 = __builtin_bit_cast(bf16x8, t1); }
#define VFRAG(W, SEL, XY) ({ v4u _t; _t.x = __builtin_amdgcn_perm(W[1].XY, W[0].XY, SEL); _t.y = __builtin_amdgcn_perm(W[3].XY, W[2].XY, SEL); \
        _t.z = __builtin_amdgcn_perm(W[5].XY, W[4].XY, SEL); _t.w = __builtin_amdgcn_perm(W[7].XY, W[6].XY, SEL); __builtin_bit_cast(bf16x8, _t); })
        o0 = MFMA32(VFRAG(w0, 0x05040100u, x), pf0, o0); o1 = MFMA32(VFRAG(w0, 0x07060302u, x), pf0, o1);
        o2 = MFMA32(VFRAG(w0, 0x05040100u, y), pf0, o2); o3 = MFMA32(VFRAG(w0, 0x07060302u, y), pf0, o3);
        o0 = MFMA32(VFRAG(w1, 0x05040100u, x), pf1, o0); o1 = MFMA32(VFRAG(w1, 0x07060302u, x), pf1, o1);
        o2 = MFMA32(VFRAG(w1, 0x05040100u, y), pf1, o2); o3 = MFMA32(VFRAG(w1, 0x07060302u, y), pf1, o3);
#undef VFRAG
    }
    const float l = l_run + __shfl_xor(l_run, 32), inv = 1.0f / l;
    GAS v2u* op = (GAS v2u*)(AO + qtok * NAW + HD * h);
#pragma unroll
    for (int v = 0; v < 16; ++v) { const int i = (v & 3) + 8 * (v >> 2) + 4 * g;
        v2u w; w.x = pkbf(o0[v] * inv, o1[v] * inv); w.y = pkbf(o2[v] * inv, o3[v] * inv); op[i] = w; }
}
__device__ __forceinline__ void attn_phase(Frame& F) {
    LAS float* rp = (LAS float*)(F.lds + RING_OFF);
    for (int i = F.tid; i < NAH * 15 * 31; i += NWAVES * 64) rp[i] = F.in[I_RPB][i] * LOG2E;
    __syncthreads();
    for (int wu = F.vcu; wu < NB * NAH * 8; wu += F.G) { const int bh = wu >> 3, rg = wu & 7;
        attn_unit(F.QB, F.KB, F.VB, F.AO, rp, bh >> 4, bh & 15, rg * 4 + (F.wave >> 1), F.wave & 1, F.lane); }
}

__device__ __forceinline__ void mix_row(Frame& F, int row) {
    unsigned lane = (unsigned)F.lane; const int t = row & (SEQ - 1);
    const GAS char* gg = (const GAS char*)F.in[I_GNG];
    asm volatile("" : "+v"(lane) :: "memory");
    { const GAS char* ap = (const GAS char*)(F.AO + (size_t)row * NAW); v4u a[4]; float ss = 0.f;
#pragma unroll
      for (int q = 0; q < 4; ++q) { a[q] = *(const GAS v4u*)(ap + (lane * 16u + q * 1024u));
#pragma unroll
          for (int e = 0; e < 4; ++e) { const float lo = bflo(a[q][e]), hi = bfhi(a[q][e]); ss += lo * lo + hi * hi; } }
      const float rstd = 1.0f / sqrtf(wave_sum(ss) * (1.0f / NAW) + EPS);
      GAS char* yp = (GAS char*)(F.YB + (size_t)row * D);
#pragma unroll
      for (int q = 0; q < 4; ++q) { const f32x4 g0 = *(const GAS f32x4*)(gg + (lane * 32u + q * 2048u)), g1 = *(const GAS f32x4*)(gg + (lane * 32u + q * 2048u + 16u)); v4u w;
          w.x = pkbf(bflo(a[q].x) * rstd * g0.x, bfhi(a[q].x) * rstd * g0.y); w.y = pkbf(bflo(a[q].y) * rstd * g0.z, bfhi(a[q].y) * rstd * g0.w);
          w.z = pkbf(bflo(a[q].z) * rstd * g1.x, bfhi(a[q].z) * rstd * g1.y); w.w = pkbf(bflo(a[q].w) * rstd * g1.z, bfhi(a[q].w) * rstd * g1.w);
          *(GAS v4u*)(yp + (lane * 16u + q * 1024u)) = w; } }
    { const GAS char* cw = (const GAS char*)F.in[I_CONVW];
      const GAS char* r0 = (const GAS char*)(F.CB + (size_t)row * 6144);
      const GAS char* rm = t > 0 ? r0 - 12288 : r0; const GAS char* rp = t < SEQ - 1 ? r0 + 12288 : r0;
      const float fm = t > 0 ? 1.f : 0.f, fp = t < SEQ - 1 ? 1.f : 0.f;
      float co[4][8]; float ss = 0.f;
#pragma unroll
      for (int q = 0; q < 4; ++q) { const unsigned vo = lane * 16u + q * 1024u, wo = lane * 32u + q * 2048u;
          if (q == 2) __builtin_amdgcn_sched_barrier(0);
          const v4u u0 = *(const GAS v4u*)(r0 + vo), gb = *(const GAS v4u*)(r0 + (vo + 4096u)), c0v = *(const GAS v4u*)(r0 + (vo + 8192u));
          const v4u um = *(const GAS v4u*)(rm + vo), cm = *(const GAS v4u*)(rm + (vo + 8192u)), upl = *(const GAS v4u*)(rp + vo), cpl = *(const GAS v4u*)(rp + (vo + 8192u));
          const f32x4 wa0 = *(const GAS f32x4*)(cw + wo), wa1 = *(const GAS f32x4*)(cw + (wo + 16u)), wb0 = *(const GAS f32x4*)(cw + (wo + 8192u)), wb1 = *(const GAS f32x4*)(cw + (wo + 8208u)),
                      wc0 = *(const GAS f32x4*)(cw + (wo + 16384u)), wc1 = *(const GAS f32x4*)(cw + (wo + 16400u));
#pragma unroll
          for (int e = 0; e < 4; ++e) {
              const float k0l = (e < 2 ? wa0[(2 * e) & 3] : wa1[(2 * e) & 3]) * fm, k0h = (e < 2 ? wa0[(2 * e + 1) & 3] : wa1[(2 * e + 1) & 3]) * fm;
              const float k1l = e < 2 ? wb0[(2 * e) & 3] : wb1[(2 * e) & 3], k1h = e < 2 ? wb0[(2 * e + 1) & 3] : wb1[(2 * e + 1) & 3];
              const float k2l = (e < 2 ? wc0[(2 * e) & 3] : wc1[(2 * e) & 3]) * fp, k2h = (e < 2 ? wc0[(2 * e + 1) & 3] : wc1[(2 * e + 1) & 3]) * fp;
              const float vl = bflo(gb[e]) * (k0l * (bflo(cm[e]) * bflo(um[e])) + k1l * (bflo(c0v[e]) * bflo(u0[e])) + k2l * (bflo(cpl[e]) * bflo(upl[e])));
              const float vh = bfhi(gb[e]) * (k0h * (bfhi(cm[e]) * bfhi(um[e])) + k1h * (bfhi(c0v[e]) * bfhi(u0[e])) + k2h * (bfhi(cpl[e]) * bfhi(upl[e])));
              co[q][2 * e] = vl; co[q][2 * e + 1] = vh; ss += vl * vl + vh * vh; } }
      const float rstd = 1.0f / sqrtf(wave_sum(ss) * (1.0f / CVW) + EPS);
      GAS char* yp = (GAS char*)(F.YB + (size_t)row * D + NAW);
#pragma unroll
      for (int q = 0; q < 4; ++q) { const unsigned wo = lane * 32u + q * 2048u; const f32x4 g0 = *(const GAS f32x4*)(gg + (8192u + wo)), g1 = *(const GAS f32x4*)(gg + (8192u + 16u + wo)); v4u w;
          w.x = pkbf(co[q][0] * rstd * g0.x, co[q][1] * rstd * g0.y); w.y = pkbf(co[q][2] * rstd * g0.z, co[q][3] * rstd * g0.w);
          w.z = pkbf(co[q][4] * rstd * g1.x, co[q][5] * rstd * g1.y); w.w = pkbf(co[q][6] * rstd * g1.z, co[q][7] * rstd * g1.w);
          *(GAS v4u*)(yp + (lane * 16u + q * 1024u)) = w; } }
}
__device__ __forceinline__ void final_norm_row(float* xrow, const float* gain, int lane) {
    GAS f32x4* xr = (GAS f32x4*)xrow + lane; const GAS f32x4* g4 = (const GAS f32x4*)gain + lane;
    f32x4 v[16]; float ss = 0.f;
#pragma unroll
    for (int j = 0; j < 16; ++j) { v[j] = xr[64 * j]; ss += (v[j].x * v[j].x + v[j].y * v[j].y) + (v[j].z * v[j].z + v[j].w * v[j].w); }
    const float rstd = 1.0f / sqrtf(wave_sum(ss) * (1.0f / D) + EPS);
#pragma unroll
    for (int j = 0; j < 16; ++j) xr[64 * j] = v[j] * rstd * g4[64 * j];
}

struct Args { const float* in[N_IN]; float* out; unsigned char* ws; int ph_lo, ph_hi; };
__global__ void __launch_bounds__(NWAVES * 64, 2) fwd_kernel(Args args) {
    extern __shared__ __attribute__((aligned(16))) unsigned char lds[];
    Frame F;
    F.lds = (LAS unsigned char*)lds;
    F.MISC = (volatile LAS unsigned*)(F.lds + MISC_OFF);
    F.tid = threadIdx.x; F.lane = F.tid & 63; F.wave = __builtin_amdgcn_readfirstlane(F.tid >> 6);
    F.G = gridDim.x; { const int bx = blockIdx.x; F.vcu = (F.G % 8 == 0) ? (bx % 8) * (F.G / 8) + bx / 8 : bx; }
    unsigned char* ws = args.ws;
    F.ctl = (gu32*)(ws + WS_CTL);
#pragma unroll
    for (int i = 0; i < N_IN; ++i) F.in[i] = args.in[i];
    F.out = args.out; F.mod = (float*)(ws + WS_MOD); F.rope = (float*)(ws + WS_ROPE);
    F.Win_t = (bf16*)(ws + WS_WIN); F.Wout_t = (bf16*)(ws + WS_WOUT); F.Wgu_t = (bf16*)(ws + WS_WGU); F.Wdn_t = (bf16*)(ws + WS_WDN);
    F.HB = (bf16*)(ws + WS_H); F.QB = (bf16*)(ws + WS_Q); F.KB = (bf16*)(ws + WS_K); F.VB = (bf16*)(ws + WS_V); F.CB = (bf16*)(ws + WS_C);
    F.AO = (bf16*)(ws + WS_AO); F.YB = (bf16*)(ws + WS_Y); F.ACT = (bf16*)(ws + WS_ACT); F.X1 = (float*)(ws + WS_X1);
    for (int u = F.tid; u < (LDS_BYTES - LDSCTL_OFF) / 4; u += NWAVES * 64) ((LAS unsigned*)(F.lds + LDSCTL_OFF))[u] = 0u;
    __syncthreads();
    XcdBarrier bar; bar.bar = (unsigned*)(F.ctl + CW_BAR); bar.x = 0; bar.st = nullptr;
    if (N_LAUNCHES == 1) bar = xcd_barrier_post((unsigned*)(F.ctl + CW_BAR), F.MISC + 8);
    const int lo = args.ph_lo, hi = args.ph_hi;
#define IN(k) (lo <= (k) && (k) < hi)
#define SEAM(k) do { if (IN(k) && IN((k) + 1)) xcd_barrier(bar); } while (0)
    const int gw = F.vcu * NWAVES + F.wave, NGW = F.G * NWAVES;

    if (IN(0)) { p0_prologue(F); SEAM(0); }
    if (IN(1)) {
        for (int m = gw; m < MT; m += NGW) {
            const bool isctx = m >= M; const float* xrow = isctx ? F.in[I_CTX] + (size_t)(m - M) * D : F.in[I_X] + (size_t)m * D;
            const float* mrow = F.mod + (size_t)(isctx ? 4 : (m >> 11)) * NMODC;
            norm_mod_row(xrow, F.HB + (size_t)m * D, F.in[I_N1G], mrow, mrow + D, F.lane); }
        SEAM(1);
    }
    if (IN(2)) {
        pg8::Gemm g{F.HB, F.Win_t, MT, INC, D}; pg8::InOrder S; S.init(F.G, (int)blockIdx.x);
        pg8::EpiIn E{F.QB, F.KB, F.VB, F.CB, F.rope, 0.08838834764831845f * LOG2E};
        pg8::gemm_phase<pg8::EpiIn, pg8::InOrder, PG8_ALIGN, PG8_SP2>(F.lds + RING_OFF, g, S, E);
        SEAM(2);
    }
    if (IN(3)) { attn_phase(F); SEAM(3); }
    if (IN(4)) { for (int m = gw; m < M; m += NGW) mix_row(F, m); SEAM(4); }
    if (IN(5)) {
        pg8::Gemm g{F.YB, F.Wout_t, M, D, D}; pg8::StaticOrder S; S.init(M, D, F.G, (int)blockIdx.x);
        pg8::EpiRes E{F.in[I_X], F.X1, D, F.mod + 2 * D};
        pg8::gemm_phase<pg8::EpiRes, pg8::StaticOrder, PG8_ALIGN, PG8_SP2>(F.lds + RING_OFF, g, S, E);
        SEAM(5);
    }
    if (IN(6)) {
        for (int m = gw; m < M; m += NGW) { const float* mrow = F.mod + (size_t)(m >> 11) * NMODC;
            norm_mod_row(F.X1 + (size_t)m * D, F.HB + (size_t)m * D, F.in[I_N2G], mrow + 3 * D, mrow + 4 * D, F.lane); }
        SEAM(6);
    }
    if (IN(7)) {
        pg8::Gemm g{F.HB, F.Wgu_t, M, 2 * FF, D}; pg8::StaticOrder S; S.init(M, 2 * FF, F.G, (int)blockIdx.x);
        pg8::EpiSwiglu E{F.ACT, FF};
        pg8::gemm_phase<pg8::EpiSwiglu, pg8::StaticOrder, PG8_ALIGN, PG8_SP2>(F.lds + RING_OFF, g, S, E);
        SEAM(7);
    }
    if (IN(8)) {
        pg8::Gemm g{F.ACT, F.Wdn_t, M, D, FF}; pg8::StaticOrder S; S.init(M, D, F.G, (int)blockIdx.x);
        pg8::EpiRes E{F.X1, F.out, D, F.mod + 5 * D};
        pg8::gemm_phase<pg8::EpiRes, pg8::StaticOrder, PG8_ALIGN, PG8_SP2>(F.lds + RING_OFF, g, S, E);
        SEAM(8);
    }
    if (IN(9)) { for (int m = gw; m < M; m += NGW) final_norm_row(F.out + (size_t)m * D, F.in[I_FNG], F.lane); }
#undef IN
#undef SEAM
}

extern "C" void kernel_launch(void* const* d_in, const int* in_sizes, int n_in, void* d_out, int out_size, void* d_ws, size_t ws_size, hipStream_t stream) {
    static int grid = 0;
    if (grid == 0) {
        if (n_in != N_IN || in_sizes[I_X] != M * D || out_size != M * D || ws_size < WS_END) { fprintf(stderr, "kernel_launch: shape / workspace mismatch (n_in %d, x %d, out %d, ws %zu); nothing launched\n", n_in, n_in > 0 ? in_sizes[0] : -1, out_size, ws_size); grid = -1; return; }
        int dev = 0, cus = 0, per_cu = 0;
        if (hipGetDevice(&dev) != hipSuccess || hipDeviceGetAttribute(&cus, hipDeviceAttributeMultiprocessorCount, dev) != hipSuccess) { fprintf(stderr, "kernel_launch: device query failed\n"); grid = -1; return; }
        if (hipFuncSetAttribute((const void*)fwd_kernel, hipFuncAttributeMaxDynamicSharedMemorySize, LDS_BYTES) != hipSuccess) { fprintf(stderr, "kernel_launch: hipFuncSetAttribute failed\n"); grid = -1; return; }
        if (hipOccupancyMaxActiveBlocksPerMultiprocessor(&per_cu, (const void*)fwd_kernel, NWAVES * 64, LDS_BYTES) != hipSuccess || per_cu < 1)
            fprintf(stderr, "kernel_launch: note: occupancy query reports %d workgroups per CU\n", per_cu);
        (void)hipGetLastError();
        grid = cus;
    }
    if (grid < 0) return;
    if (hipMemsetAsync((char*)d_ws + WS_CTL, 0, CTL_ZERO_BYTES, stream) != hipSuccess) { fprintf(stderr, "kernel_launch: memset failed\n"); return; }
    Args a{};
    for (int i = 0; i < N_IN; ++i) a.in[i] = (const float*)d_in[i];
    a.out = (float*)d_out; a.ws = (unsigned char*)d_ws;
    for (int li = 0; li < N_LAUNCHES; ++li) {
        a.ph_lo = (N_LAUNCHES == 1) ? 0 : li; a.ph_hi = (N_LAUNCHES == 1) ? N_PHASES : li + 1;
        hipLaunchKernelGGL(fwd_kernel, dim3(grid), dim3(NWAVES * 64), LDS_BYTES, stream, a);
        const hipError_t le = hipPeekAtLastError();
        if (le != hipSuccess) { fprintf(stderr, "kernel_launch: launch %d failed: %s\n", li, hipGetErrorName(le)); break; }
    }
}
```

```cpp
#include <hip/hip_runtime.h>
#include <cstdio>
#include <cstdint>
namespace pg8 {
#define PG8_LAS __attribute__((address_space(3)))
typedef unsigned short bf16_t;
typedef short bf16x8 __attribute__((ext_vector_type(8)));
typedef float f32x4 __attribute__((ext_vector_type(4)));
typedef unsigned u32x4 __attribute__((ext_vector_type(4)));
constexpr int BM = 256, BK = 64, HALF = 128, HTB = HALF * BK * 2  , STAGE_BYTES = 8 * HTB, NXCD = 8, WGM = 8;

__host__ __device__ __forceinline__ int lds_byte(int r, int c) { const int st = (r >> 4) * 2 + (c >> 5), rr = r & 15, cc = c & 31, ob = rr * 64 + cc * 2; return st * 1024 + (ob ^ (((ob >> 9) & 1) << 5)); }
__host__ __device__ __forceinline__ void stage_rc(int b, int& R, int& C) { const int st = b / 1024, sb = b % 1024, swz = sb ^ (((sb >> 9) & 1) << 5); R = (st >> 1) * 16 + swz / 64; C = (st & 1) * 32 + (swz % 64) / 2; }
__host__ __device__ __forceinline__ int perm32(int rho) { const int n = rho >> 4, i = rho & 15; return 8 * (i >> 2) + 4 * n + (i & 3); }

struct Unit { int pm, pn; };
struct Gemm { const bf16_t* A; const bf16_t* Bt; int M, N, K; };

struct StaticOrder {
    int nM, nN, nwg, G, c;
    __host__ __device__ void init(int M, int N, int G_, int c_) { nM = M / BM; nN = N / BM; nwg = nM * nN; G = G_; c = c_; }
    __host__ __device__ bool next(int i, Unit& u) const {
        const long L = (long)i * G + c; if (L >= nwg) return false;
        int wgid = (int)L; { const int q = nwg / NXCD, r = nwg % NXCD, xcd = wgid % NXCD, off = wgid / NXCD; wgid = (xcd < r ? xcd * (q + 1) : r * (q + 1) + (xcd - r) * q) + off; }
        const int nig = WGM * nN, gid = wgid / nig, fm = gid * WGM, gsz = (nM - fm) < WGM ? (nM - fm) : WGM;
        u.pm = fm + ((wgid % nig) % gsz); u.pn = (wgid % nig) / gsz; return true;
    }
    __device__ __forceinline__ void a_ready(const Unit&) const {}
    __device__ __forceinline__ void done(const Unit&) const {}
};

__device__ __forceinline__ unsigned cvt_pk_bf16(float lo, float hi) { unsigned r; asm volatile("v_cvt_pk_bf16_f32 %0, %1, %2" : "=v"(r) : "v"(lo), "v"(hi)); return r; }
typedef float f32x2 __attribute__((ext_vector_type(2)));
typedef __bf16 bf16v2 __attribute__((ext_vector_type(2)));
__device__ __forceinline__ unsigned pkbf(float lo, float hi) { f32x2 v = {lo, hi}; bf16v2 r = __builtin_convertvector(v, bf16v2); return __builtin_bit_cast(unsigned, r); }

struct EpiIn {
    static constexpr bool PERM = true, AFTER_DRAIN = false;
    bf16_t *Q, *Kd, *Vd, *Cd; const float* rope; float qscale;
    __device__ __forceinline__ void operator()(const f32x4 (&acc)[2][2][4][2], const Unit& u, int wr, int wc, int fr, int fq) const {
        const int reg = u.pn >> 3;
        bf16_t* base; int ldc, colt; bool rot = false; float sc = 1.f;
        if (reg == 0) { base = Q; ldc = 2048; colt = u.pn * BM; rot = true; sc = qscale; }
        else if (reg == 1) { base = Kd; ldc = 2048; colt = (u.pn - 8) * BM; rot = (u.pm < 32); }
        else if (reg == 2) { base = Vd; ldc = 2048; colt = (u.pn - 16) * BM; }
        else { base = Cd; ldc = 6144; colt = (u.pn - 24) * BM; }
        const int row0 = u.pm * BM + wr * 64 + fr, col0 = colt + wc * 32 + 8 * fq;
        const int blk = wc >> 1, i0 = 4 * ((4 * wc + fq) & 7);
        f32x4 cs[2], sn[2];
        cs[0] = (f32x4){1.f, 1.f, 1.f, 1.f}; sn[0] = (f32x4){0.f, 0.f, 0.f, 0.f}; cs[1] = cs[0]; sn[1] = sn[0];
        if (rot) { const int t = row0 & 2047, pos = blk ? (t & 63) : (t >> 6); cs[0] = *(const f32x4*)(rope + pos * 32 + i0); sn[0] = *(const f32x4*)(rope + 2048 + pos * 32 + i0); }
#pragma unroll
        for (int gi = 0; gi < 8; ++gi) { const int ai = gi >> 2, m = gi & 3; const int r = row0 + ai * HALF + m * 16; bf16_t* rowp = base + (size_t)r * ldc + col0;
            if (gi < 7 && rot) { const int rn = row0 + ((gi + 1) >> 2) * HALF + ((gi + 1) & 3) * 16, t = rn & 2047, pos = blk ? (t & 63) : (t >> 6);
                cs[(gi + 1) & 1] = *(const f32x4*)(rope + pos * 32 + i0); sn[(gi + 1) & 1] = *(const f32x4*)(rope + 2048 + pos * 32 + i0); }
            const f32x4 cs4 = cs[gi & 1], sn4 = sn[gi & 1];
#pragma unroll
            for (int bj = 0; bj < 2; ++bj) { const f32x4 a = acc[ai][bj][m][0], b = acc[ai][bj][m][1];
                const f32x4 v0 = (a * cs4 - b * sn4) * sc, v1 = (a * sn4 + b * cs4) * sc;
                u32x4 w; w.x = pkbf(v0[0], v0[1]); w.y = pkbf(v0[2], v0[3]); w.z = pkbf(v1[0], v1[1]); w.w = pkbf(v1[2], v1[3]);
                *(u32x4*)(rowp + bj * HALF) = w; }
            asm volatile("" ::: "memory"); }
    }
};
struct EpiRes {
    static constexpr bool PERM = false, AFTER_DRAIN = false;
    const float* resid; float* out; int ldc; const float* gate;
    __device__ __forceinline__ void operator()(const f32x4 (&acc)[2][2][4][2], const Unit& u, int wr, int wc, int fr, int fq) const {
        const int row0 = u.pm * BM + wr * 64 + fr, col0 = u.pn * BM + wc * 32 + 4 * fq;
        const float* gp = gate + (size_t)(u.pm >> 3) * 24576 + col0;
        f32x4 gv[2][2];
#pragma unroll
        for (int bj = 0; bj < 2; ++bj)
#pragma unroll
            for (int n = 0; n < 2; ++n) gv[bj][n] = *(const f32x4*)(gp + bj * HALF + n * 16);
        f32x4 rs[2][2][2];
#pragma unroll
        for (int bj = 0; bj < 2; ++bj)
#pragma unroll
            for (int n = 0; n < 2; ++n) rs[0][bj][n] = *(const f32x4*)(resid + (size_t)row0 * ldc + col0 + bj * HALF + n * 16);
#pragma unroll
        for (int gi = 0; gi < 8; ++gi) { const int ai = gi >> 2, m = gi & 3; const size_t off = (size_t)(row0 + ai * HALF + m * 16) * ldc + col0;
            if (gi < 7) { const size_t offn = (size_t)(row0 + ((gi + 1) >> 2) * HALF + ((gi + 1) & 3) * 16) * ldc + col0;
#pragma unroll
                for (int bj = 0; bj < 2; ++bj)
#pragma unroll
                    for (int n = 0; n < 2; ++n) rs[(gi + 1) & 1][bj][n] = *(const f32x4*)(resid + offn + bj * HALF + n * 16); }
#pragma unroll
            for (int bj = 0; bj < 2; ++bj)
#pragma unroll
                for (int n = 0; n < 2; ++n) *(f32x4*)(out + off + bj * HALF + n * 16) = rs[gi & 1][bj][n] + gv[bj][n] * acc[ai][bj][m][n];
            asm volatile("" ::: "memory"); }
    }
};
struct EpiSwiglu {
    static constexpr bool PERM = true, AFTER_DRAIN = false;
    bf16_t* O; int ldc;
    __device__ __forceinline__ void operator()(const f32x4 (&acc)[2][2][4][2], const Unit& u, int wr, int wc, int fr, int fq) const {
        const int row0 = u.pm * BM + wr * 64 + fr, col0 = u.pn * HALF + wc * 32 + 8 * fq;
#pragma unroll
        for (int ai = 0; ai < 2; ++ai)
#pragma unroll
            for (int m = 0; m < 4; ++m) { bf16_t* rowp = O + (size_t)(row0 + ai * HALF + m * 16) * ldc + col0;
                float o[8];
#pragma unroll
                for (int n = 0; n < 2; ++n)
#pragma unroll
                    for (int j = 0; j < 4; ++j) { const float gt = acc[ai][0][m][n][j], up = acc[ai][1][m][n][j];
                        o[4 * n + j] = gt * __builtin_amdgcn_rcpf(1.0f + __builtin_amdgcn_exp2f(-1.44269504089f * gt)) * up; }
                u32x4 w; w.x = pkbf(o[0], o[1]); w.y = pkbf(o[2], o[3]); w.z = pkbf(o[4], o[5]); w.w = pkbf(o[6], o[7]);
                *(u32x4*)rowp = w; }
    }
};
struct InOrder {
    StaticOrder so; int G, c;
    __host__ __device__ void init(int G_, int c_) { so.init(8192, 12288, G_, c_); G = G_; c = c_; }
    __host__ __device__ bool next(int i, Unit& u) const {
        const long L = (long)i * G + c; if (L >= 1600) return false;
        if (L < 1536) return so.next(i, u);
        const int e = (int)L - 1536; u.pm = 32 + (e & 3); u.pn = 8 + (e >> 2); return true;
    }
    __device__ __forceinline__ void a_ready(const Unit&) const {}
    __device__ __forceinline__ void done(const Unit&) const {}
};
template <class Epi, class Sched, bool ALIGN_EPI = false, bool SP2 = false>
__device__ __forceinline__ void gemm_phase(PG8_LAS unsigned char* lds, const Gemm g, const Sched& S, const Epi& E) {
    const int tid = threadIdx.x, wid = __builtin_amdgcn_readfirstlane(tid >> 6), lane = tid & 63, wr = wid >> 2, wc = wid & 3, fr = lane & 15, fq = lane >> 4;
    const int K = g.K, nt = K / BK;
    unsigned voffA[2], voffB[2];
#pragma unroll
    for (int i = 0; i < 2; ++i) { int R, C; stage_rc(tid * 16 + i * 8192, R, C); const int Rb = Epi::PERM ? ((R & ~31) + perm32(R & 31)) : R;
        voffA[i] = (unsigned)(R * K + C) * 2u; voffB[i] = (unsigned)(Rb * K + C) * 2u; }
    const size_t kstep = (size_t)(BK * 2);
    const size_t hstep = (size_t)HALF * K * 2;
    const size_t tstep = 2 * hstep;
    const unsigned ldsw = (unsigned)wid * 1024u;
    const int aoff = lds_byte(wr * 64 + fr, fq * 8), boff = lds_byte(wc * 32 + fr, fq * 8);
#define PG8_SA(b, h) (((b) * 2 + (h)) * HTB)
#define PG8_SB(b, h) ((4 + (b) * 2 + (h)) * HTB)
#define PG8_STAGE(bufoff, gbase, voff) do { _Pragma("unroll") for (int _i = 0; _i < 2; ++_i) \
        __builtin_amdgcn_global_load_lds((const unsigned*)((const char*)(gbase) + (voff)[_i]), (PG8_LAS unsigned*)(lds + (bufoff) + ldsw + _i * 8192), 16, 0, 0); } while (0)
#define PG8_LDA(dst, b, h) do { _Pragma("unroll") for (int m = 0; m < 4; ++m) _Pragma("unroll") for (int k = 0; k < 2; ++k) dst[m][k] = *(const PG8_LAS bf16x8*)(lds + PG8_SA(b, h) + aoff + m * 2048 + k * 1024); } while (0)
#define PG8_LDB(dst, b, h) do { _Pragma("unroll") for (int n = 0; n < 2; ++n) _Pragma("unroll") for (int k = 0; k < 2; ++k) dst[n][k] = *(const PG8_LAS bf16x8*)(lds + PG8_SB(b, h) + boff + n * 2048 + k * 1024); } while (0)
#define PG8_MMA(ai, bj, At, Bt) do { __builtin_amdgcn_s_setprio(1); _Pragma("unroll") for (int m = 0; m < 4; ++m) _Pragma("unroll") for (int n = 0; n < 2; ++n) _Pragma("unroll") for (int k = 0; k < 2; ++k) \
        acc[ai][bj][m][n] = __builtin_amdgcn_mfma_f32_16x16x32_bf16(Bt[n][k], At[m][k], acc[ai][bj][m][n], 0, 0, 0); __builtin_amdgcn_s_setprio(0); } while (0)
#define PG8_WAIT_V(n) asm volatile("s_waitcnt vmcnt(" #n ")" ::: "memory")
#define PG8_WAIT_L(n) asm volatile("s_waitcnt lgkmcnt(" #n ")" ::: "memory")
#define PG8_BAR __builtin_amdgcn_s_barrier()
#define PG8_SCHED __builtin_amdgcn_sched_barrier(0)
    Unit cur, nxt; int ui = 0;
    if (!S.next(0, cur)) return;
    f32x4 acc[2][2][4][2];
#pragma unroll
    for (int a = 0; a < 2; ++a)
#pragma unroll
        for (int b = 0; b < 2; ++b)
#pragma unroll
            for (int m = 0; m < 4; ++m)
#pragma unroll
                for (int n = 0; n < 2; ++n) acc[a][b][m][n] = (f32x4){0.f, 0.f, 0.f, 0.f};
    bf16x8 At[4][2], B0[2][2], B1[2][2];
    const char* cA = (const char*)g.A + (size_t)cur.pm * tstep; const char* cB = (const char*)g.Bt + (size_t)cur.pn * tstep;
    S.a_ready(cur);
    if constexpr (SP2) {
        PG8_STAGE(PG8_SB(0, 0), cB, voffB); PG8_STAGE(PG8_SB(0, 1), cB + hstep, voffB); PG8_STAGE(PG8_SA(0, 0), cA, voffA); PG8_STAGE(PG8_SA(0, 1), cA + hstep, voffA);
        if (wr == 1) PG8_BAR;
        PG8_WAIT_V(2); PG8_BAR;
        PG8_STAGE(PG8_SB(1, 0), cB + kstep, voffB); PG8_STAGE(PG8_SA(1, 0), cA + kstep, voffA); PG8_STAGE(PG8_SB(1, 1), cB + hstep + kstep, voffB);
        PG8_WAIT_V(6); PG8_BAR;
    } else {
        PG8_STAGE(PG8_SB(0, 0), cB, voffB); PG8_STAGE(PG8_SA(0, 0), cA, voffA); PG8_STAGE(PG8_SB(0, 1), cB + hstep, voffB); PG8_STAGE(PG8_SA(0, 1), cA + hstep, voffA);
        if (wr == 1) PG8_BAR;
        PG8_WAIT_V(4); PG8_BAR;
        PG8_STAGE(PG8_SB(1, 0), cB + kstep, voffB); PG8_STAGE(PG8_SA(1, 0), cA + kstep, voffA); PG8_STAGE(PG8_SB(1, 1), cB + hstep + kstep, voffB);
        PG8_WAIT_V(6); PG8_BAR;
    }
    for (;;) {
        const bool has_next = S.next(ui + 1, nxt);
        const char* nA = has_next ? (const char*)g.A + (size_t)nxt.pm * tstep : cA; const char* nB = has_next ? (const char*)g.Bt + (size_t)nxt.pn * tstep : cB;
        for (int t = 0; t < nt; t += 2) {
            const bool last = (t == nt - 2);
            const char* a1 = cA + (size_t)(t + 1) * kstep;
            const char* a2 = last ? nA : cA + (size_t)(t + 2) * kstep; const char* b2 = last ? nB : cB + (size_t)(t + 2) * kstep;
            const char* a3 = a2 + kstep; const char* b3 = b2 + kstep;
            if (last && has_next) S.a_ready(nxt);
            if constexpr (SP2) {
            PG8_LDB(B0, 0, 0); PG8_LDB(B1, 0, 1); PG8_SCHED; PG8_LDA(At, 0, 0); PG8_STAGE(PG8_SA(1, 1), a1 + hstep, voffA);
            PG8_WAIT_V(8); PG8_WAIT_L(0); PG8_BAR; PG8_MMA(0, 0, At, B0); PG8_MMA(0, 1, At, B1); PG8_BAR; PG8_SCHED;
            PG8_LDA(At, 0, 1); PG8_STAGE(PG8_SB(0, 0), b2, voffB); PG8_STAGE(PG8_SB(0, 1), b2 + hstep, voffB); PG8_STAGE(PG8_SA(0, 0), a2, voffA);
            PG8_WAIT_V(8); PG8_WAIT_L(0); PG8_BAR; PG8_MMA(1, 0, At, B0); PG8_MMA(1, 1, At, B1); PG8_BAR; PG8_SCHED;
            PG8_LDB(B0, 1, 0); PG8_LDB(B1, 1, 1); PG8_SCHED; PG8_LDA(At, 1, 0); PG8_STAGE(PG8_SA(0, 1), a2 + hstep, voffA);
            PG8_WAIT_V(8); PG8_WAIT_L(0); PG8_BAR; PG8_MMA(0, 0, At, B0); PG8_MMA(0, 1, At, B1); PG8_BAR; PG8_SCHED;
            PG8_LDA(At, 1, 1); PG8_STAGE(PG8_SB(1, 0), b3, voffB); PG8_STAGE(PG8_SB(1, 1), b3 + hstep, voffB); PG8_STAGE(PG8_SA(1, 0), a3, voffA);
            PG8_WAIT_V(8); PG8_WAIT_L(0); PG8_BAR; PG8_MMA(1, 0, At, B0); PG8_MMA(1, 1, At, B1); PG8_BAR; PG8_SCHED;
            } else {
            PG8_LDB(B0, 0, 0); PG8_SCHED; PG8_LDA(At, 0, 0); PG8_STAGE(PG8_SA(1, 1), a1 + hstep, voffA);
            PG8_WAIT_L(8); PG8_BAR; PG8_WAIT_L(0); PG8_MMA(0, 0, At, B0); PG8_BAR; PG8_SCHED;
            PG8_LDB(B1, 0, 1); PG8_STAGE(PG8_SB(0, 0), b2, voffB);
            PG8_BAR; PG8_WAIT_L(0); PG8_MMA(0, 1, At, B1); PG8_BAR;
            PG8_LDA(At, 0, 1); PG8_STAGE(PG8_SA(0, 0), a2, voffA);
            PG8_BAR; PG8_WAIT_L(0); PG8_MMA(1, 0, At, B0); PG8_BAR; PG8_SCHED;
            PG8_STAGE(PG8_SB(0, 1), b2 + hstep, voffB);
            PG8_WAIT_V(6); PG8_BAR; PG8_MMA(1, 1, At, B1); PG8_BAR;
            PG8_LDB(B0, 1, 0); PG8_SCHED; PG8_LDA(At, 1, 0); PG8_STAGE(PG8_SA(0, 1), a2 + hstep, voffA);
            PG8_WAIT_L(8); PG8_BAR; PG8_WAIT_L(0); PG8_MMA(0, 0, At, B0); PG8_BAR; PG8_SCHED;
            PG8_LDB(B1, 1, 1); PG8_STAGE(PG8_SB(1, 0), b3, voffB);
            PG8_BAR; PG8_WAIT_L(0); PG8_MMA(0, 1, At, B1); PG8_BAR;
            PG8_LDA(At, 1, 1); PG8_STAGE(PG8_SA(1, 0), a3, voffA);
            PG8_BAR; PG8_WAIT_L(0); PG8_MMA(1, 0, At, B0); PG8_BAR; PG8_SCHED;
            PG8_STAGE(PG8_SB(1, 1), b3 + hstep, voffB);
            PG8_WAIT_V(6); PG8_BAR; PG8_MMA(1, 1, At, B1); PG8_BAR;
            }
        }
        if constexpr (ALIGN_EPI) { if (wr == 0) PG8_BAR; }
        if constexpr (!Epi::AFTER_DRAIN) { E(acc, cur, wr, wc, fr, fq); S.done(cur); }
        if (!has_next) break;
#pragma unroll
        for (int a = 0; a < 2; ++a)
#pragma unroll
            for (int b = 0; b < 2; ++b)
#pragma unroll
                for (int m = 0; m < 4; ++m)
#pragma unroll
                    for (int n = 0; n < 2; ++n) acc[a][b][m][n] = (f32x4){0.f, 0.f, 0.f, 0.f};
        cur = nxt; cA = nA; cB = nB; ++ui;
        if constexpr (ALIGN_EPI) { if (wr == 1) PG8_BAR; }
    }
    PG8_WAIT_V(0);
    if constexpr (!ALIGN_EPI) { if (wr == 0) PG8_BAR; }
    PG8_BAR;
    if constexpr (Epi::AFTER_DRAIN) { E.fused(acc, cur, wr, wc, fr, fq, lds, wid, lane); S.done(cur); }
#undef PG8_SA
#undef PG8_SB
#undef PG8_STAGE
#undef PG8_LDA
#undef PG8_LDB
#undef PG8_MMA
#undef PG8_WAIT_V
#undef PG8_WAIT_L
#undef PG8_BAR
#undef PG8_SCHED
}
}
#ifndef PG8_SP2
#define PG8_SP2 true
#endif
#ifndef PG8_ALIGN
#define PG8_ALIGN true
#endif
constexpr int NWAVES = 8;
#ifndef MK_N_LAUNCHES
#define MK_N_LAUNCHES 1
#endif
constexpr int N_PHASES = 10;
constexpr int N_LAUNCHES = MK_N_LAUNCHES;

constexpr int D = 4096, NB = 4, SEQ = 2048, M = NB * SEQ, CTXL = 256, MC = NB * CTXL, MT = M + MC;
constexpr int HD = 128, NAH = 16, NAW = 2048, CVW = 2048, INC = 12288, FF = 11008, NMODC = 6 * D;
constexpr int GRIDW = 64, ROWS = 32, NAKH = 8, NAKW = 16;
constexpr float EPS = 1e-6f, LOG2E = 1.44269504089f;
enum { I_X = 0, I_C, I_CTX, I_CCTX, I_ADAW, I_ADAB, I_N1G, I_WIN, I_CONVW, I_RPB, I_GNG, I_WOUT, I_N2G, I_WGU, I_WDN, I_FNG, N_IN };

constexpr size_t MiB = 1u << 20;
constexpr size_t WS_CTL = 0, WS_MOD = 1 * MiB, CTL_ZERO_BYTES = 2 * MiB;
constexpr size_t WS_ROPE = 2 * MiB;
constexpr size_t WS_WIN = 4 * MiB, WS_WOUT = 100 * MiB, WS_WGU = 132 * MiB, WS_WDN = 304 * MiB;
constexpr size_t WS_H = 390 * MiB;
constexpr size_t WS_Q = 462 * MiB;
constexpr size_t WS_K = 494 * MiB;
constexpr size_t WS_V = 530 * MiB;
constexpr size_t WS_C = 566 * MiB;
constexpr size_t WS_AO = 662 * MiB;
constexpr size_t WS_Y = 694 * MiB;
constexpr size_t WS_X1 = 758 * MiB;
constexpr size_t WS_ACT = 886 * MiB;
constexpr size_t WS_END = 1058 * MiB;
static_assert(WS_WIN + (size_t)INC * D * 2 <= WS_WOUT && WS_WOUT + (size_t)D * D * 2 <= WS_WGU && WS_WGU + (size_t)2 * FF * D * 2 <= WS_WDN && WS_WDN + (size_t)D * FF * 2 <= WS_H, "ws map (weights)");
static_assert(WS_H + (size_t)MT * D * 2 <= WS_Q && WS_Q + (size_t)M * NAW * 2 <= WS_K && WS_K + (size_t)MT * NAW * 2 <= WS_V && WS_V + (size_t)MT * NAW * 2 <= WS_C && WS_C + (size_t)M * 6144 * 2 <= WS_AO, "ws map (acts 1)");
static_assert(WS_AO + (size_t)M * NAW * 2 <= WS_Y && WS_Y + (size_t)M * D * 2 <= WS_X1 && WS_X1 + (size_t)M * D * 4 <= WS_ACT && WS_ACT + (size_t)M * FF * 2 <= WS_END, "ws map (acts 2)");
constexpr int CW_BAR = 4096;

#ifndef P0_DN_ITEMS
#define P0_DN_ITEMS 8192
#endif
constexpr int RING_OFF = 0, RING_BYTES = 131072;
constexpr int LDSCTL_OFF = RING_BYTES, MISC_OFF = LDSCTL_OFF + 320;
constexpr int LDS_BYTES = 147456;
static_assert(MISC_OFF + 128 <= LDS_BYTES, "LDS map");

#define GAS __attribute__((address_space(1)))
#define LAS __attribute__((address_space(3)))
typedef unsigned short bf16;
typedef unsigned v4u __attribute__((ext_vector_type(4)));
typedef float f32x4 __attribute__((ext_vector_type(4)));
typedef short bf16x8 __attribute__((ext_vector_type(8)));
typedef GAS unsigned gu32;
typedef GAS unsigned long long gu64;
#define RLX_AGENT __ATOMIC_RELAXED, __HIP_MEMORY_SCOPE_AGENT
#define LDS_WAIT() asm volatile("s_waitcnt lgkmcnt(0)" ::: "memory")
#define VM_WAIT() asm volatile("s_waitcnt vmcnt(0)" ::: "memory")
__device__ __forceinline__ unsigned long long rt() { return __builtin_amdgcn_s_memrealtime(); }
__device__ __forceinline__ unsigned f2bf(float f) { unsigned u = __builtin_bit_cast(unsigned, f); return (u + 0x7fffu + ((u >> 16) & 1u)) >> 16; }
__device__ __forceinline__ unsigned pk2(float lo, float hi) { return f2bf(lo) | (f2bf(hi) << 16); }

#define XB_TMO      128
#define XB_XCNT(j)  (256  + 64 * (j))
#define XB_XSUB(j)  (1280 + 64 * (j))
#define XB_XGEN(j)  (2304 + 64 * (j))
#define XB_TOP      3328
#define XB_TOPGEN   3392
#define XCD_BAR_WORDS 3456
#define XB_SPIN_CAP (1u << 18)

__device__ __forceinline__ unsigned xb_ld(unsigned* p)              { return __hip_atomic_load(p, __ATOMIC_RELAXED, __HIP_MEMORY_SCOPE_AGENT); }
__device__ __forceinline__ unsigned xb_add(unsigned* p, unsigned v) { return __hip_atomic_fetch_add(p, v, __ATOMIC_RELAXED, __HIP_MEMORY_SCOPE_AGENT); }
__device__ __forceinline__ unsigned xb_xcc_id() { return (unsigned)__builtin_amdgcn_s_getreg((3 << 11) | 20) & 0xFu; }
#define XB_SPIN(cond, bar) do { unsigned _sp = 0; while (cond) { __builtin_amdgcn_s_sleep(1); \
    if ((++_sp & 255u) == 0u) { if (xb_ld(&(bar)[XB_TMO])) break; if (_sp > XB_SPIN_CAP) { atomicAdd(&(bar)[XB_TMO], 1u); break; } } } } while (0)

struct XcdBarrier {
    unsigned* bar; unsigned x;
    volatile LAS unsigned* st;
};

__device__ __forceinline__ XcdBarrier xcd_barrier_post(unsigned* bar, volatile LAS unsigned* st) {
    XcdBarrier b; b.bar = bar; b.x = xb_xcc_id(); b.st = st;
    if (threadIdx.x == 0) (void)xb_add(&bar[XB_XCNT(b.x)], 1u);
    return b;
}
__device__ __forceinline__ void xcd_barrier_complete(unsigned* bar, unsigned x, unsigned& nloc, unsigned& nx) {
    const unsigned G = gridDim.x * gridDim.y * gridDim.z;
    unsigned sum, cnt, mine, sp = 0u;
    for (;;) {
        sum = 0u; cnt = 0u; mine = 0u;
#pragma unroll
        for (unsigned j = 0; j < 16; ++j) { const unsigned c = xb_ld(&bar[XB_XCNT(j)]); sum += c; cnt += (c > 0u) ? 1u : 0u; mine = (j == x) ? c : mine; }
        if (sum == G) break;
        __builtin_amdgcn_s_sleep(1);
        if ((++sp & 255u) == 0u) { if (xb_ld(&bar[XB_TMO])) break; if (sp > XB_SPIN_CAP) { atomicAdd(&bar[XB_TMO], 1u); break; } }
    }
    nloc = mine > 0u ? mine : 1u; nx = cnt > 0u ? cnt : 1u;
}

__device__ __forceinline__ void xcd_barrier(const XcdBarrier& b) {
    asm volatile("s_waitcnt vmcnt(0)" ::: "memory");
    __syncthreads();
    if (threadIdx.x == 0) {
        unsigned* bar = b.bar;
        __builtin_amdgcn_s_waitcnt(0);
        unsigned nloc = b.st[0], nx = b.st[1];
        if (nloc == 0u) { xcd_barrier_complete(bar, b.x, nloc, nx); b.st[0] = nloc; b.st[1] = nx; }
        const unsigned old = xb_add(&bar[XB_XSUB(b.x)], 1u);
        const unsigned gen = old / nloc;
        if (old + 1u == (gen + 1u) * nloc) {
            __builtin_amdgcn_fence(__ATOMIC_RELEASE, "agent");
            asm volatile("s_waitcnt vmcnt(0)" ::: "memory");
            const unsigned og = xb_add(&bar[XB_TOP], 1u);
            const unsigned tg = og / nx;
            if (og + 1u == (tg + 1u) * nx) xb_add(&bar[XB_TOPGEN], 1u);
            else XB_SPIN(xb_ld(&bar[XB_TOPGEN]) == tg, bar);
            __builtin_amdgcn_fence(__ATOMIC_ACQUIRE, "agent");
            xb_add(&bar[XB_XGEN(b.x)], 1u);
            asm volatile("s_waitcnt vmcnt(0)" ::: "memory");
        } else {
            XB_SPIN(xb_ld(&bar[XB_XGEN(b.x)]) == gen, bar);
            __builtin_amdgcn_fence(__ATOMIC_ACQUIRE, "agent");
            asm volatile("s_waitcnt vmcnt(0)" ::: "memory");
        }
    }
    __syncthreads();
}

typedef float f32x16 __attribute__((ext_vector_type(16)));
typedef unsigned v2u __attribute__((ext_vector_type(2)));
struct Frame {
    LAS unsigned char* lds;
    volatile LAS unsigned* MISC;
    gu32* ctl;
    int tid, lane, wave, vcu, G;
    const float* in[N_IN]; float* out;
    float* mod; float* rope;
    bf16 *Win_t, *Wout_t, *Wgu_t, *Wdn_t;
    bf16 *HB, *QB, *KB, *VB, *CB, *AO, *YB, *ACT; float* X1;
};
template <int CTRL> __device__ __forceinline__ float dpp_add(float v) { return v + __builtin_bit_cast(float, __builtin_amdgcn_update_dpp(0, __builtin_bit_cast(int, v), CTRL, 0xf, 0xf, true)); }
__device__ __forceinline__ float wave_sum(float v) {
    v = dpp_add<0xB1>(v); v = dpp_add<0x4E>(v); v = dpp_add<0x141>(v); v = dpp_add<0x140>(v);
    v += __builtin_bit_cast(float, __builtin_amdgcn_ds_swizzle(__builtin_bit_cast(int, v), 0x401F));
    return __builtin_bit_cast(float, __builtin_amdgcn_readlane(__builtin_bit_cast(int, v), 0)) + __builtin_bit_cast(float, __builtin_amdgcn_readlane(__builtin_bit_cast(int, v), 32));
}
__device__ __forceinline__ unsigned pkbf(float lo, float hi) { return pg8::pkbf(lo, hi); }
__device__ __forceinline__ float bflo(unsigned w) { return __builtin_bit_cast(float, w << 16); }
__device__ __forceinline__ float bfhi(unsigned w) { return __builtin_bit_cast(float, w & 0xffff0000u); }

__device__ __forceinline__ int map_in(int n) {
    if (n < 4096) { const int hd = n & ~127, d = n & 127, blk = d >> 6, e4 = (d >> 5) & 1, i = d & 31; return hd + 64 * blk + 8 * (i >> 2) + 4 * e4 + (i & 3); }
    return n;
}
__device__ __forceinline__ int map_gu(int n) { const int up = n >= FF ? 1 : 0, jx = up ? n - FF : n; return 256 * (jx >> 7) + 128 * up + (jx & 127); }
template <int MAP> __device__ __forceinline__ void transpose_items(const float* W, int K, int N, bf16* WT, LAS float* scr, int first, int stride, int end, int lane) {
    const int nblk = N / 32;
    const GAS float* Wl = (const GAS float*)W + (size_t)(lane >> 3) * N + 4 * (lane & 7);
    LAS float* sw = scr + (lane >> 3) * 33 + 4 * (lane & 7);
    const int c = lane & 7;
    f32x4 v[8];
    int it = first;
    if (it < end) { const GAS float* Wg = Wl + (size_t)(64 * (it / nblk)) * N + 32 * (it % nblk);
#pragma unroll
        for (int i = 0; i < 8; ++i) v[i] = *(const GAS f32x4*)(Wg + (size_t)(8 * i) * N); }
    while (it < end) {
        const int k0 = 64 * (it / nblk), n0 = 32 * (it % nblk);
#pragma unroll
        for (int i = 0; i < 8; ++i) { sw[(8 * i) * 33 + 0] = v[i].x; sw[(8 * i) * 33 + 1] = v[i].y; sw[(8 * i) * 33 + 2] = v[i].z; sw[(8 * i) * 33 + 3] = v[i].w; }
        const int nx = it + stride;
        if (nx < end) { const GAS float* Wg = Wl + (size_t)(64 * (nx / nblk)) * N + 32 * (nx % nblk);
#pragma unroll
            for (int i = 0; i < 8; ++i) v[i] = *(const GAS f32x4*)(Wg + (size_t)(8 * i) * N); }
        LDS_WAIT(); asm volatile("" ::: "memory");
#pragma unroll
        for (int j = 0; j < 4; ++j) { const int n = (lane >> 3) + 8 * j; const LAS float* s = scr + (8 * c) * 33 + n;
            v4u o; o.x = pkbf(s[0 * 33], s[1 * 33]); o.y = pkbf(s[2 * 33], s[3 * 33]); o.z = pkbf(s[4 * 33], s[5 * 33]); o.w = pkbf(s[6 * 33], s[7 * 33]);
            const int nsrc = n0 + n, nd = MAP == 1 ? map_in(nsrc) : (MAP == 2 ? map_gu(nsrc) : nsrc);
            *(GAS v4u*)(WT + (size_t)nd * K + k0 + 8 * c) = o; }
        LDS_WAIT(); asm volatile("" ::: "memory");
        it = nx;
    }
}
constexpr int IT_IN = (D / 64) * (INC / 32), IT_OUT = (D / 64) * (D / 32), IT_GU = (D / 64) * (2 * FF / 32), IT_DN = (FF / 64) * (D / 32);
__device__ __forceinline__ void p0_prologue(Frame& F, const float amul) {
    { const int gi = blockIdx.x * (NWAVES * 64) + F.tid;
      if (gi < 2048) { const int pos = gi >> 5, i = gi & 31; const float fr = exp2f(-(float)i * (13.287712379549449f / 32.0f)); const float ang = (float)pos * fr;
          F.rope[gi] = cosf(ang); F.rope[2048 + gi] = sinf(ang); } }
    { LAS float* sil = (LAS float*)(F.lds + RING_OFF);
      LAS float* red = (LAS float*)(F.lds + RING_OFF + 16384);
      const GAS float* aw = (const GAS float*)F.in[I_ADAW];
      for (int it = blockIdx.x; it < 768; it += F.G) {
          const int cs = it % 96, ks = it / 96, k0 = 512 * ks;
          for (int idx = F.tid; idx < 5 * 512; idx += NWAVES * 64) { const int bb = idx >> 9, kk = idx & 511;
              const float v = bb < 4 ? F.in[I_C][bb * D + k0 + kk] : F.in[I_CCTX][k0 + kk]; sil[idx] = v / (1.0f + __expf(-v)); }
          __syncthreads();
          f32x4 a0 = {0.f, 0.f, 0.f, 0.f}, a1 = a0, a2 = a0, a3 = a0, a4 = a0;
          const GAS float* wp = aw + (size_t)(k0 + F.wave) * NMODC + 256 * cs + 4 * F.lane;
#pragma unroll 8
          for (int i = 0; i < 64; ++i) { const f32x4 w = *(const GAS f32x4*)(wp + (size_t)(8 * i) * NMODC); const int k = F.wave + 8 * i;
              a0 += sil[k] * w; a1 += sil[512 + k] * w; a2 += sil[1024 + k] * w; a3 += sil[1536 + k] * w; a4 += sil[2048 + k] * w; }
          LAS f32x4* rw = (LAS f32x4*)(red + F.wave * 1280) + F.lane;
          rw[0] = a0; rw[64] = a1; rw[128] = a2; rw[192] = a3; rw[256] = a4;
          __syncthreads();
          for (int idx = F.tid; idx < 1280; idx += NWAVES * 64) { float s = 0.f;
#pragma unroll
              for (int w = 0; w < 8; ++w) s += red[w * 1280 + idx];
              const int bb = idx >> 8, cc = idx & 255, n = 256 * cs + cc;
              if (ks == 0) s += F.in[I_ADAB][n];
              atomicAdd(F.mod + bb * NMODC + n, s * amul); }
          __syncthreads();
      } }
    LAS float* scr = (LAS float*)(F.lds + RING_OFF + F.wave * 16384);
    const int gw = F.vcu * NWAVES + F.wave, NGW = F.G * NWAVES;
    transpose_items<1>(F.in[I_WIN], D, INC, F.Win_t, scr, gw, NGW, IT_IN, F.lane);
    transpose_items<0>(F.in[I_WDN], FF, D, F.Wdn_t, scr, gw, NGW, P0_DN_ITEMS, F.lane);
}

__device__ __forceinline__ void norm_mod_row(const float* xrow, bf16* orow, const float* gain, const float* shift, const float* scale, int lane) {
    const GAS f32x4* xr = (const GAS f32x4*)xrow + lane;
    f32x4 v[16]; float ss = 0.f;
#pragma unroll
    for (int j = 0; j < 16; ++j) { v[j] = xr[64 * j]; ss += (v[j].x * v[j].x + v[j].y * v[j].y) + (v[j].z * v[j].z + v[j].w * v[j].w); }
    const float rstd = 1.0f / sqrtf(wave_sum(ss) * (1.0f / D) + EPS);
    const GAS f32x4* g4 = (const GAS f32x4*)gain + lane; const GAS f32x4* sh4 = (const GAS f32x4*)shift + lane; const GAS f32x4* sc4 = (const GAS f32x4*)scale + lane;
    GAS v2u* o8 = (GAS v2u*)orow + lane;
#pragma unroll
    for (int j = 0; j < 16; ++j) { const f32x4 g = g4[64 * j], sh = sh4[64 * j], sc = sc4[64 * j];
        const f32x4 y = v[j] * rstd * g * (1.0f + sc) + sh; v2u w; w.x = pkbf(y.x, y.y); w.y = pkbf(y.z, y.w); o8[64 * j] = w; }
}

#define MFMA32(a, b, c) __builtin_amdgcn_mfma_f32_32x32x16_bf16((a), (b), (c), 0, 0, 0)
__device__ __forceinline__ void attn_unit(const bf16* Qb, const bf16* Kb, const bf16* Vb, bf16* AO, const LAS float* rp, LAS bf16x8* qs, int b, int h, int r, int qblk, int lane) {
    const int j = lane & 31, g = lane >> 5;
    const int kap = (j & 19) | ((j & 4) << 1) | ((j & 8) >> 1);
    const size_t qtok = (size_t)b * SEQ + r * GRIDW + 32 * qblk + j;
    { const GAS bf16x8* qp = (const GAS bf16x8*)(Qb + qtok * NAW + HD * h + 8 * g); bf16x8 qf0[8];
#pragma unroll
      for (int kd = 0; kd < 8; ++kd) qf0[kd] = qp[2 * kd];
#pragma unroll
      for (int kd = 0; kd < 8; ++kd) qs[kd * 64 + lane] = qf0[kd]; }
    f32x16 o0, o1, o2, o3;
#pragma unroll
    for (int v = 0; v < 16; ++v) { o0[v] = 0.f; o1[v] = 0.f; o2[v] = 0.f; o3[v] = 0.f; }
    float m_run = -__builtin_inff(), l_run = 0.f;
    const int rs = min(max(r - NAKH / 2, 0), ROWS - NAKH);
    const int qc = 32 * qblk + j, cs = min(max(qc - NAKW / 2, 0), GRIDW - NAKW);
    const int bias_lane = (h * 15 + rs - r + NAKH - 1) * 31 + 8 * g - qc + NAKW - 1;
    const int mask_lane = 8 * g - cs;
#define KEYBASE(T) ((T) >= 8 ? (b * SEQ + (rs + (((T) - 8) >> 1)) * GRIDW + 32 * (((T) - 8) & 1)) : (M + b * CTXL + 32 * (T)))
#define LOADK(T) do { const GAS bf16x8* kp_ = (const GAS bf16x8*)(Kb + (size_t)(KEYBASE(T) + kap) * NAW + HD * h + 8 * g); \
        _Pragma("unroll") for (int kd = 0; kd < 8; ++kd) kf[kd] = kp_[2 * kd]; } while (0)
#define LOADV(T) do { const GAS v2u* vp_ = (const GAS v2u*)(Vb + (size_t)(KEYBASE(T) + 8 * g) * NAW + HD * h + 4 * j); \
        _Pragma("unroll") for (int jj = 0; jj < 8; ++jj) { w0[jj] = vp_[(size_t)jj * (NAW / 4)]; w1[jj] = vp_[(size_t)(16 + jj) * (NAW / 4)]; } } while (0)
#define VFRAG(W, SEL, XY) ({ v4u _t; _t.x = __builtin_amdgcn_perm(W[1].XY, W[0].XY, SEL); _t.y = __builtin_amdgcn_perm(W[3].XY, W[2].XY, SEL); \
        _t.z = __builtin_amdgcn_perm(W[5].XY, W[4].XY, SEL); _t.w = __builtin_amdgcn_perm(W[7].XY, W[6].XY, SEL); __builtin_bit_cast(bf16x8, _t); })
#define TILE(TN, LAT, KBLK, BROW) do { \
        f32x16 s; \
        _Pragma("unroll") for (int v = 0; v < 16; ++v) s[v] = 0.f; \
        { bf16x8 qf[8]; \
          _Pragma("unroll") for (int kd = 0; kd < 8; ++kd) qf[kd] = qs[kd * 64 + lane]; \
          _Pragma("unroll") for (int kd = 0; kd < 8; ++kd) s = MFMA32(kf[kd], qf[kd], s); } \
        LOADK(TN); \
        if (LAT) { int ml = mask_lane; asm volatile("" : "+v"(ml)); const LAS float* bp = (BROW); \
            _Pragma("unroll") for (int v = 0; v < 16; ++v) { const int c = 32 * (KBLK) + (v & 7) + 16 * (v >> 3); float bias = bp[c]; asm volatile("" : "+v"(bias)); \
                s[v] = ((unsigned)(c + ml) < 16u) ? s[v] + bias : -__builtin_inff(); } } \
        float mx = s[0]; \
        _Pragma("unroll") for (int v = 1; v < 16; ++v) mx = fmaxf(mx, s[v]); \
        mx = fmaxf(mx, __shfl_xor(mx, 32)); \
        const float m_new = fmaxf(m_run, mx); \
        const float alpha = __builtin_amdgcn_exp2f(m_run - m_new); \
        float ps = 0.f; \
        _Pragma("unroll") for (int v = 0; v < 16; ++v) { s[v] = __builtin_amdgcn_exp2f(s[v] - m_new); ps += s[v]; } \
        l_run = l_run * alpha + ps; m_run = m_new; \
        _Pragma("unroll") for (int v = 0; v < 16; ++v) { o0[v] *= alpha; o1[v] *= alpha; o2[v] *= alpha; o3[v] *= alpha; } \
        bf16x8 pf0, pf1; \
        { v4u t0, t1; t0.x = pkbf(s[0], s[1]); t0.y = pkbf(s[2], s[3]); t0.z = pkbf(s[4], s[5]); t0.w = pkbf(s[6], s[7]); \
          t1.x = pkbf(s[8], s[9]); t1.y = pkbf(s[10], s[11]); t1.z = pkbf(s[12], s[13]); t1.w = pkbf(s[14], s[15]); \
          pf0 = __builtin_bit_cast(bf16x8, t0); pf1 = __builtin_bit_cast(bf16x8, t1); } \
        const bf16x8 va0 = VFRAG(w0, 0x05040100u, x), va1 = VFRAG(w0, 0x07060302u, x), va2 = VFRAG(w0, 0x05040100u, y), va3 = VFRAG(w0, 0x07060302u, y); \
        const bf16x8 vb0 = VFRAG(w1, 0x05040100u, x), vb1 = VFRAG(w1, 0x07060302u, x), vb2 = VFRAG(w1, 0x05040100u, y), vb3 = VFRAG(w1, 0x07060302u, y); \
        LOADV(TN); \
        o0 = MFMA32(va0, pf0, o0); o1 = MFMA32(va1, pf0, o1); o2 = MFMA32(va2, pf0, o2); o3 = MFMA32(va3, pf0, o3); \
        o0 = MFMA32(vb0, pf1, o0); o1 = MFMA32(vb1, pf1, o1); o2 = MFMA32(vb2, pf1, o2); o3 = MFMA32(vb3, pf1, o3); \
    } while (0)
    bf16x8 kf[8]; v2u w0[8], w1[8];
    LOADK(0); LOADV(0);
    for (int t = 0; t < 8; ++t) TILE(t + 1, false, 0, rp);
    for (int q2 = 0; q2 < 8; ++q2) { const LAS float* brow = rp + bias_lane + 31 * q2;
        TILE(9 + 2 * q2, true, 0, brow);
        const int tn = q2 < 7 ? 10 + 2 * q2 : 23;
        TILE(tn, true, 1, brow); }
#undef TILE
#undef VFRAG
#undef KEYBASE
#undef LOADK
#undef LOADV
    const float l = l_run + __shfl_xor(l_run, 32), inv = 1.0f / l;
    GAS v2u* op = (GAS v2u*)(AO + qtok * NAW + HD * h);
#pragma unroll
    for (int v = 0; v < 16; ++v) { const int i = (v & 3) + 8 * (v >> 2) + 4 * g;
        v2u w; w.x = pkbf(o0[v] * inv, o1[v] * inv); w.y = pkbf(o2[v] * inv, o3[v] * inv); op[i] = w; }
}
__device__ __forceinline__ void attn_phase(Frame& F) {
    LAS float* rp = (LAS float*)(F.lds + RING_OFF + 1024);
    for (int i = F.tid; i < NAH * 15 * 31; i += NWAVES * 64) rp[i] = F.in[I_RPB][i] * LOG2E;
    __syncthreads();
    for (int wu = F.vcu; wu < NB * NAH * 8; wu += F.G) { const int bh = wu >> 3, rg = wu & 7;
        attn_unit(F.QB, F.KB, F.VB, F.AO, rp, (LAS bf16x8*)(F.lds + RING_OFF + 32768 + F.wave * 8192), bh >> 4, bh & 15, rg * 4 + (F.wave >> 1), F.wave & 1, F.lane); }
}

__device__ __forceinline__ void mix_row(Frame& F, int row) {
    unsigned lane = (unsigned)F.lane; const int t = row & (SEQ - 1);
    const GAS char* gg = (const GAS char*)F.in[I_GNG];
    asm volatile("" : "+v"(lane) :: "memory");
    { const GAS char* ap = (const GAS char*)(F.AO + (size_t)row * NAW); v4u a[4]; float ss = 0.f;
#pragma unroll
      for (int q = 0; q < 4; ++q) { a[q] = *(const GAS v4u*)(ap + (lane * 16u + q * 1024u));
#pragma unroll
          for (int e = 0; e < 4; ++e) { const float lo = bflo(a[q][e]), hi = bfhi(a[q][e]); ss += lo * lo + hi * hi; } }
      const float rstd = 1.0f / sqrtf(wave_sum(ss) * (1.0f / NAW) + EPS);
      GAS char* yp = (GAS char*)(F.YB + (size_t)row * D);
#pragma unroll
      for (int q = 0; q < 4; ++q) { const f32x4 g0 = *(const GAS f32x4*)(gg + (lane * 32u + q * 2048u)), g1 = *(const GAS f32x4*)(gg + (lane * 32u + q * 2048u + 16u)); v4u w;
          w.x = pkbf(bflo(a[q].x) * rstd * g0.x, bfhi(a[q].x) * rstd * g0.y); w.y = pkbf(bflo(a[q].y) * rstd * g0.z, bfhi(a[q].y) * rstd * g0.w);
          w.z = pkbf(bflo(a[q].z) * rstd * g1.x, bfhi(a[q].z) * rstd * g1.y); w.w = pkbf(bflo(a[q].w) * rstd * g1.z, bfhi(a[q].w) * rstd * g1.w);
          *(GAS v4u*)(yp + (lane * 16u + q * 1024u)) = w; } }
    { const GAS char* cw = (const GAS char*)F.in[I_CONVW];
      const GAS char* r0 = (const GAS char*)(F.CB + (size_t)row * 6144);
      const GAS char* rm = t > 0 ? r0 - 12288 : r0; const GAS char* rp = t < SEQ - 1 ? r0 + 12288 : r0;
      const float fm = t > 0 ? 1.f : 0.f, fp = t < SEQ - 1 ? 1.f : 0.f;
      float co[4][8]; float ss = 0.f;
#pragma unroll
      for (int q = 0; q < 4; ++q) { const unsigned vo = lane * 16u + q * 1024u, wo = lane * 32u + q * 2048u;
          if (q == 2) __builtin_amdgcn_sched_barrier(0);
          const v4u u0 = *(const GAS v4u*)(r0 + vo), gb = *(const GAS v4u*)(r0 + (vo + 4096u)), c0v = *(const GAS v4u*)(r0 + (vo + 8192u));
          const v4u um = *(const GAS v4u*)(rm + vo), cm = *(const GAS v4u*)(rm + (vo + 8192u)), upl = *(const GAS v4u*)(rp + vo), cpl = *(const GAS v4u*)(rp + (vo + 8192u));
          const f32x4 wa0 = *(const GAS f32x4*)(cw + wo), wa1 = *(const GAS f32x4*)(cw + (wo + 16u)), wb0 = *(const GAS f32x4*)(cw + (wo + 8192u)), wb1 = *(const GAS f32x4*)(cw + (wo + 8208u)),
                      wc0 = *(const GAS f32x4*)(cw + (wo + 16384u)), wc1 = *(const GAS f32x4*)(cw + (wo + 16400u));
#pragma unroll
          for (int e = 0; e < 4; ++e) {
              const float k0l = (e < 2 ? wa0[(2 * e) & 3] : wa1[(2 * e) & 3]) * fm, k0h = (e < 2 ? wa0[(2 * e + 1) & 3] : wa1[(2 * e + 1) & 3]) * fm;
              const float k1l = e < 2 ? wb0[(2 * e) & 3] : wb1[(2 * e) & 3], k1h = e < 2 ? wb0[(2 * e + 1) & 3] : wb1[(2 * e + 1) & 3];
              const float k2l = (e < 2 ? wc0[(2 * e) & 3] : wc1[(2 * e) & 3]) * fp, k2h = (e < 2 ? wc0[(2 * e + 1) & 3] : wc1[(2 * e + 1) & 3]) * fp;
              const float vl = bflo(gb[e]) * (k0l * (bflo(cm[e]) * bflo(um[e])) + k1l * (bflo(c0v[e]) * bflo(u0[e])) + k2l * (bflo(cpl[e]) * bflo(upl[e])));
              const float vh = bfhi(gb[e]) * (k0h * (bfhi(cm[e]) * bfhi(um[e])) + k1h * (bfhi(c0v[e]) * bfhi(u0[e])) + k2h * (bfhi(cpl[e]) * bfhi(upl[e])));
              co[q][2 * e] = vl; co[q][2 * e + 1] = vh; ss += vl * vl + vh * vh; } }
      const float rstd = 1.0f / sqrtf(wave_sum(ss) * (1.0f / CVW) + EPS);
      GAS char* yp = (GAS char*)(F.YB + (size_t)row * D + NAW);
#pragma unroll
      for (int q = 0; q < 4; ++q) { const unsigned wo = lane * 32u + q * 2048u; const f32x4 g0 = *(const GAS f32x4*)(gg + (8192u + wo)), g1 = *(const GAS f32x4*)(gg + (8192u + 16u + wo)); v4u w;
          w.x = pkbf(co[q][0] * rstd * g0.x, co[q][1] * rstd * g0.y); w.y = pkbf(co[q][2] * rstd * g0.z, co[q][3] * rstd * g0.w);
          w.z = pkbf(co[q][4] * rstd * g1.x, co[q][5] * rstd * g1.y); w.w = pkbf(co[q][6] * rstd * g1.z, co[q][7] * rstd * g1.w);
          *(GAS v4u*)(yp + (lane * 16u + q * 1024u)) = w; } }
}
__device__ __forceinline__ void final_norm_row(float* xrow, const float* gain, int lane) {
    GAS f32x4* xr = (GAS f32x4*)xrow + lane; const GAS f32x4* g4 = (const GAS f32x4*)gain + lane;
    f32x4 v[16]; float ss = 0.f;
#pragma unroll
    for (int j = 0; j < 16; ++j) { v[j] = xr[64 * j]; ss += (v[j].x * v[j].x + v[j].y * v[j].y) + (v[j].z * v[j].z + v[j].w * v[j].w); }
    const float rstd = 1.0f / sqrtf(wave_sum(ss) * (1.0f / D) + EPS);
#pragma unroll
    for (int j = 0; j < 16; ++j) xr[64 * j] = v[j] * rstd * g4[64 * j];
}

struct Args { const float* in[N_IN]; float* out; unsigned char* ws; int ph_lo, ph_hi; };
__global__ void __launch_bounds__(NWAVES * 64, 2) fwd_kernel(Args args) {
    extern __shared__ __attribute__((aligned(16))) unsigned char lds[];
    Frame F;
    F.lds = (LAS unsigned char*)lds;
    F.MISC = (volatile LAS unsigned*)(F.lds + MISC_OFF);
    F.tid = threadIdx.x; F.lane = F.tid & 63; F.wave = __builtin_amdgcn_readfirstlane(F.tid >> 6);
    F.G = gridDim.x; { const int bx = blockIdx.x; F.vcu = (F.G % 8 == 0) ? (bx % 8) * (F.G / 8) + bx / 8 : bx; }
    unsigned char* ws = args.ws;
    F.ctl = (gu32*)(ws + WS_CTL);
#pragma unroll
    for (int i = 0; i < N_IN; ++i) F.in[i] = args.in[i];
    F.out = args.out; F.mod = (float*)(ws + WS_MOD); F.rope = (float*)(ws + WS_ROPE);
    F.Win_t = (bf16*)(ws + WS_WIN); F.Wout_t = (bf16*)(ws + WS_WOUT); F.Wgu_t = (bf16*)(ws + WS_WGU); F.Wdn_t = (bf16*)(ws + WS_WDN);
    F.HB = (bf16*)(ws + WS_H); F.QB = (bf16*)(ws + WS_Q); F.KB = (bf16*)(ws + WS_K); F.VB = (bf16*)(ws + WS_V); F.CB = (bf16*)(ws + WS_C);
    F.AO = (bf16*)(ws + WS_AO); F.YB = (bf16*)(ws + WS_Y); F.ACT = (bf16*)(ws + WS_ACT); F.X1 = (float*)(ws + WS_X1);
    for (int u = F.tid; u < (LDS_BYTES - LDSCTL_OFF) / 4; u += NWAVES * 64) ((LAS unsigned*)(F.lds + LDSCTL_OFF))[u] = 0u;
    __syncthreads();
    XcdBarrier bar; bar.bar = (unsigned*)(F.ctl + CW_BAR); bar.x = 0; bar.st = nullptr;
    if (N_LAUNCHES == 1) bar = xcd_barrier_post((unsigned*)(F.ctl + CW_BAR), F.MISC + 8);
    const int lo = args.ph_lo, hi = args.ph_hi;
#define IN(k) (lo <= (k) && (k) < hi)
#define SEAM(k) do { if (IN(k) && IN((k) + 1)) xcd_barrier(bar); } while (0)
    const int gw = F.vcu * NWAVES + F.wave, NGW = F.G * NWAVES;
#ifndef PROBE_DUP
#define PROBE_DUP (-1)
#endif
#define DUP(k, body) do { body; if (PROBE_DUP == (k)) { xcd_barrier(bar); body; } } while (0)

    if (IN(0)) { p0_prologue(F, 1.0f); if (PROBE_DUP == 0) { xcd_barrier(bar); p0_prologue(F, 0.0f); } SEAM(0); }
    if (IN(1)) {
        DUP(1, for (int m = gw; m < MT; m += NGW) {
            const bool isctx = m >= M; const float* xrow = isctx ? F.in[I_CTX] + (size_t)(m - M) * D : F.in[I_X] + (size_t)m * D;
            const float* mrow = F.mod + (size_t)(isctx ? 4 : (m >> 11)) * NMODC;
            norm_mod_row(xrow, F.HB + (size_t)m * D, F.in[I_N1G], mrow, mrow + D, F.lane); });
        SEAM(1);
    }
    if (IN(2)) {
        pg8::Gemm g{F.HB, F.Win_t, MT, INC, D}; pg8::InOrder S; S.init(F.G, (int)blockIdx.x);
        pg8::EpiIn E{F.QB, F.KB, F.VB, F.CB, F.rope, 0.08838834764831845f * LOG2E};
        DUP(2, (pg8::gemm_phase<pg8::EpiIn, pg8::InOrder, PG8_ALIGN, PG8_SP2>(F.lds + RING_OFF, g, S, E)));
        if (F.G == 256 && blockIdx.x >= 64) {
            LAS float* scr = (LAS float*)(F.lds + RING_OFF + F.wave * 16384); const int p = ((int)blockIdx.x - 64) * NWAVES + F.wave;
            transpose_items<0>(F.in[I_WOUT], D, D, F.Wout_t, scr, p, 192 * NWAVES, IT_OUT, F.lane);
            transpose_items<2>(F.in[I_WGU], D, 2 * FF, F.Wgu_t, scr, p, 192 * NWAVES, IT_GU, F.lane);
        } else if (F.G != 256) {
            LAS float* scr = (LAS float*)(F.lds + RING_OFF + F.wave * 16384);
            transpose_items<0>(F.in[I_WOUT], D, D, F.Wout_t, scr, gw, NGW, IT_OUT, F.lane);
            transpose_items<2>(F.in[I_WGU], D, 2 * FF, F.Wgu_t, scr, gw, NGW, IT_GU, F.lane);
        }
        SEAM(2);
    }
    if (IN(3)) { DUP(3, attn_phase(F)); SEAM(3); }
    if (IN(4)) { DUP(4, for (int m = gw; m < M; m += NGW) mix_row(F, m)); SEAM(4); }
    if (IN(5)) {
        pg8::Gemm g{F.YB, F.Wout_t, M, D, D}; pg8::StaticOrder S; S.init(M, D, F.G, (int)blockIdx.x);
        pg8::EpiRes E{F.in[I_X], F.X1, D, F.mod + 2 * D};
        DUP(5, (pg8::gemm_phase<pg8::EpiRes, pg8::StaticOrder, PG8_ALIGN, PG8_SP2>(F.lds + RING_OFF, g, S, E)));
        SEAM(5);
    }
    if (IN(6)) {
        DUP(6, for (int m = gw; m < M; m += NGW) { const float* mrow = F.mod + (size_t)(m >> 11) * NMODC;
            norm_mod_row(F.X1 + (size_t)m * D, F.HB + (size_t)m * D, F.in[I_N2G], mrow + 3 * D, mrow + 4 * D, F.lane); });
        SEAM(6);
    }
    if (IN(7)) {
        pg8::Gemm g{F.HB, F.Wgu_t, M, 2 * FF, D}; pg8::StaticOrder S; S.init(M, 2 * FF, F.G, (int)blockIdx.x);
        pg8::EpiSwiglu E{F.ACT, FF};
        DUP(7, (pg8::gemm_phase<pg8::EpiSwiglu, pg8::StaticOrder, PG8_ALIGN, PG8_SP2>(F.lds + RING_OFF, g, S, E)));
        if (F.G == 256 && blockIdx.x >= 192) {
            LAS float* scr = (LAS float*)(F.lds + RING_OFF + F.wave * 16384); const int p = ((int)blockIdx.x - 192) * NWAVES + F.wave;
            transpose_items<0>(F.in[I_WDN], FF, D, F.Wdn_t, scr, P0_DN_ITEMS + p, 64 * NWAVES, IT_DN, F.lane);
        } else if (F.G != 256) {
            LAS float* scr = (LAS float*)(F.lds + RING_OFF + F.wave * 16384);
            transpose_items<0>(F.in[I_WDN], FF, D, F.Wdn_t, scr, P0_DN_ITEMS + gw, NGW, IT_DN, F.lane);
        }
        SEAM(7);
    }
    if (IN(8)) {
        pg8::Gemm g{F.ACT, F.Wdn_t, M, D, FF}; pg8::StaticOrder S; S.init(M, D, F.G, (int)blockIdx.x);
        pg8::EpiRes E{F.X1, F.out, D, F.mod + 5 * D};
        DUP(8, (pg8::gemm_phase<pg8::EpiRes, pg8::StaticOrder, PG8_ALIGN, PG8_SP2>(F.lds + RING_OFF, g, S, E)));
        SEAM(8);
    }
    if (IN(9)) { for (int m = gw; m < M; m += NGW) final_norm_row(F.out + (size_t)m * D, F.in[I_FNG], F.lane); }
#undef IN
#undef SEAM
}

extern "C" void kernel_launch(void* const* d_in, const int* in_sizes, int n_in, void* d_out, int out_size, void* d_ws, size_t ws_size, hipStream_t stream) {
    static int grid = 0;
    if (grid == 0) {
        if (n_in != N_IN || in_sizes[I_X] != M * D || out_size != M * D || ws_size < WS_END) { fprintf(stderr, "kernel_launch: shape / workspace mismatch (n_in %d, x %d, out %d, ws %zu); nothing launched\n", n_in, n_in > 0 ? in_sizes[0] : -1, out_size, ws_size); grid = -1; return; }
        int dev = 0, cus = 0, per_cu = 0;
        if (hipGetDevice(&dev) != hipSuccess || hipDeviceGetAttribute(&cus, hipDeviceAttributeMultiprocessorCount, dev) != hipSuccess) { fprintf(stderr, "kernel_launch: device query failed\n"); grid = -1; return; }
        if (hipFuncSetAttribute((const void*)fwd_kernel, hipFuncAttributeMaxDynamicSharedMemorySize, LDS_BYTES) != hipSuccess) { fprintf(stderr, "kernel_launch: hipFuncSetAttribute failed\n"); grid = -1; return; }
        if (hipOccupancyMaxActiveBlocksPerMultiprocessor(&per_cu, (const void*)fwd_kernel, NWAVES * 64, LDS_BYTES) != hipSuccess || per_cu < 1)
            fprintf(stderr, "kernel_launch: note: occupancy query reports %d workgroups per CU\n", per_cu);
        (void)hipGetLastError();
        grid = cus;
    }
    if (grid < 0) return;
    if (hipMemsetAsync((char*)d_ws + WS_CTL, 0, CTL_ZERO_BYTES, stream) != hipSuccess) { fprintf(stderr, "kernel_launch: memset failed\n"); return; }
    Args a{};
    for (int i = 0; i < N_IN; ++i) a.in[i] = (const float*)d_in[i];
    a.out = (float*)d_out; a.ws = (unsigned char*)d_ws;
    for (int li = 0; li < N_LAUNCHES; ++li) {
        a.ph_lo = (N_LAUNCHES == 1) ? 0 : li; a.ph_hi = (N_LAUNCHES == 1) ? N_PHASES : li + 1;
        hipLaunchKernelGGL(fwd_kernel, dim3(grid), dim3(NWAVES * 64), LDS_BYTES, stream, a);
        const hipError_t le = hipPeekAtLastError();
        if (le != hipSuccess) { fprintf(stderr, "kernel_launch: launch %d failed: %s\n", li, hipGetErrorName(le)); break; }
    }
}
```

```cpp
#include <hip/hip_runtime.h>
#include <cstdio>
#include <cstdint>
namespace pg8 {
#define PG8_LAS __attribute__((address_space(3)))
typedef unsigned short bf16_t;
typedef short bf16x8 __attribute__((ext_vector_type(8)));
typedef float f32x4 __attribute__((ext_vector_type(4)));
typedef unsigned u32x4 __attribute__((ext_vector_type(4)));
constexpr int BM = 256, BK = 64, HALF = 128, HTB = HALF * BK * 2  , STAGE_BYTES = 8 * HTB, NXCD = 8, WGM = 8;

__host__ __device__ __forceinline__ int lds_byte(int r, int c) { const int st = (r >> 4) * 2 + (c >> 5), rr = r & 15, cc = c & 31, ob = rr * 64 + cc * 2; return st * 1024 + (ob ^ (((ob >> 9) & 1) << 5)); }
__host__ __device__ __forceinline__ void stage_rc(int b, int& R, int& C) { const int st = b / 1024, sb = b % 1024, swz = sb ^ (((sb >> 9) & 1) << 5); R = (st >> 1) * 16 + swz / 64; C = (st & 1) * 32 + (swz % 64) / 2; }
__host__ __device__ __forceinline__ int perm32(int rho) { const int n = rho >> 4, i = rho & 15; return 8 * (i >> 2) + 4 * n + (i & 3); }

struct Unit { int pm, pn; };
struct Gemm { const bf16_t* A; const bf16_t* Bt; int M, N, K; };

struct StaticOrder {
    int nM, nN, nwg, G, c;
    __host__ __device__ void init(int M, int N, int G_, int c_) { nM = M / BM; nN = N / BM; nwg = nM * nN; G = G_; c = c_; }
    __host__ __device__ bool next(int i, Unit& u) const {
        const long L = (long)i * G + c; if (L >= nwg) return false;
        int wgid = (int)L; { const int q = nwg / NXCD, r = nwg % NXCD, xcd = wgid % NXCD, off = wgid / NXCD; wgid = (xcd < r ? xcd * (q + 1) : r * (q + 1) + (xcd - r) * q) + off; }
        const int nig = WGM * nN, gid = wgid / nig, fm = gid * WGM, gsz = (nM - fm) < WGM ? (nM - fm) : WGM;
        u.pm = fm + ((wgid % nig) % gsz); u.pn = (wgid % nig) / gsz; return true;
    }
    __device__ __forceinline__ void a_ready(const Unit&) const {}
    __device__ __forceinline__ void done(const Unit&) const {}
};

__device__ __forceinline__ unsigned cvt_pk_bf16(float lo, float hi) { unsigned r; asm volatile("v_cvt_pk_bf16_f32 %0, %1, %2" : "=v"(r) : "v"(lo), "v"(hi)); return r; }
typedef float f32x2 __attribute__((ext_vector_type(2)));
typedef __bf16 bf16v2 __attribute__((ext_vector_type(2)));
__device__ __forceinline__ unsigned pkbf(float lo, float hi) { f32x2 v = {lo, hi}; bf16v2 r = __builtin_convertvector(v, bf16v2); return __builtin_bit_cast(unsigned, r); }

struct EpiIn {
    static constexpr bool PERM = true, AFTER_DRAIN = false;
    bf16_t *Q, *Kd, *Vd, *Cd; const float* rope; float qscale;
    __device__ __forceinline__ void operator()(const f32x4 (&acc)[2][2][4][2], const Unit& u, int wr, int wc, int fr, int fq) const {
        const int reg = u.pn >> 3;
        bf16_t* base; int ldc, colt; bool rot = false; float sc = 1.f;
        if (reg == 0) { base = Q; ldc = 2048; colt = u.pn * BM; rot = true; sc = qscale; }
        else if (reg == 1) { base = Kd; ldc = 2048; colt = (u.pn - 8) * BM; rot = (u.pm < 32); }
        else if (reg == 2) { base = Vd; ldc = 2048; colt = (u.pn - 16) * BM; }
        else { base = Cd; ldc = 6144; colt = (u.pn - 24) * BM; }
        const int row0 = u.pm * BM + wr * 64 + fr, col0 = colt + wc * 32 + 8 * fq;
        const int blk = wc >> 1, i0 = 4 * ((4 * wc + fq) & 7);
        f32x4 cs[2], sn[2];
        cs[0] = (f32x4){1.f, 1.f, 1.f, 1.f}; sn[0] = (f32x4){0.f, 0.f, 0.f, 0.f}; cs[1] = cs[0]; sn[1] = sn[0];
        if (rot) { const int t = row0 & 2047, pos = blk ? (t & 63) : (t >> 6); cs[0] = *(const f32x4*)(rope + pos * 32 + i0); sn[0] = *(const f32x4*)(rope + 2048 + pos * 32 + i0); }
#pragma unroll
        for (int gi = 0; gi < 8; ++gi) { const int ai = gi >> 2, m = gi & 3; const int r = row0 + ai * HALF + m * 16; bf16_t* rowp = base + (size_t)r * ldc + col0;
            if (gi < 7 && rot) { const int rn = row0 + ((gi + 1) >> 2) * HALF + ((gi + 1) & 3) * 16, t = rn & 2047, pos = blk ? (t & 63) : (t >> 6);
                cs[(gi + 1) & 1] = *(const f32x4*)(rope + pos * 32 + i0); sn[(gi + 1) & 1] = *(const f32x4*)(rope + 2048 + pos * 32 + i0); }
            const f32x4 cs4 = cs[gi & 1], sn4 = sn[gi & 1];
#pragma unroll
            for (int bj = 0; bj < 2; ++bj) { const f32x4 a = acc[ai][bj][m][0], b = acc[ai][bj][m][1];
                const f32x4 v0 = (a * cs4 - b * sn4) * sc, v1 = (a * sn4 + b * cs4) * sc;
                u32x4 w; w.x = pkbf(v0[0], v0[1]); w.y = pkbf(v0[2], v0[3]); w.z = pkbf(v1[0], v1[1]); w.w = pkbf(v1[2], v1[3]);
                *(u32x4*)(rowp + bj * HALF) = w; }
            asm volatile("" ::: "memory"); }
    }
};
struct EpiGate {
    static constexpr bool PERM = true, AFTER_DRAIN = false;
    bf16_t* O; int ldc; const float* gate;
    __device__ __forceinline__ void operator()(const f32x4 (&acc)[2][2][4][2], const Unit& u, int wr, int wc, int fr, int fq) const {
        const int row0 = u.pm * BM + wr * 64 + fr, col0 = u.pn * BM + wc * 32 + 8 * fq;
        const float* gp = gate + (size_t)(u.pm >> 3) * 24576 + col0;
        f32x4 gv[2][2];
#pragma unroll
        for (int bj = 0; bj < 2; ++bj)
#pragma unroll
            for (int n = 0; n < 2; ++n) gv[bj][n] = *(const f32x4*)(gp + bj * HALF + 4 * n);
#pragma unroll
        for (int ai = 0; ai < 2; ++ai)
#pragma unroll
            for (int m = 0; m < 4; ++m) { bf16_t* rowp = O + (size_t)(row0 + ai * HALF + m * 16) * ldc + col0;
#pragma unroll
                for (int bj = 0; bj < 2; ++bj) { const f32x4 v0 = acc[ai][bj][m][0] * gv[bj][0], v1 = acc[ai][bj][m][1] * gv[bj][1];
                    u32x4 w; w.x = pkbf(v0[0], v0[1]); w.y = pkbf(v0[2], v0[3]); w.z = pkbf(v1[0], v1[1]); w.w = pkbf(v1[2], v1[3]);
                    *(u32x4*)(rowp + bj * HALF) = w; } }
    }
};
struct EpiSwiglu {
    static constexpr bool PERM = true, AFTER_DRAIN = false;
    bf16_t* O; int ldc;
    __device__ __forceinline__ void operator()(const f32x4 (&acc)[2][2][4][2], const Unit& u, int wr, int wc, int fr, int fq) const {
        const int row0 = u.pm * BM + wr * 64 + fr, col0 = u.pn * HALF + wc * 32 + 8 * fq;
#pragma unroll
        for (int ai = 0; ai < 2; ++ai)
#pragma unroll
            for (int m = 0; m < 4; ++m) { bf16_t* rowp = O + (size_t)(row0 + ai * HALF + m * 16) * ldc + col0;
                float o[8];
#pragma unroll
                for (int n = 0; n < 2; ++n)
#pragma unroll
                    for (int j = 0; j < 4; ++j) { const float gt = acc[ai][0][m][n][j], up = acc[ai][1][m][n][j];
                        o[4 * n + j] = gt * __builtin_amdgcn_rcpf(1.0f + __builtin_amdgcn_exp2f(-1.44269504089f * gt)) * up; }
                u32x4 w; w.x = pkbf(o[0], o[1]); w.y = pkbf(o[2], o[3]); w.z = pkbf(o[4], o[5]); w.w = pkbf(o[6], o[7]);
                *(u32x4*)rowp = w; }
    }
};
struct InOrder {
    StaticOrder so; int G, c;
    __host__ __device__ void init(int G_, int c_) { so.init(8192, 12288, G_, c_); G = G_; c = c_; }
    __host__ __device__ bool next(int i, Unit& u) const {
        const long L = (long)i * G + c; if (L >= 1600) return false;
        if (L < 1536) return so.next(i, u);
        const int e = (int)L - 1536; u.pm = 32 + (e & 3); u.pn = 8 + (e >> 2); return true;
    }
    __device__ __forceinline__ void a_ready(const Unit&) const {}
    __device__ __forceinline__ void done(const Unit&) const {}
};
template <class Epi, class Sched, bool ALIGN_EPI = false, bool SP2 = false>
__device__ __forceinline__ void gemm_phase(PG8_LAS unsigned char* lds, const Gemm g, const Sched& S, const Epi& E) {
    const int tid = threadIdx.x, wid = __builtin_amdgcn_readfirstlane(tid >> 6), lane = tid & 63, wr = wid >> 2, wc = wid & 3, fr = lane & 15, fq = lane >> 4;
    const int K = g.K, nt = K / BK;
    unsigned voffA[2], voffB[2];
#pragma unroll
    for (int i = 0; i < 2; ++i) { int R, C; stage_rc(tid * 16 + i * 8192, R, C); const int Rb = Epi::PERM ? ((R & ~31) + perm32(R & 31)) : R;
        voffA[i] = (unsigned)(R * K + C) * 2u; voffB[i] = (unsigned)(Rb * K + C) * 2u; }
    const size_t kstep = (size_t)(BK * 2);
    const size_t hstep = (size_t)HALF * K * 2;
    const size_t tstep = 2 * hstep;
    const unsigned ldsw = (unsigned)wid * 1024u;
    const int aoff = lds_byte(wr * 64 + fr, fq * 8), boff = lds_byte(wc * 32 + fr, fq * 8);
#define PG8_SA(b, h) (((b) * 2 + (h)) * HTB)
#define PG8_SB(b, h) ((4 + (b) * 2 + (h)) * HTB)
#define PG8_STAGE(bufoff, gbase, voff) do { _Pragma("unroll") for (int _i = 0; _i < 2; ++_i) \
        __builtin_amdgcn_global_load_lds((const unsigned*)((const char*)(gbase) + (voff)[_i]), (PG8_LAS unsigned*)(lds + (bufoff) + ldsw + _i * 8192), 16, 0, 0); } while (0)
#define PG8_LDA(dst, b, h) do { _Pragma("unroll") for (int m = 0; m < 4; ++m) _Pragma("unroll") for (int k = 0; k < 2; ++k) dst[m][k] = *(const PG8_LAS bf16x8*)(lds + PG8_SA(b, h) + aoff + m * 2048 + k * 1024); } while (0)
#define PG8_LDB(dst, b, h) do { _Pragma("unroll") for (int n = 0; n < 2; ++n) _Pragma("unroll") for (int k = 0; k < 2; ++k) dst[n][k] = *(const PG8_LAS bf16x8*)(lds + PG8_SB(b, h) + boff + n * 2048 + k * 1024); } while (0)
#define PG8_MMA(ai, bj, At, Bt) do { __builtin_amdgcn_s_setprio(1); _Pragma("unroll") for (int m = 0; m < 4; ++m) _Pragma("unroll") for (int n = 0; n < 2; ++n) _Pragma("unroll") for (int k = 0; k < 2; ++k) \
        acc[ai][bj][m][n] = __builtin_amdgcn_mfma_f32_16x16x32_bf16(Bt[n][k], At[m][k], acc[ai][bj][m][n], 0, 0, 0); __builtin_amdgcn_s_setprio(0); } while (0)
#define PG8_WAIT_V(n) asm volatile("s_waitcnt vmcnt(" #n ")" ::: "memory")
#define PG8_WAIT_L(n) asm volatile("s_waitcnt lgkmcnt(" #n ")" ::: "memory")
#define PG8_BAR __builtin_amdgcn_s_barrier()
#define PG8_SCHED __builtin_amdgcn_sched_barrier(0)
    Unit cur, nxt; int ui = 0;
    if (!S.next(0, cur)) return;
    f32x4 acc[2][2][4][2];
#pragma unroll
    for (int a = 0; a < 2; ++a)
#pragma unroll
        for (int b = 0; b < 2; ++b)
#pragma unroll
            for (int m = 0; m < 4; ++m)
#pragma unroll
                for (int n = 0; n < 2; ++n) acc[a][b][m][n] = (f32x4){0.f, 0.f, 0.f, 0.f};
    bf16x8 At[4][2], B0[2][2], B1[2][2];
    const char* cA = (const char*)g.A + (size_t)cur.pm * tstep; const char* cB = (const char*)g.Bt + (size_t)cur.pn * tstep;
    S.a_ready(cur);
    if constexpr (SP2) {
        PG8_STAGE(PG8_SB(0, 0), cB, voffB); PG8_STAGE(PG8_SB(0, 1), cB + hstep, voffB); PG8_STAGE(PG8_SA(0, 0), cA, voffA); PG8_STAGE(PG8_SA(0, 1), cA + hstep, voffA);
        if (wr == 1) PG8_BAR;
        PG8_WAIT_V(2); PG8_BAR;
        PG8_STAGE(PG8_SB(1, 0), cB + kstep, voffB); PG8_STAGE(PG8_SA(1, 0), cA + kstep, voffA); PG8_STAGE(PG8_SB(1, 1), cB + hstep + kstep, voffB);
        PG8_WAIT_V(6); PG8_BAR;
    } else {
        PG8_STAGE(PG8_SB(0, 0), cB, voffB); PG8_STAGE(PG8_SA(0, 0), cA, voffA); PG8_STAGE(PG8_SB(0, 1), cB + hstep, voffB); PG8_STAGE(PG8_SA(0, 1), cA + hstep, voffA);
        if (wr == 1) PG8_BAR;
        PG8_WAIT_V(4); PG8_BAR;
        PG8_STAGE(PG8_SB(1, 0), cB + kstep, voffB); PG8_STAGE(PG8_SA(1, 0), cA + kstep, voffA); PG8_STAGE(PG8_SB(1, 1), cB + hstep + kstep, voffB);
        PG8_WAIT_V(6); PG8_BAR;
    }
    for (;;) {
        const bool has_next = S.next(ui + 1, nxt);
        const char* nA = has_next ? (const char*)g.A + (size_t)nxt.pm * tstep : cA; const char* nB = has_next ? (const char*)g.Bt + (size_t)nxt.pn * tstep : cB;
        for (int t = 0; t < nt; t += 2) {
            const bool last = (t == nt - 2);
            const char* a1 = cA + (size_t)(t + 1) * kstep;
            const char* a2 = last ? nA : cA + (size_t)(t + 2) * kstep; const char* b2 = last ? nB : cB + (size_t)(t + 2) * kstep;
            const char* a3 = a2 + kstep; const char* b3 = b2 + kstep;
            if (last && has_next) S.a_ready(nxt);
            if constexpr (SP2) {
            PG8_LDB(B0, 0, 0); PG8_LDB(B1, 0, 1); PG8_SCHED; PG8_LDA(At, 0, 0); PG8_STAGE(PG8_SA(1, 1), a1 + hstep, voffA);
            PG8_WAIT_V(8); PG8_WAIT_L(0); PG8_BAR; PG8_MMA(0, 0, At, B0); PG8_MMA(0, 1, At, B1); PG8_BAR; PG8_SCHED;
            PG8_LDA(At, 0, 1); PG8_STAGE(PG8_SB(0, 0), b2, voffB); PG8_STAGE(PG8_SB(0, 1), b2 + hstep, voffB); PG8_STAGE(PG8_SA(0, 0), a2, voffA);
            PG8_WAIT_V(8); PG8_WAIT_L(0); PG8_BAR; PG8_MMA(1, 0, At, B0); PG8_MMA(1, 1, At, B1); PG8_BAR; PG8_SCHED;
            PG8_LDB(B0, 1, 0); PG8_LDB(B1, 1, 1); PG8_SCHED; PG8_LDA(At, 1, 0); PG8_STAGE(PG8_SA(0, 1), a2 + hstep, voffA);
            PG8_WAIT_V(8); PG8_WAIT_L(0); PG8_BAR; PG8_MMA(0, 0, At, B0); PG8_MMA(0, 1, At, B1); PG8_BAR; PG8_SCHED;
            PG8_LDA(At, 1, 1); PG8_STAGE(PG8_SB(1, 0), b3, voffB); PG8_STAGE(PG8_SB(1, 1), b3 + hstep, voffB); PG8_STAGE(PG8_SA(1, 0), a3, voffA);
            PG8_WAIT_V(8); PG8_WAIT_L(0); PG8_BAR; PG8_MMA(1, 0, At, B0); PG8_MMA(1, 1, At, B1); PG8_BAR; PG8_SCHED;
            } else {
            PG8_LDB(B0, 0, 0); PG8_SCHED; PG8_LDA(At, 0, 0); PG8_STAGE(PG8_SA(1, 1), a1 + hstep, voffA);
            PG8_WAIT_L(8); PG8_BAR; PG8_WAIT_L(0); PG8_MMA(0, 0, At, B0); PG8_BAR; PG8_SCHED;
            PG8_LDB(B1, 0, 1); PG8_STAGE(PG8_SB(0, 0), b2, voffB);
            PG8_BAR; PG8_WAIT_L(0); PG8_MMA(0, 1, At, B1); PG8_BAR;
            PG8_LDA(At, 0, 1); PG8_STAGE(PG8_SA(0, 0), a2, voffA);
            PG8_BAR; PG8_WAIT_L(0); PG8_MMA(1, 0, At, B0); PG8_BAR; PG8_SCHED;
            PG8_STAGE(PG8_SB(0, 1), b2 + hstep, voffB);
            PG8_WAIT_V(6); PG8_BAR; PG8_MMA(1, 1, At, B1); PG8_BAR;
            PG8_LDB(B0, 1, 0); PG8_SCHED; PG8_LDA(At, 1, 0); PG8_STAGE(PG8_SA(0, 1), a2 + hstep, voffA);
            PG8_WAIT_L(8); PG8_BAR; PG8_WAIT_L(0); PG8_MMA(0, 0, At, B0); PG8_BAR; PG8_SCHED;
            PG8_LDB(B1, 1, 1); PG8_STAGE(PG8_SB(1, 0), b3, voffB);
            PG8_BAR; PG8_WAIT_L(0); PG8_MMA(0, 1, At, B1); PG8_BAR;
            PG8_LDA(At, 1, 1); PG8_STAGE(PG8_SA(1, 0), a3, voffA);
            PG8_BAR; PG8_WAIT_L(0); PG8_MMA(1, 0, At, B0); PG8_BAR; PG8_SCHED;
            PG8_STAGE(PG8_SB(1, 1), b3 + hstep, voffB);
            PG8_WAIT_V(6); PG8_BAR; PG8_MMA(1, 1, At, B1); PG8_BAR;
            }
        }
        if constexpr (ALIGN_EPI) { if (wr == 0) PG8_BAR; }
        if constexpr (!Epi::AFTER_DRAIN) { E(acc, cur, wr, wc, fr, fq); S.done(cur); }
        if (!has_next) break;
#pragma unroll
        for (int a = 0; a < 2; ++a)
#pragma unroll
            for (int b = 0; b < 2; ++b)
#pragma unroll
                for (int m = 0; m < 4; ++m)
#pragma unroll
                    for (int n = 0; n < 2; ++n) acc[a][b][m][n] = (f32x4){0.f, 0.f, 0.f, 0.f};
        cur = nxt; cA = nA; cB = nB; ++ui;
        if constexpr (ALIGN_EPI) { if (wr == 1) PG8_BAR; }
    }
    PG8_WAIT_V(0);
    if constexpr (!ALIGN_EPI) { if (wr == 0) PG8_BAR; }
    PG8_BAR;
    if constexpr (Epi::AFTER_DRAIN) { E.fused(acc, cur, wr, wc, fr, fq, lds, wid, lane); S.done(cur); }
#undef PG8_SA
#undef PG8_SB
#undef PG8_STAGE
#undef PG8_LDA
#undef PG8_LDB
#undef PG8_MMA
#undef PG8_WAIT_V
#undef PG8_WAIT_L
#undef PG8_BAR
#undef PG8_SCHED
}
}
#ifndef PG8_SP2
#define PG8_SP2 true
#endif
#ifndef PG8_ALIGN
#define PG8_ALIGN true
#endif
constexpr int NWAVES = 8;
#ifndef MK_N_LAUNCHES
#define MK_N_LAUNCHES 1
#endif
constexpr int N_PHASES = 10;
constexpr int N_LAUNCHES = MK_N_LAUNCHES;

constexpr int D = 4096, NB = 4, SEQ = 2048, M = NB * SEQ, CTXL = 256, MC = NB * CTXL, MT = M + MC;
constexpr int HD = 128, NAH = 16, NAW = 2048, CVW = 2048, INC = 12288, FF = 11008, NMODC = 6 * D;
constexpr int GRIDW = 64, ROWS = 32, NAKH = 8, NAKW = 16;
constexpr float EPS = 1e-6f, LOG2E = 1.44269504089f;
enum { I_X = 0, I_C, I_CTX, I_CCTX, I_ADAW, I_ADAB, I_N1G, I_WIN, I_CONVW, I_RPB, I_GNG, I_WOUT, I_N2G, I_WGU, I_WDN, I_FNG, N_IN };

constexpr size_t MiB = 1u << 20;
constexpr size_t WS_CTL = 0, WS_MOD = 1 * MiB, CTL_ZERO_BYTES = 2 * MiB;
constexpr size_t WS_ROPE = 2 * MiB;
constexpr size_t WS_WIN = 4 * MiB, WS_WOUT = 100 * MiB, WS_WGU = 132 * MiB, WS_WDN = 304 * MiB;
constexpr size_t WS_H = 390 * MiB;
constexpr size_t WS_Q = 462 * MiB;
constexpr size_t WS_K = 494 * MiB;
constexpr size_t WS_V = 530 * MiB;
constexpr size_t WS_C = 566 * MiB;
constexpr size_t WS_AO = 662 * MiB;
constexpr size_t WS_Y = 694 * MiB;
constexpr size_t WS_X1 = 758 * MiB;
constexpr size_t WS_ACT = 886 * MiB;
constexpr size_t WS_END = 1058 * MiB;
static_assert(WS_WIN + (size_t)INC * D * 2 <= WS_WOUT && WS_WOUT + (size_t)D * D * 2 <= WS_WGU && WS_WGU + (size_t)2 * FF * D * 2 <= WS_WDN && WS_WDN + (size_t)D * FF * 2 <= WS_H, "ws map (weights)");
static_assert(WS_H + (size_t)MT * D * 2 <= WS_Q && WS_Q + (size_t)M * NAW * 2 <= WS_K && WS_K + (size_t)MT * NAW * 2 <= WS_V && WS_V + (size_t)MT * NAW * 2 <= WS_C && WS_C + (size_t)M * 6144 * 2 <= WS_AO, "ws map (acts 1)");
static_assert(WS_AO + (size_t)M * NAW * 2 <= WS_Y && WS_Y + (size_t)M * D * 2 <= WS_X1 && WS_X1 + (size_t)M * D * 4 <= WS_ACT && WS_ACT + (size_t)M * FF * 2 <= WS_END, "ws map (acts 2)");
constexpr int CW_BAR = 4096;

#ifndef P0_DN_ITEMS
#define P0_DN_ITEMS 0
#endif
#ifndef P0_OUT_ITEMS
#define P0_OUT_ITEMS 0
#endif
#ifndef P0_GU_ITEMS
#define P0_GU_ITEMS 0
#endif
constexpr int RING_OFF = 0, RING_BYTES = 131072;
constexpr int LDSCTL_OFF = RING_BYTES, MISC_OFF = LDSCTL_OFF + 320;
constexpr int LDS_BYTES = 147456;
static_assert(MISC_OFF + 128 <= LDS_BYTES, "LDS map");

#define GAS __attribute__((address_space(1)))
#define LAS __attribute__((address_space(3)))
typedef unsigned short bf16;
typedef unsigned v4u __attribute__((ext_vector_type(4)));
typedef float f32x4 __attribute__((ext_vector_type(4)));
typedef short bf16x8 __attribute__((ext_vector_type(8)));
typedef GAS unsigned gu32;
typedef GAS unsigned long long gu64;
#define RLX_AGENT __ATOMIC_RELAXED, __HIP_MEMORY_SCOPE_AGENT
#define LDS_WAIT() asm volatile("s_waitcnt lgkmcnt(0)" ::: "memory")
#define VM_WAIT() asm volatile("s_waitcnt vmcnt(0)" ::: "memory")
__device__ __forceinline__ unsigned long long rt() { return __builtin_amdgcn_s_memrealtime(); }
__device__ __forceinline__ unsigned f2bf(float f) { unsigned u = __builtin_bit_cast(unsigned, f); return (u + 0x7fffu + ((u >> 16) & 1u)) >> 16; }
__device__ __forceinline__ unsigned pk2(float lo, float hi) { return f2bf(lo) | (f2bf(hi) << 16); }

#define XB_TMO      128
#define XB_XCNT(j)  (256  + 64 * (j))
#define XB_XSUB(j)  (1280 + 64 * (j))
#define XB_XGEN(j)  (2304 + 64 * (j))
#define XB_TOP      3328
#define XB_TOPGEN   3392
#define XCD_BAR_WORDS 3456
#define XB_SPIN_CAP (1u << 18)

__device__ __forceinline__ unsigned xb_ld(unsigned* p)              { return __hip_atomic_load(p, __ATOMIC_RELAXED, __HIP_MEMORY_SCOPE_AGENT); }
__device__ __forceinline__ unsigned xb_add(unsigned* p, unsigned v) { return __hip_atomic_fetch_add(p, v, __ATOMIC_RELAXED, __HIP_MEMORY_SCOPE_AGENT); }
__device__ __forceinline__ unsigned xb_xcc_id() { return (unsigned)__builtin_amdgcn_s_getreg((3 << 11) | 20) & 0xFu; }
#define XB_SPIN(cond, bar) do { unsigned _sp = 0; while (cond) { __builtin_amdgcn_s_sleep(1); \
    if ((++_sp & 255u) == 0u) { if (xb_ld(&(bar)[XB_TMO])) break; if (_sp > XB_SPIN_CAP) { atomicAdd(&(bar)[XB_TMO], 1u); break; } } } } while (0)

struct XcdBarrier {
    unsigned* bar; unsigned x;
    volatile LAS unsigned* st;
};

__device__ __forceinline__ XcdBarrier xcd_barrier_post(unsigned* bar, volatile LAS unsigned* st) {
    XcdBarrier b; b.bar = bar; b.x = xb_xcc_id(); b.st = st;
    if (threadIdx.x == 0) (void)xb_add(&bar[XB_XCNT(b.x)], 1u);
    return b;
}
__device__ __forceinline__ void xcd_barrier_complete(unsigned* bar, unsigned x, unsigned& nloc, unsigned& nx) {
    const unsigned G = gridDim.x * gridDim.y * gridDim.z;
    unsigned sum, cnt, mine, sp = 0u;
    for (;;) {
        sum = 0u; cnt = 0u; mine = 0u;
#pragma unroll
        for (unsigned j = 0; j < 16; ++j) { const unsigned c = xb_ld(&bar[XB_XCNT(j)]); sum += c; cnt += (c > 0u) ? 1u : 0u; mine = (j == x) ? c : mine; }
        if (sum == G) break;
        __builtin_amdgcn_s_sleep(1);
        if ((++sp & 255u) == 0u) { if (xb_ld(&bar[XB_TMO])) break; if (sp > XB_SPIN_CAP) { atomicAdd(&bar[XB_TMO], 1u); break; } }
    }
    nloc = mine > 0u ? mine : 1u; nx = cnt > 0u ? cnt : 1u;
}

__device__ __forceinline__ void xcd_barrier(const XcdBarrier& b) {
    asm volatile("s_waitcnt vmcnt(0)" ::: "memory");
    __syncthreads();
    if (threadIdx.x == 0) {
        unsigned* bar = b.bar;
        __builtin_amdgcn_s_waitcnt(0);
        unsigned nloc = b.st[0], nx = b.st[1];
        if (nloc == 0u) { xcd_barrier_complete(bar, b.x, nloc, nx); b.st[0] = nloc; b.st[1] = nx; }
        const unsigned old = xb_add(&bar[XB_XSUB(b.x)], 1u);
        const unsigned gen = old / nloc;
        if (old + 1u == (gen + 1u) * nloc) {
            __builtin_amdgcn_fence(__ATOMIC_RELEASE, "agent");
            asm volatile("s_waitcnt vmcnt(0)" ::: "memory");
            const unsigned og = xb_add(&bar[XB_TOP], 1u);
            const unsigned tg = og / nx;
            if (og + 1u == (tg + 1u) * nx) xb_add(&bar[XB_TOPGEN], 1u);
            else XB_SPIN(xb_ld(&bar[XB_TOPGEN]) == tg, bar);
            __builtin_amdgcn_fence(__ATOMIC_ACQUIRE, "agent");
            xb_add(&bar[XB_XGEN(b.x)], 1u);
            asm volatile("s_waitcnt vmcnt(0)" ::: "memory");
        } else {
            XB_SPIN(xb_ld(&bar[XB_XGEN(b.x)]) == gen, bar);
            __builtin_amdgcn_fence(__ATOMIC_ACQUIRE, "agent");
            asm volatile("s_waitcnt vmcnt(0)" ::: "memory");
        }
    }
    __syncthreads();
}

typedef float f32x16 __attribute__((ext_vector_type(16)));
typedef unsigned v2u __attribute__((ext_vector_type(2)));
struct Frame {
    LAS unsigned char* lds;
    volatile LAS unsigned* MISC;
    gu32* ctl;
    int tid, lane, wave, vcu, G;
    const float* in[N_IN]; float* out;
    float* mod; float* rope;
    bf16 *Win_t, *Wout_t, *Wgu_t, *Wdn_t;
    bf16 *HB, *QB, *KB, *VB, *CB, *AO, *YB, *ACT, *MX, *FX;
};
template <int CTRL> __device__ __forceinline__ float dpp_add(float v) { return v + __builtin_bit_cast(float, __builtin_amdgcn_update_dpp(0, __builtin_bit_cast(int, v), CTRL, 0xf, 0xf, true)); }
__device__ __forceinline__ float wave_sum(float v) {
    v = dpp_add<0xB1>(v); v = dpp_add<0x4E>(v); v = dpp_add<0x141>(v); v = dpp_add<0x140>(v);
    v += __builtin_bit_cast(float, __builtin_amdgcn_ds_swizzle(__builtin_bit_cast(int, v), 0x401F));
    return __builtin_bit_cast(float, __builtin_amdgcn_readlane(__builtin_bit_cast(int, v), 0)) + __builtin_bit_cast(float, __builtin_amdgcn_readlane(__builtin_bit_cast(int, v), 32));
}
__device__ __forceinline__ unsigned pkbf(float lo, float hi) { return pg8::pkbf(lo, hi); }
__device__ __forceinline__ float bflo(unsigned w) { return __builtin_bit_cast(float, w << 16); }
__device__ __forceinline__ float bfhi(unsigned w) { return __builtin_bit_cast(float, w & 0xffff0000u); }

__device__ __forceinline__ int map_in(int n) {
    if (n < 4096) { const int hd = n & ~127, d = n & 127, blk = d >> 6, e4 = (d >> 5) & 1, i = d & 31; return hd + 64 * blk + 8 * (i >> 2) + 4 * e4 + (i & 3); }
    return n;
}
__device__ __forceinline__ int map_gu(int n) { const int up = n >= FF ? 1 : 0, jx = up ? n - FF : n; return 256 * (jx >> 7) + 128 * up + (jx & 127); }
#ifndef TR_NT
#define TR_NT 1
#endif
#if TR_NT
#define TR_LOAD(p) __builtin_nontemporal_load(p)
#define TR_STORE(v, p) __builtin_nontemporal_store((v), (p))
#else
#define TR_LOAD(p) (*(p))
#define TR_STORE(v, p) (*(p) = (v))
#endif
template <int MAP> __device__ __forceinline__ void transpose_items(const float* W, int K, int N, bf16* WT, LAS float* scr, int first, int stride, int end, int lane) {
    const int nblk = N / 32;
    const GAS float* Wl = (const GAS float*)W + (size_t)(lane >> 3) * N + 4 * (lane & 7);
    LAS float* sw = scr + (lane >> 3) * 33 + 4 * (lane & 7);
    const int c = lane & 7;
    f32x4 v[8];
    int it = first;
    if (it < end) { const GAS float* Wg = Wl + (size_t)(64 * (it / nblk)) * N + 32 * (it % nblk);
#pragma unroll
        for (int i = 0; i < 8; ++i) v[i] = TR_LOAD((const GAS f32x4*)(Wg + (size_t)(8 * i) * N)); }
    while (it < end) {
        const int k0 = 64 * (it / nblk), n0 = 32 * (it % nblk);
#pragma unroll
        for (int i = 0; i < 8; ++i) { sw[(8 * i) * 33 + 0] = v[i].x; sw[(8 * i) * 33 + 1] = v[i].y; sw[(8 * i) * 33 + 2] = v[i].z; sw[(8 * i) * 33 + 3] = v[i].w; }
        const int nx = it + stride;
        if (nx < end) { const GAS float* Wg = Wl + (size_t)(64 * (nx / nblk)) * N + 32 * (nx % nblk);
#pragma unroll
            for (int i = 0; i < 8; ++i) v[i] = TR_LOAD((const GAS f32x4*)(Wg + (size_t)(8 * i) * N)); }
        LDS_WAIT(); asm volatile("" ::: "memory");
#pragma unroll
        for (int j = 0; j < 4; ++j) { const int n = (lane >> 3) + 8 * j; const LAS float* s = scr + (8 * c) * 33 + n;
            v4u o; o.x = pkbf(s[0 * 33], s[1 * 33]); o.y = pkbf(s[2 * 33], s[3 * 33]); o.z = pkbf(s[4 * 33], s[5 * 33]); o.w = pkbf(s[6 * 33], s[7 * 33]);
            const int nsrc = n0 + n, nd = MAP == 1 ? map_in(nsrc) : (MAP == 2 ? map_gu(nsrc) : nsrc);
            TR_STORE(o, (GAS v4u*)(WT + (size_t)nd * K + k0 + 8 * c)); }
        LDS_WAIT(); asm volatile("" ::: "memory");
        it = nx;
    }
}
constexpr int IT_IN = (D / 64) * (INC / 32), IT_OUT = (D / 64) * (D / 32), IT_GU = (D / 64) * (2 * FF / 32), IT_DN = (FF / 64) * (D / 32);
__device__ __forceinline__ void p0_prologue(Frame& F, const float amul) {
    { const int gi = blockIdx.x * (NWAVES * 64) + F.tid;
      if (gi < 2048) { const int pos = gi >> 5, i = gi & 31; const float fr = exp2f(-(float)i * (13.287712379549449f / 32.0f)); const float ang = (float)pos * fr;
          F.rope[gi] = cosf(ang); F.rope[2048 + gi] = sinf(ang); } }
    { LAS float* sil = (LAS float*)(F.lds + RING_OFF);
      LAS float* red = (LAS float*)(F.lds + RING_OFF + 16384);
      const GAS float* aw = (const GAS float*)F.in[I_ADAW];
      for (int it = blockIdx.x; it < 768; it += F.G) {
          const int cs = it % 96, ks = it / 96, k0 = 512 * ks;
          for (int idx = F.tid; idx < 5 * 512; idx += NWAVES * 64) { const int bb = idx >> 9, kk = idx & 511;
              const float v = bb < 4 ? F.in[I_C][bb * D + k0 + kk] : F.in[I_CCTX][k0 + kk]; sil[idx] = v / (1.0f + __expf(-v)); }
          __syncthreads();
          f32x4 a0 = {0.f, 0.f, 0.f, 0.f}, a1 = a0, a2 = a0, a3 = a0, a4 = a0;
          const GAS float* wp = aw + (size_t)(k0 + F.wave) * NMODC + 256 * cs + 4 * F.lane;
#pragma unroll 8
          for (int i = 0; i < 64; ++i) { const f32x4 w = *(const GAS f32x4*)(wp + (size_t)(8 * i) * NMODC); const int k = F.wave + 8 * i;
              a0 += sil[k] * w; a1 += sil[512 + k] * w; a2 += sil[1024 + k] * w; a3 += sil[1536 + k] * w; a4 += sil[2048 + k] * w; }
          LAS f32x4* rw = (LAS f32x4*)(red + F.wave * 1280) + F.lane;
          rw[0] = a0; rw[64] = a1; rw[128] = a2; rw[192] = a3; rw[256] = a4;
          __syncthreads();
          for (int idx = F.tid; idx < 1280; idx += NWAVES * 64) { float s = 0.f;
#pragma unroll
              for (int w = 0; w < 8; ++w) s += red[w * 1280 + idx];
              const int bb = idx >> 8, cc = idx & 255, n = 256 * cs + cc;
              if (ks == 0) s += F.in[I_ADAB][n];
              atomicAdd(F.mod + bb * NMODC + n, s * amul); }
          __syncthreads();
      } }
    LAS float* scr = (LAS float*)(F.lds + RING_OFF + F.wave * 16384);
    const int gw = F.vcu * NWAVES + F.wave, NGW = F.G * NWAVES;
    transpose_items<1>(F.in[I_WIN], D, INC, F.Win_t, scr, gw, NGW, IT_IN, F.lane);
    transpose_items<0>(F.in[I_WDN], FF, D, F.Wdn_t, scr, gw, NGW, P0_DN_ITEMS, F.lane);
    transpose_items<2>(F.in[I_WGU], D, 2 * FF, F.Wgu_t, scr, gw, NGW, P0_GU_ITEMS, F.lane);
    transpose_items<0>(F.in[I_WOUT], D, D, F.Wout_t, scr, gw, NGW, P0_OUT_ITEMS, F.lane);
}

__device__ __forceinline__ void norm_mod_row(const float* xrow, bf16* orow, const float* gain, const float* shift, const float* scale, int lane) {
    const GAS f32x4* xr = (const GAS f32x4*)xrow + lane;
    f32x4 v[16]; float ss = 0.f;
#pragma unroll
    for (int j = 0; j < 16; ++j) { v[j] = xr[64 * j]; ss += (v[j].x * v[j].x + v[j].y * v[j].y) + (v[j].z * v[j].z + v[j].w * v[j].w); }
    const float rstd = 1.0f / sqrtf(wave_sum(ss) * (1.0f / D) + EPS);
    const GAS f32x4* g4 = (const GAS f32x4*)gain + lane; const GAS f32x4* sh4 = (const GAS f32x4*)shift + lane; const GAS f32x4* sc4 = (const GAS f32x4*)scale + lane;
    GAS v2u* o8 = (GAS v2u*)orow + lane;
#pragma unroll
    for (int j = 0; j < 16; ++j) { const f32x4 g = g4[64 * j], sh = sh4[64 * j], sc = sc4[64 * j];
        const f32x4 y = v[j] * rstd * g * (1.0f + sc) + sh; v2u w; w.x = pkbf(y.x, y.y); w.y = pkbf(y.z, y.w); o8[64 * j] = w; }
}

__device__ __forceinline__ void norm_mod_row_x1(const float* xrow, const bf16* mrow, bf16* orow, const float* gain, const float* shift, const float* scale, int lane) {
    const GAS f32x4* xr = (const GAS f32x4*)xrow + lane; const GAS v2u* mr = (const GAS v2u*)mrow + lane;
    f32x4 v[16]; float ss = 0.f;
#pragma unroll
    for (int j = 0; j < 16; ++j) { const f32x4 x = xr[64 * j]; const v2u m = mr[64 * j];
        v[j] = (f32x4){x.x + bflo(m.x), x.y + bfhi(m.x), x.z + bflo(m.y), x.w + bfhi(m.y)};
        ss += (v[j].x * v[j].x + v[j].y * v[j].y) + (v[j].z * v[j].z + v[j].w * v[j].w); }
    const float rstd = 1.0f / sqrtf(wave_sum(ss) * (1.0f / D) + EPS);
    const GAS f32x4* g4 = (const GAS f32x4*)gain + lane; const GAS f32x4* sh4 = (const GAS f32x4*)shift + lane; const GAS f32x4* sc4 = (const GAS f32x4*)scale + lane;
    GAS v2u* o8 = (GAS v2u*)orow + lane;
#pragma unroll
    for (int j = 0; j < 16; ++j) { const f32x4 g = g4[64 * j], sh = sh4[64 * j], sc = sc4[64 * j];
        const f32x4 y = v[j] * rstd * g * (1.0f + sc) + sh; v2u w; w.x = pkbf(y.x, y.y); w.y = pkbf(y.z, y.w); o8[64 * j] = w; }
}

#define MFMA32(a, b, c) __builtin_amdgcn_mfma_f32_32x32x16_bf16((a), (b), (c), 0, 0, 0)
constexpr int A_NST = 6, A_STAGE = 16384, A_RING = 32768;
typedef short s16x4 __attribute__((ext_vector_type(4)));
__device__ __forceinline__ void attn_wg_unit(Frame& F, const LAS float* rp, int b, int h, int R0) {
    const int lane = F.lane, w = F.wave, j = lane & 31, g = lane >> 5;
    const int r = R0 + (w >> 1), qblk = w & 1;
    const int rs = min(max(r - NAKH / 2, 0), ROWS - NAKH);
    const int KR0 = min(max(R0 - NAKH / 2, 0), ROWS - NAKH), KR1 = min(max(R0 + 3 - NAKH / 2, 0), ROWS - NAKH) + NAKH - 1;
    const int NT = 8 + 2 * (KR1 - KR0 + 1);
    const int qc = 32 * qblk + j, cs = min(max(qc - NAKW / 2, 0), GRIDW - NAKW);
    const int bias_lane = (h * 15 + rs - r + NAKH - 1) * 31 + 8 * g - qc + NAKW - 1;
    const int mask_lane = 8 * g - cs;
    const unsigned drow = 4u * w + (lane >> 4), dsw = ((drow & 3u) << 2) | ((drow >> 2) & 3u);
    const unsigned dma_off = (drow * NAW + 8u * ((lane & 15u) ^ dsw)) * 2u;
    const char* kbase = (const char*)(F.KB + HD * h); const char* vbase = (const char*)(F.VB + HD * h);
    LAS unsigned char* ring = F.lds + RING_OFF + A_RING;
#define KEYBASE(T) ((T) >= 8 ? (b * SEQ + (KR0 + (((T) - 8) >> 1)) * GRIDW + 32 * (((T) - 8) & 1)) : (M + b * CTXL + 32 * (T)))
#define DMA(T, ST) do { const size_t go_ = (size_t)KEYBASE(T) * (NAW * 2) + dma_off; \
        __builtin_amdgcn_global_load_lds((const unsigned*)(kbase + go_), (LAS unsigned*)(ring + (ST) * A_STAGE + w * 1024), 16, 0, 0); \
        __builtin_amdgcn_global_load_lds((const unsigned*)(vbase + go_), (LAS unsigned*)(ring + (ST) * A_STAGE + 8192 + w * 1024), 16, 0, 0); } while (0)
    const unsigned kap = (j & 19) | ((j & 4) << 1) | ((j & 8) >> 1), ksw = ((kap & 3u) << 2) | ((kap >> 2) & 3u);
    unsigned ka[8];
#pragma unroll
    for (int kd = 0; kd < 8; ++kd) ka[kd] = 256u * kap + 16u * ((2u * kd + g) ^ ksw);
    const unsigned blk = (lane >> 4) & 1, q4 = (lane & 15) >> 2, p4 = lane & 3;
    unsigned va_[2][4];
#pragma unroll
    for (int t = 0; t < 2; ++t)
#pragma unroll
        for (int jb = 0; jb < 4; ++jb) { const unsigned row = 8u * g + 4u * t + q4, sw = ((row & 3u) << 2) | ((row >> 2) & 3u);
            va_[t][jb] = 8192u + 256u * row + 16u * ((4u * jb + 2u * blk + (p4 >> 1)) ^ sw) + 8u * (p4 & 1); }
    const size_t qtok = (size_t)b * SEQ + r * GRIDW + 32 * qblk + j;
    bf16x8 qf[8];
    { const GAS bf16x8* qp = (const GAS bf16x8*)(F.QB + qtok * NAW + HD * h + 8 * g);
#pragma unroll
      for (int kd = 0; kd < 8; ++kd) qf[kd] = qp[2 * kd]; }
#pragma unroll
    for (int t = 0; t < A_NST - 1; ++t) DMA(t, t);
    f32x16 o0, o1, o2, o3;
#pragma unroll
    for (int v = 0; v < 16; ++v) { o0[v] = 0.f; o1[v] = 0.f; o2[v] = 0.f; o3[v] = 0.f; }
    float m_run = -__builtin_inff(), l_run = 0.f;
    int st = 0, stp = A_NST - 1;
    for (int t = 0; t < NT; ++t) {
        asm volatile("s_waitcnt vmcnt(%0)" :: "n"(2 * (A_NST - 2)) : "memory");
        __builtin_amdgcn_s_barrier();
        asm volatile("" ::: "memory");
        { const int tp = min(t + A_NST - 1, NT - 1); DMA(tp, stp); }
        const bool lat = t >= 8; const int kr = KR0 + ((t - 8) >> 1), kblk = (t - 8) & 1;
        const bool active = !lat || (kr >= rs && kr < rs + NAKH);
        if (active) {
            const LAS unsigned char* sb = ring + st * A_STAGE;
            f32x16 s;
#pragma unroll
            for (int v = 0; v < 16; ++v) s[v] = 0.f;
            { bf16x8 kf[8];
#pragma unroll
              for (int kd = 0; kd < 8; ++kd) kf[kd] = *(const LAS bf16x8*)(sb + ka[kd]);
#pragma unroll
              for (int kd = 0; kd < 8; ++kd) s = MFMA32(kf[kd], qf[kd], s); }
            s16x4 tv[2][2][4];
            { const unsigned sa = (unsigned)(size_t)sb;
#pragma unroll
              for (int t2 = 0; t2 < 2; ++t2)
#pragma unroll
                for (int jb = 0; jb < 4; ++jb) { asm volatile("ds_read_b64_tr_b16 %0, %1" : "=v"(tv[0][t2][jb]) : "v"(sa + va_[t2][jb]) : "memory");
                                                 asm volatile("ds_read_b64_tr_b16 %0, %1 offset:4096" : "=v"(tv[1][t2][jb]) : "v"(sa + va_[t2][jb]) : "memory"); } }
            if (lat) { int ml = mask_lane; asm volatile("" : "+v"(ml)); const LAS float* bp = rp + bias_lane + 31 * (kr - rs) + 32 * kblk;
                float bias[16];
#pragma unroll
                for (int v = 0; v < 16; ++v) bias[v] = bp[(v & 7) + 16 * (v >> 3)];
                asm volatile("" : "+v"(bias[0]), "+v"(bias[1]), "+v"(bias[2]), "+v"(bias[3]), "+v"(bias[4]), "+v"(bias[5]), "+v"(bias[6]), "+v"(bias[7]),
                             "+v"(bias[8]), "+v"(bias[9]), "+v"(bias[10]), "+v"(bias[11]), "+v"(bias[12]), "+v"(bias[13]), "+v"(bias[14]), "+v"(bias[15]));
                const int mk = ml + 32 * kblk;
#pragma unroll
                for (int v = 0; v < 16; ++v) { const int c = (v & 7) + 16 * (v >> 3); s[v] = ((unsigned)(c + mk) < 16u) ? s[v] + bias[v] : -__builtin_inff(); } }
            float mx = s[0];
#pragma unroll
            for (int v = 1; v < 16; ++v) mx = fmaxf(mx, s[v]);
            mx = fmaxf(mx, __shfl_xor(mx, 32));
            const float m_new = fmaxf(m_run, mx);
            const float alpha = __builtin_amdgcn_exp2f(m_run - m_new);
            float ps = 0.f;
#pragma unroll
            for (int v = 0; v < 16; ++v) { s[v] = __builtin_amdgcn_exp2f(s[v] - m_new); ps += s[v]; }
            l_run = l_run * alpha + ps; m_run = m_new;
#pragma unroll
            for (int v = 0; v < 16; ++v) { o0[v] *= alpha; o1[v] *= alpha; o2[v] *= alpha; o3[v] *= alpha; }
            bf16x8 pf0, pf1;
            { v4u t0, t1; t0.x = pkbf(s[0], s[1]); t0.y = pkbf(s[2], s[3]); t0.z = pkbf(s[4], s[5]); t0.w = pkbf(s[6], s[7]);
              t1.x = pkbf(s[8], s[9]); t1.y = pkbf(s[10], s[11]); t1.z = pkbf(s[12], s[13]); t1.w = pkbf(s[14], s[15]);
              pf0 = __builtin_bit_cast(bf16x8, t0); pf1 = __builtin_bit_cast(bf16x8, t1); }
            asm volatile("s_waitcnt lgkmcnt(0)" : "+v"(tv[0][0][0]), "+v"(tv[0][0][1]), "+v"(tv[0][0][2]), "+v"(tv[0][0][3]), "+v"(tv[0][1][0]), "+v"(tv[0][1][1]), "+v"(tv[0][1][2]), "+v"(tv[0][1][3]),
                         "+v"(tv[1][0][0]), "+v"(tv[1][0][1]), "+v"(tv[1][0][2]), "+v"(tv[1][0][3]), "+v"(tv[1][1][0]), "+v"(tv[1][1][1]), "+v"(tv[1][1][2]), "+v"(tv[1][1][3]) :: "memory");
#define VF(KS, JB) __builtin_shufflevector(tv[KS][0][JB], tv[KS][1][JB], 0, 1, 2, 3, 4, 5, 6, 7)
            o0 = MFMA32(VF(0, 0), pf0, o0); o1 = MFMA32(VF(0, 1), pf0, o1); o2 = MFMA32(VF(0, 2), pf0, o2); o3 = MFMA32(VF(0, 3), pf0, o3);
            o0 = MFMA32(VF(1, 0), pf1, o0); o1 = MFMA32(VF(1, 1), pf1, o1); o2 = MFMA32(VF(1, 2), pf1, o2); o3 = MFMA32(VF(1, 3), pf1, o3);
#undef VF
        }
        st = (st + 1 == A_NST) ? 0 : st + 1; stp = (stp + 1 == A_NST) ? 0 : stp + 1;
    }
#undef KEYBASE
#undef DMA
    asm volatile("s_waitcnt vmcnt(0)" ::: "memory");
    __builtin_amdgcn_s_barrier();
    asm volatile("" ::: "memory");
    const float l = l_run + __shfl_xor(l_run, 32), inv = 1.0f / l;
    GAS v2u* op = (GAS v2u*)(F.AO + qtok * NAW + HD * h);
#define OST(JB, OV) do { _Pragma("unroll") for (int u = 0; u < 4; ++u) { v2u w_; w_.x = pkbf(OV[4 * u] * inv, OV[4 * u + 1] * inv); w_.y = pkbf(OV[4 * u + 2] * inv, OV[4 * u + 3] * inv); op[8 * (JB) + 2 * u + g] = w_; } } while (0)
    OST(0, o0); OST(1, o1); OST(2, o2); OST(3, o3);
#undef OST
}
__device__ __forceinline__ void attn_phase(Frame& F) {
    LAS float* rp = (LAS float*)(F.lds + RING_OFF + 1024);
    for (int i = F.tid; i < NAH * 15 * 31; i += NWAVES * 64) rp[i] = F.in[I_RPB][i] * LOG2E;
    __syncthreads();
    for (int wu = F.vcu; wu < NB * NAH * 8; wu += F.G) { const int bh = wu >> 3, rg = wu & 7; attn_wg_unit(F, rp, bh >> 4, bh & 15, rg * 4); }
}

__device__ __forceinline__ void mix_row(Frame& F, int row) {
    unsigned lane = (unsigned)F.lane; const int t = row & (SEQ - 1);
    const GAS char* gg = (const GAS char*)F.in[I_GNG];
    asm volatile("" : "+v"(lane) :: "memory");
    { const GAS char* ap = (const GAS char*)(F.AO + (size_t)row * NAW); v4u a[4]; float ss = 0.f;
#pragma unroll
      for (int q = 0; q < 4; ++q) { a[q] = *(const GAS v4u*)(ap + (lane * 16u + q * 1024u));
#pragma unroll
          for (int e = 0; e < 4; ++e) { const float lo = bflo(a[q][e]), hi = bfhi(a[q][e]); ss += lo * lo + hi * hi; } }
      const float rstd = 1.0f / sqrtf(wave_sum(ss) * (1.0f / NAW) + EPS);
      GAS char* yp = (GAS char*)(F.YB + (size_t)row * D);
#pragma unroll
      for (int q = 0; q < 4; ++q) { const f32x4 g0 = *(const GAS f32x4*)(gg + (lane * 32u + q * 2048u)), g1 = *(const GAS f32x4*)(gg + (lane * 32u + q * 2048u + 16u)); v4u w;
          w.x = pkbf(bflo(a[q].x) * rstd * g0.x, bfhi(a[q].x) * rstd * g0.y); w.y = pkbf(bflo(a[q].y) * rstd * g0.z, bfhi(a[q].y) * rstd * g0.w);
          w.z = pkbf(bflo(a[q].z) * rstd * g1.x, bfhi(a[q].z) * rstd * g1.y); w.w = pkbf(bflo(a[q].w) * rstd * g1.z, bfhi(a[q].w) * rstd * g1.w);
          *(GAS v4u*)(yp + (lane * 16u + q * 1024u)) = w; } }
    { const GAS char* cw = (const GAS char*)F.in[I_CONVW];
      const GAS char* r0 = (const GAS char*)(F.CB + (size_t)row * 6144);
      const GAS char* rm = t > 0 ? r0 - 12288 : r0; const GAS char* rp = t < SEQ - 1 ? r0 + 12288 : r0;
      const float fm = t > 0 ? 1.f : 0.f, fp = t < SEQ - 1 ? 1.f : 0.f;
      float co[4][8]; float ss = 0.f;
#pragma unroll
      for (int q = 0; q < 4; ++q) { const unsigned vo = lane * 16u + q * 1024u, wo = lane * 32u + q * 2048u;
          if (q == 2) __builtin_amdgcn_sched_barrier(0);
          const v4u u0 = *(const GAS v4u*)(r0 + vo), gb = *(const GAS v4u*)(r0 + (vo + 4096u)), c0v = *(const GAS v4u*)(r0 + (vo + 8192u));
          const v4u um = *(const GAS v4u*)(rm + vo), cm = *(const GAS v4u*)(rm + (vo + 8192u)), upl = *(const GAS v4u*)(rp + vo), cpl = *(const GAS v4u*)(rp + (vo + 8192u));
          const f32x4 wa0 = *(const GAS f32x4*)(cw + wo), wa1 = *(const GAS f32x4*)(cw + (wo + 16u)), wb0 = *(const GAS f32x4*)(cw + (wo + 8192u)), wb1 = *(const GAS f32x4*)(cw + (wo + 8208u)),
                      wc0 = *(const GAS f32x4*)(cw + (wo + 16384u)), wc1 = *(const GAS f32x4*)(cw + (wo + 16400u));
#pragma unroll
          for (int e = 0; e < 4; ++e) {
              const float k0l = (e < 2 ? wa0[(2 * e) & 3] : wa1[(2 * e) & 3]) * fm, k0h = (e < 2 ? wa0[(2 * e + 1) & 3] : wa1[(2 * e + 1) & 3]) * fm;
              const float k1l = e < 2 ? wb0[(2 * e) & 3] : wb1[(2 * e) & 3], k1h = e < 2 ? wb0[(2 * e + 1) & 3] : wb1[(2 * e + 1) & 3];
              const float k2l = (e < 2 ? wc0[(2 * e) & 3] : wc1[(2 * e) & 3]) * fp, k2h = (e < 2 ? wc0[(2 * e + 1) & 3] : wc1[(2 * e + 1) & 3]) * fp;
              const float vl = bflo(gb[e]) * (k0l * (bflo(cm[e]) * bflo(um[e])) + k1l * (bflo(c0v[e]) * bflo(u0[e])) + k2l * (bflo(cpl[e]) * bflo(upl[e])));
              const float vh = bfhi(gb[e]) * (k0h * (bfhi(cm[e]) * bfhi(um[e])) + k1h * (bfhi(c0v[e]) * bfhi(u0[e])) + k2h * (bfhi(cpl[e]) * bfhi(upl[e])));
              co[q][2 * e] = vl; co[q][2 * e + 1] = vh; ss += vl * vl + vh * vh; } }
      const float rstd = 1.0f / sqrtf(wave_sum(ss) * (1.0f / CVW) + EPS);
      GAS char* yp = (GAS char*)(F.YB + (size_t)row * D + NAW);
#pragma unroll
      for (int q = 0; q < 4; ++q) { const unsigned wo = lane * 32u + q * 2048u; const f32x4 g0 = *(const GAS f32x4*)(gg + (8192u + wo)), g1 = *(const GAS f32x4*)(gg + (8192u + 16u + wo)); v4u w;
          w.x = pkbf(co[q][0] * rstd * g0.x, co[q][1] * rstd * g0.y); w.y = pkbf(co[q][2] * rstd * g0.z, co[q][3] * rstd * g0.w);
          w.z = pkbf(co[q][4] * rstd * g1.x, co[q][5] * rstd * g1.y); w.w = pkbf(co[q][6] * rstd * g1.z, co[q][7] * rstd * g1.w);
          *(GAS v4u*)(yp + (lane * 16u + q * 1024u)) = w; } }
}
__device__ __forceinline__ void final_norm_row(const float* xrow, const bf16* mrow, const bf16* frow, float* orow, const float* gain, int lane) {
    const GAS f32x4* xr = (const GAS f32x4*)xrow + lane; const GAS v2u* mr = (const GAS v2u*)mrow + lane; const GAS v2u* fr = (const GAS v2u*)frow + lane;
    const GAS f32x4* g4 = (const GAS f32x4*)gain + lane; GAS f32x4* o4 = (GAS f32x4*)orow + lane;
    f32x4 v[16]; float ss = 0.f;
#pragma unroll
    for (int j = 0; j < 16; ++j) { const f32x4 x = xr[64 * j]; const v2u m = mr[64 * j], f = fr[64 * j];
        v[j] = (f32x4){x.x + bflo(m.x) + bflo(f.x), x.y + bfhi(m.x) + bfhi(f.x), x.z + bflo(m.y) + bflo(f.y), x.w + bfhi(m.y) + bfhi(f.y)};
        ss += (v[j].x * v[j].x + v[j].y * v[j].y) + (v[j].z * v[j].z + v[j].w * v[j].w); }
    const float rstd = 1.0f / sqrtf(wave_sum(ss) * (1.0f / D) + EPS);
#pragma unroll
    for (int j = 0; j < 16; ++j) o4[64 * j] = v[j] * rstd * g4[64 * j];
}

struct Args { const float* in[N_IN]; float* out; unsigned char* ws; int ph_lo, ph_hi; };
__global__ void __launch_bounds__(NWAVES * 64, 2) fwd_kernel(Args args) {
    extern __shared__ __attribute__((aligned(16))) unsigned char lds[];
    Frame F;
    F.lds = (LAS unsigned char*)lds;
    F.MISC = (volatile LAS unsigned*)(F.lds + MISC_OFF);
    F.tid = threadIdx.x; F.lane = F.tid & 63; F.wave = __builtin_amdgcn_readfirstlane(F.tid >> 6);
    F.G = gridDim.x; { const int bx = blockIdx.x; F.vcu = (F.G % 8 == 0) ? (bx % 8) * (F.G / 8) + bx / 8 : bx; }
    unsigned char* ws = args.ws;
    F.ctl = (gu32*)(ws + WS_CTL);
#pragma unroll
    for (int i = 0; i < N_IN; ++i) F.in[i] = args.in[i];
    F.out = args.out; F.mod = (float*)(ws + WS_MOD); F.rope = (float*)(ws + WS_ROPE);
    F.Win_t = (bf16*)(ws + WS_WIN); F.Wout_t = (bf16*)(ws + WS_WOUT); F.Wgu_t = (bf16*)(ws + WS_WGU); F.Wdn_t = (bf16*)(ws + WS_WDN);
    F.HB = (bf16*)(ws + WS_H); F.QB = (bf16*)(ws + WS_Q); F.KB = (bf16*)(ws + WS_K); F.VB = (bf16*)(ws + WS_V); F.CB = (bf16*)(ws + WS_C);
    F.AO = (bf16*)(ws + WS_AO); F.YB = (bf16*)(ws + WS_Y); F.ACT = (bf16*)(ws + WS_ACT); F.MX = (bf16*)(ws + WS_X1); F.FX = (bf16*)(ws + WS_X1 + 64 * MiB);
    for (int u = F.tid; u < (LDS_BYTES - LDSCTL_OFF) / 4; u += NWAVES * 64) ((LAS unsigned*)(F.lds + LDSCTL_OFF))[u] = 0u;
    __syncthreads();
    XcdBarrier bar; bar.bar = (unsigned*)(F.ctl + CW_BAR); bar.x = 0; bar.st = nullptr;
    if (N_LAUNCHES == 1) bar = xcd_barrier_post((unsigned*)(F.ctl + CW_BAR), F.MISC + 8);
    const int lo = args.ph_lo, hi = args.ph_hi;
#define IN(k) (lo <= (k) && (k) < hi)
#define SEAM(k) do { if (IN(k) && IN((k) + 1)) xcd_barrier(bar); } while (0)
    const int gw = F.vcu * NWAVES + F.wave, NGW = F.G * NWAVES;
#ifndef PROBE_DUP
#define PROBE_DUP (-1)
#endif
#define DUP(k, body) do { body; if (PROBE_DUP == (k)) { xcd_barrier(bar); body; } } while (0)

    if (IN(0)) { p0_prologue(F, 1.0f); if (PROBE_DUP == 0) { xcd_barrier(bar); p0_prologue(F, 0.0f); } SEAM(0); }
    if (IN(1)) {
        DUP(1, for (int m = gw; m < MT; m += NGW) {
            const bool isctx = m >= M; const float* xrow = isctx ? F.in[I_CTX] + (size_t)(m - M) * D : F.in[I_X] + (size_t)m * D;
            const float* mrow = F.mod + (size_t)(isctx ? 4 : (m >> 11)) * NMODC;
            norm_mod_row(xrow, F.HB + (size_t)m * D, F.in[I_N1G], mrow, mrow + D, F.lane); });
        SEAM(1);
    }
#if defined(PROBE_IDLE_US)
    if (IN(2)) { const unsigned long long t0 = __builtin_amdgcn_s_memrealtime(); while (__builtin_amdgcn_s_memrealtime() - t0 < (unsigned long long)(PROBE_IDLE_US) * 100ull) __builtin_amdgcn_s_sleep(32); }
#endif
    if (IN(2)) {
        pg8::Gemm g{F.HB, F.Win_t, MT, INC, D}; pg8::InOrder S; S.init(F.G, (int)blockIdx.x);
        pg8::EpiIn E{F.QB, F.KB, F.VB, F.CB, F.rope, 0.08838834764831845f * LOG2E};
        DUP(2, (pg8::gemm_phase<pg8::EpiIn, pg8::InOrder, PG8_ALIGN, PG8_SP2>(F.lds + RING_OFF, g, S, E)));
        if (F.G == 256 && blockIdx.x >= 64) {
            LAS float* scr = (LAS float*)(F.lds + RING_OFF + F.wave * 16384); const int p = ((int)blockIdx.x - 64) * NWAVES + F.wave;
            transpose_items<0>(F.in[I_WOUT], D, D, F.Wout_t, scr, P0_OUT_ITEMS + p, 192 * NWAVES, IT_OUT, F.lane);
            transpose_items<2>(F.in[I_WGU], D, 2 * FF, F.Wgu_t, scr, P0_GU_ITEMS + p, 192 * NWAVES, IT_GU, F.lane);
        } else if (F.G != 256) {
            LAS float* scr = (LAS float*)(F.lds + RING_OFF + F.wave * 16384);
            transpose_items<0>(F.in[I_WOUT], D, D, F.Wout_t, scr, P0_OUT_ITEMS + gw, NGW, IT_OUT, F.lane);
            transpose_items<2>(F.in[I_WGU], D, 2 * FF, F.Wgu_t, scr, P0_GU_ITEMS + gw, NGW, IT_GU, F.lane);
        }
        SEAM(2);
    }
    if (IN(3)) { DUP(3, attn_phase(F)); SEAM(3); }
    if (IN(4)) { DUP(4, for (int m = gw; m < M; m += NGW) mix_row(F, m)); SEAM(4); }
    if (IN(5)) {
        pg8::Gemm g{F.YB, F.Wout_t, M, D, D}; pg8::StaticOrder S; S.init(M, D, F.G, (int)blockIdx.x);
        pg8::EpiGate E{F.MX, D, F.mod + 2 * D};
        DUP(5, (pg8::gemm_phase<pg8::EpiGate, pg8::StaticOrder, PG8_ALIGN, PG8_SP2>(F.lds + RING_OFF, g, S, E)));
        SEAM(5);
    }
    if (IN(6)) {
        DUP(6, for (int m = gw; m < M; m += NGW) { const float* mrow = F.mod + (size_t)(m >> 11) * NMODC;
            norm_mod_row_x1(F.in[I_X] + (size_t)m * D, F.MX + (size_t)m * D, F.HB + (size_t)m * D, F.in[I_N2G], mrow + 3 * D, mrow + 4 * D, F.lane); });
        SEAM(6);
    }
    if (IN(7)) {
        pg8::Gemm g{F.HB, F.Wgu_t, M, 2 * FF, D}; pg8::StaticOrder S; S.init(M, 2 * FF, F.G, (int)blockIdx.x);
        pg8::EpiSwiglu E{F.ACT, FF};
        DUP(7, (pg8::gemm_phase<pg8::EpiSwiglu, pg8::StaticOrder, PG8_ALIGN, PG8_SP2>(F.lds + RING_OFF, g, S, E)));
        if (F.G == 256 && blockIdx.x >= 192) {
            LAS float* scr = (LAS float*)(F.lds + RING_OFF + F.wave * 16384); const int p = ((int)blockIdx.x - 192) * NWAVES + F.wave;
            transpose_items<0>(F.in[I_WDN], FF, D, F.Wdn_t, scr, P0_DN_ITEMS + p, 64 * NWAVES, IT_DN, F.lane);
        } else if (F.G != 256) {
            LAS float* scr = (LAS float*)(F.lds + RING_OFF + F.wave * 16384);
            transpose_items<0>(F.in[I_WDN], FF, D, F.Wdn_t, scr, P0_DN_ITEMS + gw, NGW, IT_DN, F.lane);
        }
        SEAM(7);
    }
    if (IN(8)) {
        pg8::Gemm g{F.ACT, F.Wdn_t, M, D, FF}; pg8::StaticOrder S; S.init(M, D, F.G, (int)blockIdx.x);
        pg8::EpiGate E{F.FX, D, F.mod + 5 * D};
        DUP(8, (pg8::gemm_phase<pg8::EpiGate, pg8::StaticOrder, PG8_ALIGN, PG8_SP2>(F.lds + RING_OFF, g, S, E)));
        SEAM(8);
    }
    if (IN(9)) { for (int m = gw; m < M; m += NGW) final_norm_row(F.in[I_X] + (size_t)m * D, F.MX + (size_t)m * D, F.FX + (size_t)m * D, F.out + (size_t)m * D, F.in[I_FNG], F.lane); }
#undef IN
#undef SEAM
}

extern "C" void kernel_launch(void* const* d_in, const int* in_sizes, int n_in, void* d_out, int out_size, void* d_ws, size_t ws_size, hipStream_t stream) {
    static int grid = 0;
    if (grid == 0) {
        if (n_in != N_IN || in_sizes[I_X] != M * D || out_size != M * D || ws_size < WS_END) { fprintf(stderr, "kernel_launch: shape / workspace mismatch (n_in %d, x %d, out %d, ws %zu); nothing launched\n", n_in, n_in > 0 ? in_sizes[0] : -1, out_size, ws_size); grid = -1; return; }
        int dev = 0, cus = 0, per_cu = 0;
        if (hipGetDevice(&dev) != hipSuccess || hipDeviceGetAttribute(&cus, hipDeviceAttributeMultiprocessorCount, dev) != hipSuccess) { fprintf(stderr, "kernel_launch: device query failed\n"); grid = -1; return; }
        if (hipFuncSetAttribute((const void*)fwd_kernel, hipFuncAttributeMaxDynamicSharedMemorySize, LDS_BYTES) != hipSuccess) { fprintf(stderr, "kernel_launch: hipFuncSetAttribute failed\n"); grid = -1; return; }
        if (hipOccupancyMaxActiveBlocksPerMultiprocessor(&per_cu, (const void*)fwd_kernel, NWAVES * 64, LDS_BYTES) != hipSuccess || per_cu < 1)
            fprintf(stderr, "kernel_launch: note: occupancy query reports %d workgroups per CU\n", per_cu);
        (void)hipGetLastError();
        grid = cus;
    }
    if (grid < 0) return;
    if (hipMemsetAsync((char*)d_ws + WS_CTL, 0, CTL_ZERO_BYTES, stream) != hipSuccess) { fprintf(stderr, "kernel_launch: memset failed\n"); return; }
    Args a{};
    for (int i = 0; i < N_IN; ++i) a.in[i] = (const float*)d_in[i];
    a.out = (float*)d_out; a.ws = (unsigned char*)d_ws;
    for (int li = 0; li < N_LAUNCHES; ++li) {
        a.ph_lo = (N_LAUNCHES == 1) ? 0 : li; a.ph_hi = (N_LAUNCHES == 1) ? N_PHASES : li + 1;
        hipLaunchKernelGGL(fwd_kernel, dim3(grid), dim3(NWAVES * 64), LDS_BYTES, stream, a);
        const hipError_t le = hipPeekAtLastError();
        if (le != hipSuccess) { fprintf(stderr, "kernel_launch: launch %d failed: %s\n", li, hipGetErrorName(le)); break; }
    }
}
```

```cpp
#include <hip/hip_runtime.h>
#include <cstdio>
#include <cstdint>
namespace pg8 {
#define PG8_LAS __attribute__((address_space(3)))
typedef unsigned short bf16_t;
typedef short bf16x8 __attribute__((ext_vector_type(8)));
typedef float f32x4 __attribute__((ext_vector_type(4)));
typedef unsigned u32x4 __attribute__((ext_vector_type(4)));
constexpr int BM = 256, BK = 64, HALF = 128, HTB = HALF * BK * 2  , STAGE_BYTES = 8 * HTB, NXCD = 8, WGM = 8;

__host__ __device__ __forceinline__ int lds_byte(int r, int c) { const int st = (r >> 4) * 2 + (c >> 5), rr = r & 15, cc = c & 31, ob = rr * 64 + cc * 2; return st * 1024 + (ob ^ (((ob >> 9) & 1) << 5)); }
__host__ __device__ __forceinline__ void stage_rc(int b, int& R, int& C) { const int st = b / 1024, sb = b % 1024, swz = sb ^ (((sb >> 9) & 1) << 5); R = (st >> 1) * 16 + swz / 64; C = (st & 1) * 32 + (swz % 64) / 2; }
__host__ __device__ __forceinline__ int perm32(int rho) { const int n = rho >> 4, i = rho & 15; return 8 * (i >> 2) + 4 * n + (i & 3); }

struct Unit { int pm, pn; };
struct Gemm { const bf16_t* A; const bf16_t* Bt; int M, N, K; };

struct StaticOrder {
    int nM, nN, nwg, G, c;
    __host__ __device__ void init(int M, int N, int G_, int c_) { nM = M / BM; nN = N / BM; nwg = nM * nN; G = G_; c = c_; }
    __host__ __device__ bool next(int i, Unit& u) const {
        const long L = (long)i * G + c; if (L >= nwg) return false;
        int wgid = (int)L; { const int q = nwg / NXCD, r = nwg % NXCD, xcd = wgid % NXCD, off = wgid / NXCD; wgid = (xcd < r ? xcd * (q + 1) : r * (q + 1) + (xcd - r) * q) + off; }
        const int nig = WGM * nN, gid = wgid / nig, fm = gid * WGM, gsz = (nM - fm) < WGM ? (nM - fm) : WGM;
        u.pm = fm + ((wgid % nig) % gsz); u.pn = (wgid % nig) / gsz; return true;
    }
    __device__ __forceinline__ void a_ready(const Unit&) const {}
    __device__ __forceinline__ void done(const Unit&) const {}
};

__device__ __forceinline__ unsigned cvt_pk_bf16(float lo, float hi) { unsigned r; asm volatile("v_cvt_pk_bf16_f32 %0, %1, %2" : "=v"(r) : "v"(lo), "v"(hi)); return r; }
typedef float f32x2 __attribute__((ext_vector_type(2)));
typedef __bf16 bf16v2 __attribute__((ext_vector_type(2)));
__device__ __forceinline__ unsigned pkbf(float lo, float hi) { f32x2 v = {lo, hi}; bf16v2 r = __builtin_convertvector(v, bf16v2); return __builtin_bit_cast(unsigned, r); }

struct EpiIn {
    static constexpr bool PERM = true, AFTER_DRAIN = false;
    bf16_t *Q, *Kd, *Vd, *Cd; const float* rope; float qscale;
    __device__ __forceinline__ void operator()(const f32x4 (&acc)[2][2][4][2], const Unit& u, int wr, int wc, int fr, int fq) const {
        const int reg = u.pn >> 3;
        bf16_t* base; int ldc, colt; bool rot = false; float sc = 1.f;
        if (reg == 0) { base = Q; ldc = 2048; colt = u.pn * BM; rot = true; sc = qscale; }
        else if (reg == 1) { base = Kd; ldc = 2048; colt = (u.pn - 8) * BM; rot = (u.pm < 32); }
        else if (reg == 2) { base = Vd; ldc = 2048; colt = (u.pn - 16) * BM; }
        else { base = Cd; ldc = 6144; colt = (u.pn - 24) * BM; }
        const int row0 = u.pm * BM + wr * 64 + fr, col0 = colt + wc * 32 + 8 * fq;
        const int blk = wc >> 1, i0 = 4 * ((4 * wc + fq) & 7);
        f32x4 cs[2], sn[2];
        cs[0] = (f32x4){1.f, 1.f, 1.f, 1.f}; sn[0] = (f32x4){0.f, 0.f, 0.f, 0.f}; cs[1] = cs[0]; sn[1] = sn[0];
        if (rot) { const int t = row0 & 2047, pos = blk ? (t & 63) : (t >> 6); cs[0] = *(const f32x4*)(rope + pos * 32 + i0); sn[0] = *(const f32x4*)(rope + 2048 + pos * 32 + i0); }
#pragma unroll
        for (int gi = 0; gi < 8; ++gi) { const int ai = gi >> 2, m = gi & 3; const int r = row0 + ai * HALF + m * 16; bf16_t* rowp = base + (size_t)r * ldc + col0;
            if (gi < 7 && rot) { const int rn = row0 + ((gi + 1) >> 2) * HALF + ((gi + 1) & 3) * 16, t = rn & 2047, pos = blk ? (t & 63) : (t >> 6);
                cs[(gi + 1) & 1] = *(const f32x4*)(rope + pos * 32 + i0); sn[(gi + 1) & 1] = *(const f32x4*)(rope + 2048 + pos * 32 + i0); }
            const f32x4 cs4 = cs[gi & 1], sn4 = sn[gi & 1];
#pragma unroll
            for (int bj = 0; bj < 2; ++bj) { const f32x4 a = acc[ai][bj][m][0], b = acc[ai][bj][m][1];
                const f32x4 v0 = (a * cs4 - b * sn4) * sc, v1 = (a * sn4 + b * cs4) * sc;
                u32x4 w; w.x = pkbf(v0[0], v0[1]); w.y = pkbf(v0[2], v0[3]); w.z = pkbf(v1[0], v1[1]); w.w = pkbf(v1[2], v1[3]);
                *(u32x4*)(rowp + bj * HALF) = w; }
            asm volatile("" ::: "memory"); }
    }
};
#ifndef EPI_NT_GATE
#define EPI_NT_GATE 0
#endif
#ifndef EPI_NT_ACT
#define EPI_NT_ACT 0
#endif
#if EPI_NT_GATE
#define EPI_GATE_STORE(v, p) __builtin_nontemporal_store((v), (p))
#else
#define EPI_GATE_STORE(v, p) (*(p) = (v))
#endif
#if EPI_NT_ACT
#define EPI_ACT_STORE(v, p) __builtin_nontemporal_store((v), (p))
#else
#define EPI_ACT_STORE(v, p) (*(p) = (v))
#endif
struct EpiGate {
    static constexpr bool PERM = true, AFTER_DRAIN = false;
    bf16_t* O; int ldc; const float* gate;
    __device__ __forceinline__ void operator()(const f32x4 (&acc)[2][2][4][2], const Unit& u, int wr, int wc, int fr, int fq) const {
        const int row0 = u.pm * BM + wr * 64 + fr, col0 = u.pn * BM + wc * 32 + 8 * fq;
        const float* gp = gate + (size_t)(u.pm >> 3) * 24576 + col0;
        f32x4 gv[2][2];
#pragma unroll
        for (int bj = 0; bj < 2; ++bj)
#pragma unroll
            for (int n = 0; n < 2; ++n) gv[bj][n] = *(const f32x4*)(gp + bj * HALF + 4 * n);
#pragma unroll
        for (int ai = 0; ai < 2; ++ai)
#pragma unroll
            for (int m = 0; m < 4; ++m) { bf16_t* rowp = O + (size_t)(row0 + ai * HALF + m * 16) * ldc + col0;
#pragma unroll
                for (int bj = 0; bj < 2; ++bj) { const f32x4 v0 = acc[ai][bj][m][0] * gv[bj][0], v1 = acc[ai][bj][m][1] * gv[bj][1];
                    u32x4 w; w.x = pkbf(v0[0], v0[1]); w.y = pkbf(v0[2], v0[3]); w.z = pkbf(v1[0], v1[1]); w.w = pkbf(v1[2], v1[3]);
                    EPI_GATE_STORE(w, (u32x4*)(rowp + bj * HALF)); } }
    }
};
struct EpiSwiglu {
    static constexpr bool PERM = true, AFTER_DRAIN = false;
    bf16_t* O; int ldc;
    __device__ __forceinline__ void operator()(const f32x4 (&acc)[2][2][4][2], const Unit& u, int wr, int wc, int fr, int fq) const {
        const int row0 = u.pm * BM + wr * 64 + fr, col0 = u.pn * HALF + wc * 32 + 8 * fq;
#pragma unroll
        for (int ai = 0; ai < 2; ++ai)
#pragma unroll
            for (int m = 0; m < 4; ++m) { bf16_t* rowp = O + (size_t)(row0 + ai * HALF + m * 16) * ldc + col0;
                float o[8];
#pragma unroll
                for (int n = 0; n < 2; ++n)
#pragma unroll
                    for (int j = 0; j < 4; ++j) { const float gt = acc[ai][0][m][n][j], up = acc[ai][1][m][n][j];
                        o[4 * n + j] = gt * __builtin_amdgcn_rcpf(1.0f + __builtin_amdgcn_exp2f(-1.44269504089f * gt)) * up; }
                u32x4 w; w.x = pkbf(o[0], o[1]); w.y = pkbf(o[2], o[3]); w.z = pkbf(o[4], o[5]); w.w = pkbf(o[6], o[7]);
                EPI_ACT_STORE(w, (u32x4*)rowp); }
    }
};
struct InOrder {
    StaticOrder so; int G, c;
    __host__ __device__ void init(int G_, int c_) { so.init(8192, 12288, G_, c_); G = G_; c = c_; }
    __host__ __device__ bool next(int i, Unit& u) const {
        const long L = (long)i * G + c; if (L >= 1600) return false;
        if (L < 1536) return so.next(i, u);
        const int e = (int)L - 1536; u.pm = 32 + (e & 3); u.pn = 8 + (e >> 2); return true;
    }
    __device__ __forceinline__ void a_ready(const Unit&) const {}
    __device__ __forceinline__ void done(const Unit&) const {}
};
template <class Epi, class Sched, bool ALIGN_EPI = false, bool SP2 = false>
__device__ __forceinline__ void gemm_phase(PG8_LAS unsigned char* lds, const Gemm g, const Sched& S, const Epi& E) {
    const int tid = threadIdx.x, wid = __builtin_amdgcn_readfirstlane(tid >> 6), lane = tid & 63, wr = wid >> 2, wc = wid & 3, fr = lane & 15, fq = lane >> 4;
    const int K = g.K, nt = K / BK;
    unsigned voffA[2], voffB[2];
#pragma unroll
    for (int i = 0; i < 2; ++i) { int R, C; stage_rc(tid * 16 + i * 8192, R, C); const int Rb = Epi::PERM ? ((R & ~31) + perm32(R & 31)) : R;
        voffA[i] = (unsigned)(R * K + C) * 2u; voffB[i] = (unsigned)(Rb * K + C) * 2u; }
    const size_t kstep = (size_t)(BK * 2);
    const size_t hstep = (size_t)HALF * K * 2;
    const size_t tstep = 2 * hstep;
    const unsigned ldsw = (unsigned)wid * 1024u;
    const int aoff = lds_byte(wr * 64 + fr, fq * 8), boff = lds_byte(wc * 32 + fr, fq * 8);
#define PG8_SA(b, h) (((b) * 2 + (h)) * HTB)
#define PG8_SB(b, h) ((4 + (b) * 2 + (h)) * HTB)
#define PG8_STAGE(bufoff, gbase, voff) do { _Pragma("unroll") for (int _i = 0; _i < 2; ++_i) \
        __builtin_amdgcn_global_load_lds((const unsigned*)((const char*)(gbase) + (voff)[_i]), (PG8_LAS unsigned*)(lds + (bufoff) + ldsw + _i * 8192), 16, 0, 0); } while (0)
#define PG8_LDA(dst, b, h) do { _Pragma("unroll") for (int m = 0; m < 4; ++m) _Pragma("unroll") for (int k = 0; k < 2; ++k) dst[m][k] = *(const PG8_LAS bf16x8*)(lds + PG8_SA(b, h) + aoff + m * 2048 + k * 1024); } while (0)
#define PG8_LDB(dst, b, h) do { _Pragma("unroll") for (int n = 0; n < 2; ++n) _Pragma("unroll") for (int k = 0; k < 2; ++k) dst[n][k] = *(const PG8_LAS bf16x8*)(lds + PG8_SB(b, h) + boff + n * 2048 + k * 1024); } while (0)
#define PG8_MMA(ai, bj, At, Bt) do { __builtin_amdgcn_s_setprio(1); _Pragma("unroll") for (int m = 0; m < 4; ++m) _Pragma("unroll") for (int n = 0; n < 2; ++n) _Pragma("unroll") for (int k = 0; k < 2; ++k) \
        acc[ai][bj][m][n] = __builtin_amdgcn_mfma_f32_16x16x32_bf16(Bt[n][k], At[m][k], acc[ai][bj][m][n], 0, 0, 0); __builtin_amdgcn_s_setprio(0); } while (0)
#define PG8_WAIT_V(n) asm volatile("s_waitcnt vmcnt(" #n ")" ::: "memory")
#define PG8_WAIT_L(n) asm volatile("s_waitcnt lgkmcnt(" #n ")" ::: "memory")
#define PG8_BAR __builtin_amdgcn_s_barrier()
#define PG8_SCHED __builtin_amdgcn_sched_barrier(0)
    Unit cur, nxt; int ui = 0;
    if (!S.next(0, cur)) return;
    f32x4 acc[2][2][4][2];
#pragma unroll
    for (int a = 0; a < 2; ++a)
#pragma unroll
        for (int b = 0; b < 2; ++b)
#pragma unroll
            for (int m = 0; m < 4; ++m)
#pragma unroll
                for (int n = 0; n < 2; ++n) acc[a][b][m][n] = (f32x4){0.f, 0.f, 0.f, 0.f};
    bf16x8 At[4][2], B0[2][2], B1[2][2];
    const char* cA = (const char*)g.A + (size_t)cur.pm * tstep; const char* cB = (const char*)g.Bt + (size_t)cur.pn * tstep;
    S.a_ready(cur);
    if constexpr (SP2) {
        PG8_STAGE(PG8_SB(0, 0), cB, voffB); PG8_STAGE(PG8_SB(0, 1), cB + hstep, voffB); PG8_STAGE(PG8_SA(0, 0), cA, voffA); PG8_STAGE(PG8_SA(0, 1), cA + hstep, voffA);
        if (wr == 1) PG8_BAR;
        PG8_WAIT_V(2); PG8_BAR;
        PG8_STAGE(PG8_SB(1, 0), cB + kstep, voffB); PG8_STAGE(PG8_SA(1, 0), cA + kstep, voffA); PG8_STAGE(PG8_SB(1, 1), cB + hstep + kstep, voffB);
        PG8_WAIT_V(6); PG8_BAR;
    } else {
        PG8_STAGE(PG8_SB(0, 0), cB, voffB); PG8_STAGE(PG8_SA(0, 0), cA, voffA); PG8_STAGE(PG8_SB(0, 1), cB + hstep, voffB); PG8_STAGE(PG8_SA(0, 1), cA + hstep, voffA);
        if (wr == 1) PG8_BAR;
        PG8_WAIT_V(4); PG8_BAR;
        PG8_STAGE(PG8_SB(1, 0), cB + kstep, voffB); PG8_STAGE(PG8_SA(1, 0), cA + kstep, voffA); PG8_STAGE(PG8_SB(1, 1), cB + hstep + kstep, voffB);
        PG8_WAIT_V(6); PG8_BAR;
    }
    for (;;) {
        const bool has_next = S.next(ui + 1, nxt);
        const char* nA = has_next ? (const char*)g.A + (size_t)nxt.pm * tstep : cA; const char* nB = has_next ? (const char*)g.Bt + (size_t)nxt.pn * tstep : cB;
        for (int t = 0; t < nt; t += 2) {
            const bool last = (t == nt - 2);
            const char* a1 = cA + (size_t)(t + 1) * kstep;
            const char* a2 = last ? nA : cA + (size_t)(t + 2) * kstep; const char* b2 = last ? nB : cB + (size_t)(t + 2) * kstep;
            const char* a3 = a2 + kstep; const char* b3 = b2 + kstep;
            if (last && has_next) S.a_ready(nxt);
            if constexpr (SP2) {
            PG8_LDB(B0, 0, 0); PG8_LDB(B1, 0, 1); PG8_SCHED; PG8_LDA(At, 0, 0); PG8_STAGE(PG8_SA(1, 1), a1 + hstep, voffA);
            PG8_WAIT_V(8); PG8_WAIT_L(0); PG8_BAR; PG8_MMA(0, 0, At, B0); PG8_MMA(0, 1, At, B1); PG8_BAR; PG8_SCHED;
            PG8_LDA(At, 0, 1); PG8_STAGE(PG8_SB(0, 0), b2, voffB); PG8_STAGE(PG8_SB(0, 1), b2 + hstep, voffB); PG8_STAGE(PG8_SA(0, 0), a2, voffA);
            PG8_WAIT_V(8); PG8_WAIT_L(0); PG8_BAR; PG8_MMA(1, 0, At, B0); PG8_MMA(1, 1, At, B1); PG8_BAR; PG8_SCHED;
            PG8_LDB(B0, 1, 0); PG8_LDB(B1, 1, 1); PG8_SCHED; PG8_LDA(At, 1, 0); PG8_STAGE(PG8_SA(0, 1), a2 + hstep, voffA);
            PG8_WAIT_V(8); PG8_WAIT_L(0); PG8_BAR; PG8_MMA(0, 0, At, B0); PG8_MMA(0, 1, At, B1); PG8_BAR; PG8_SCHED;
            PG8_LDA(At, 1, 1); PG8_STAGE(PG8_SB(1, 0), b3, voffB); PG8_STAGE(PG8_SB(1, 1), b3 + hstep, voffB); PG8_STAGE(PG8_SA(1, 0), a3, voffA);
            PG8_WAIT_V(8); PG8_WAIT_L(0); PG8_BAR; PG8_MMA(1, 0, At, B0); PG8_MMA(1, 1, At, B1); PG8_BAR; PG8_SCHED;
            } else {
            PG8_LDB(B0, 0, 0); PG8_SCHED; PG8_LDA(At, 0, 0); PG8_STAGE(PG8_SA(1, 1), a1 + hstep, voffA);
            PG8_WAIT_L(8); PG8_BAR; PG8_WAIT_L(0); PG8_MMA(0, 0, At, B0); PG8_BAR; PG8_SCHED;
            PG8_LDB(B1, 0, 1); PG8_STAGE(PG8_SB(0, 0), b2, voffB);
            PG8_BAR; PG8_WAIT_L(0); PG8_MMA(0, 1, At, B1); PG8_BAR;
            PG8_LDA(At, 0, 1); PG8_STAGE(PG8_SA(0, 0), a2, voffA);
            PG8_BAR; PG8_WAIT_L(0); PG8_MMA(1, 0, At, B0); PG8_BAR; PG8_SCHED;
            PG8_STAGE(PG8_SB(0, 1), b2 + hstep, voffB);
            PG8_WAIT_V(6); PG8_BAR; PG8_MMA(1, 1, At, B1); PG8_BAR;
            PG8_LDB(B0, 1, 0); PG8_SCHED; PG8_LDA(At, 1, 0); PG8_STAGE(PG8_SA(0, 1), a2 + hstep, voffA);
            PG8_WAIT_L(8); PG8_BAR; PG8_WAIT_L(0); PG8_MMA(0, 0, At, B0); PG8_BAR; PG8_SCHED;
            PG8_LDB(B1, 1, 1); PG8_STAGE(PG8_SB(1, 0), b3, voffB);
            PG8_BAR; PG8_WAIT_L(0); PG8_MMA(0, 1, At, B1); PG8_BAR;
            PG8_LDA(At, 1, 1); PG8_STAGE(PG8_SA(1, 0), a3, voffA);
            PG8_BAR; PG8_WAIT_L(0); PG8_MMA(1, 0, At, B0); PG8_BAR; PG8_SCHED;
            PG8_STAGE(PG8_SB(1, 1), b3 + hstep, voffB);
            PG8_WAIT_V(6); PG8_BAR; PG8_MMA(1, 1, At, B1); PG8_BAR;
            }
        }
        if constexpr (ALIGN_EPI) { if (wr == 0) PG8_BAR; }
        if constexpr (!Epi::AFTER_DRAIN) { E(acc, cur, wr, wc, fr, fq); S.done(cur); }
        if (!has_next) break;
#pragma unroll
        for (int a = 0; a < 2; ++a)
#pragma unroll
            for (int b = 0; b < 2; ++b)
#pragma unroll
                for (int m = 0; m < 4; ++m)
#pragma unroll
                    for (int n = 0; n < 2; ++n) acc[a][b][m][n] = (f32x4){0.f, 0.f, 0.f, 0.f};
        cur = nxt; cA = nA; cB = nB; ++ui;
        if constexpr (ALIGN_EPI) { if (wr == 1) PG8_BAR; }
    }
    PG8_WAIT_V(0);
    if constexpr (!ALIGN_EPI) { if (wr == 0) PG8_BAR; }
    PG8_BAR;
    if constexpr (Epi::AFTER_DRAIN) { E.fused(acc, cur, wr, wc, fr, fq, lds, wid, lane); S.done(cur); }
#undef PG8_SA
#undef PG8_SB
#undef PG8_STAGE
#undef PG8_LDA
#undef PG8_LDB
#undef PG8_MMA
#undef PG8_WAIT_V
#undef PG8_WAIT_L
#undef PG8_BAR
#undef PG8_SCHED
}
}
#ifndef PG8_SP2
#define PG8_SP2 true
#endif
#ifndef PG8_ALIGN
#define PG8_ALIGN true
#endif
constexpr int NWAVES = 8;
#ifndef MK_N_LAUNCHES
#define MK_N_LAUNCHES 1
#endif
constexpr int N_PHASES = 10;
constexpr int N_LAUNCHES = MK_N_LAUNCHES;

constexpr int D = 4096, NB = 4, SEQ = 2048, M = NB * SEQ, CTXL = 256, MC = NB * CTXL, MT = M + MC;
constexpr int HD = 128, NAH = 16, NAW = 2048, CVW = 2048, INC = 12288, FF = 11008, NMODC = 6 * D;
constexpr int GRIDW = 64, ROWS = 32, NAKH = 8, NAKW = 16;
constexpr float EPS = 1e-6f, LOG2E = 1.44269504089f;
enum { I_X = 0, I_C, I_CTX, I_CCTX, I_ADAW, I_ADAB, I_N1G, I_WIN, I_CONVW, I_RPB, I_GNG, I_WOUT, I_N2G, I_WGU, I_WDN, I_FNG, N_IN };

constexpr size_t MiB = 1u << 20;
constexpr size_t WS_CTL = 0, WS_MOD = 1 * MiB, CTL_ZERO_BYTES = 2 * MiB;
constexpr size_t WS_ROPE = 2 * MiB;
constexpr size_t WS_WIN = 4 * MiB, WS_WOUT = 100 * MiB, WS_WGU = 132 * MiB, WS_WDN = 304 * MiB;
constexpr size_t WS_H = 390 * MiB;
constexpr size_t WS_Q = 462 * MiB;
constexpr size_t WS_K = 494 * MiB;
constexpr size_t WS_V = 530 * MiB;
constexpr size_t WS_C = 566 * MiB;
constexpr size_t WS_AO = 662 * MiB;
constexpr size_t WS_Y = 694 * MiB;
constexpr size_t WS_X1 = 758 * MiB;
constexpr size_t WS_ACT = 886 * MiB;
constexpr size_t WS_END = 1058 * MiB;
static_assert(WS_WIN + (size_t)INC * D * 2 <= WS_WOUT && WS_WOUT + (size_t)D * D * 2 <= WS_WGU && WS_WGU + (size_t)2 * FF * D * 2 <= WS_WDN && WS_WDN + (size_t)D * FF * 2 <= WS_H, "ws map (weights)");
static_assert(WS_H + (size_t)MT * D * 2 <= WS_Q && WS_Q + (size_t)M * NAW * 2 <= WS_K && WS_K + (size_t)MT * NAW * 2 <= WS_V && WS_V + (size_t)MT * NAW * 2 <= WS_C && WS_C + (size_t)M * 6144 * 2 <= WS_AO, "ws map (acts 1)");
static_assert(WS_AO + (size_t)M * NAW * 2 <= WS_Y && WS_Y + (size_t)M * D * 2 <= WS_X1 && WS_X1 + (size_t)M * D * 4 <= WS_ACT && WS_ACT + (size_t)M * FF * 2 <= WS_END, "ws map (acts 2)");
constexpr int CW_BAR = 4096;

#ifndef P0_DN_ITEMS
#define P0_DN_ITEMS 0
#endif
#ifndef P0_OUT_ITEMS
#define P0_OUT_ITEMS 0
#endif
#ifndef P0_GU_ITEMS
#define P0_GU_ITEMS 0
#endif
constexpr int RING_OFF = 0, RING_BYTES = 131072;
constexpr int LDSCTL_OFF = RING_BYTES, MISC_OFF = LDSCTL_OFF + 320;
constexpr int LDS_BYTES = 147456;
static_assert(MISC_OFF + 128 <= LDS_BYTES, "LDS map");

#define GAS __attribute__((address_space(1)))
#define LAS __attribute__((address_space(3)))
typedef unsigned short bf16;
typedef unsigned v4u __attribute__((ext_vector_type(4)));
typedef float f32x4 __attribute__((ext_vector_type(4)));
typedef short bf16x8 __attribute__((ext_vector_type(8)));
typedef GAS unsigned gu32;
typedef GAS unsigned long long gu64;
#define RLX_AGENT __ATOMIC_RELAXED, __HIP_MEMORY_SCOPE_AGENT
#define LDS_WAIT() asm volatile("s_waitcnt lgkmcnt(0)" ::: "memory")
#define VM_WAIT() asm volatile("s_waitcnt vmcnt(0)" ::: "memory")
__device__ __forceinline__ unsigned long long rt() { return __builtin_amdgcn_s_memrealtime(); }
__device__ __forceinline__ unsigned f2bf(float f) { unsigned u = __builtin_bit_cast(unsigned, f); return (u + 0x7fffu + ((u >> 16) & 1u)) >> 16; }
__device__ __forceinline__ unsigned pk2(float lo, float hi) { return f2bf(lo) | (f2bf(hi) << 16); }

#define XB_TMO      128
#define XB_XCNT(j)  (256  + 64 * (j))
#define XB_XSUB(j)  (1280 + 64 * (j))
#define XB_XGEN(j)  (2304 + 64 * (j))
#define XB_TOP      3328
#define XB_TOPGEN   3392
#define XCD_BAR_WORDS 3456
#define XB_SPIN_CAP (1u << 18)

__device__ __forceinline__ unsigned xb_ld(unsigned* p)              { return __hip_atomic_load(p, __ATOMIC_RELAXED, __HIP_MEMORY_SCOPE_AGENT); }
__device__ __forceinline__ unsigned xb_add(unsigned* p, unsigned v) { return __hip_atomic_fetch_add(p, v, __ATOMIC_RELAXED, __HIP_MEMORY_SCOPE_AGENT); }
__device__ __forceinline__ unsigned xb_xcc_id() { return (unsigned)__builtin_amdgcn_s_getreg((3 << 11) | 20) & 0xFu; }
#define XB_SPIN(cond, bar) do { unsigned _sp = 0; while (cond) { __builtin_amdgcn_s_sleep(1); \
    if ((++_sp & 255u) == 0u) { if (xb_ld(&(bar)[XB_TMO])) break; if (_sp > XB_SPIN_CAP) { atomicAdd(&(bar)[XB_TMO], 1u); break; } } } } while (0)

struct XcdBarrier {
    unsigned* bar; unsigned x;
    volatile LAS unsigned* st;
};

__device__ __forceinline__ XcdBarrier xcd_barrier_post(unsigned* bar, volatile LAS unsigned* st) {
    XcdBarrier b; b.bar = bar; b.x = xb_xcc_id(); b.st = st;
    if (threadIdx.x == 0) (void)xb_add(&bar[XB_XCNT(b.x)], 1u);
    return b;
}
__device__ __forceinline__ void xcd_barrier_complete(unsigned* bar, unsigned x, unsigned& nloc, unsigned& nx) {
    const unsigned G = gridDim.x * gridDim.y * gridDim.z;
    unsigned sum, cnt, mine, sp = 0u;
    for (;;) {
        sum = 0u; cnt = 0u; mine = 0u;
#pragma unroll
        for (unsigned j = 0; j < 16; ++j) { const unsigned c = xb_ld(&bar[XB_XCNT(j)]); sum += c; cnt += (c > 0u) ? 1u : 0u; mine = (j == x) ? c : mine; }
        if (sum == G) break;
        __builtin_amdgcn_s_sleep(1);
        if ((++sp & 255u) == 0u) { if (xb_ld(&bar[XB_TMO])) break; if (sp > XB_SPIN_CAP) { atomicAdd(&bar[XB_TMO], 1u); break; } }
    }
    nloc = mine > 0u ? mine : 1u; nx = cnt > 0u ? cnt : 1u;
}

__device__ __forceinline__ void xcd_barrier(const XcdBarrier& b) {
    asm volatile("s_waitcnt vmcnt(0)" ::: "memory");
    __syncthreads();
    if (threadIdx.x == 0) {
        unsigned* bar = b.bar;
        __builtin_amdgcn_s_waitcnt(0);
        unsigned nloc = b.st[0], nx = b.st[1];
        if (nloc == 0u) { xcd_barrier_complete(bar, b.x, nloc, nx); b.st[0] = nloc; b.st[1] = nx; }
        const unsigned old = xb_add(&bar[XB_XSUB(b.x)], 1u);
        const unsigned gen = old / nloc;
        if (old + 1u == (gen + 1u) * nloc) {
            __builtin_amdgcn_fence(__ATOMIC_RELEASE, "agent");
            asm volatile("s_waitcnt vmcnt(0)" ::: "memory");
            const unsigned og = xb_add(&bar[XB_TOP], 1u);
            const unsigned tg = og / nx;
            if (og + 1u == (tg + 1u) * nx) xb_add(&bar[XB_TOPGEN], 1u);
            else XB_SPIN(xb_ld(&bar[XB_TOPGEN]) == tg, bar);
            __builtin_amdgcn_fence(__ATOMIC_ACQUIRE, "agent");
            xb_add(&bar[XB_XGEN(b.x)], 1u);
            asm volatile("s_waitcnt vmcnt(0)" ::: "memory");
        } else {
            XB_SPIN(xb_ld(&bar[XB_XGEN(b.x)]) == gen, bar);
            __builtin_amdgcn_fence(__ATOMIC_ACQUIRE, "agent");
            asm volatile("s_waitcnt vmcnt(0)" ::: "memory");
        }
    }
    __syncthreads();
}

typedef float f32x16 __attribute__((ext_vector_type(16)));
typedef unsigned v2u __attribute__((ext_vector_type(2)));
struct Frame {
    LAS unsigned char* lds;
    volatile LAS unsigned* MISC;
    gu32* ctl;
    int tid, lane, wave, vcu, G;
    const float* in[N_IN]; float* out;
    float* mod; float* rope;
    bf16 *Win_t, *Wout_t, *Wgu_t, *Wdn_t;
    bf16 *HB, *QB, *KB, *VB, *CB, *AO, *YB, *ACT, *MX, *FX;
};
template <int CTRL> __device__ __forceinline__ float dpp_add(float v) { return v + __builtin_bit_cast(float, __builtin_amdgcn_update_dpp(0, __builtin_bit_cast(int, v), CTRL, 0xf, 0xf, true)); }
__device__ __forceinline__ float wave_sum(float v) {
    v = dpp_add<0xB1>(v); v = dpp_add<0x4E>(v); v = dpp_add<0x141>(v); v = dpp_add<0x140>(v);
    v += __builtin_bit_cast(float, __builtin_amdgcn_ds_swizzle(__builtin_bit_cast(int, v), 0x401F));
    return __builtin_bit_cast(float, __builtin_amdgcn_readlane(__builtin_bit_cast(int, v), 0)) + __builtin_bit_cast(float, __builtin_amdgcn_readlane(__builtin_bit_cast(int, v), 32));
}
__device__ __forceinline__ unsigned pkbf(float lo, float hi) { return pg8::pkbf(lo, hi); }
__device__ __forceinline__ float bflo(unsigned w) { return __builtin_bit_cast(float, w << 16); }
__device__ __forceinline__ float bfhi(unsigned w) { return __builtin_bit_cast(float, w & 0xffff0000u); }

__device__ __forceinline__ int map_in(int n) {
    if (n < 4096) { const int hd = n & ~127, d = n & 127, blk = d >> 6, e4 = (d >> 5) & 1, i = d & 31; return hd + 64 * blk + 8 * (i >> 2) + 4 * e4 + (i & 3); }
    return n;
}
__device__ __forceinline__ int map_gu(int n) { const int up = n >= FF ? 1 : 0, jx = up ? n - FF : n; return 256 * (jx >> 7) + 128 * up + (jx & 127); }
#ifndef TR_NT
#define TR_NT 1
#endif
#ifndef TR_NT_ST
#define TR_NT_ST 1
#endif
#if TR_NT
#define TR_LOAD(p) __builtin_nontemporal_load(p)
#else
#define TR_LOAD(p) (*(p))
#endif
#if TR_NT_ST
#define TR_STORE(v, p) __builtin_nontemporal_store((v), (p))
#else
#define TR_STORE(v, p) (*(p) = (v))
#endif
template <int MAP> __device__ __forceinline__ void transpose_items(const float* W, int K, int N, bf16* WT, LAS float* scr, int first, int stride, int end, int lane) {
    const int nblk = N / 32;
    const GAS float* Wl = (const GAS float*)W + (size_t)(lane >> 3) * N + 4 * (lane & 7);
    LAS float* sw = scr + (lane >> 3) * 33 + 4 * (lane & 7);
    const int c = lane & 7;
    f32x4 v[8];
    int it = first;
    if (it < end) { const GAS float* Wg = Wl + (size_t)(64 * (it / nblk)) * N + 32 * (it % nblk);
#pragma unroll
        for (int i = 0; i < 8; ++i) v[i] = TR_LOAD((const GAS f32x4*)(Wg + (size_t)(8 * i) * N)); }
    while (it < end) {
        const int k0 = 64 * (it / nblk), n0 = 32 * (it % nblk);
#pragma unroll
        for (int i = 0; i < 8; ++i) { sw[(8 * i) * 33 + 0] = v[i].x; sw[(8 * i) * 33 + 1] = v[i].y; sw[(8 * i) * 33 + 2] = v[i].z; sw[(8 * i) * 33 + 3] = v[i].w; }
        const int nx = it + stride;
        if (nx < end) { const GAS float* Wg = Wl + (size_t)(64 * (nx / nblk)) * N + 32 * (nx % nblk);
#pragma unroll
            for (int i = 0; i < 8; ++i) v[i] = TR_LOAD((const GAS f32x4*)(Wg + (size_t)(8 * i) * N)); }
        LDS_WAIT(); asm volatile("" ::: "memory");
#pragma unroll
        for (int j = 0; j < 4; ++j) { const int n = (lane >> 3) + 8 * j; const LAS float* s = scr + (8 * c) * 33 + n;
            v4u o; o.x = pkbf(s[0 * 33], s[1 * 33]); o.y = pkbf(s[2 * 33], s[3 * 33]); o.z = pkbf(s[4 * 33], s[5 * 33]); o.w = pkbf(s[6 * 33], s[7 * 33]);
            const int nsrc = n0 + n, nd = MAP == 1 ? map_in(nsrc) : (MAP == 2 ? map_gu(nsrc) : nsrc);
            TR_STORE(o, (GAS v4u*)(WT + (size_t)nd * K + k0 + 8 * c)); }
        LDS_WAIT(); asm volatile("" ::: "memory");
        it = nx;
    }
}
constexpr int IT_IN = (D / 64) * (INC / 32), IT_OUT = (D / 64) * (D / 32), IT_GU = (D / 64) * (2 * FF / 32), IT_DN = (FF / 64) * (D / 32);
__device__ __forceinline__ void p0_prologue(Frame& F, const float amul) {
    { const int gi = blockIdx.x * (NWAVES * 64) + F.tid;
      if (gi < 2048) { const int pos = gi >> 5, i = gi & 31; const float fr = exp2f(-(float)i * (13.287712379549449f / 32.0f)); const float ang = (float)pos * fr;
          F.rope[gi] = cosf(ang); F.rope[2048 + gi] = sinf(ang); } }
    { LAS float* sil = (LAS float*)(F.lds + RING_OFF);
      LAS float* red = (LAS float*)(F.lds + RING_OFF + 16384);
      const GAS float* aw = (const GAS float*)F.in[I_ADAW];
      for (int it = blockIdx.x; it < 768; it += F.G) {
          const int cs = it % 96, ks = it / 96, k0 = 512 * ks;
          for (int idx = F.tid; idx < 5 * 512; idx += NWAVES * 64) { const int bb = idx >> 9, kk = idx & 511;
              const float v = bb < 4 ? F.in[I_C][bb * D + k0 + kk] : F.in[I_CCTX][k0 + kk]; sil[idx] = v / (1.0f + __expf(-v)); }
          __syncthreads();
          f32x4 a0 = {0.f, 0.f, 0.f, 0.f}, a1 = a0, a2 = a0, a3 = a0, a4 = a0;
          const GAS float* wp = aw + (size_t)(k0 + F.wave) * NMODC + 256 * cs + 4 * F.lane;
#pragma unroll 8
          for (int i = 0; i < 64; ++i) { const f32x4 w = __builtin_nontemporal_load((const GAS f32x4*)(wp + (size_t)(8 * i) * NMODC)); const int k = F.wave + 8 * i;
              a0 += sil[k] * w; a1 += sil[512 + k] * w; a2 += sil[1024 + k] * w; a3 += sil[1536 + k] * w; a4 += sil[2048 + k] * w; }
          LAS f32x4* rw = (LAS f32x4*)(red + F.wave * 1280) + F.lane;
          rw[0] = a0; rw[64] = a1; rw[128] = a2; rw[192] = a3; rw[256] = a4;
          __syncthreads();
          for (int idx = F.tid; idx < 1280; idx += NWAVES * 64) { float s = 0.f;
#pragma unroll
              for (int w = 0; w < 8; ++w) s += red[w * 1280 + idx];
              const int bb = idx >> 8, cc = idx & 255, n = 256 * cs + cc;
              if (ks == 0) s += F.in[I_ADAB][n];
              atomicAdd(F.mod + bb * NMODC + n, s * amul); }
          __syncthreads();
      } }
    LAS float* scr = (LAS float*)(F.lds + RING_OFF + F.wave * 16384);
    const int gw = F.vcu * NWAVES + F.wave, NGW = F.G * NWAVES;
    transpose_items<1>(F.in[I_WIN], D, INC, F.Win_t, scr, gw, NGW, IT_IN, F.lane);
    transpose_items<0>(F.in[I_WDN], FF, D, F.Wdn_t, scr, gw, NGW, P0_DN_ITEMS, F.lane);
    transpose_items<2>(F.in[I_WGU], D, 2 * FF, F.Wgu_t, scr, gw, NGW, P0_GU_ITEMS, F.lane);
    transpose_items<0>(F.in[I_WOUT], D, D, F.Wout_t, scr, gw, NGW, P0_OUT_ITEMS, F.lane);
}

__device__ __forceinline__ void norm_mod_row(const float* xrow, bf16* orow, const float* gain, const float* shift, const float* scale, int lane) {
    const GAS f32x4* xr = (const GAS f32x4*)xrow + lane;
    f32x4 v[16]; float ss = 0.f;
#pragma unroll
    for (int j = 0; j < 16; ++j) { v[j] = __builtin_nontemporal_load(xr + 64 * j); ss += (v[j].x * v[j].x + v[j].y * v[j].y) + (v[j].z * v[j].z + v[j].w * v[j].w); }
    const float rstd = 1.0f / sqrtf(wave_sum(ss) * (1.0f / D) + EPS);
    const GAS f32x4* g4 = (const GAS f32x4*)gain + lane; const GAS f32x4* sh4 = (const GAS f32x4*)shift + lane; const GAS f32x4* sc4 = (const GAS f32x4*)scale + lane;
    GAS v2u* o8 = (GAS v2u*)orow + lane;
#pragma unroll
    for (int j = 0; j < 16; ++j) { const f32x4 g = g4[64 * j], sh = sh4[64 * j], sc = sc4[64 * j];
        const f32x4 y = v[j] * rstd * g * (1.0f + sc) + sh; v2u w; w.x = pkbf(y.x, y.y); w.y = pkbf(y.z, y.w); o8[64 * j] = w; }
}

__device__ __forceinline__ void norm_mod_row_x1(const float* xrow, const bf16* mrow, bf16* orow, const float* gain, const float* shift, const float* scale, int lane) {
    const GAS f32x4* xr = (const GAS f32x4*)xrow + lane; const GAS v2u* mr = (const GAS v2u*)mrow + lane;
    f32x4 v[16]; float ss = 0.f;
#pragma unroll
    for (int j = 0; j < 16; ++j) { const f32x4 x = __builtin_nontemporal_load(xr + 64 * j); const v2u m = __builtin_nontemporal_load(mr + 64 * j);
        v[j] = (f32x4){x.x + bflo(m.x), x.y + bfhi(m.x), x.z + bflo(m.y), x.w + bfhi(m.y)};
        ss += (v[j].x * v[j].x + v[j].y * v[j].y) + (v[j].z * v[j].z + v[j].w * v[j].w); }
    const float rstd = 1.0f / sqrtf(wave_sum(ss) * (1.0f / D) + EPS);
    const GAS f32x4* g4 = (const GAS f32x4*)gain + lane; const GAS f32x4* sh4 = (const GAS f32x4*)shift + lane; const GAS f32x4* sc4 = (const GAS f32x4*)scale + lane;
    GAS v2u* o8 = (GAS v2u*)orow + lane;
#pragma unroll
    for (int j = 0; j < 16; ++j) { const f32x4 g = g4[64 * j], sh = sh4[64 * j], sc = sc4[64 * j];
        const f32x4 y = v[j] * rstd * g * (1.0f + sc) + sh; v2u w; w.x = pkbf(y.x, y.y); w.y = pkbf(y.z, y.w); o8[64 * j] = w; }
}

#define MFMA32(a, b, c) __builtin_amdgcn_mfma_f32_32x32x16_bf16((a), (b), (c), 0, 0, 0)
constexpr int A_NST = 6, A_STAGE = 16384, A_RING = 32768;
typedef short s16x4 __attribute__((ext_vector_type(4)));
__device__ __forceinline__ void attn_wg_unit(Frame& F, const LAS float* rp, int b, int h, int R0) {
    const int lane = F.lane, w = F.wave, j = lane & 31, g = lane >> 5;
    const int r = R0 + (w >> 1), qblk = w & 1;
    const int rs = min(max(r - NAKH / 2, 0), ROWS - NAKH);
    const int KR0 = min(max(R0 - NAKH / 2, 0), ROWS - NAKH), KR1 = min(max(R0 + 3 - NAKH / 2, 0), ROWS - NAKH) + NAKH - 1;
    const int NT = 8 + 2 * (KR1 - KR0 + 1);
    const int qc = 32 * qblk + j, cs = min(max(qc - NAKW / 2, 0), GRIDW - NAKW);
    const int bias_lane = (h * 15 + rs - r + NAKH - 1) * 31 + 8 * g - qc + NAKW - 1;
    const int mask_lane = 8 * g - cs;
    const unsigned drow = 4u * w + (lane >> 4), dsw = ((drow & 3u) << 2) | ((drow >> 2) & 3u);
    const unsigned dma_off = (drow * NAW + 8u * ((lane & 15u) ^ dsw)) * 2u;
    const char* kbase = (const char*)(F.KB + HD * h); const char* vbase = (const char*)(F.VB + HD * h);
    LAS unsigned char* ring = F.lds + RING_OFF + A_RING;
#define KEYBASE(T) ((T) >= 8 ? (b * SEQ + (KR0 + (((T) - 8) >> 1)) * GRIDW + 32 * (((T) - 8) & 1)) : (M + b * CTXL + 32 * (T)))
#define DMA(T, ST) do { const size_t go_ = (size_t)KEYBASE(T) * (NAW * 2) + dma_off; \
        __builtin_amdgcn_global_load_lds((const unsigned*)(kbase + go_), (LAS unsigned*)(ring + (ST) * A_STAGE + w * 1024), 16, 0, 0); \
        __builtin_amdgcn_global_load_lds((const unsigned*)(vbase + go_), (LAS unsigned*)(ring + (ST) * A_STAGE + 8192 + w * 1024), 16, 0, 0); } while (0)
    const unsigned kap = (j & 19) | ((j & 4) << 1) | ((j & 8) >> 1), ksw = ((kap & 3u) << 2) | ((kap >> 2) & 3u);
    unsigned ka[8];
#pragma unroll
    for (int kd = 0; kd < 8; ++kd) ka[kd] = 256u * kap + 16u * ((2u * kd + g) ^ ksw);
    const unsigned blk = (lane >> 4) & 1, q4 = (lane & 15) >> 2, p4 = lane & 3;
    unsigned va_[2][4];
#pragma unroll
    for (int t = 0; t < 2; ++t)
#pragma unroll
        for (int jb = 0; jb < 4; ++jb) { const unsigned row = 8u * g + 4u * t + q4, sw = ((row & 3u) << 2) | ((row >> 2) & 3u);
            va_[t][jb] = 8192u + 256u * row + 16u * ((4u * jb + 2u * blk + (p4 >> 1)) ^ sw) + 8u * (p4 & 1); }
    const size_t qtok = (size_t)b * SEQ + r * GRIDW + 32 * qblk + j;
    bf16x8 qf[8];
    { const GAS bf16x8* qp = (const GAS bf16x8*)(F.QB + qtok * NAW + HD * h + 8 * g);
#pragma unroll
      for (int kd = 0; kd < 8; ++kd) qf[kd] = __builtin_nontemporal_load(qp + 2 * kd); }
#pragma unroll
    for (int t = 0; t < A_NST - 1; ++t) DMA(t, t);
    f32x16 o0, o1, o2, o3;
#pragma unroll
    for (int v = 0; v < 16; ++v) { o0[v] = 0.f; o1[v] = 0.f; o2[v] = 0.f; o3[v] = 0.f; }
    float m_run = -__builtin_inff(), l_run = 0.f;
    int st = 0, stp = A_NST - 1;
    for (int t = 0; t < NT; ++t) {
        asm volatile("s_waitcnt vmcnt(%0)" :: "n"(2 * (A_NST - 2)) : "memory");
        __builtin_amdgcn_s_barrier();
        asm volatile("" ::: "memory");
        { const int tp = min(t + A_NST - 1, NT - 1); DMA(tp, stp); }
        const bool lat = t >= 8; const int kr = KR0 + ((t - 8) >> 1), kblk = (t - 8) & 1;
        const bool active = !lat || (kr >= rs && kr < rs + NAKH);
        if (active) {
            const LAS unsigned char* sb = ring + st * A_STAGE;
            f32x16 s;
#pragma unroll
            for (int v = 0; v < 16; ++v) s[v] = 0.f;
            { bf16x8 kf[8];
#pragma unroll
              for (int kd = 0; kd < 8; ++kd) kf[kd] = *(const LAS bf16x8*)(sb + ka[kd]);
#pragma unroll
              for (int kd = 0; kd < 8; ++kd) s = MFMA32(kf[kd], qf[kd], s); }
            s16x4 tv[2][2][4];
            { const unsigned sa = (unsigned)(size_t)sb;
#pragma unroll
              for (int t2 = 0; t2 < 2; ++t2)
#pragma unroll
                for (int jb = 0; jb < 4; ++jb) { asm volatile("ds_read_b64_tr_b16 %0, %1" : "=v"(tv[0][t2][jb]) : "v"(sa + va_[t2][jb]) : "memory");
                                                 asm volatile("ds_read_b64_tr_b16 %0, %1 offset:4096" : "=v"(tv[1][t2][jb]) : "v"(sa + va_[t2][jb]) : "memory"); } }
            if (lat) { int ml = mask_lane; asm volatile("" : "+v"(ml)); const LAS float* bp = rp + bias_lane + 31 * (kr - rs) + 32 * kblk;
                float bias[16];
#pragma unroll
                for (int v = 0; v < 16; ++v) bias[v] = bp[(v & 7) + 16 * (v >> 3)];
                asm volatile("" : "+v"(bias[0]), "+v"(bias[1]), "+v"(bias[2]), "+v"(bias[3]), "+v"(bias[4]), "+v"(bias[5]), "+v"(bias[6]), "+v"(bias[7]),
                             "+v"(bias[8]), "+v"(bias[9]), "+v"(bias[10]), "+v"(bias[11]), "+v"(bias[12]), "+v"(bias[13]), "+v"(bias[14]), "+v"(bias[15]));
                const int mk = ml + 32 * kblk;
#pragma unroll
                for (int v = 0; v < 16; ++v) { const int c = (v & 7) + 16 * (v >> 3); s[v] = ((unsigned)(c + mk) < 16u) ? s[v] + bias[v] : -__builtin_inff(); } }
            float mx = s[0];
#pragma unroll
            for (int v = 1; v < 16; ++v) mx = fmaxf(mx, s[v]);
            mx = fmaxf(mx, __shfl_xor(mx, 32));
            const float m_new = fmaxf(m_run, mx);
            const float alpha = __builtin_amdgcn_exp2f(m_run - m_new);
            float ps = 0.f;
#pragma unroll
            for (int v = 0; v < 16; ++v) { s[v] = __builtin_amdgcn_exp2f(s[v] - m_new); ps += s[v]; }
            l_run = l_run * alpha + ps; m_run = m_new;
#pragma unroll
            for (int v = 0; v < 16; ++v) { o0[v] *= alpha; o1[v] *= alpha; o2[v] *= alpha; o3[v] *= alpha; }
            bf16x8 pf0, pf1;
            { v4u t0, t1; t0.x = pkbf(s[0], s[1]); t0.y = pkbf(s[2], s[3]); t0.z = pkbf(s[4], s[5]); t0.w = pkbf(s[6], s[7]);
              t1.x = pkbf(s[8], s[9]); t1.y = pkbf(s[10], s[11]); t1.z = pkbf(s[12], s[13]); t1.w = pkbf(s[14], s[15]);
              pf0 = __builtin_bit_cast(bf16x8, t0); pf1 = __builtin_bit_cast(bf16x8, t1); }
            asm volatile("s_waitcnt lgkmcnt(0)" : "+v"(tv[0][0][0]), "+v"(tv[0][0][1]), "+v"(tv[0][0][2]), "+v"(tv[0][0][3]), "+v"(tv[0][1][0]), "+v"(tv[0][1][1]), "+v"(tv[0][1][2]), "+v"(tv[0][1][3]),
                         "+v"(tv[1][0][0]), "+v"(tv[1][0][1]), "+v"(tv[1][0][2]), "+v"(tv[1][0][3]), "+v"(tv[1][1][0]), "+v"(tv[1][1][1]), "+v"(tv[1][1][2]), "+v"(tv[1][1][3]) :: "memory");
#define VF(KS, JB) __builtin_shufflevector(tv[KS][0][JB], tv[KS][1][JB], 0, 1, 2, 3, 4, 5, 6, 7)
            o0 = MFMA32(VF(0, 0), pf0, o0); o1 = MFMA32(VF(0, 1), pf0, o1); o2 = MFMA32(VF(0, 2), pf0, o2); o3 = MFMA32(VF(0, 3), pf0, o3);
            o0 = MFMA32(VF(1, 0), pf1, o0); o1 = MFMA32(VF(1, 1), pf1, o1); o2 = MFMA32(VF(1, 2), pf1, o2); o3 = MFMA32(VF(1, 3), pf1, o3);
#undef VF
        }
        st = (st + 1 == A_NST) ? 0 : st + 1; stp = (stp + 1 == A_NST) ? 0 : stp + 1;
    }
#undef KEYBASE
#undef DMA
    asm volatile("s_waitcnt vmcnt(0)" ::: "memory");
    __builtin_amdgcn_s_barrier();
    asm volatile("" ::: "memory");
    const float l = l_run + __shfl_xor(l_run, 32), inv = 1.0f / l;
    GAS v2u* op = (GAS v2u*)(F.AO + qtok * NAW + HD * h);
#define OST(JB, OV) do { _Pragma("unroll") for (int u = 0; u < 4; ++u) { v2u w_; w_.x = pkbf(OV[4 * u] * inv, OV[4 * u + 1] * inv); w_.y = pkbf(OV[4 * u + 2] * inv, OV[4 * u + 3] * inv); op[8 * (JB) + 2 * u + g] = w_; } } while (0)
    OST(0, o0); OST(1, o1); OST(2, o2); OST(3, o3);
#undef OST
}
__device__ __forceinline__ void attn_phase(Frame& F) {
    LAS float* rp = (LAS float*)(F.lds + RING_OFF + 1024);
    for (int i = F.tid; i < NAH * 15 * 31; i += NWAVES * 64) rp[i] = F.in[I_RPB][i] * LOG2E;
    __syncthreads();
    for (int wu = F.vcu; wu < NB * NAH * 8; wu += F.G) { const int bh = wu >> 3, rg = wu & 7; attn_wg_unit(F, rp, bh >> 4, bh & 15, rg * 4); }
}

__device__ __forceinline__ void mix_row(Frame& F, int row) {
    unsigned lane = (unsigned)F.lane; const int t = row & (SEQ - 1);
    const GAS char* gg = (const GAS char*)F.in[I_GNG];
    asm volatile("" : "+v"(lane) :: "memory");
    { const GAS char* ap = (const GAS char*)(F.AO + (size_t)row * NAW); v4u a[4]; float ss = 0.f;
#pragma unroll
      for (int q = 0; q < 4; ++q) { a[q] = __builtin_nontemporal_load((const GAS v4u*)(ap + (lane * 16u + q * 1024u)));
#pragma unroll
          for (int e = 0; e < 4; ++e) { const float lo = bflo(a[q][e]), hi = bfhi(a[q][e]); ss += lo * lo + hi * hi; } }
      const float rstd = 1.0f / sqrtf(wave_sum(ss) * (1.0f / NAW) + EPS);
      GAS char* yp = (GAS char*)(F.YB + (size_t)row * D);
#pragma unroll
      for (int q = 0; q < 4; ++q) { const f32x4 g0 = *(const GAS f32x4*)(gg + (lane * 32u + q * 2048u)), g1 = *(const GAS f32x4*)(gg + (lane * 32u + q * 2048u + 16u)); v4u w;
          w.x = pkbf(bflo(a[q].x) * rstd * g0.x, bfhi(a[q].x) * rstd * g0.y); w.y = pkbf(bflo(a[q].y) * rstd * g0.z, bfhi(a[q].y) * rstd * g0.w);
          w.z = pkbf(bflo(a[q].z) * rstd * g1.x, bfhi(a[q].z) * rstd * g1.y); w.w = pkbf(bflo(a[q].w) * rstd * g1.z, bfhi(a[q].w) * rstd * g1.w);
          *(GAS v4u*)(yp + (lane * 16u + q * 1024u)) = w; } }
    { const GAS char* cw = (const GAS char*)F.in[I_CONVW];
      const GAS char* r0 = (const GAS char*)(F.CB + (size_t)row * 6144);
      const GAS char* rm = t > 0 ? r0 - 12288 : r0; const GAS char* rp = t < SEQ - 1 ? r0 + 12288 : r0;
      const float fm = t > 0 ? 1.f : 0.f, fp = t < SEQ - 1 ? 1.f : 0.f;
      float co[4][8]; float ss = 0.f;
#pragma unroll
      for (int q = 0; q < 4; ++q) { const unsigned vo = lane * 16u + q * 1024u, wo = lane * 32u + q * 2048u;
          if (q == 2) __builtin_amdgcn_sched_barrier(0);
          const v4u u0 = *(const GAS v4u*)(r0 + vo), gb = __builtin_nontemporal_load((const GAS v4u*)(r0 + (vo + 4096u))), c0v = *(const GAS v4u*)(r0 + (vo + 8192u));
          const v4u um = *(const GAS v4u*)(rm + vo), cm = *(const GAS v4u*)(rm + (vo + 8192u)), upl = *(const GAS v4u*)(rp + vo), cpl = *(const GAS v4u*)(rp + (vo + 8192u));
          const f32x4 wa0 = *(const GAS f32x4*)(cw + wo), wa1 = *(const GAS f32x4*)(cw + (wo + 16u)), wb0 = *(const GAS f32x4*)(cw + (wo + 8192u)), wb1 = *(const GAS f32x4*)(cw + (wo + 8208u)),
                      wc0 = *(const GAS f32x4*)(cw + (wo + 16384u)), wc1 = *(const GAS f32x4*)(cw + (wo + 16400u));
#pragma unroll
          for (int e = 0; e < 4; ++e) {
              const float k0l = (e < 2 ? wa0[(2 * e) & 3] : wa1[(2 * e) & 3]) * fm, k0h = (e < 2 ? wa0[(2 * e + 1) & 3] : wa1[(2 * e + 1) & 3]) * fm;
              const float k1l = e < 2 ? wb0[(2 * e) & 3] : wb1[(2 * e) & 3], k1h = e < 2 ? wb0[(2 * e + 1) & 3] : wb1[(2 * e + 1) & 3];
              const float k2l = (e < 2 ? wc0[(2 * e) & 3] : wc1[(2 * e) & 3]) * fp, k2h = (e < 2 ? wc0[(2 * e + 1) & 3] : wc1[(2 * e + 1) & 3]) * fp;
              const float vl = bflo(gb[e]) * (k0l * (bflo(cm[e]) * bflo(um[e])) + k1l * (bflo(c0v[e]) * bflo(u0[e])) + k2l * (bflo(cpl[e]) * bflo(upl[e])));
              const float vh = bfhi(gb[e]) * (k0h * (bfhi(cm[e]) * bfhi(um[e])) + k1h * (bfhi(c0v[e]) * bfhi(u0[e])) + k2h * (bfhi(cpl[e]) * bfhi(upl[e])));
              co[q][2 * e] = vl; co[q][2 * e + 1] = vh; ss += vl * vl + vh * vh; } }
      const float rstd = 1.0f / sqrtf(wave_sum(ss) * (1.0f / CVW) + EPS);
      GAS char* yp = (GAS char*)(F.YB + (size_t)row * D + NAW);
#pragma unroll
      for (int q = 0; q < 4; ++q) { const unsigned wo = lane * 32u + q * 2048u; const f32x4 g0 = *(const GAS f32x4*)(gg + (8192u + wo)), g1 = *(const GAS f32x4*)(gg + (8192u + 16u + wo)); v4u w;
          w.x = pkbf(co[q][0] * rstd * g0.x, co[q][1] * rstd * g0.y); w.y = pkbf(co[q][2] * rstd * g0.z, co[q][3] * rstd * g0.w);
          w.z = pkbf(co[q][4] * rstd * g1.x, co[q][5] * rstd * g1.y); w.w = pkbf(co[q][6] * rstd * g1.z, co[q][7] * rstd * g1.w);
          *(GAS v4u*)(yp + (lane * 16u + q * 1024u)) = w; } }
}
__device__ __forceinline__ void final_norm_row(const float* xrow, const bf16* mrow, const bf16* frow, float* orow, const float* gain, int lane) {
    const GAS f32x4* xr = (const GAS f32x4*)xrow + lane; const GAS v2u* mr = (const GAS v2u*)mrow + lane; const GAS v2u* fr = (const GAS v2u*)frow + lane;
    const GAS f32x4* g4 = (const GAS f32x4*)gain + lane; GAS f32x4* o4 = (GAS f32x4*)orow + lane;
    f32x4 v[16]; float ss = 0.f;
#pragma unroll
    for (int j = 0; j < 16; ++j) { const f32x4 x = __builtin_nontemporal_load(xr + 64 * j); const v2u m = __builtin_nontemporal_load(mr + 64 * j), f = __builtin_nontemporal_load(fr + 64 * j);
        v[j] = (f32x4){x.x + bflo(m.x) + bflo(f.x), x.y + bfhi(m.x) + bfhi(f.x), x.z + bflo(m.y) + bflo(f.y), x.w + bfhi(m.y) + bfhi(f.y)};
        ss += (v[j].x * v[j].x + v[j].y * v[j].y) + (v[j].z * v[j].z + v[j].w * v[j].w); }
    const float rstd = 1.0f / sqrtf(wave_sum(ss) * (1.0f / D) + EPS);
#pragma unroll
    for (int j = 0; j < 16; ++j) __builtin_nontemporal_store(v[j] * rstd * g4[64 * j], o4 + 64 * j);
}

struct Args { const float* in[N_IN]; float* out; unsigned char* ws; int ph_lo, ph_hi; };
__global__ void __launch_bounds__(NWAVES * 64, 2) fwd_kernel(Args args) {
    extern __shared__ __attribute__((aligned(16))) unsigned char lds[];
    Frame F;
    F.lds = (LAS unsigned char*)lds;
    F.MISC = (volatile LAS unsigned*)(F.lds + MISC_OFF);
    F.tid = threadIdx.x; F.lane = F.tid & 63; F.wave = __builtin_amdgcn_readfirstlane(F.tid >> 6);
    F.G = gridDim.x; { const int bx = blockIdx.x; F.vcu = (F.G % 8 == 0) ? (bx % 8) * (F.G / 8) + bx / 8 : bx; }
    unsigned char* ws = args.ws;
    F.ctl = (gu32*)(ws + WS_CTL);
#pragma unroll
    for (int i = 0; i < N_IN; ++i) F.in[i] = args.in[i];
    F.out = args.out; F.mod = (float*)(ws + WS_MOD); F.rope = (float*)(ws + WS_ROPE);
    F.Win_t = (bf16*)(ws + WS_WIN); F.Wout_t = (bf16*)(ws + WS_WOUT); F.Wgu_t = (bf16*)(ws + WS_WGU); F.Wdn_t = (bf16*)(ws + WS_WDN);
    F.HB = (bf16*)(ws + WS_H); F.QB = (bf16*)(ws + WS_Q); F.KB = (bf16*)(ws + WS_K); F.VB = (bf16*)(ws + WS_V); F.CB = (bf16*)(ws + WS_C);
    F.AO = (bf16*)(ws + WS_AO); F.YB = (bf16*)(ws + WS_Y); F.ACT = (bf16*)(ws + WS_ACT); F.MX = (bf16*)(ws + WS_X1); F.FX = (bf16*)(ws + WS_X1 + 64 * MiB);
    for (int u = F.tid; u < (LDS_BYTES - LDSCTL_OFF) / 4; u += NWAVES * 64) ((LAS unsigned*)(F.lds + LDSCTL_OFF))[u] = 0u;
    __syncthreads();
    XcdBarrier bar; bar.bar = (unsigned*)(F.ctl + CW_BAR); bar.x = 0; bar.st = nullptr;
    if (N_LAUNCHES == 1) bar = xcd_barrier_post((unsigned*)(F.ctl + CW_BAR), F.MISC + 8);
    const int lo = args.ph_lo, hi = args.ph_hi;
#define IN(k) (lo <= (k) && (k) < hi)
#define SEAM(k) do { if (IN(k) && IN((k) + 1)) xcd_barrier(bar); } while (0)
    const int gw = F.vcu * NWAVES + F.wave, NGW = F.G * NWAVES;
#ifndef PROBE_DUP
#define PROBE_DUP (-1)
#endif
#define DUP(k, body) do { body; if (PROBE_DUP == (k)) { xcd_barrier(bar); body; } } while (0)

    if (IN(0)) { p0_prologue(F, 1.0f); if (PROBE_DUP == 0) { xcd_barrier(bar); p0_prologue(F, 0.0f); } SEAM(0); }
    if (IN(1)) {
        DUP(1, for (int m = gw; m < MT; m += NGW) {
            const bool isctx = m >= M; const float* xrow = isctx ? F.in[I_CTX] + (size_t)(m - M) * D : F.in[I_X] + (size_t)m * D;
            const float* mrow = F.mod + (size_t)(isctx ? 4 : (m >> 11)) * NMODC;
            norm_mod_row(xrow, F.HB + (size_t)m * D, F.in[I_N1G], mrow, mrow + D, F.lane); });
        SEAM(1);
    }
#if defined(PROBE_IDLE_US)
    if (IN(2)) { const unsigned long long t0 = __builtin_amdgcn_s_memrealtime(); while (__builtin_amdgcn_s_memrealtime() - t0 < (unsigned long long)(PROBE_IDLE_US) * 100ull) __builtin_amdgcn_s_sleep(32); }
#endif
    if (IN(2)) {
        pg8::Gemm g{F.HB, F.Win_t, MT, INC, D}; pg8::InOrder S; S.init(F.G, (int)blockIdx.x);
        pg8::EpiIn E{F.QB, F.KB, F.VB, F.CB, F.rope, 0.08838834764831845f * LOG2E};
        DUP(2, (pg8::gemm_phase<pg8::EpiIn, pg8::InOrder, PG8_ALIGN, PG8_SP2>(F.lds + RING_OFF, g, S, E)));
        if (F.G == 256 && blockIdx.x >= 64) {
            LAS float* scr = (LAS float*)(F.lds + RING_OFF + F.wave * 16384); const int p = ((int)blockIdx.x - 64) * NWAVES + F.wave;
            transpose_items<0>(F.in[I_WOUT], D, D, F.Wout_t, scr, P0_OUT_ITEMS + p, 192 * NWAVES, IT_OUT, F.lane);
            transpose_items<2>(F.in[I_WGU], D, 2 * FF, F.Wgu_t, scr, P0_GU_ITEMS + p, 192 * NWAVES, IT_GU, F.lane);
        } else if (F.G != 256) {
            LAS float* scr = (LAS float*)(F.lds + RING_OFF + F.wave * 16384);
            transpose_items<0>(F.in[I_WOUT], D, D, F.Wout_t, scr, P0_OUT_ITEMS + gw, NGW, IT_OUT, F.lane);
            transpose_items<2>(F.in[I_WGU], D, 2 * FF, F.Wgu_t, scr, P0_GU_ITEMS + gw, NGW, IT_GU, F.lane);
        }
        SEAM(2);
    }
    if (IN(3)) { DUP(3, attn_phase(F)); SEAM(3); }
    if (IN(4)) { DUP(4, for (int m = gw; m < M; m += NGW) mix_row(F, m)); SEAM(4); }
    if (IN(5)) {
        pg8::Gemm g{F.YB, F.Wout_t, M, D, D}; pg8::StaticOrder S; S.init(M, D, F.G, (int)blockIdx.x);
        pg8::EpiGate E{F.MX, D, F.mod + 2 * D};
        DUP(5, (pg8::gemm_phase<pg8::EpiGate, pg8::StaticOrder, PG8_ALIGN, PG8_SP2>(F.lds + RING_OFF, g, S, E)));
        SEAM(5);
    }
    if (IN(6)) {
        DUP(6, for (int m = gw; m < M; m += NGW) { const float* mrow = F.mod + (size_t)(m >> 11) * NMODC;
            norm_mod_row_x1(F.in[I_X] + (size_t)m * D, F.MX + (size_t)m * D, F.HB + (size_t)m * D, F.in[I_N2G], mrow + 3 * D, mrow + 4 * D, F.lane); });
        SEAM(6);
    }
    if (IN(7)) {
        pg8::Gemm g{F.HB, F.Wgu_t, M, 2 * FF, D}; pg8::StaticOrder S; S.init(M, 2 * FF, F.G, (int)blockIdx.x);
        pg8::EpiSwiglu E{F.ACT, FF};
        DUP(7, (pg8::gemm_phase<pg8::EpiSwiglu, pg8::StaticOrder, PG8_ALIGN, PG8_SP2>(F.lds + RING_OFF, g, S, E)));
        if (F.G == 256 && blockIdx.x >= 192) {
            LAS float* scr = (LAS float*)(F.lds + RING_OFF + F.wave * 16384); const int p = ((int)blockIdx.x - 192) * NWAVES + F.wave;
            transpose_items<0>(F.in[I_WDN], FF, D, F.Wdn_t, scr, P0_DN_ITEMS + p, 64 * NWAVES, IT_DN, F.lane);
        } else if (F.G != 256) {
            LAS float* scr = (LAS float*)(F.lds + RING_OFF + F.wave * 16384);
            transpose_items<0>(F.in[I_WDN], FF, D, F.Wdn_t, scr, P0_DN_ITEMS + gw, NGW, IT_DN, F.lane);
        }
        SEAM(7);
    }
    if (IN(8)) {
        pg8::Gemm g{F.ACT, F.Wdn_t, M, D, FF}; pg8::StaticOrder S; S.init(M, D, F.G, (int)blockIdx.x);
        pg8::EpiGate E{F.FX, D, F.mod + 5 * D};
        DUP(8, (pg8::gemm_phase<pg8::EpiGate, pg8::StaticOrder, PG8_ALIGN, PG8_SP2>(F.lds + RING_OFF, g, S, E)));
        SEAM(8);
    }
    if (IN(9)) { for (int m = gw; m < M; m += NGW) final_norm_row(F.in[I_X] + (size_t)m * D, F.MX + (size_t)m * D, F.FX + (size_t)m * D, F.out + (size_t)m * D, F.in[I_FNG], F.lane); }
#undef IN
#undef SEAM
}

extern "C" void kernel_launch(void* const* d_in, const int* in_sizes, int n_in, void* d_out, int out_size, void* d_ws, size_t ws_size, hipStream_t stream) {
    static int grid = 0;
    if (grid == 0) {
        if (n_in != N_IN || in_sizes[I_X] != M * D || out_size != M * D || ws_size < WS_END) { fprintf(stderr, "kernel_launch: shape / workspace mismatch (n_in %d, x %d, out %d, ws %zu); nothing launched\n", n_in, n_in > 0 ? in_sizes[0] : -1, out_size, ws_size); grid = -1; return; }
        int dev = 0, cus = 0, per_cu = 0;
        if (hipGetDevice(&dev) != hipSuccess || hipDeviceGetAttribute(&cus, hipDeviceAttributeMultiprocessorCount, dev) != hipSuccess) { fprintf(stderr, "kernel_launch: device query failed\n"); grid = -1; return; }
        if (hipFuncSetAttribute((const void*)fwd_kernel, hipFuncAttributeMaxDynamicSharedMemorySize, LDS_BYTES) != hipSuccess) { fprintf(stderr, "kernel_launch: hipFuncSetAttribute failed\n"); grid = -1; return; }
        if (hipOccupancyMaxActiveBlocksPerMultiprocessor(&per_cu, (const void*)fwd_kernel, NWAVES * 64, LDS_BYTES) != hipSuccess || per_cu < 1)
            fprintf(stderr, "kernel_launch: note: occupancy query reports %d workgroups per CU\n", per_cu);
        (void)hipGetLastError();
        grid = cus;
    }
    if (grid < 0) return;
    if (hipMemsetAsync((char*)d_ws + WS_CTL, 0, CTL_ZERO_BYTES, stream) != hipSuccess) { fprintf(stderr, "kernel_launch: memset failed\n"); return; }
    Args a{};
    for (int i = 0; i < N_IN; ++i) a.in[i] = (const float*)d_in[i];
    a.out = (float*)d_out; a.ws = (unsigned char*)d_ws;
    for (int li = 0; li < N_LAUNCHES; ++li) {
        a.ph_lo = (N_LAUNCHES == 1) ? 0 : li; a.ph_hi = (N_LAUNCHES == 1) ? N_PHASES : li + 1;
        hipLaunchKernelGGL(fwd_kernel, dim3(grid), dim3(NWAVES * 64), LDS_BYTES, stream, a);
        const hipError_t le = hipPeekAtLastError();
        if (le != hipSuccess) { fprintf(stderr, "kernel_launch: launch %d failed: %s\n", li, hipGetErrorName(le)); break; }
    }
}
```

```cpp
#include <hip/hip_runtime.h>
#include <cstdio>
#include <cstdint>
namespace pg8 {
#define PG8_LAS __attribute__((address_space(3)))
typedef unsigned short bf16_t;
typedef short bf16x8 __attribute__((ext_vector_type(8)));
typedef float f32x4 __attribute__((ext_vector_type(4)));
typedef unsigned u32x4 __attribute__((ext_vector_type(4)));
constexpr int BM = 256, BK = 64, HALF = 128, HTB = HALF * BK * 2  , STAGE_BYTES = 8 * HTB, NXCD = 8, WGM = 8;

__host__ __device__ __forceinline__ int lds_byte(int r, int c) { const int st = (r >> 4) * 2 + (c >> 5), rr = r & 15, cc = c & 31, ob = rr * 64 + cc * 2; return st * 1024 + (ob ^ (((ob >> 9) & 1) << 5)); }
__host__ __device__ __forceinline__ void stage_rc(int b, int& R, int& C) { const int st = b / 1024, sb = b % 1024, swz = sb ^ (((sb >> 9) & 1) << 5); R = (st >> 1) * 16 + swz / 64; C = (st & 1) * 32 + (swz % 64) / 2; }
__host__ __device__ __forceinline__ int perm32(int rho) { const int n = rho >> 4, i = rho & 15; return 8 * (i >> 2) + 4 * n + (i & 3); }

struct Unit { int pm, pn; };
struct Gemm { const bf16_t* A; const bf16_t* Bt; int M, N, K; };

struct StaticOrder {
    int nM, nN, nwg, G, c;
    __host__ __device__ void init(int M, int N, int G_, int c_) { nM = M / BM; nN = N / BM; nwg = nM * nN; G = G_; c = c_; }
    __host__ __device__ bool next(int i, Unit& u) const {
        const long L = (long)i * G + c; if (L >= nwg) return false;
        int wgid = (int)L; { const int q = nwg / NXCD, r = nwg % NXCD, xcd = wgid % NXCD, off = wgid / NXCD; wgid = (xcd < r ? xcd * (q + 1) : r * (q + 1) + (xcd - r) * q) + off; }
        const int nig = WGM * nN, gid = wgid / nig, fm = gid * WGM, gsz = (nM - fm) < WGM ? (nM - fm) : WGM;
        u.pm = fm + ((wgid % nig) % gsz); u.pn = (wgid % nig) / gsz; return true;
    }
    __device__ __forceinline__ void a_ready(const Unit&) const {}
    __device__ __forceinline__ void done(const Unit&) const {}
};

__device__ __forceinline__ unsigned cvt_pk_bf16(float lo, float hi) { unsigned r; asm volatile("v_cvt_pk_bf16_f32 %0, %1, %2" : "=v"(r) : "v"(lo), "v"(hi)); return r; }
typedef float f32x2 __attribute__((ext_vector_type(2)));
typedef __bf16 bf16v2 __attribute__((ext_vector_type(2)));
__device__ __forceinline__ unsigned pkbf(float lo, float hi) { f32x2 v = {lo, hi}; bf16v2 r = __builtin_convertvector(v, bf16v2); return __builtin_bit_cast(unsigned, r); }

struct EpiIn {
    static constexpr bool PERM = true, AFTER_DRAIN = false;
    bf16_t *Q, *Kd, *Vd, *Cd; const float* rope; float qscale;
    __device__ __forceinline__ void operator()(const f32x4 (&acc)[2][2][4][2], const Unit& u, int wr, int wc, int fr, int fq) const {
        const int reg = u.pn >> 3;
        bf16_t* base; int ldc, colt; bool rot = false; float sc = 1.f;
        if (reg == 0) { base = Q; ldc = 2048; colt = u.pn * BM; rot = true; sc = qscale; }
        else if (reg == 1) { base = Kd; ldc = 2048; colt = (u.pn - 8) * BM; rot = (u.pm < 32); }
        else if (reg == 2) { base = Vd; ldc = 2048; colt = (u.pn - 16) * BM; }
        else { base = Cd; ldc = 6144; colt = (u.pn - 24) * BM; }
        const int row0 = u.pm * BM + wr * 64 + fr, col0 = colt + wc * 32 + 8 * fq;
        const int blk = wc >> 1, i0 = 4 * ((4 * wc + fq) & 7);
        f32x4 cs[2], sn[2];
        cs[0] = (f32x4){1.f, 1.f, 1.f, 1.f}; sn[0] = (f32x4){0.f, 0.f, 0.f, 0.f}; cs[1] = cs[0]; sn[1] = sn[0];
        if (rot) { const int t = row0 & 2047, pos = blk ? (t & 63) : (t >> 6); cs[0] = *(const f32x4*)(rope + pos * 32 + i0); sn[0] = *(const f32x4*)(rope + 2048 + pos * 32 + i0); }
#pragma unroll
        for (int gi = 0; gi < 8; ++gi) { const int ai = gi >> 2, m = gi & 3; const int r = row0 + ai * HALF + m * 16; bf16_t* rowp = base + (size_t)r * ldc + col0;
            if (gi < 7 && rot) { const int rn = row0 + ((gi + 1) >> 2) * HALF + ((gi + 1) & 3) * 16, t = rn & 2047, pos = blk ? (t & 63) : (t >> 6);
                cs[(gi + 1) & 1] = *(const f32x4*)(rope + pos * 32 + i0); sn[(gi + 1) & 1] = *(const f32x4*)(rope + 2048 + pos * 32 + i0); }
            const f32x4 cs4 = cs[gi & 1], sn4 = sn[gi & 1];
#pragma unroll
            for (int bj = 0; bj < 2; ++bj) { const f32x4 a = acc[ai][bj][m][0], b = acc[ai][bj][m][1];
                const f32x4 v0 = (a * cs4 - b * sn4) * sc, v1 = (a * sn4 + b * cs4) * sc;
                u32x4 w; w.x = pkbf(v0[0], v0[1]); w.y = pkbf(v0[2], v0[3]); w.z = pkbf(v1[0], v1[1]); w.w = pkbf(v1[2], v1[3]);
                *(u32x4*)(rowp + bj * HALF) = w; }
            asm volatile("" ::: "memory"); }
    }
};
#ifndef EPI_NT_GATE
#define EPI_NT_GATE 0
#endif
#ifndef EPI_NT_ACT
#define EPI_NT_ACT 0
#endif
#if EPI_NT_GATE
#define EPI_GATE_STORE(v, p) __builtin_nontemporal_store((v), (p))
#else
#define EPI_GATE_STORE(v, p) (*(p) = (v))
#endif
#if EPI_NT_ACT
#define EPI_ACT_STORE(v, p) __builtin_nontemporal_store((v), (p))
#else
#define EPI_ACT_STORE(v, p) (*(p) = (v))
#endif
struct EpiGate {
    static constexpr bool PERM = true, AFTER_DRAIN = false;
    bf16_t* O; int ldc; const float* gate;
    __device__ __forceinline__ void operator()(const f32x4 (&acc)[2][2][4][2], const Unit& u, int wr, int wc, int fr, int fq) const {
        const int row0 = u.pm * BM + wr * 64 + fr, col0 = u.pn * BM + wc * 32 + 8 * fq;
        const float* gp = gate + (size_t)(u.pm >> 3) * 24576 + col0;
        f32x4 gv[2][2];
#pragma unroll
        for (int bj = 0; bj < 2; ++bj)
#pragma unroll
            for (int n = 0; n < 2; ++n) gv[bj][n] = *(const f32x4*)(gp + bj * HALF + 4 * n);
#pragma unroll
        for (int ai = 0; ai < 2; ++ai)
#pragma unroll
            for (int m = 0; m < 4; ++m) { bf16_t* rowp = O + (size_t)(row0 + ai * HALF + m * 16) * ldc + col0;
#pragma unroll
                for (int bj = 0; bj < 2; ++bj) { const f32x4 v0 = acc[ai][bj][m][0] * gv[bj][0], v1 = acc[ai][bj][m][1] * gv[bj][1];
                    u32x4 w; w.x = pkbf(v0[0], v0[1]); w.y = pkbf(v0[2], v0[3]); w.z = pkbf(v1[0], v1[1]); w.w = pkbf(v1[2], v1[3]);
                    EPI_GATE_STORE(w, (u32x4*)(rowp + bj * HALF)); } }
    }
};
struct EpiSwiglu {
    static constexpr bool PERM = true, AFTER_DRAIN = false;
    bf16_t* O; int ldc;
    __device__ __forceinline__ void operator()(const f32x4 (&acc)[2][2][4][2], const Unit& u, int wr, int wc, int fr, int fq) const {
        const int row0 = u.pm * BM + wr * 64 + fr, col0 = u.pn * HALF + wc * 32 + 8 * fq;
#pragma unroll
        for (int ai = 0; ai < 2; ++ai)
#pragma unroll
            for (int m = 0; m < 4; ++m) { bf16_t* rowp = O + (size_t)(row0 + ai * HALF + m * 16) * ldc + col0;
                float o[8];
#pragma unroll
                for (int n = 0; n < 2; ++n)
#pragma unroll
                    for (int j = 0; j < 4; ++j) { const float gt = acc[ai][0][m][n][j], up = acc[ai][1][m][n][j];
                        o[4 * n + j] = gt * __builtin_amdgcn_rcpf(1.0f + __builtin_amdgcn_exp2f(-1.44269504089f * gt)) * up; }
                u32x4 w; w.x = pkbf(o[0], o[1]); w.y = pkbf(o[2], o[3]); w.z = pkbf(o[4], o[5]); w.w = pkbf(o[6], o[7]);
                EPI_ACT_STORE(w, (u32x4*)rowp); }
    }
};
struct InOrder {
    StaticOrder so; int G, c;
    __host__ __device__ void init(int G_, int c_) { so.init(8192, 12288, G_, c_); G = G_; c = c_; }
    __host__ __device__ bool next(int i, Unit& u) const {
        const long L = (long)i * G + c; if (L >= 1600) return false;
        if (L < 1536) return so.next(i, u);
        const int e = (int)L - 1536; u.pm = 32 + (e & 3); u.pn = 8 + (e >> 2); return true;
    }
    __device__ __forceinline__ void a_ready(const Unit&) const {}
    __device__ __forceinline__ void done(const Unit&) const {}
};
template <class Epi, class Sched, bool ALIGN_EPI = false, bool SP2 = false>
__device__ __forceinline__ void gemm_phase(PG8_LAS unsigned char* lds, const Gemm g, const Sched& S, const Epi& E) {
    const int tid = threadIdx.x, wid = __builtin_amdgcn_readfirstlane(tid >> 6), lane = tid & 63, wr = wid >> 2, wc = wid & 3, fr = lane & 15, fq = lane >> 4;
    const int K = g.K, nt = K / BK;
    unsigned voffA[2], voffB[2];
#pragma unroll
    for (int i = 0; i < 2; ++i) { int R, C; stage_rc(tid * 16 + i * 8192, R, C); const int Rb = Epi::PERM ? ((R & ~31) + perm32(R & 31)) : R;
        voffA[i] = (unsigned)(R * K + C) * 2u; voffB[i] = (unsigned)(Rb * K + C) * 2u; }
    const size_t kstep = (size_t)(BK * 2);
    const size_t hstep = (size_t)HALF * K * 2;
    const size_t tstep = 2 * hstep;
    const unsigned ldsw = (unsigned)wid * 1024u;
    const int aoff = lds_byte(wr * 64 + fr, fq * 8), boff = lds_byte(wc * 32 + fr, fq * 8);
#define PG8_SA(b, h) (((b) * 2 + (h)) * HTB)
#define PG8_SB(b, h) ((4 + (b) * 2 + (h)) * HTB)
#define PG8_STAGE(bufoff, gbase, voff) do { _Pragma("unroll") for (int _i = 0; _i < 2; ++_i) \
        __builtin_amdgcn_global_load_lds((const unsigned*)((const char*)(gbase) + (voff)[_i]), (PG8_LAS unsigned*)(lds + (bufoff) + ldsw + _i * 8192), 16, 0, 0); } while (0)
#define PG8_LDA(dst, b, h) do { _Pragma("unroll") for (int m = 0; m < 4; ++m) _Pragma("unroll") for (int k = 0; k < 2; ++k) dst[m][k] = *(const PG8_LAS bf16x8*)(lds + PG8_SA(b, h) + aoff + m * 2048 + k * 1024); } while (0)
#define PG8_LDB(dst, b, h) do { _Pragma("unroll") for (int n = 0; n < 2; ++n) _Pragma("unroll") for (int k = 0; k < 2; ++k) dst[n][k] = *(const PG8_LAS bf16x8*)(lds + PG8_SB(b, h) + boff + n * 2048 + k * 1024); } while (0)
#define PG8_MMA(ai, bj, At, Bt) do { __builtin_amdgcn_s_setprio(1); _Pragma("unroll") for (int m = 0; m < 4; ++m) _Pragma("unroll") for (int n = 0; n < 2; ++n) _Pragma("unroll") for (int k = 0; k < 2; ++k) \
        acc[ai][bj][m][n] = __builtin_amdgcn_mfma_f32_16x16x32_bf16(Bt[n][k], At[m][k], acc[ai][bj][m][n], 0, 0, 0); __builtin_amdgcn_s_setprio(0); } while (0)
#define PG8_WAIT_V(n) asm volatile("s_waitcnt vmcnt(" #n ")" ::: "memory")
#define PG8_WAIT_L(n) asm volatile("s_waitcnt lgkmcnt(" #n ")" ::: "memory")
#define PG8_BAR __builtin_amdgcn_s_barrier()
#define PG8_SCHED __builtin_amdgcn_sched_barrier(0)
    Unit cur, nxt; int ui = 0;
    if (!S.next(0, cur)) return;
    f32x4 acc[2][2][4][2];
#pragma unroll
    for (int a = 0; a < 2; ++a)
#pragma unroll
        for (int b = 0; b < 2; ++b)
#pragma unroll
            for (int m = 0; m < 4; ++m)
#pragma unroll
                for (int n = 0; n < 2; ++n) acc[a][b][m][n] = (f32x4){0.f, 0.f, 0.f, 0.f};
    bf16x8 At[4][2], B0[2][2], B1[2][2];
    const char* cA = (const char*)g.A + (size_t)cur.pm * tstep; const char* cB = (const char*)g.Bt + (size_t)cur.pn * tstep;
    S.a_ready(cur);
    if constexpr (SP2) {
        PG8_STAGE(PG8_SB(0, 0), cB, voffB); PG8_STAGE(PG8_SB(0, 1), cB + hstep, voffB); PG8_STAGE(PG8_SA(0, 0), cA, voffA); PG8_STAGE(PG8_SA(0, 1), cA + hstep, voffA);
        if (wr == 1) PG8_BAR;
        PG8_WAIT_V(2); PG8_BAR;
        PG8_STAGE(PG8_SB(1, 0), cB + kstep, voffB); PG8_STAGE(PG8_SA(1, 0), cA + kstep, voffA); PG8_STAGE(PG8_SB(1, 1), cB + hstep + kstep, voffB);
        PG8_WAIT_V(6); PG8_BAR;
    } else {
        PG8_STAGE(PG8_SB(0, 0), cB, voffB); PG8_STAGE(PG8_SA(0, 0), cA, voffA); PG8_STAGE(PG8_SB(0, 1), cB + hstep, voffB); PG8_STAGE(PG8_SA(0, 1), cA + hstep, voffA);
        if (wr == 1) PG8_BAR;
        PG8_WAIT_V(4); PG8_BAR;
        PG8_STAGE(PG8_SB(1, 0), cB + kstep, voffB); PG8_STAGE(PG8_SA(1, 0), cA + kstep, voffA); PG8_STAGE(PG8_SB(1, 1), cB + hstep + kstep, voffB);
        PG8_WAIT_V(6); PG8_BAR;
    }
    for (;;) {
        const bool has_next = S.next(ui + 1, nxt);
        const char* nA = has_next ? (const char*)g.A + (size_t)nxt.pm * tstep : cA; const char* nB = has_next ? (const char*)g.Bt + (size_t)nxt.pn * tstep : cB;
        for (int t = 0; t < nt; t += 2) {
            const bool last = (t == nt - 2);
            const char* a1 = cA + (size_t)(t + 1) * kstep;
            const char* a2 = last ? nA : cA + (size_t)(t + 2) * kstep; const char* b2 = last ? nB : cB + (size_t)(t + 2) * kstep;
            const char* a3 = a2 + kstep; const char* b3 = b2 + kstep;
            if (last && has_next) S.a_ready(nxt);
            if constexpr (SP2) {
            PG8_LDB(B0, 0, 0); PG8_LDB(B1, 0, 1); PG8_SCHED; PG8_LDA(At, 0, 0); PG8_STAGE(PG8_SA(1, 1), a1 + hstep, voffA);
            PG8_WAIT_V(8); PG8_WAIT_L(0); PG8_BAR; PG8_MMA(0, 0, At, B0); PG8_MMA(0, 1, At, B1); PG8_BAR; PG8_SCHED;
            PG8_LDA(At, 0, 1); PG8_STAGE(PG8_SB(0, 0), b2, voffB); PG8_STAGE(PG8_SB(0, 1), b2 + hstep, voffB); PG8_STAGE(PG8_SA(0, 0), a2, voffA);
            PG8_WAIT_V(8); PG8_WAIT_L(0); PG8_BAR; PG8_MMA(1, 0, At, B0); PG8_MMA(1, 1, At, B1); PG8_BAR; PG8_SCHED;
            PG8_LDB(B0, 1, 0); PG8_LDB(B1, 1, 1); PG8_SCHED; PG8_LDA(At, 1, 0); PG8_STAGE(PG8_SA(0, 1), a2 + hstep, voffA);
            PG8_WAIT_V(8); PG8_WAIT_L(0); PG8_BAR; PG8_MMA(0, 0, At, B0); PG8_MMA(0, 1, At, B1); PG8_BAR; PG8_SCHED;
            PG8_LDA(At, 1, 1); PG8_STAGE(PG8_SB(1, 0), b3, voffB); PG8_STAGE(PG8_SB(1, 1), b3 + hstep, voffB); PG8_STAGE(PG8_SA(1, 0), a3, voffA);
            PG8_WAIT_V(8); PG8_WAIT_L(0); PG8_BAR; PG8_MMA(1, 0, At, B0); PG8_MMA(1, 1, At, B1); PG8_BAR; PG8_SCHED;
            } else {
            PG8_LDB(B0, 0, 0); PG8_SCHED; PG8_LDA(At, 0, 0); PG8_STAGE(PG8_SA(1, 1), a1 + hstep, voffA);
            PG8_WAIT_L(8); PG8_BAR; PG8_WAIT_L(0); PG8_MMA(0, 0, At, B0); PG8_BAR; PG8_SCHED;
            PG8_LDB(B1, 0, 1); PG8_STAGE(PG8_SB(0, 0), b2, voffB);
            PG8_BAR; PG8_WAIT_L(0); PG8_MMA(0, 1, At, B1); PG8_BAR;
            PG8_LDA(At, 0, 1); PG8_STAGE(PG8_SA(0, 0), a2, voffA);
            PG8_BAR; PG8_WAIT_L(0); PG8_MMA(1, 0, At, B0); PG8_BAR; PG8_SCHED;
            PG8_STAGE(PG8_SB(0, 1), b2 + hstep, voffB);
            PG8_WAIT_V(6); PG8_BAR; PG8_MMA(1, 1, At, B1); PG8_BAR;
            PG8_LDB(B0, 1, 0); PG8_SCHED; PG8_LDA(At, 1, 0); PG8_STAGE(PG8_SA(0, 1), a2 + hstep, voffA);
            PG8_WAIT_L(8); PG8_BAR; PG8_WAIT_L(0); PG8_MMA(0, 0, At, B0); PG8_BAR; PG8_SCHED;
            PG8_LDB(B1, 1, 1); PG8_STAGE(PG8_SB(1, 0), b3, voffB);
            PG8_BAR; PG8_WAIT_L(0); PG8_MMA(0, 1, At, B1); PG8_BAR;
            PG8_LDA(At, 1, 1); PG8_STAGE(PG8_SA(1, 0), a3, voffA);
            PG8_BAR; PG8_WAIT_L(0); PG8_MMA(1, 0, At, B0); PG8_BAR; PG8_SCHED;
            PG8_STAGE(PG8_SB(1, 1), b3 + hstep, voffB);
            PG8_WAIT_V(6); PG8_BAR; PG8_MMA(1, 1, At, B1); PG8_BAR;
            }
        }
        if constexpr (ALIGN_EPI) { if (wr == 0) PG8_BAR; }
        if constexpr (!Epi::AFTER_DRAIN) { E(acc, cur, wr, wc, fr, fq); S.done(cur); }
        if (!has_next) break;
#pragma unroll
        for (int a = 0; a < 2; ++a)
#pragma unroll
            for (int b = 0; b < 2; ++b)
#pragma unroll
                for (int m = 0; m < 4; ++m)
#pragma unroll
                    for (int n = 0; n < 2; ++n) acc[a][b][m][n] = (f32x4){0.f, 0.f, 0.f, 0.f};
        cur = nxt; cA = nA; cB = nB; ++ui;
        if constexpr (ALIGN_EPI) { if (wr == 1) PG8_BAR; }
    }
    PG8_WAIT_V(0);
    if constexpr (!ALIGN_EPI) { if (wr == 0) PG8_BAR; }
    PG8_BAR;
    if constexpr (Epi::AFTER_DRAIN) { E.fused(acc, cur, wr, wc, fr, fq, lds, wid, lane); S.done(cur); }
#undef PG8_SA
#undef PG8_SB
#undef PG8_STAGE
#undef PG8_LDA
#undef PG8_LDB
#undef PG8_MMA
#undef PG8_WAIT_V
#undef PG8_WAIT_L
#undef PG8_BAR
#undef PG8_SCHED
}
}
#ifndef PG8_SP2
#define PG8_SP2 true
#endif
#ifndef PG8_ALIGN
#define PG8_ALIGN true
#endif
constexpr int NWAVES = 8;
#ifndef MK_N_LAUNCHES
#define MK_N_LAUNCHES 1
#endif
constexpr int N_PHASES = 10;
constexpr int N_LAUNCHES = MK_N_LAUNCHES;

constexpr int D = 4096, NB = 4, SEQ = 2048, M = NB * SEQ, CTXL = 256, MC = NB * CTXL, MT = M + MC;
constexpr int HD = 128, NAH = 16, NAW = 2048, CVW = 2048, INC = 12288, FF = 11008, NMODC = 6 * D;
constexpr int GRIDW = 64, ROWS = 32, NAKH = 8, NAKW = 16;
constexpr float EPS = 1e-6f, LOG2E = 1.44269504089f;
enum { I_X = 0, I_C, I_CTX, I_CCTX, I_ADAW, I_ADAB, I_N1G, I_WIN, I_CONVW, I_RPB, I_GNG, I_WOUT, I_N2G, I_WGU, I_WDN, I_FNG, N_IN };

constexpr size_t MiB = 1u << 20;
constexpr size_t WS_CTL = 0, WS_MOD = 1 * MiB, CTL_ZERO_BYTES = 2 * MiB;
constexpr size_t WS_ROPE = 2 * MiB;
constexpr size_t WS_WIN = 4 * MiB, WS_WOUT = 100 * MiB, WS_WGU = 132 * MiB, WS_WDN = 304 * MiB;
constexpr size_t WS_H = 390 * MiB;
constexpr size_t WS_Q = 462 * MiB;
constexpr size_t WS_K = 494 * MiB;
constexpr size_t WS_V = 530 * MiB;
constexpr size_t WS_C = 566 * MiB;
constexpr size_t WS_AO = 662 * MiB;
constexpr size_t WS_Y = 694 * MiB;
constexpr size_t WS_X1 = 758 * MiB;
constexpr size_t WS_ACT = 886 * MiB;
constexpr size_t WS_END = 1058 * MiB;
static_assert(WS_WIN + (size_t)INC * D * 2 <= WS_WOUT && WS_WOUT + (size_t)D * D * 2 <= WS_WGU && WS_WGU + (size_t)2 * FF * D * 2 <= WS_WDN && WS_WDN + (size_t)D * FF * 2 <= WS_H, "ws map (weights)");
static_assert(WS_H + (size_t)MT * D * 2 <= WS_Q && WS_Q + (size_t)M * NAW * 2 <= WS_K && WS_K + (size_t)MT * NAW * 2 <= WS_V && WS_V + (size_t)MT * NAW * 2 <= WS_C && WS_C + (size_t)M * 6144 * 2 <= WS_AO, "ws map (acts 1)");
static_assert(WS_AO + (size_t)M * NAW * 2 <= WS_Y && WS_Y + (size_t)M * D * 2 <= WS_X1 && WS_X1 + (size_t)M * D * 4 <= WS_ACT && WS_ACT + (size_t)M * FF * 2 <= WS_END, "ws map (acts 2)");
constexpr int CW_BAR = 4096;

#ifndef P0_DN_ITEMS
#define P0_DN_ITEMS 0
#endif
#ifndef P0_OUT_ITEMS
#define P0_OUT_ITEMS 0
#endif
#ifndef P0_GU_ITEMS
#define P0_GU_ITEMS 0
#endif
constexpr int RING_OFF = 0, RING_BYTES = 131072;
constexpr int LDSCTL_OFF = RING_BYTES, MISC_OFF = LDSCTL_OFF + 320;
constexpr int LDS_BYTES = 147456;
static_assert(MISC_OFF + 128 <= LDS_BYTES, "LDS map");

#define GAS __attribute__((address_space(1)))
#define LAS __attribute__((address_space(3)))
typedef unsigned short bf16;
typedef unsigned v4u __attribute__((ext_vector_type(4)));
typedef float f32x4 __attribute__((ext_vector_type(4)));
typedef short bf16x8 __attribute__((ext_vector_type(8)));
typedef GAS unsigned gu32;
typedef GAS unsigned long long gu64;
#define RLX_AGENT __ATOMIC_RELAXED, __HIP_MEMORY_SCOPE_AGENT
#define LDS_WAIT() asm volatile("s_waitcnt lgkmcnt(0)" ::: "memory")
#define VM_WAIT() asm volatile("s_waitcnt vmcnt(0)" ::: "memory")
__device__ __forceinline__ unsigned long long rt() { return __builtin_amdgcn_s_memrealtime(); }
__device__ __forceinline__ unsigned f2bf(float f) { unsigned u = __builtin_bit_cast(unsigned, f); return (u + 0x7fffu + ((u >> 16) & 1u)) >> 16; }
__device__ __forceinline__ unsigned pk2(float lo, float hi) { return f2bf(lo) | (f2bf(hi) << 16); }

#define XB_TMO      128
#define XB_XCNT(j)  (256  + 64 * (j))
#define XB_XSUB(j)  (1280 + 64 * (j))
#define XB_XGEN(j)  (2304 + 64 * (j))
#define XB_TOP      3328
#define XB_TOPGEN   3392
#define XCD_BAR_WORDS 3456
#define XB_SPIN_CAP (1u << 18)

__device__ __forceinline__ unsigned xb_ld(unsigned* p)              { return __hip_atomic_load(p, __ATOMIC_RELAXED, __HIP_MEMORY_SCOPE_AGENT); }
__device__ __forceinline__ unsigned xb_add(unsigned* p, unsigned v) { return __hip_atomic_fetch_add(p, v, __ATOMIC_RELAXED, __HIP_MEMORY_SCOPE_AGENT); }
__device__ __forceinline__ unsigned xb_xcc_id() { return (unsigned)__builtin_amdgcn_s_getreg((3 << 11) | 20) & 0xFu; }
#define XB_SPIN(cond, bar) do { unsigned _sp = 0; while (cond) { __builtin_amdgcn_s_sleep(1); \
    if ((++_sp & 255u) == 0u) { if (xb_ld(&(bar)[XB_TMO])) break; if (_sp > XB_SPIN_CAP) { atomicAdd(&(bar)[XB_TMO], 1u); break; } } } } while (0)

struct XcdBarrier {
    unsigned* bar; unsigned x;
    volatile LAS unsigned* st;
};

__device__ __forceinline__ XcdBarrier xcd_barrier_post(unsigned* bar, volatile LAS unsigned* st) {
    XcdBarrier b; b.bar = bar; b.x = xb_xcc_id(); b.st = st;
    if (threadIdx.x == 0) (void)xb_add(&bar[XB_XCNT(b.x)], 1u);
    return b;
}
__device__ __forceinline__ void xcd_barrier_complete(unsigned* bar, unsigned x, unsigned& nloc, unsigned& nx) {
    const unsigned G = gridDim.x * gridDim.y * gridDim.z;
    unsigned sum, cnt, mine, sp = 0u;
    for (;;) {
        sum = 0u; cnt = 0u; mine = 0u;
#pragma unroll
        for (unsigned j = 0; j < 16; ++j) { const unsigned c = xb_ld(&bar[XB_XCNT(j)]); sum += c; cnt += (c > 0u) ? 1u : 0u; mine = (j == x) ? c : mine; }
        if (sum == G) break;
        __builtin_amdgcn_s_sleep(1);
        if ((++sp & 255u) == 0u) { if (xb_ld(&bar[XB_TMO])) break; if (sp > XB_SPIN_CAP) { atomicAdd(&bar[XB_TMO], 1u); break; } }
    }
    nloc = mine > 0u ? mine : 1u; nx = cnt > 0u ? cnt : 1u;
}

__device__ __forceinline__ void xcd_barrier(const XcdBarrier& b) {
    asm volatile("s_waitcnt vmcnt(0)" ::: "memory");
    __syncthreads();
    if (threadIdx.x == 0) {
        unsigned* bar = b.bar;
        __builtin_amdgcn_s_waitcnt(0);
        unsigned nloc = b.st[0], nx = b.st[1];
        if (nloc == 0u) { xcd_barrier_complete(bar, b.x, nloc, nx); b.st[0] = nloc; b.st[1] = nx; }
        const unsigned old = xb_add(&bar[XB_XSUB(b.x)], 1u);
        const unsigned gen = old / nloc;
        if (old + 1u == (gen + 1u) * nloc) {
            __builtin_amdgcn_fence(__ATOMIC_RELEASE, "agent");
            asm volatile("s_waitcnt vmcnt(0)" ::: "memory");
            const unsigned og = xb_add(&bar[XB_TOP], 1u);
            const unsigned tg = og / nx;
            if (og + 1u == (tg + 1u) * nx) xb_add(&bar[XB_TOPGEN], 1u);
            else XB_SPIN(xb_ld(&bar[XB_TOPGEN]) == tg, bar);
            __builtin_amdgcn_fence(__ATOMIC_ACQUIRE, "agent");
            xb_add(&bar[XB_XGEN(b.x)], 1u);
            asm volatile("s_waitcnt vmcnt(0)" ::: "memory");
        } else {
            XB_SPIN(xb_ld(&bar[XB_XGEN(b.x)]) == gen, bar);
            __builtin_amdgcn_fence(__ATOMIC_ACQUIRE, "agent");
            asm volatile("s_waitcnt vmcnt(0)" ::: "memory");
        }
    }
    __syncthreads();
}

typedef float f32x16 __attribute__((ext_vector_type(16)));
typedef unsigned v2u __attribute__((ext_vector_type(2)));
struct Frame {
    LAS unsigned char* lds;
    volatile LAS unsigned* MISC;
    gu32* ctl;
    int tid, lane, wave, vcu, G;
    const float* in[N_IN]; float* out;
    float* mod; float* rope;
    bf16 *Win_t, *Wout_t, *Wgu_t, *Wdn_t;
    bf16 *HB, *QB, *KB, *VB, *CB, *AO, *YB, *ACT, *MX, *FX;
};
template <int CTRL> __device__ __forceinline__ float dpp_add(float v) { return v + __builtin_bit_cast(float, __builtin_amdgcn_update_dpp(0, __builtin_bit_cast(int, v), CTRL, 0xf, 0xf, true)); }
__device__ __forceinline__ float wave_sum(float v) {
    v = dpp_add<0xB1>(v); v = dpp_add<0x4E>(v); v = dpp_add<0x141>(v); v = dpp_add<0x140>(v);
    v += __builtin_bit_cast(float, __builtin_amdgcn_ds_swizzle(__builtin_bit_cast(int, v), 0x401F));
    return __builtin_bit_cast(float, __builtin_amdgcn_readlane(__builtin_bit_cast(int, v), 0)) + __builtin_bit_cast(float, __builtin_amdgcn_readlane(__builtin_bit_cast(int, v), 32));
}
__device__ __forceinline__ unsigned pkbf(float lo, float hi) { return pg8::pkbf(lo, hi); }
__device__ __forceinline__ float bflo(unsigned w) { return __builtin_bit_cast(float, w << 16); }
__device__ __forceinline__ float bfhi(unsigned w) { return __builtin_bit_cast(float, w & 0xffff0000u); }

__device__ __forceinline__ int map_in(int n) {
    if (n < 4096) { const int hd = n & ~127, d = n & 127, blk = d >> 6, e4 = (d >> 5) & 1, i = d & 31; return hd + 64 * blk + 8 * (i >> 2) + 4 * e4 + (i & 3); }
    return n;
}
__device__ __forceinline__ int map_gu(int n) { const int up = n >= FF ? 1 : 0, jx = up ? n - FF : n; return 256 * (jx >> 7) + 128 * up + (jx & 127); }
#ifndef TR_NT
#define TR_NT 1
#endif
#ifndef TR_NT_ST
#define TR_NT_ST 1
#endif
#if TR_NT
#define TR_LOAD(p) __builtin_nontemporal_load(p)
#else
#define TR_LOAD(p) (*(p))
#endif
#if TR_NT_ST
#define TR_STORE(v, p) __builtin_nontemporal_store((v), (p))
#else
#define TR_STORE(v, p) (*(p) = (v))
#endif
template <int MAP> __device__ __forceinline__ void transpose_items(const float* W, int K, int N, bf16* WT, LAS float* scr, int first, int stride, int end, int lane) {
    const int nblk = N / 32;
    const GAS float* Wl = (const GAS float*)W + (size_t)(lane >> 3) * N + 4 * (lane & 7);
    LAS float* sw = scr + (lane >> 3) * 33 + 4 * (lane & 7);
    const int c = lane & 7;
    f32x4 v[8];
    int it = first;
    if (it < end) { const GAS float* Wg = Wl + (size_t)(64 * (it / nblk)) * N + 32 * (it % nblk);
#pragma unroll
        for (int i = 0; i < 8; ++i) v[i] = TR_LOAD((const GAS f32x4*)(Wg + (size_t)(8 * i) * N)); }
    while (it < end) {
        const int k0 = 64 * (it / nblk), n0 = 32 * (it % nblk);
#pragma unroll
        for (int i = 0; i < 8; ++i) { sw[(8 * i) * 33 + 0] = v[i].x; sw[(8 * i) * 33 + 1] = v[i].y; sw[(8 * i) * 33 + 2] = v[i].z; sw[(8 * i) * 33 + 3] = v[i].w; }
        const int nx = it + stride;
        if (nx < end) { const GAS float* Wg = Wl + (size_t)(64 * (nx / nblk)) * N + 32 * (nx % nblk);
#pragma unroll
            for (int i = 0; i < 8; ++i) v[i] = TR_LOAD((const GAS f32x4*)(Wg + (size_t)(8 * i) * N)); }
        LDS_WAIT(); asm volatile("" ::: "memory");
#pragma unroll
        for (int j = 0; j < 4; ++j) { const int n = (lane >> 3) + 8 * j; const LAS float* s = scr + (8 * c) * 33 + n;
            v4u o; o.x = pkbf(s[0 * 33], s[1 * 33]); o.y = pkbf(s[2 * 33], s[3 * 33]); o.z = pkbf(s[4 * 33], s[5 * 33]); o.w = pkbf(s[6 * 33], s[7 * 33]);
            const int nsrc = n0 + n, nd = MAP == 1 ? map_in(nsrc) : (MAP == 2 ? map_gu(nsrc) : nsrc);
            TR_STORE(o, (GAS v4u*)(WT + (size_t)nd * K + k0 + 8 * c)); }
        LDS_WAIT(); asm volatile("" ::: "memory");
        it = nx;
    }
}
constexpr int IT_IN = (D / 64) * (INC / 32), IT_OUT = (D / 64) * (D / 32), IT_GU = (D / 64) * (2 * FF / 32), IT_DN = (FF / 64) * (D / 32);
__device__ __forceinline__ void p0_prologue(Frame& F, const float amul) {
    { const int gi = blockIdx.x * (NWAVES * 64) + F.tid;
      if (gi < 2048) { const int pos = gi >> 5, i = gi & 31; const float fr = exp2f(-(float)i * (13.287712379549449f / 32.0f)); const float ang = (float)pos * fr;
          F.rope[gi] = cosf(ang); F.rope[2048 + gi] = sinf(ang); } }
    { LAS float* sil = (LAS float*)(F.lds + RING_OFF);
      LAS float* red = (LAS float*)(F.lds + RING_OFF + 16384);
      const GAS float* aw = (const GAS float*)F.in[I_ADAW];
      for (int it = blockIdx.x; it < 768; it += F.G) {
          const int cs = it % 96, ks = it / 96, k0 = 512 * ks;
          for (int idx = F.tid; idx < 5 * 512; idx += NWAVES * 64) { const int bb = idx >> 9, kk = idx & 511;
              const float v = bb < 4 ? F.in[I_C][bb * D + k0 + kk] : F.in[I_CCTX][k0 + kk]; sil[idx] = v / (1.0f + __expf(-v)); }
          __syncthreads();
          f32x4 a0 = {0.f, 0.f, 0.f, 0.f}, a1 = a0, a2 = a0, a3 = a0, a4 = a0;
          const GAS float* wp = aw + (size_t)(k0 + F.wave) * NMODC + 256 * cs + 4 * F.lane;
#pragma unroll 8
          for (int i = 0; i < 64; ++i) { const f32x4 w = __builtin_nontemporal_load((const GAS f32x4*)(wp + (size_t)(8 * i) * NMODC)); const int k = F.wave + 8 * i;
              a0 += sil[k] * w; a1 += sil[512 + k] * w; a2 += sil[1024 + k] * w; a3 += sil[1536 + k] * w; a4 += sil[2048 + k] * w; }
          LAS f32x4* rw = (LAS f32x4*)(red + F.wave * 1280) + F.lane;
          rw[0] = a0; rw[64] = a1; rw[128] = a2; rw[192] = a3; rw[256] = a4;
          __syncthreads();
          for (int idx = F.tid; idx < 1280; idx += NWAVES * 64) { float s = 0.f;
#pragma unroll
              for (int w = 0; w < 8; ++w) s += red[w * 1280 + idx];
              const int bb = idx >> 8, cc = idx & 255, n = 256 * cs + cc;
              if (ks == 0) s += F.in[I_ADAB][n];
              atomicAdd(F.mod + bb * NMODC + n, s * amul); }
          __syncthreads();
      } }
    LAS float* scr = (LAS float*)(F.lds + RING_OFF + F.wave * 16384);
    const int gw = F.vcu * NWAVES + F.wave, NGW = F.G * NWAVES;
    transpose_items<1>(F.in[I_WIN], D, INC, F.Win_t, scr, gw, NGW, IT_IN, F.lane);
    transpose_items<0>(F.in[I_WDN], FF, D, F.Wdn_t, scr, gw, NGW, P0_DN_ITEMS, F.lane);
    transpose_items<2>(F.in[I_WGU], D, 2 * FF, F.Wgu_t, scr, gw, NGW, P0_GU_ITEMS, F.lane);
    transpose_items<0>(F.in[I_WOUT], D, D, F.Wout_t, scr, gw, NGW, P0_OUT_ITEMS, F.lane);
}

__device__ __forceinline__ void norm_mod_row(const float* xrow, bf16* orow, const float* gain, const float* shift, const float* scale, int lane) {
    const GAS f32x4* xr = (const GAS f32x4*)xrow + lane;
    f32x4 v[16]; float ss = 0.f;
#pragma unroll
    for (int j = 0; j < 16; ++j) { v[j] = __builtin_nontemporal_load(xr + 64 * j); ss += (v[j].x * v[j].x + v[j].y * v[j].y) + (v[j].z * v[j].z + v[j].w * v[j].w); }
    const float rstd = 1.0f / sqrtf(wave_sum(ss) * (1.0f / D) + EPS);
    const GAS f32x4* g4 = (const GAS f32x4*)gain + lane; const GAS f32x4* sh4 = (const GAS f32x4*)shift + lane; const GAS f32x4* sc4 = (const GAS f32x4*)scale + lane;
    GAS v2u* o8 = (GAS v2u*)orow + lane;
#pragma unroll
    for (int j = 0; j < 16; ++j) { const f32x4 g = g4[64 * j], sh = sh4[64 * j], sc = sc4[64 * j];
        const f32x4 y = v[j] * rstd * g * (1.0f + sc) + sh; v2u w; w.x = pkbf(y.x, y.y); w.y = pkbf(y.z, y.w); o8[64 * j] = w; }
}

__device__ __forceinline__ void norm_mod_row_x1(const float* xrow, const bf16* mrow, bf16* orow, const float* gain, const float* shift, const float* scale, int lane) {
    const GAS f32x4* xr = (const GAS f32x4*)xrow + lane; const GAS v2u* mr = (const GAS v2u*)mrow + lane;
    f32x4 v[16]; float ss = 0.f;
#pragma unroll
    for (int j = 0; j < 16; ++j) { const f32x4 x = __builtin_nontemporal_load(xr + 64 * j); const v2u m = __builtin_nontemporal_load(mr + 64 * j);
        v[j] = (f32x4){x.x + bflo(m.x), x.y + bfhi(m.x), x.z + bflo(m.y), x.w + bfhi(m.y)};
        ss += (v[j].x * v[j].x + v[j].y * v[j].y) + (v[j].z * v[j].z + v[j].w * v[j].w); }
    const float rstd = 1.0f / sqrtf(wave_sum(ss) * (1.0f / D) + EPS);
    const GAS f32x4* g4 = (const GAS f32x4*)gain + lane; const GAS f32x4* sh4 = (const GAS f32x4*)shift + lane; const GAS f32x4* sc4 = (const GAS f32x4*)scale + lane;
    GAS v2u* o8 = (GAS v2u*)orow + lane;
#pragma unroll
    for (int j = 0; j < 16; ++j) { const f32x4 g = g4[64 * j], sh = sh4[64 * j], sc = sc4[64 * j];
        const f32x4 y = v[j] * rstd * g * (1.0f + sc) + sh; v2u w; w.x = pkbf(y.x, y.y); w.y = pkbf(y.z, y.w); o8[64 * j] = w; }
}

#define MFMA32(a, b, c) __builtin_amdgcn_mfma_f32_32x32x16_bf16((a), (b), (c), 0, 0, 0)
constexpr int A_NST = 6, A_STAGE = 16384, A_RING = 32768;
typedef short s16x4 __attribute__((ext_vector_type(4)));
__device__ __forceinline__ void attn_wg_unit(Frame& F, const LAS float* rp, int b, int h, int R0) {
    const int lane = F.lane, w = F.wave, j = lane & 31, g = lane >> 5;
    const int r = R0 + (w >> 1), qblk = w & 1;
    const int rs = min(max(r - NAKH / 2, 0), ROWS - NAKH);
    const int KR0 = min(max(R0 - NAKH / 2, 0), ROWS - NAKH), KR1 = min(max(R0 + 3 - NAKH / 2, 0), ROWS - NAKH) + NAKH - 1;
    const int NT = 8 + 2 * (KR1 - KR0 + 1);
    const int qc = 32 * qblk + j, cs = min(max(qc - NAKW / 2, 0), GRIDW - NAKW);
    const int bias_lane = (h * 15 + rs - r + NAKH - 1) * 31 + 8 * g - qc + NAKW - 1;
    const int mask_lane = 8 * g - cs;
    const unsigned drow = 4u * w + (lane >> 4), dsw = ((drow & 3u) << 2) | ((drow >> 2) & 3u);
    const unsigned dma_off = (drow * NAW + 8u * ((lane & 15u) ^ dsw)) * 2u;
    const char* kbase = (const char*)(F.KB + HD * h); const char* vbase = (const char*)(F.VB + HD * h);
    LAS unsigned char* ring = F.lds + RING_OFF + A_RING;
#define KEYBASE(T) ((T) >= 8 ? (b * SEQ + (KR0 + (((T) - 8) >> 1)) * GRIDW + 32 * (((T) - 8) & 1)) : (M + b * CTXL + 32 * (T)))
#define DMA(T, ST) do { const size_t go_ = (size_t)KEYBASE(T) * (NAW * 2) + dma_off; \
        __builtin_amdgcn_global_load_lds((const unsigned*)(kbase + go_), (LAS unsigned*)(ring + (ST) * A_STAGE + w * 1024), 16, 0, 0); \
        __builtin_amdgcn_global_load_lds((const unsigned*)(vbase + go_), (LAS unsigned*)(ring + (ST) * A_STAGE + 8192 + w * 1024), 16, 0, 0); } while (0)
    const unsigned kap = (j & 19) | ((j & 4) << 1) | ((j & 8) >> 1), ksw = ((kap & 3u) << 2) | ((kap >> 2) & 3u);
    unsigned ka[8];
#pragma unroll
    for (int kd = 0; kd < 8; ++kd) ka[kd] = 256u * kap + 16u * ((2u * kd + g) ^ ksw);
    const unsigned blk = (lane >> 4) & 1, q4 = (lane & 15) >> 2, p4 = lane & 3;
    unsigned va_[2][4];
#pragma unroll
    for (int t = 0; t < 2; ++t)
#pragma unroll
        for (int jb = 0; jb < 4; ++jb) { const unsigned row = 8u * g + 4u * t + q4, sw = ((row & 3u) << 2) | ((row >> 2) & 3u);
            va_[t][jb] = 8192u + 256u * row + 16u * ((4u * jb + 2u * blk + (p4 >> 1)) ^ sw) + 8u * (p4 & 1); }
    const size_t qtok = (size_t)b * SEQ + r * GRIDW + 32 * qblk + j;
    bf16x8 qf[8];
    { const GAS bf16x8* qp = (const GAS bf16x8*)(F.QB + qtok * NAW + HD * h + 8 * g);
#pragma unroll
      for (int kd = 0; kd < 8; ++kd) qf[kd] = __builtin_nontemporal_load(qp + 2 * kd); }
#pragma unroll
    for (int t = 0; t < A_NST - 1; ++t) DMA(t, t);
    f32x16 o0, o1, o2, o3;
#pragma unroll
    for (int v = 0; v < 16; ++v) { o0[v] = 0.f; o1[v] = 0.f; o2[v] = 0.f; o3[v] = 0.f; }
    float m_run = -__builtin_inff(), l_run = 0.f;
    int st = 0, stp = A_NST - 1;
    for (int t = 0; t < NT; ++t) {
        asm volatile("s_waitcnt vmcnt(%0)" :: "n"(2 * (A_NST - 2)) : "memory");
        __builtin_amdgcn_s_barrier();
        asm volatile("" ::: "memory");
        { const int tp = min(t + A_NST - 1, NT - 1); DMA(tp, stp); }
        const bool lat = t >= 8; const int kr = KR0 + ((t - 8) >> 1), kblk = (t - 8) & 1;
        const bool active = !lat || (kr >= rs && kr < rs + NAKH);
        if (active) {
            const LAS unsigned char* sb = ring + st * A_STAGE;
            f32x16 s;
#pragma unroll
            for (int v = 0; v < 16; ++v) s[v] = 0.f;
            { bf16x8 kf[8];
#pragma unroll
              for (int kd = 0; kd < 8; ++kd) kf[kd] = *(const LAS bf16x8*)(sb + ka[kd]);
#pragma unroll
              for (int kd = 0; kd < 8; ++kd) s = MFMA32(kf[kd], qf[kd], s); }
            s16x4 tv[2][2][4];
            { const unsigned sa = (unsigned)(size_t)sb;
#pragma unroll
              for (int t2 = 0; t2 < 2; ++t2)
#pragma unroll
                for (int jb = 0; jb < 4; ++jb) { asm volatile("ds_read_b64_tr_b16 %0, %1" : "=v"(tv[0][t2][jb]) : "v"(sa + va_[t2][jb]) : "memory");
                                                 asm volatile("ds_read_b64_tr_b16 %0, %1 offset:4096" : "=v"(tv[1][t2][jb]) : "v"(sa + va_[t2][jb]) : "memory"); } }
            if (lat) { int ml = mask_lane; asm volatile("" : "+v"(ml)); const LAS float* bp = rp + bias_lane + 31 * (kr - rs) + 32 * kblk;
                float bias[16];
#pragma unroll
                for (int v = 0; v < 16; ++v) bias[v] = bp[(v & 7) + 16 * (v >> 3)];
                asm volatile("" : "+v"(bias[0]), "+v"(bias[1]), "+v"(bias[2]), "+v"(bias[3]), "+v"(bias[4]), "+v"(bias[5]), "+v"(bias[6]), "+v"(bias[7]),
                             "+v"(bias[8]), "+v"(bias[9]), "+v"(bias[10]), "+v"(bias[11]), "+v"(bias[12]), "+v"(bias[13]), "+v"(bias[14]), "+v"(bias[15]));
                const int mk = ml + 32 * kblk;
#pragma unroll
                for (int v = 0; v < 16; ++v) { const int c = (v & 7) + 16 * (v >> 3); s[v] = ((unsigned)(c + mk) < 16u) ? s[v] + bias[v] : -__builtin_inff(); } }
            float mx = s[0];
#pragma unroll
            for (int v = 1; v < 16; ++v) mx = fmaxf(mx, s[v]);
            mx = fmaxf(mx, __shfl_xor(mx, 32));
            if (__builtin_amdgcn_ballot_w64(mx > m_run) != 0ull) {
                const float m_new = fmaxf(m_run, mx), alpha = __builtin_amdgcn_exp2f(m_run - m_new);
                l_run *= alpha; m_run = m_new;
#pragma unroll
                for (int v = 0; v < 16; ++v) { o0[v] *= alpha; o1[v] *= alpha; o2[v] *= alpha; o3[v] *= alpha; } }
            float ps = 0.f;
#pragma unroll
            for (int v = 0; v < 16; ++v) { s[v] = __builtin_amdgcn_exp2f(s[v] - m_run); ps += s[v]; }
            l_run += ps;
            bf16x8 pf0, pf1;
            { v4u t0, t1; t0.x = pkbf(s[0], s[1]); t0.y = pkbf(s[2], s[3]); t0.z = pkbf(s[4], s[5]); t0.w = pkbf(s[6], s[7]);
              t1.x = pkbf(s[8], s[9]); t1.y = pkbf(s[10], s[11]); t1.z = pkbf(s[12], s[13]); t1.w = pkbf(s[14], s[15]);
              pf0 = __builtin_bit_cast(bf16x8, t0); pf1 = __builtin_bit_cast(bf16x8, t1); }
            asm volatile("s_waitcnt lgkmcnt(0)" : "+v"(tv[0][0][0]), "+v"(tv[0][0][1]), "+v"(tv[0][0][2]), "+v"(tv[0][0][3]), "+v"(tv[0][1][0]), "+v"(tv[0][1][1]), "+v"(tv[0][1][2]), "+v"(tv[0][1][3]),
                         "+v"(tv[1][0][0]), "+v"(tv[1][0][1]), "+v"(tv[1][0][2]), "+v"(tv[1][0][3]), "+v"(tv[1][1][0]), "+v"(tv[1][1][1]), "+v"(tv[1][1][2]), "+v"(tv[1][1][3]) :: "memory");
#define VF(KS, JB) __builtin_shufflevector(tv[KS][0][JB], tv[KS][1][JB], 0, 1, 2, 3, 4, 5, 6, 7)
            o0 = MFMA32(VF(0, 0), pf0, o0); o1 = MFMA32(VF(0, 1), pf0, o1); o2 = MFMA32(VF(0, 2), pf0, o2); o3 = MFMA32(VF(0, 3), pf0, o3);
            o0 = MFMA32(VF(1, 0), pf1, o0); o1 = MFMA32(VF(1, 1), pf1, o1); o2 = MFMA32(VF(1, 2), pf1, o2); o3 = MFMA32(VF(1, 3), pf1, o3);
#undef VF
        }
        st = (st + 1 == A_NST) ? 0 : st + 1; stp = (stp + 1 == A_NST) ? 0 : stp + 1;
    }
#undef KEYBASE
#undef DMA
    asm volatile("s_waitcnt vmcnt(0)" ::: "memory");
    __builtin_amdgcn_s_barrier();
    asm volatile("" ::: "memory");
    const float l = l_run + __shfl_xor(l_run, 32), inv = 1.0f / l;
    GAS v2u* op = (GAS v2u*)(F.AO + qtok * NAW + HD * h);
#define OST(JB, OV) do { _Pragma("unroll") for (int u = 0; u < 4; ++u) { v2u w_; w_.x = pkbf(OV[4 * u] * inv, OV[4 * u + 1] * inv); w_.y = pkbf(OV[4 * u + 2] * inv, OV[4 * u + 3] * inv); op[8 * (JB) + 2 * u + g] = w_; } } while (0)
    OST(0, o0); OST(1, o1); OST(2, o2); OST(3, o3);
#undef OST
}
__device__ __forceinline__ void attn_phase(Frame& F) {
    LAS float* rp = (LAS float*)(F.lds + RING_OFF + 1024);
    for (int i = F.tid; i < NAH * 15 * 31; i += NWAVES * 64) rp[i] = F.in[I_RPB][i] * LOG2E;
    __syncthreads();
    for (int wu = F.vcu; wu < NB * NAH * 8; wu += F.G) { const int bh = wu >> 3, rg = wu & 7; attn_wg_unit(F, rp, bh >> 4, bh & 15, rg * 4); }
}

__device__ __forceinline__ void mix_row(Frame& F, int row) {
    unsigned lane = (unsigned)F.lane; const int t = row & (SEQ - 1);
    const GAS char* gg = (const GAS char*)F.in[I_GNG];
    asm volatile("" : "+v"(lane) :: "memory");
    { const GAS char* ap = (const GAS char*)(F.AO + (size_t)row * NAW); v4u a[4]; float ss = 0.f;
#pragma unroll
      for (int q = 0; q < 4; ++q) { a[q] = __builtin_nontemporal_load((const GAS v4u*)(ap + (lane * 16u + q * 1024u)));
#pragma unroll
          for (int e = 0; e < 4; ++e) { const float lo = bflo(a[q][e]), hi = bfhi(a[q][e]); ss += lo * lo + hi * hi; } }
      const float rstd = 1.0f / sqrtf(wave_sum(ss) * (1.0f / NAW) + EPS);
      GAS char* yp = (GAS char*)(F.YB + (size_t)row * D);
#pragma unroll
      for (int q = 0; q < 4; ++q) { const f32x4 g0 = *(const GAS f32x4*)(gg + (lane * 32u + q * 2048u)), g1 = *(const GAS f32x4*)(gg + (lane * 32u + q * 2048u + 16u)); v4u w;
          w.x = pkbf(bflo(a[q].x) * rstd * g0.x, bfhi(a[q].x) * rstd * g0.y); w.y = pkbf(bflo(a[q].y) * rstd * g0.z, bfhi(a[q].y) * rstd * g0.w);
          w.z = pkbf(bflo(a[q].z) * rstd * g1.x, bfhi(a[q].z) * rstd * g1.y); w.w = pkbf(bflo(a[q].w) * rstd * g1.z, bfhi(a[q].w) * rstd * g1.w);
          *(GAS v4u*)(yp + (lane * 16u + q * 1024u)) = w; } }
    { const GAS char* cw = (const GAS char*)F.in[I_CONVW];
      const GAS char* r0 = (const GAS char*)(F.CB + (size_t)row * 6144);
      const GAS char* rm = t > 0 ? r0 - 12288 : r0; const GAS char* rp = t < SEQ - 1 ? r0 + 12288 : r0;
      const float fm = t > 0 ? 1.f : 0.f, fp = t < SEQ - 1 ? 1.f : 0.f;
      float co[4][8]; float ss = 0.f;
#pragma unroll
      for (int q = 0; q < 4; ++q) { const unsigned vo = lane * 16u + q * 1024u, wo = lane * 32u + q * 2048u;
          if (q == 2) __builtin_amdgcn_sched_barrier(0);
          const v4u u0 = *(const GAS v4u*)(r0 + vo), gb = __builtin_nontemporal_load((const GAS v4u*)(r0 + (vo + 4096u))), c0v = *(const GAS v4u*)(r0 + (vo + 8192u));
          const v4u um = *(const GAS v4u*)(rm + vo), cm = *(const GAS v4u*)(rm + (vo + 8192u)), upl = *(const GAS v4u*)(rp + vo), cpl = *(const GAS v4u*)(rp + (vo + 8192u));
          const f32x4 wa0 = *(const GAS f32x4*)(cw + wo), wa1 = *(const GAS f32x4*)(cw + (wo + 16u)), wb0 = *(const GAS f32x4*)(cw + (wo + 8192u)), wb1 = *(const GAS f32x4*)(cw + (wo + 8208u)),
                      wc0 = *(const GAS f32x4*)(cw + (wo + 16384u)), wc1 = *(const GAS f32x4*)(cw + (wo + 16400u));
#pragma unroll
          for (int e = 0; e < 4; ++e) {
              const float k0l = (e < 2 ? wa0[(2 * e) & 3] : wa1[(2 * e) & 3]) * fm, k0h = (e < 2 ? wa0[(2 * e + 1) & 3] : wa1[(2 * e + 1) & 3]) * fm;
              const float k1l = e < 2 ? wb0[(2 * e) & 3] : wb1[(2 * e) & 3], k1h = e < 2 ? wb0[(2 * e + 1) & 3] : wb1[(2 * e + 1) & 3];
              const float k2l = (e < 2 ? wc0[(2 * e) & 3] : wc1[(2 * e) & 3]) * fp, k2h = (e < 2 ? wc0[(2 * e + 1) & 3] : wc1[(2 * e + 1) & 3]) * fp;
              const float vl = bflo(gb[e]) * (k0l * (bflo(cm[e]) * bflo(um[e])) + k1l * (bflo(c0v[e]) * bflo(u0[e])) + k2l * (bflo(cpl[e]) * bflo(upl[e])));
              const float vh = bfhi(gb[e]) * (k0h * (bfhi(cm[e]) * bfhi(um[e])) + k1h * (bfhi(c0v[e]) * bfhi(u0[e])) + k2h * (bfhi(cpl[e]) * bfhi(upl[e])));
              co[q][2 * e] = vl; co[q][2 * e + 1] = vh; ss += vl * vl + vh * vh; } }
      const float rstd = 1.0f / sqrtf(wave_sum(ss) * (1.0f / CVW) + EPS);
      GAS char* yp = (GAS char*)(F.YB + (size_t)row * D + NAW);
#pragma unroll
      for (int q = 0; q < 4; ++q) { const unsigned wo = lane * 32u + q * 2048u; const f32x4 g0 = *(const GAS f32x4*)(gg + (8192u + wo)), g1 = *(const GAS f32x4*)(gg + (8192u + 16u + wo)); v4u w;
          w.x = pkbf(co[q][0] * rstd * g0.x, co[q][1] * rstd * g0.y); w.y = pkbf(co[q][2] * rstd * g0.z, co[q][3] * rstd * g0.w);
          w.z = pkbf(co[q][4] * rstd * g1.x, co[q][5] * rstd * g1.y); w.w = pkbf(co[q][6] * rstd * g1.z, co[q][7] * rstd * g1.w);
          *(GAS v4u*)(yp + (lane * 16u + q * 1024u)) = w; } }
}
__device__ __forceinline__ void final_norm_row(const float* xrow, const bf16* mrow, const bf16* frow, float* orow, const float* gain, int lane) {
    const GAS f32x4* xr = (const GAS f32x4*)xrow + lane; const GAS v2u* mr = (const GAS v2u*)mrow + lane; const GAS v2u* fr = (const GAS v2u*)frow + lane;
    const GAS f32x4* g4 = (const GAS f32x4*)gain + lane; GAS f32x4* o4 = (GAS f32x4*)orow + lane;
    f32x4 v[16]; float ss = 0.f;
#pragma unroll
    for (int j = 0; j < 16; ++j) { const f32x4 x = __builtin_nontemporal_load(xr + 64 * j); const v2u m = __builtin_nontemporal_load(mr + 64 * j), f = __builtin_nontemporal_load(fr + 64 * j);
        v[j] = (f32x4){x.x + bflo(m.x) + bflo(f.x), x.y + bfhi(m.x) + bfhi(f.x), x.z + bflo(m.y) + bflo(f.y), x.w + bfhi(m.y) + bfhi(f.y)};
        ss += (v[j].x * v[j].x + v[j].y * v[j].y) + (v[j].z * v[j].z + v[j].w * v[j].w); }
    const float rstd = 1.0f / sqrtf(wave_sum(ss) * (1.0f / D) + EPS);
#pragma unroll
    for (int j = 0; j < 16; ++j) __builtin_nontemporal_store(v[j] * rstd * g4[64 * j], o4 + 64 * j);
}

struct Args { const float* in[N_IN]; float* out; unsigned char* ws; int ph_lo, ph_hi; };
__global__ void __launch_bounds__(NWAVES * 64, 2) fwd_kernel(Args args) {
    extern __shared__ __attribute__((aligned(16))) unsigned char lds[];
    Frame F;
    F.lds = (LAS unsigned char*)lds;
    F.MISC = (volatile LAS unsigned*)(F.lds + MISC_OFF);
    F.tid = threadIdx.x; F.lane = F.tid & 63; F.wave = __builtin_amdgcn_readfirstlane(F.tid >> 6);
    F.G = gridDim.x; { const int bx = blockIdx.x; F.vcu = (F.G % 8 == 0) ? (bx % 8) * (F.G / 8) + bx / 8 : bx; }
    unsigned char* ws = args.ws;
    F.ctl = (gu32*)(ws + WS_CTL);
#pragma unroll
    for (int i = 0; i < N_IN; ++i) F.in[i] = args.in[i];
    F.out = args.out; F.mod = (float*)(ws + WS_MOD); F.rope = (float*)(ws + WS_ROPE);
    F.Win_t = (bf16*)(ws + WS_WIN); F.Wout_t = (bf16*)(ws + WS_WOUT); F.Wgu_t = (bf16*)(ws + WS_WGU); F.Wdn_t = (bf16*)(ws + WS_WDN);
    F.HB = (bf16*)(ws + WS_H); F.QB = (bf16*)(ws + WS_Q); F.KB = (bf16*)(ws + WS_K); F.VB = (bf16*)(ws + WS_V); F.CB = (bf16*)(ws + WS_C);
    F.AO = (bf16*)(ws + WS_AO); F.YB = (bf16*)(ws + WS_Y); F.ACT = (bf16*)(ws + WS_ACT); F.MX = (bf16*)(ws + WS_X1); F.FX = (bf16*)(ws + WS_X1 + 64 * MiB);
    for (int u = F.tid; u < (LDS_BYTES - LDSCTL_OFF) / 4; u += NWAVES * 64) ((LAS unsigned*)(F.lds + LDSCTL_OFF))[u] = 0u;
    __syncthreads();
    XcdBarrier bar; bar.bar = (unsigned*)(F.ctl + CW_BAR); bar.x = 0; bar.st = nullptr;
    if (N_LAUNCHES == 1) bar = xcd_barrier_post((unsigned*)(F.ctl + CW_BAR), F.MISC + 8);
    const int lo = args.ph_lo, hi = args.ph_hi;
#define IN(k) (lo <= (k) && (k) < hi)
#define SEAM(k) do { if (IN(k) && IN((k) + 1)) xcd_barrier(bar); } while (0)
    const int gw = F.vcu * NWAVES + F.wave, NGW = F.G * NWAVES;
#ifndef PROBE_DUP
#define PROBE_DUP (-1)
#endif
#define DUP(k, body) do { body; if (PROBE_DUP == (k)) { xcd_barrier(bar); body; } } while (0)

    if (IN(0)) { p0_prologue(F, 1.0f); if (PROBE_DUP == 0) { xcd_barrier(bar); p0_prologue(F, 0.0f); } SEAM(0); }
    if (IN(1)) {
        DUP(1, for (int m = gw; m < MT; m += NGW) {
            const bool isctx = m >= M; const float* xrow = isctx ? F.in[I_CTX] + (size_t)(m - M) * D : F.in[I_X] + (size_t)m * D;
            const float* mrow = F.mod + (size_t)(isctx ? 4 : (m >> 11)) * NMODC;
            norm_mod_row(xrow, F.HB + (size_t)m * D, F.in[I_N1G], mrow, mrow + D, F.lane); });
        SEAM(1);
    }
#if defined(PROBE_IDLE_US)
    if (IN(2)) { const unsigned long long t0 = __builtin_amdgcn_s_memrealtime(); while (__builtin_amdgcn_s_memrealtime() - t0 < (unsigned long long)(PROBE_IDLE_US) * 100ull) __builtin_amdgcn_s_sleep(32); }
#endif
    if (IN(2)) {
        pg8::Gemm g{F.HB, F.Win_t, MT, INC, D}; pg8::InOrder S; S.init(F.G, (int)blockIdx.x);
        pg8::EpiIn E{F.QB, F.KB, F.VB, F.CB, F.rope, 0.08838834764831845f * LOG2E};
        DUP(2, (pg8::gemm_phase<pg8::EpiIn, pg8::InOrder, PG8_ALIGN, PG8_SP2>(F.lds + RING_OFF, g, S, E)));
        if (F.G == 256 && blockIdx.x >= 64) {
            LAS float* scr = (LAS float*)(F.lds + RING_OFF + F.wave * 16384); const int p = ((int)blockIdx.x - 64) * NWAVES + F.wave;
            transpose_items<0>(F.in[I_WOUT], D, D, F.Wout_t, scr, P0_OUT_ITEMS + p, 192 * NWAVES, IT_OUT, F.lane);
            transpose_items<2>(F.in[I_WGU], D, 2 * FF, F.Wgu_t, scr, P0_GU_ITEMS + p, 192 * NWAVES, IT_GU, F.lane);
        } else if (F.G != 256) {
            LAS float* scr = (LAS float*)(F.lds + RING_OFF + F.wave * 16384);
            transpose_items<0>(F.in[I_WOUT], D, D, F.Wout_t, scr, P0_OUT_ITEMS + gw, NGW, IT_OUT, F.lane);
            transpose_items<2>(F.in[I_WGU], D, 2 * FF, F.Wgu_t, scr, P0_GU_ITEMS + gw, NGW, IT_GU, F.lane);
        }
        SEAM(2);
    }
    if (IN(3)) { DUP(3, attn_phase(F)); SEAM(3); }
    if (IN(4)) { DUP(4, for (int m = gw; m < M; m += NGW) mix_row(F, m)); SEAM(4); }
    if (IN(5)) {
        pg8::Gemm g{F.YB, F.Wout_t, M, D, D}; pg8::StaticOrder S; S.init(M, D, F.G, (int)blockIdx.x);
        pg8::EpiGate E{F.MX, D, F.mod + 2 * D};
        DUP(5, (pg8::gemm_phase<pg8::EpiGate, pg8::StaticOrder, PG8_ALIGN, PG8_SP2>(F.lds + RING_OFF, g, S, E)));
        SEAM(5);
    }
    if (IN(6)) {
        DUP(6, for (int m = gw; m < M; m += NGW) { const float* mrow = F.mod + (size_t)(m >> 11) * NMODC;
            norm_mod_row_x1(F.in[I_X] + (size_t)m * D, F.MX + (size_t)m * D, F.HB + (size_t)m * D, F.in[I_N2G], mrow + 3 * D, mrow + 4 * D, F.lane); });
        SEAM(6);
    }
    if (IN(7)) {
        pg8::Gemm g{F.HB, F.Wgu_t, M, 2 * FF, D}; pg8::StaticOrder S; S.init(M, 2 * FF, F.G, (int)blockIdx.x);
        pg8::EpiSwiglu E{F.ACT, FF};
        DUP(7, (pg8::gemm_phase<pg8::EpiSwiglu, pg8::StaticOrder, PG8_ALIGN, PG8_SP2>(F.lds + RING_OFF, g, S, E)));
        if (F.G == 256 && blockIdx.x >= 192) {
            LAS float* scr = (LAS float*)(F.lds + RING_OFF + F.wave * 16384); const int p = ((int)blockIdx.x - 192) * NWAVES + F.wave;
            transpose_items<0>(F.in[I_WDN], FF, D, F.Wdn_t, scr, P0_DN_ITEMS + p, 64 * NWAVES, IT_DN, F.lane);
        } else if (F.G != 256) {
            LAS float* scr = (LAS float*)(F.lds + RING_OFF + F.wave * 16384);
            transpose_items<0>(F.in[I_WDN], FF, D, F.Wdn_t, scr, P0_DN_ITEMS + gw, NGW, IT_DN, F.lane);
        }
        SEAM(7);
    }
    if (IN(8)) {
        pg8::Gemm g{F.ACT, F.Wdn_t, M, D, FF}; pg8::StaticOrder S; S.init(M, D, F.G, (int)blockIdx.x);
        pg8::EpiGate E{F.FX, D, F.mod + 5 * D};
        DUP(8, (pg8::gemm_phase<pg8::EpiGate, pg8::StaticOrder, PG8_ALIGN, PG8_SP2>(F.lds + RING_OFF, g, S, E)));
        SEAM(8);
    }
    if (IN(9)) { for (int m = gw; m < M; m += NGW) final_norm_row(F.in[I_X] + (size_t)m * D, F.MX + (size_t)m * D, F.FX + (size_t)m * D, F.out + (size_t)m * D, F.in[I_FNG], F.lane); }
#undef IN
#undef SEAM
}

extern "C" void kernel_launch(void* const* d_in, const int* in_sizes, int n_in, void* d_out, int out_size, void* d_ws, size_t ws_size, hipStream_t stream) {
    static int grid = 0;
    if (grid == 0) {
        if (n_in != N_IN || in_sizes[I_X] != M * D || out_size != M * D || ws_size < WS_END) { fprintf(stderr, "kernel_launch: shape / workspace mismatch (n_in %d, x %d, out %d, ws %zu); nothing launched\n", n_in, n_in > 0 ? in_sizes[0] : -1, out_size, ws_size); grid = -1; return; }
        int dev = 0, cus = 0, per_cu = 0;
        if (hipGetDevice(&dev) != hipSuccess || hipDeviceGetAttribute(&cus, hipDeviceAttributeMultiprocessorCount, dev) != hipSuccess) { fprintf(stderr, "kernel_launch: device query failed\n"); grid = -1; return; }
        if (hipFuncSetAttribute((const void*)fwd_kernel, hipFuncAttributeMaxDynamicSharedMemorySize, LDS_BYTES) != hipSuccess) { fprintf(stderr, "kernel_launch: hipFuncSetAttribute failed\n"); grid = -1; return; }
        if (hipOccupancyMaxActiveBlocksPerMultiprocessor(&per_cu, (const void*)fwd_kernel, NWAVES * 64, LDS_BYTES) != hipSuccess || per_cu < 1)
            fprintf(stderr, "kernel_launch: note: occupancy query reports %d workgroups per CU\n", per_cu);
        (void)hipGetLastError();
        grid = cus;
    }
    if (grid < 0) return;
    if (hipMemsetAsync((char*)d_ws + WS_CTL, 0, CTL_ZERO_BYTES, stream) != hipSuccess) { fprintf(stderr, "kernel_launch: memset failed\n"); return; }
    Args a{};
    for (int i = 0; i < N_IN; ++i) a.in[i] = (const float*)d_in[i];
    a.out = (float*)d_out; a.ws = (unsigned char*)d_ws;
    for (int li = 0; li < N_LAUNCHES; ++li) {
        a.ph_lo = (N_LAUNCHES == 1) ? 0 : li; a.ph_hi = (N_LAUNCHES == 1) ? N_PHASES : li + 1;
        hipLaunchKernelGGL(fwd_kernel, dim3(grid), dim3(NWAVES * 64), LDS_BYTES, stream, a);
        const hipError_t le = hipPeekAtLastError();
        if (le != hipSuccess) { fprintf(stderr, "kernel_launch: launch %d failed: %s\n", li, hipGetErrorName(le)); break; }
    }
}
```

```cpp
#include <hip/hip_runtime.h>
#include <cstdio>
#include <cstdint>
namespace pg8 {
#define PG8_LAS __attribute__((address_space(3)))
typedef unsigned short bf16_t;
typedef short bf16x8 __attribute__((ext_vector_type(8)));
typedef float f32x4 __attribute__((ext_vector_type(4)));
typedef unsigned u32x4 __attribute__((ext_vector_type(4)));
constexpr int BM = 256, BK = 64, HALF = 128, HTB = HALF * BK * 2  , STAGE_BYTES = 8 * HTB, NXCD = 8, WGM = 8;

__host__ __device__ __forceinline__ int lds_byte(int r, int c) { const int st = (r >> 4) * 2 + (c >> 5), rr = r & 15, cc = c & 31, ob = rr * 64 + cc * 2; return st * 1024 + (ob ^ (((ob >> 9) & 1) << 5)); }
__host__ __device__ __forceinline__ void stage_rc(int b, int& R, int& C) { const int st = b / 1024, sb = b % 1024, swz = sb ^ (((sb >> 9) & 1) << 5); R = (st >> 1) * 16 + swz / 64; C = (st & 1) * 32 + (swz % 64) / 2; }
__host__ __device__ __forceinline__ int perm32(int rho) { const int n = rho >> 4, i = rho & 15; return 8 * (i >> 2) + 4 * n + (i & 3); }

struct Unit { int pm, pn; };
struct Gemm { const bf16_t* A; const bf16_t* Bt; int M, N, K; };

struct StaticOrder {
    int nM, nN, nwg, G, c;
    __host__ __device__ void init(int M, int N, int G_, int c_) { nM = M / BM; nN = N / BM; nwg = nM * nN; G = G_; c = c_; }
    __host__ __device__ bool next(int i, Unit& u) const {
        const long L = (long)i * G + c; if (L >= nwg) return false;
        int wgid = (int)L; { const int q = nwg / NXCD, r = nwg % NXCD, xcd = wgid % NXCD, off = wgid / NXCD; wgid = (xcd < r ? xcd * (q + 1) : r * (q + 1) + (xcd - r) * q) + off; }
        const int nig = WGM * nN, gid = wgid / nig, fm = gid * WGM, gsz = (nM - fm) < WGM ? (nM - fm) : WGM;
        u.pm = fm + ((wgid % nig) % gsz); u.pn = (wgid % nig) / gsz; return true;
    }
    __device__ __forceinline__ void a_ready(const Unit&) const {}
    __device__ __forceinline__ void done(const Unit&) const {}
};

__device__ __forceinline__ unsigned cvt_pk_bf16(float lo, float hi) { unsigned r; asm volatile("v_cvt_pk_bf16_f32 %0, %1, %2" : "=v"(r) : "v"(lo), "v"(hi)); return r; }
typedef float f32x2 __attribute__((ext_vector_type(2)));
typedef __bf16 bf16v2 __attribute__((ext_vector_type(2)));
__device__ __forceinline__ unsigned pkbf(float lo, float hi) { f32x2 v = {lo, hi}; bf16v2 r = __builtin_convertvector(v, bf16v2); return __builtin_bit_cast(unsigned, r); }

struct EpiIn {
    static constexpr bool PERM = true, AFTER_DRAIN = false;
    bf16_t *Q, *Kd, *Vd, *Cd; const float* rope; float qscale;
    __device__ __forceinline__ void operator()(const f32x4 (&acc)[2][2][4][2], const Unit& u, int wr, int wc, int fr, int fq) const {
        const int reg = u.pn >> 3;
        if (reg == 3 || reg == 4) {
            const int row0 = u.pm * BM + wr * 64 + fr, col0 = (u.pn - 24) * HALF + wc * 32 + 8 * fq;
#pragma unroll
            for (int ai = 0; ai < 2; ++ai)
#pragma unroll
                for (int m = 0; m < 4; ++m) { bf16_t* rowp = Cd + (size_t)(row0 + ai * HALF + m * 16) * 4096 + col0;
                    const f32x4 p0 = acc[ai][0][m][0] * acc[ai][1][m][0], p1 = acc[ai][0][m][1] * acc[ai][1][m][1];
                    u32x4 w; w.x = pkbf(p0[0], p0[1]); w.y = pkbf(p0[2], p0[3]); w.z = pkbf(p1[0], p1[1]); w.w = pkbf(p1[2], p1[3]);
                    *(u32x4*)rowp = w; }
            return; }
        bf16_t* base; int ldc, colt; bool rot = false; float sc = 1.f;
        if (reg == 0) { base = Q; ldc = 2048; colt = u.pn * BM; rot = true; sc = qscale; }
        else if (reg == 1) { base = Kd; ldc = 2048; colt = (u.pn - 8) * BM; rot = (u.pm < 32); }
        else if (reg == 2) { base = Vd; ldc = 2048; colt = (u.pn - 16) * BM; }
        else { base = Cd; ldc = 4096; colt = 2048 + (u.pn - 40) * BM; }
        const int row0 = u.pm * BM + wr * 64 + fr, col0 = colt + wc * 32 + 8 * fq;
        const int blk = wc >> 1, i0 = 4 * ((4 * wc + fq) & 7);
        f32x4 cs[2], sn[2];
        cs[0] = (f32x4){1.f, 1.f, 1.f, 1.f}; sn[0] = (f32x4){0.f, 0.f, 0.f, 0.f}; cs[1] = cs[0]; sn[1] = sn[0];
        if (rot) { const int t = row0 & 2047, pos = blk ? (t & 63) : (t >> 6); cs[0] = *(const f32x4*)(rope + pos * 32 + i0); sn[0] = *(const f32x4*)(rope + 2048 + pos * 32 + i0); }
#pragma unroll
        for (int gi = 0; gi < 8; ++gi) { const int ai = gi >> 2, m = gi & 3; const int r = row0 + ai * HALF + m * 16; bf16_t* rowp = base + (size_t)r * ldc + col0;
            if (gi < 7 && rot) { const int rn = row0 + ((gi + 1) >> 2) * HALF + ((gi + 1) & 3) * 16, t = rn & 2047, pos = blk ? (t & 63) : (t >> 6);
                cs[(gi + 1) & 1] = *(const f32x4*)(rope + pos * 32 + i0); sn[(gi + 1) & 1] = *(const f32x4*)(rope + 2048 + pos * 32 + i0); }
            const f32x4 cs4 = cs[gi & 1], sn4 = sn[gi & 1];
#pragma unroll
            for (int bj = 0; bj < 2; ++bj) { const f32x4 a = acc[ai][bj][m][0], b = acc[ai][bj][m][1];
                const f32x4 v0 = (a * cs4 - b * sn4) * sc, v1 = (a * sn4 + b * cs4) * sc;
                u32x4 w; w.x = pkbf(v0[0], v0[1]); w.y = pkbf(v0[2], v0[3]); w.z = pkbf(v1[0], v1[1]); w.w = pkbf(v1[2], v1[3]);
                *(u32x4*)(rowp + bj * HALF) = w; }
            asm volatile("" ::: "memory"); }
    }
};
#ifndef EPI_NT_GATE
#define EPI_NT_GATE 0
#endif
#ifndef EPI_NT_ACT
#define EPI_NT_ACT 0
#endif
#if EPI_NT_GATE
#define EPI_GATE_STORE(v, p) __builtin_nontemporal_store((v), (p))
#else
#define EPI_GATE_STORE(v, p) (*(p) = (v))
#endif
#if EPI_NT_ACT
#define EPI_ACT_STORE(v, p) __builtin_nontemporal_store((v), (p))
#else
#define EPI_ACT_STORE(v, p) (*(p) = (v))
#endif
template <bool ROWSCALE> struct EpiGate {
    static constexpr bool PERM = true, AFTER_DRAIN = false;
    bf16_t* O; int ldc; const float* gate; const float* ssq;
    __device__ __forceinline__ void operator()(const f32x4 (&acc)[2][2][4][2], const Unit& u, int wr, int wc, int fr, int fq) const {
        const int row0 = u.pm * BM + wr * 64 + fr, col0 = u.pn * BM + wc * 32 + 8 * fq;
        const float* gp = gate + (size_t)(u.pm >> 3) * 24576 + col0;
        f32x4 gv[2][2];
#pragma unroll
        for (int bj = 0; bj < 2; ++bj)
#pragma unroll
            for (int n = 0; n < 2; ++n) gv[bj][n] = *(const f32x4*)(gp + bj * HALF + 4 * n);
        float rs[8];
#pragma unroll
        for (int gi = 0; gi < 8; ++gi) rs[gi] = ROWSCALE ? ssq[row0 + (gi >> 2) * HALF + (gi & 3) * 16] : 1.0f;
#pragma unroll
        for (int ai = 0; ai < 2; ++ai)
#pragma unroll
            for (int m = 0; m < 4; ++m) { bf16_t* rowp = O + (size_t)(row0 + ai * HALF + m * 16) * ldc + col0;
                const float rsc = ROWSCALE ? 1.0f / sqrtf(rs[ai * 4 + m] * (1.0f / 2048.0f) + 1e-6f) : 1.0f;
#pragma unroll
                for (int bj = 0; bj < 2; ++bj) { const f32x4 v0 = acc[ai][bj][m][0] * gv[bj][0] * rsc, v1 = acc[ai][bj][m][1] * gv[bj][1] * rsc;
                    u32x4 w; w.x = pkbf(v0[0], v0[1]); w.y = pkbf(v0[2], v0[3]); w.z = pkbf(v1[0], v1[1]); w.w = pkbf(v1[2], v1[3]);
                    EPI_GATE_STORE(w, (u32x4*)(rowp + bj * HALF)); } }
    }
};
struct EpiSwiglu {
    static constexpr bool PERM = true, AFTER_DRAIN = false;
    bf16_t* O; int ldc;
    __device__ __forceinline__ void operator()(const f32x4 (&acc)[2][2][4][2], const Unit& u, int wr, int wc, int fr, int fq) const {
        const int row0 = u.pm * BM + wr * 64 + fr, col0 = u.pn * HALF + wc * 32 + 8 * fq;
#pragma unroll
        for (int ai = 0; ai < 2; ++ai)
#pragma unroll
            for (int m = 0; m < 4; ++m) { bf16_t* rowp = O + (size_t)(row0 + ai * HALF + m * 16) * ldc + col0;
                float o[8];
#pragma unroll
                for (int n = 0; n < 2; ++n)
#pragma unroll
                    for (int j = 0; j < 4; ++j) { const float gt = acc[ai][0][m][n][j], up = acc[ai][1][m][n][j];
                        o[4 * n + j] = gt * __builtin_amdgcn_rcpf(1.0f + __builtin_amdgcn_exp2f(-1.44269504089f * gt)) * up; }
                u32x4 w; w.x = pkbf(o[0], o[1]); w.y = pkbf(o[2], o[3]); w.z = pkbf(o[4], o[5]); w.w = pkbf(o[6], o[7]);
                EPI_ACT_STORE(w, (u32x4*)rowp); }
    }
};
struct InOrder {
    StaticOrder so; int G, c;
    __host__ __device__ void init(int G_, int c_) { so.init(8192, 12288, G_, c_); G = G_; c = c_; }
    __host__ __device__ bool next(int i, Unit& u) const {
        const long L = (long)i * G + c; if (L >= 1600) return false;
        if (L < 1536) return so.next(i, u);
        const int e = (int)L - 1536; u.pm = 32 + (e & 3); u.pn = 8 + (e >> 2); return true;
    }
    __device__ __forceinline__ void a_ready(const Unit&) const {}
    __device__ __forceinline__ void done(const Unit&) const {}
};
template <class Epi, class Sched, bool ALIGN_EPI = false, bool SP2 = false>
__device__ __forceinline__ void gemm_phase(PG8_LAS unsigned char* lds, const Gemm g, const Sched& S, const Epi& E) {
    const int tid = threadIdx.x, wid = __builtin_amdgcn_readfirstlane(tid >> 6), lane = tid & 63, wr = wid >> 2, wc = wid & 3, fr = lane & 15, fq = lane >> 4;
    const int K = g.K, nt = K / BK;
    unsigned voffA[2], voffB[2];
#pragma unroll
    for (int i = 0; i < 2; ++i) { int R, C; stage_rc(tid * 16 + i * 8192, R, C); const int Rb = Epi::PERM ? ((R & ~31) + perm32(R & 31)) : R;
        voffA[i] = (unsigned)(R * K + C) * 2u; voffB[i] = (unsigned)(Rb * K + C) * 2u; }
    const size_t kstep = (size_t)(BK * 2);
    const size_t hstep = (size_t)HALF * K * 2;
    const size_t tstep = 2 * hstep;
    const unsigned ldsw = (unsigned)wid * 1024u;
    const int aoff = lds_byte(wr * 64 + fr, fq * 8), boff = lds_byte(wc * 32 + fr, fq * 8);
#define PG8_SA(b, h) (((b) * 2 + (h)) * HTB)
#define PG8_SB(b, h) ((4 + (b) * 2 + (h)) * HTB)
#define PG8_STAGE(bufoff, gbase, voff) do { _Pragma("unroll") for (int _i = 0; _i < 2; ++_i) \
        __builtin_amdgcn_global_load_lds((const unsigned*)((const char*)(gbase) + (voff)[_i]), (PG8_LAS unsigned*)(lds + (bufoff) + ldsw + _i * 8192), 16, 0, 0); } while (0)
#define PG8_LDA(dst, b, h) do { _Pragma("unroll") for (int m = 0; m < 4; ++m) _Pragma("unroll") for (int k = 0; k < 2; ++k) dst[m][k] = *(const PG8_LAS bf16x8*)(lds + PG8_SA(b, h) + aoff + m * 2048 + k * 1024); } while (0)
#define PG8_LDB(dst, b, h) do { _Pragma("unroll") for (int n = 0; n < 2; ++n) _Pragma("unroll") for (int k = 0; k < 2; ++k) dst[n][k] = *(const PG8_LAS bf16x8*)(lds + PG8_SB(b, h) + boff + n * 2048 + k * 1024); } while (0)
#define PG8_MMA(ai, bj, At, Bt) do { __builtin_amdgcn_s_setprio(1); _Pragma("unroll") for (int m = 0; m < 4; ++m) _Pragma("unroll") for (int n = 0; n < 2; ++n) _Pragma("unroll") for (int k = 0; k < 2; ++k) \
        acc[ai][bj][m][n] = __builtin_amdgcn_mfma_f32_16x16x32_bf16(Bt[n][k], At[m][k], acc[ai][bj][m][n], 0, 0, 0); __builtin_amdgcn_s_setprio(0); } while (0)
#define PG8_WAIT_V(n) asm volatile("s_waitcnt vmcnt(" #n ")" ::: "memory")
#define PG8_WAIT_L(n) asm volatile("s_waitcnt lgkmcnt(" #n ")" ::: "memory")
#define PG8_BAR __builtin_amdgcn_s_barrier()
#define PG8_SCHED __builtin_amdgcn_sched_barrier(0)
    Unit cur, nxt; int ui = 0;
    if (!S.next(0, cur)) return;
    f32x4 acc[2][2][4][2];
#pragma unroll
    for (int a = 0; a < 2; ++a)
#pragma unroll
        for (int b = 0; b < 2; ++b)
#pragma unroll
            for (int m = 0; m < 4; ++m)
#pragma unroll
                for (int n = 0; n < 2; ++n) acc[a][b][m][n] = (f32x4){0.f, 0.f, 0.f, 0.f};
    bf16x8 At[4][2], B0[2][2], B1[2][2];
    const char* cA = (const char*)g.A + (size_t)cur.pm * tstep; const char* cB = (const char*)g.Bt + (size_t)cur.pn * tstep;
    S.a_ready(cur);
    if constexpr (SP2) {
        PG8_STAGE(PG8_SB(0, 0), cB, voffB); PG8_STAGE(PG8_SB(0, 1), cB + hstep, voffB); PG8_STAGE(PG8_SA(0, 0), cA, voffA); PG8_STAGE(PG8_SA(0, 1), cA + hstep, voffA);
        if (wr == 1) PG8_BAR;
        PG8_WAIT_V(2); PG8_BAR;
        PG8_STAGE(PG8_SB(1, 0), cB + kstep, voffB); PG8_STAGE(PG8_SA(1, 0), cA + kstep, voffA); PG8_STAGE(PG8_SB(1, 1), cB + hstep + kstep, voffB);
        PG8_WAIT_V(6); PG8_BAR;
    } else {
        PG8_STAGE(PG8_SB(0, 0), cB, voffB); PG8_STAGE(PG8_SA(0, 0), cA, voffA); PG8_STAGE(PG8_SB(0, 1), cB + hstep, voffB); PG8_STAGE(PG8_SA(0, 1), cA + hstep, voffA);
        if (wr == 1) PG8_BAR;
        PG8_WAIT_V(4); PG8_BAR;
        PG8_STAGE(PG8_SB(1, 0), cB + kstep, voffB); PG8_STAGE(PG8_SA(1, 0), cA + kstep, voffA); PG8_STAGE(PG8_SB(1, 1), cB + hstep + kstep, voffB);
        PG8_WAIT_V(6); PG8_BAR;
    }
    for (;;) {
        const bool has_next = S.next(ui + 1, nxt);
        const char* nA = has_next ? (const char*)g.A + (size_t)nxt.pm * tstep : cA; const char* nB = has_next ? (const char*)g.Bt + (size_t)nxt.pn * tstep : cB;
        for (int t = 0; t < nt; t += 2) {
            const bool last = (t == nt - 2);
            const char* a1 = cA + (size_t)(t + 1) * kstep;
            const char* a2 = last ? nA : cA + (size_t)(t + 2) * kstep; const char* b2 = last ? nB : cB + (size_t)(t + 2) * kstep;
            const char* a3 = a2 + kstep; const char* b3 = b2 + kstep;
            if (last && has_next) S.a_ready(nxt);
            if constexpr (SP2) {
            PG8_LDB(B0, 0, 0); PG8_LDB(B1, 0, 1); PG8_SCHED; PG8_LDA(At, 0, 0); PG8_STAGE(PG8_SA(1, 1), a1 + hstep, voffA);
            PG8_WAIT_V(8); PG8_WAIT_L(0); PG8_BAR; PG8_MMA(0, 0, At, B0); PG8_MMA(0, 1, At, B1); PG8_BAR; PG8_SCHED;
            PG8_LDA(At, 0, 1); PG8_STAGE(PG8_SB(0, 0), b2, voffB); PG8_STAGE(PG8_SB(0, 1), b2 + hstep, voffB); PG8_STAGE(PG8_SA(0, 0), a2, voffA);
            PG8_WAIT_V(8); PG8_WAIT_L(0); PG8_BAR; PG8_MMA(1, 0, At, B0); PG8_MMA(1, 1, At, B1); PG8_BAR; PG8_SCHED;
            PG8_LDB(B0, 1, 0); PG8_LDB(B1, 1, 1); PG8_SCHED; PG8_LDA(At, 1, 0); PG8_STAGE(PG8_SA(0, 1), a2 + hstep, voffA);
            PG8_WAIT_V(8); PG8_WAIT_L(0); PG8_BAR; PG8_MMA(0, 0, At, B0); PG8_MMA(0, 1, At, B1); PG8_BAR; PG8_SCHED;
            PG8_LDA(At, 1, 1); PG8_STAGE(PG8_SB(1, 0), b3, voffB); PG8_STAGE(PG8_SB(1, 1), b3 + hstep, voffB); PG8_STAGE(PG8_SA(1, 0), a3, voffA);
            PG8_WAIT_V(8); PG8_WAIT_L(0); PG8_BAR; PG8_MMA(1, 0, At, B0); PG8_MMA(1, 1, At, B1); PG8_BAR; PG8_SCHED;
            } else {
            PG8_LDB(B0, 0, 0); PG8_SCHED; PG8_LDA(At, 0, 0); PG8_STAGE(PG8_SA(1, 1), a1 + hstep, voffA);
            PG8_WAIT_L(8); PG8_BAR; PG8_WAIT_L(0); PG8_MMA(0, 0, At, B0); PG8_BAR; PG8_SCHED;
            PG8_LDB(B1, 0, 1); PG8_STAGE(PG8_SB(0, 0), b2, voffB);
            PG8_BAR; PG8_WAIT_L(0); PG8_MMA(0, 1, At, B1); PG8_BAR;
            PG8_LDA(At, 0, 1); PG8_STAGE(PG8_SA(0, 0), a2, voffA);
            PG8_BAR; PG8_WAIT_L(0); PG8_MMA(1, 0, At, B0); PG8_BAR; PG8_SCHED;
            PG8_STAGE(PG8_SB(0, 1), b2 + hstep, voffB);
            PG8_WAIT_V(6); PG8_BAR; PG8_MMA(1, 1, At, B1); PG8_BAR;
            PG8_LDB(B0, 1, 0); PG8_SCHED; PG8_LDA(At, 1, 0); PG8_STAGE(PG8_SA(0, 1), a2 + hstep, voffA);
            PG8_WAIT_L(8); PG8_BAR; PG8_WAIT_L(0); PG8_MMA(0, 0, At, B0); PG8_BAR; PG8_SCHED;
            PG8_LDB(B1, 1, 1); PG8_STAGE(PG8_SB(1, 0), b3, voffB);
            PG8_BAR; PG8_WAIT_L(0); PG8_MMA(0, 1, At, B1); PG8_BAR;
            PG8_LDA(At, 1, 1); PG8_STAGE(PG8_SA(1, 0), a3, voffA);
            PG8_BAR; PG8_WAIT_L(0); PG8_MMA(1, 0, At, B0); PG8_BAR; PG8_SCHED;
            PG8_STAGE(PG8_SB(1, 1), b3 + hstep, voffB);
            PG8_WAIT_V(6); PG8_BAR; PG8_MMA(1, 1, At, B1); PG8_BAR;
            }
        }
        if constexpr (ALIGN_EPI) { if (wr == 0) PG8_BAR; }
        if constexpr (!Epi::AFTER_DRAIN) { E(acc, cur, wr, wc, fr, fq); S.done(cur); }
        if (!has_next) break;
#pragma unroll
        for (int a = 0; a < 2; ++a)
#pragma unroll
            for (int b = 0; b < 2; ++b)
#pragma unroll
                for (int m = 0; m < 4; ++m)
#pragma unroll
                    for (int n = 0; n < 2; ++n) acc[a][b][m][n] = (f32x4){0.f, 0.f, 0.f, 0.f};
        cur = nxt; cA = nA; cB = nB; ++ui;
        if constexpr (ALIGN_EPI) { if (wr == 1) PG8_BAR; }
    }
    PG8_WAIT_V(0);
    if constexpr (!ALIGN_EPI) { if (wr == 0) PG8_BAR; }
    PG8_BAR;
    if constexpr (Epi::AFTER_DRAIN) { E.fused(acc, cur, wr, wc, fr, fq, lds, wid, lane); S.done(cur); }
#undef PG8_SA
#undef PG8_SB
#undef PG8_STAGE
#undef PG8_LDA
#undef PG8_LDB
#undef PG8_MMA
#undef PG8_WAIT_V
#undef PG8_WAIT_L
#undef PG8_BAR
#undef PG8_SCHED
}
}
#ifndef PG8_SP2
#define PG8_SP2 true
#endif
#ifndef PG8_ALIGN
#define PG8_ALIGN true
#endif
constexpr int NWAVES = 8;
#ifndef MK_N_LAUNCHES
#define MK_N_LAUNCHES 1
#endif
constexpr int N_PHASES = 10;
constexpr int N_LAUNCHES = MK_N_LAUNCHES;

constexpr int D = 4096, NB = 4, SEQ = 2048, M = NB * SEQ, CTXL = 256, MC = NB * CTXL, MT = M + MC;
constexpr int HD = 128, NAH = 16, NAW = 2048, CVW = 2048, INC = 12288, FF = 11008, NMODC = 6 * D;
constexpr int GRIDW = 64, ROWS = 32, NAKH = 8, NAKW = 16;
constexpr float EPS = 1e-6f, LOG2E = 1.44269504089f;
enum { I_X = 0, I_C, I_CTX, I_CCTX, I_ADAW, I_ADAB, I_N1G, I_WIN, I_CONVW, I_RPB, I_GNG, I_WOUT, I_N2G, I_WGU, I_WDN, I_FNG, N_IN };

constexpr size_t MiB = 1u << 20;
constexpr size_t WS_CTL = 0, WS_MOD = 1 * MiB, CTL_ZERO_BYTES = 2 * MiB;
constexpr size_t WS_SSQ = 1536 * 1024;
constexpr size_t WS_ROPE = 2 * MiB;
constexpr size_t WS_WIN = 4 * MiB, WS_WOUT = 100 * MiB, WS_WGU = 132 * MiB, WS_WDN = 304 * MiB;
constexpr size_t WS_H = 390 * MiB;
constexpr size_t WS_Q = 462 * MiB;
constexpr size_t WS_K = 494 * MiB;
constexpr size_t WS_V = 530 * MiB;
constexpr size_t WS_C = 566 * MiB;
constexpr size_t WS_AO = 662 * MiB;
constexpr size_t WS_Y = 694 * MiB;
constexpr size_t WS_X1 = 758 * MiB;
constexpr size_t WS_ACT = 886 * MiB;
constexpr size_t WS_END = 1058 * MiB;
static_assert(WS_WIN + (size_t)INC * D * 2 <= WS_WOUT && WS_WOUT + (size_t)D * D * 2 <= WS_WGU && WS_WGU + (size_t)2 * FF * D * 2 <= WS_WDN && WS_WDN + (size_t)D * FF * 2 <= WS_H, "ws map (weights)");
static_assert(WS_H + (size_t)MT * D * 2 <= WS_Q && WS_Q + (size_t)M * NAW * 2 <= WS_K && WS_K + (size_t)MT * NAW * 2 <= WS_V && WS_V + (size_t)MT * NAW * 2 <= WS_C && WS_C + (size_t)M * 6144 * 2 <= WS_AO, "ws map (acts 1)");
static_assert(WS_AO + (size_t)M * NAW * 2 <= WS_Y && WS_Y + (size_t)M * D * 2 <= WS_X1 && WS_X1 + (size_t)M * D * 4 <= WS_ACT && WS_ACT + (size_t)M * FF * 2 <= WS_END, "ws map (acts 2)");
constexpr int CW_BAR = 4096;

#ifndef P0_DN_ITEMS
#define P0_DN_ITEMS 0
#endif
#ifndef P0_OUT_ITEMS
#define P0_OUT_ITEMS 0
#endif
#ifndef P0_GU_ITEMS
#define P0_GU_ITEMS 0
#endif
constexpr int RING_OFF = 0, RING_BYTES = 131072;
constexpr int LDSCTL_OFF = RING_BYTES, MISC_OFF = LDSCTL_OFF + 320;
constexpr int LDS_BYTES = 147456;
static_assert(MISC_OFF + 128 <= LDS_BYTES, "LDS map");

#define GAS __attribute__((address_space(1)))
#define LAS __attribute__((address_space(3)))
typedef unsigned short bf16;
typedef unsigned v4u __attribute__((ext_vector_type(4)));
typedef float f32x4 __attribute__((ext_vector_type(4)));
typedef short bf16x8 __attribute__((ext_vector_type(8)));
typedef GAS unsigned gu32;
typedef GAS unsigned long long gu64;
#define RLX_AGENT __ATOMIC_RELAXED, __HIP_MEMORY_SCOPE_AGENT
#define LDS_WAIT() asm volatile("s_waitcnt lgkmcnt(0)" ::: "memory")
#define VM_WAIT() asm volatile("s_waitcnt vmcnt(0)" ::: "memory")
__device__ __forceinline__ unsigned long long rt() { return __builtin_amdgcn_s_memrealtime(); }
__device__ __forceinline__ unsigned f2bf(float f) { unsigned u = __builtin_bit_cast(unsigned, f); return (u + 0x7fffu + ((u >> 16) & 1u)) >> 16; }
__device__ __forceinline__ unsigned pk2(float lo, float hi) { return f2bf(lo) | (f2bf(hi) << 16); }

#define XB_TMO      128
#define XB_XCNT(j)  (256  + 64 * (j))
#define XB_XSUB(j)  (1280 + 64 * (j))
#define XB_XGEN(j)  (2304 + 64 * (j))
#define XB_TOP      3328
#define XB_TOPGEN   3392
#define XCD_BAR_WORDS 3456
#define XB_SPIN_CAP (1u << 18)

__device__ __forceinline__ unsigned xb_ld(unsigned* p)              { return __hip_atomic_load(p, __ATOMIC_RELAXED, __HIP_MEMORY_SCOPE_AGENT); }
__device__ __forceinline__ unsigned xb_add(unsigned* p, unsigned v) { return __hip_atomic_fetch_add(p, v, __ATOMIC_RELAXED, __HIP_MEMORY_SCOPE_AGENT); }
__device__ __forceinline__ unsigned xb_xcc_id() { return (unsigned)__builtin_amdgcn_s_getreg((3 << 11) | 20) & 0xFu; }
#define XB_SPIN(cond, bar) do { unsigned _sp = 0; while (cond) { __builtin_amdgcn_s_sleep(1); \
    if ((++_sp & 255u) == 0u) { if (xb_ld(&(bar)[XB_TMO])) break; if (_sp > XB_SPIN_CAP) { atomicAdd(&(bar)[XB_TMO], 1u); break; } } } } while (0)

struct XcdBarrier {
    unsigned* bar; unsigned x;
    volatile LAS unsigned* st;
};

__device__ __forceinline__ XcdBarrier xcd_barrier_post(unsigned* bar, volatile LAS unsigned* st) {
    XcdBarrier b; b.bar = bar; b.x = xb_xcc_id(); b.st = st;
    if (threadIdx.x == 0) (void)xb_add(&bar[XB_XCNT(b.x)], 1u);
    return b;
}
__device__ __forceinline__ void xcd_barrier_complete(unsigned* bar, unsigned x, unsigned& nloc, unsigned& nx) {
    const unsigned G = gridDim.x * gridDim.y * gridDim.z;
    unsigned sum, cnt, mine, sp = 0u;
    for (;;) {
        sum = 0u; cnt = 0u; mine = 0u;
#pragma unroll
        for (unsigned j = 0; j < 16; ++j) { const unsigned c = xb_ld(&bar[XB_XCNT(j)]); sum += c; cnt += (c > 0u) ? 1u : 0u; mine = (j == x) ? c : mine; }
        if (sum == G) break;
        __builtin_amdgcn_s_sleep(1);
        if ((++sp & 255u) == 0u) { if (xb_ld(&bar[XB_TMO])) break; if (sp > XB_SPIN_CAP) { atomicAdd(&bar[XB_TMO], 1u); break; } }
    }
    nloc = mine > 0u ? mine : 1u; nx = cnt > 0u ? cnt : 1u;
}

__device__ __forceinline__ void xcd_barrier(const XcdBarrier& b) {
    asm volatile("s_waitcnt vmcnt(0)" ::: "memory");
    __syncthreads();
    if (threadIdx.x == 0) {
        unsigned* bar = b.bar;
        __builtin_amdgcn_s_waitcnt(0);
        unsigned nloc = b.st[0], nx = b.st[1];
        if (nloc == 0u) { xcd_barrier_complete(bar, b.x, nloc, nx); b.st[0] = nloc; b.st[1] = nx; }
        const unsigned old = xb_add(&bar[XB_XSUB(b.x)], 1u);
        const unsigned gen = old / nloc;
        if (old + 1u == (gen + 1u) * nloc) {
            __builtin_amdgcn_fence(__ATOMIC_RELEASE, "agent");
            asm volatile("s_waitcnt vmcnt(0)" ::: "memory");
            const unsigned og = xb_add(&bar[XB_TOP], 1u);
            const unsigned tg = og / nx;
            if (og + 1u == (tg + 1u) * nx) xb_add(&bar[XB_TOPGEN], 1u);
            else XB_SPIN(xb_ld(&bar[XB_TOPGEN]) == tg, bar);
            __builtin_amdgcn_fence(__ATOMIC_ACQUIRE, "agent");
            xb_add(&bar[XB_XGEN(b.x)], 1u);
            asm volatile("s_waitcnt vmcnt(0)" ::: "memory");
        } else {
            XB_SPIN(xb_ld(&bar[XB_XGEN(b.x)]) == gen, bar);
            __builtin_amdgcn_fence(__ATOMIC_ACQUIRE, "agent");
            asm volatile("s_waitcnt vmcnt(0)" ::: "memory");
        }
    }
    __syncthreads();
}

typedef float f32x16 __attribute__((ext_vector_type(16)));
typedef unsigned v2u __attribute__((ext_vector_type(2)));
struct Frame {
    LAS unsigned char* lds;
    volatile LAS unsigned* MISC;
    gu32* ctl;
    int tid, lane, wave, vcu, G;
    const float* in[N_IN]; float* out;
    float* mod; float* rope;
    bf16 *Win_t, *Wout_t, *Wgu_t, *Wdn_t;
    bf16 *HB, *QB, *KB, *VB, *CB, *YB, *ACT, *MX, *FX; float* ssq;
};
template <int CTRL> __device__ __forceinline__ float dpp_add(float v) { return v + __builtin_bit_cast(float, __builtin_amdgcn_update_dpp(0, __builtin_bit_cast(int, v), CTRL, 0xf, 0xf, true)); }
__device__ __forceinline__ float wave_sum(float v) {
    v = dpp_add<0xB1>(v); v = dpp_add<0x4E>(v); v = dpp_add<0x141>(v); v = dpp_add<0x140>(v);
    v += __builtin_bit_cast(float, __builtin_amdgcn_ds_swizzle(__builtin_bit_cast(int, v), 0x401F));
    return __builtin_bit_cast(float, __builtin_amdgcn_readlane(__builtin_bit_cast(int, v), 0)) + __builtin_bit_cast(float, __builtin_amdgcn_readlane(__builtin_bit_cast(int, v), 32));
}
__device__ __forceinline__ unsigned pkbf(float lo, float hi) { return pg8::pkbf(lo, hi); }
__device__ __forceinline__ float bflo(unsigned w) { return __builtin_bit_cast(float, w << 16); }
__device__ __forceinline__ float bfhi(unsigned w) { return __builtin_bit_cast(float, w & 0xffff0000u); }

__device__ __forceinline__ int map_in(int n) {
    if (n < 4096) { const int hd = n & ~127, d = n & 127, blk = d >> 6, e4 = (d >> 5) & 1, i = d & 31; return hd + 64 * blk + 8 * (i >> 2) + 4 * e4 + (i & 3); }
    if (n < 6144) return n;
    const int kind = (n - 6144) >> 11, c = (n - 6144) & 2047;
    if (kind == 1) return 10240 + c;
    return 6144 + 256 * (c >> 7) + (kind == 2 ? 128 : 0) + (c & 127);
}
__device__ __forceinline__ int map_gu(int n) { const int up = n >= FF ? 1 : 0, jx = up ? n - FF : n; return 256 * (jx >> 7) + 128 * up + (jx & 127); }
#ifndef TR_NT
#define TR_NT 1
#endif
#ifndef TR_NT_ST
#define TR_NT_ST 1
#endif
#if TR_NT
#define TR_LOAD(p) __builtin_nontemporal_load(p)
#else
#define TR_LOAD(p) (*(p))
#endif
#if TR_NT_ST
#define TR_STORE(v, p) __builtin_nontemporal_store((v), (p))
#else
#define TR_STORE(v, p) (*(p) = (v))
#endif
#ifndef W_DROP_BITS
#define W_DROP_BITS 0
#endif
__device__ __forceinline__ unsigned pkw(float lo, float hi) {
#if W_DROP_BITS > 0
    constexpr unsigned SH = 16 + W_DROP_BITS, HALF_ = (1u << (SH - 1)) - 1u, MASK = ~((1u << SH) - 1u);
    unsigned a = __builtin_bit_cast(unsigned, lo), b = __builtin_bit_cast(unsigned, hi);
    a = (a + HALF_ + ((a >> SH) & 1u)) & MASK; b = (b + HALF_ + ((b >> SH) & 1u)) & MASK;
    return (a >> 16) | (b & 0xffff0000u);
#else
    return pkbf(lo, hi);
#endif
}
template <int MAP> __device__ __forceinline__ void transpose_items(const float* W, int K, int N, bf16* WT, LAS float* scr, int first, int stride, int end, int lane, const float* kscale = nullptr) {
    const int nblk = N / 32;
    const GAS float* Wl = (const GAS float*)W + (size_t)(lane >> 3) * N + 4 * (lane & 7);
    LAS float* sw = scr + (lane >> 3) * 33 + 4 * (lane & 7);
    const int c = lane & 7;
    f32x4 v[8];
    int it = first;
    if (it < end) { const GAS float* Wg = Wl + (size_t)(64 * (it / nblk)) * N + 32 * (it % nblk);
#pragma unroll
        for (int i = 0; i < 8; ++i) v[i] = TR_LOAD((const GAS f32x4*)(Wg + (size_t)(8 * i) * N)); }
    while (it < end) {
        const int k0 = 64 * (it / nblk), n0 = 32 * (it % nblk);
#pragma unroll
        for (int i = 0; i < 8; ++i) { sw[(8 * i) * 33 + 0] = v[i].x; sw[(8 * i) * 33 + 1] = v[i].y; sw[(8 * i) * 33 + 2] = v[i].z; sw[(8 * i) * 33 + 3] = v[i].w; }
        const int nx = it + stride;
        if (nx < end) { const GAS float* Wg = Wl + (size_t)(64 * (nx / nblk)) * N + 32 * (nx % nblk);
#pragma unroll
            for (int i = 0; i < 8; ++i) v[i] = TR_LOAD((const GAS f32x4*)(Wg + (size_t)(8 * i) * N)); }
        LDS_WAIT(); asm volatile("" ::: "memory");
#pragma unroll
        for (int j = 0; j < 4; ++j) { const int n = (lane >> 3) + 8 * j; const LAS float* s = scr + (8 * c) * 33 + n;
            v4u o;
            if (MAP == 3) { const f32x4 g0 = *(const GAS f32x4*)(kscale + k0 + 8 * c), g1 = *(const GAS f32x4*)(kscale + k0 + 8 * c + 4);
                o.x = pkw(s[0 * 33] * g0.x, s[1 * 33] * g0.y); o.y = pkw(s[2 * 33] * g0.z, s[3 * 33] * g0.w); o.z = pkw(s[4 * 33] * g1.x, s[5 * 33] * g1.y); o.w = pkw(s[6 * 33] * g1.z, s[7 * 33] * g1.w); }
            else { o.x = pkw(s[0 * 33], s[1 * 33]); o.y = pkw(s[2 * 33], s[3 * 33]); o.z = pkw(s[4 * 33], s[5 * 33]); o.w = pkw(s[6 * 33], s[7 * 33]); }
            const int nsrc = n0 + n, nd = MAP == 1 ? map_in(nsrc) : (MAP == 2 ? map_gu(nsrc) : nsrc);
            TR_STORE(o, (GAS v4u*)(WT + (size_t)nd * K + k0 + 8 * c)); }
        LDS_WAIT(); asm volatile("" ::: "memory");
        it = nx;
    }
}
constexpr int IT_IN = (D / 64) * (INC / 32), IT_OUT = (D / 64) * (D / 32), IT_GU = (D / 64) * (2 * FF / 32), IT_DN = (FF / 64) * (D / 32);
__device__ __forceinline__ void p0_prologue(Frame& F, const float amul) {
    { const int gi = blockIdx.x * (NWAVES * 64) + F.tid;
      if (gi < 2048) { const int pos = gi >> 5, i = gi & 31; const float fr = exp2f(-(float)i * (13.287712379549449f / 32.0f)); const float ang = (float)pos * fr;
          F.rope[gi] = cosf(ang); F.rope[2048 + gi] = sinf(ang); } }
    { LAS float* sil = (LAS float*)(F.lds + RING_OFF);
      LAS float* red = (LAS float*)(F.lds + RING_OFF + 16384);
      const GAS float* aw = (const GAS float*)F.in[I_ADAW];
      for (int it = blockIdx.x; it < 768; it += F.G) {
          const int cs = it % 96, ks = it / 96, k0 = 512 * ks;
          for (int idx = F.tid; idx < 5 * 512; idx += NWAVES * 64) { const int bb = idx >> 9, kk = idx & 511;
              const float v = bb < 4 ? F.in[I_C][bb * D + k0 + kk] : F.in[I_CCTX][k0 + kk]; sil[idx] = v / (1.0f + __expf(-v)); }
          __syncthreads();
          f32x4 a0 = {0.f, 0.f, 0.f, 0.f}, a1 = a0, a2 = a0, a3 = a0, a4 = a0;
          const GAS float* wp = aw + (size_t)(k0 + F.wave) * NMODC + 256 * cs + 4 * F.lane;
#pragma unroll 8
          for (int i = 0; i < 64; ++i) { const f32x4 w = __builtin_nontemporal_load((const GAS f32x4*)(wp + (size_t)(8 * i) * NMODC)); const int k = F.wave + 8 * i;
              a0 += sil[k] * w; a1 += sil[512 + k] * w; a2 += sil[1024 + k] * w; a3 += sil[1536 + k] * w; a4 += sil[2048 + k] * w; }
          LAS f32x4* rw = (LAS f32x4*)(red + F.wave * 1280) + F.lane;
          rw[0] = a0; rw[64] = a1; rw[128] = a2; rw[192] = a3; rw[256] = a4;
          __syncthreads();
          for (int idx = F.tid; idx < 1280; idx += NWAVES * 64) { float s = 0.f;
#pragma unroll
              for (int w = 0; w < 8; ++w) s += red[w * 1280 + idx];
              const int bb = idx >> 8, cc = idx & 255, n = 256 * cs + cc;
              if (ks == 0) s += F.in[I_ADAB][n];
              atomicAdd(F.mod + bb * NMODC + n, s * amul); }
          __syncthreads();
      } }
    LAS float* scr = (LAS float*)(F.lds + RING_OFF + F.wave * 16384);
    const int gw = F.vcu * NWAVES + F.wave, NGW = F.G * NWAVES;
    transpose_items<1>(F.in[I_WIN], D, INC, F.Win_t, scr, gw, NGW, IT_IN, F.lane);
    transpose_items<0>(F.in[I_WDN], FF, D, F.Wdn_t, scr, gw, NGW, P0_DN_ITEMS, F.lane);
    transpose_items<2>(F.in[I_WGU], D, 2 * FF, F.Wgu_t, scr, gw, NGW, P0_GU_ITEMS, F.lane);
    transpose_items<3>(F.in[I_WOUT], D, D, F.Wout_t, scr, gw, NGW, P0_OUT_ITEMS, F.lane, F.in[I_GNG]);
}

__device__ __forceinline__ void norm_mod_row(const float* xrow, bf16* orow, const float* gain, const float* shift, const float* scale, int lane) {
    const GAS f32x4* xr = (const GAS f32x4*)xrow + lane;
    f32x4 v[16]; float ss = 0.f;
#pragma unroll
    for (int j = 0; j < 16; ++j) { v[j] = __builtin_nontemporal_load(xr + 64 * j); ss += (v[j].x * v[j].x + v[j].y * v[j].y) + (v[j].z * v[j].z + v[j].w * v[j].w); }
    const float rstd = 1.0f / sqrtf(wave_sum(ss) * (1.0f / D) + EPS);
    const GAS f32x4* g4 = (const GAS f32x4*)gain + lane; const GAS f32x4* sh4 = (const GAS f32x4*)shift + lane; const GAS f32x4* sc4 = (const GAS f32x4*)scale + lane;
    GAS v2u* o8 = (GAS v2u*)orow + lane;
#pragma unroll
    for (int j = 0; j < 16; ++j) { const f32x4 g = g4[64 * j], sh = sh4[64 * j], sc = sc4[64 * j];
        const f32x4 y = v[j] * rstd * g * (1.0f + sc) + sh; v2u w; w.x = pkbf(y.x, y.y); w.y = pkbf(y.z, y.w); o8[64 * j] = w; }
}

__device__ __forceinline__ void norm_mod_row_x1(const float* xrow, const bf16* mrow, bf16* orow, const float* gain, const float* shift, const float* scale, int lane) {
    const GAS f32x4* xr = (const GAS f32x4*)xrow + lane; const GAS v2u* mr = (const GAS v2u*)mrow + lane;
    f32x4 v[16]; float ss = 0.f;
#pragma unroll
    for (int j = 0; j < 16; ++j) { const f32x4 x = __builtin_nontemporal_load(xr + 64 * j); const v2u m = __builtin_nontemporal_load(mr + 64 * j);
        v[j] = (f32x4){x.x + bflo(m.x), x.y + bfhi(m.x), x.z + bflo(m.y), x.w + bfhi(m.y)};
        ss += (v[j].x * v[j].x + v[j].y * v[j].y) + (v[j].z * v[j].z + v[j].w * v[j].w); }
    const float rstd = 1.0f / sqrtf(wave_sum(ss) * (1.0f / D) + EPS);
    const GAS f32x4* g4 = (const GAS f32x4*)gain + lane; const GAS f32x4* sh4 = (const GAS f32x4*)shift + lane; const GAS f32x4* sc4 = (const GAS f32x4*)scale + lane;
    GAS v2u* o8 = (GAS v2u*)orow + lane;
#pragma unroll
    for (int j = 0; j < 16; ++j) { const f32x4 g = g4[64 * j], sh = sh4[64 * j], sc = sc4[64 * j];
        const f32x4 y = v[j] * rstd * g * (1.0f + sc) + sh; v2u w; w.x = pkbf(y.x, y.y); w.y = pkbf(y.z, y.w); o8[64 * j] = w; }
}

#define MFMA32(a, b, c) __builtin_amdgcn_mfma_f32_32x32x16_bf16((a), (b), (c), 0, 0, 0)
constexpr int A_NST = 6, A_STAGE = 16384, A_RING = 32768;
typedef short s16x4 __attribute__((ext_vector_type(4)));
__device__ __forceinline__ void attn_wg_unit(Frame& F, const LAS float* rp, int b, int h, int R0) {
    const int lane = F.lane, w = F.wave, j = lane & 31, g = lane >> 5;
    const int r = R0 + (w >> 1), qblk = w & 1;
    const int rs = min(max(r - NAKH / 2, 0), ROWS - NAKH);
    const int KR0 = min(max(R0 - NAKH / 2, 0), ROWS - NAKH), KR1 = min(max(R0 + 3 - NAKH / 2, 0), ROWS - NAKH) + NAKH - 1;
    const int NT = 8 + 2 * (KR1 - KR0 + 1);
    const int qc = 32 * qblk + j, cs = min(max(qc - NAKW / 2, 0), GRIDW - NAKW);
    const int bias_lane = (h * 15 + rs - r + NAKH - 1) * 31 + 8 * g - qc + NAKW - 1;
    const int mask_lane = 8 * g - cs;
    const unsigned drow = 4u * w + (lane >> 4), dsw = ((drow & 3u) << 2) | ((drow >> 2) & 3u);
    const unsigned dma_off = (drow * NAW + 8u * ((lane & 15u) ^ dsw)) * 2u;
    const char* kbase = (const char*)(F.KB + HD * h); const char* vbase = (const char*)(F.VB + HD * h);
    LAS unsigned char* ring = F.lds + RING_OFF + A_RING;
#define KEYBASE(T) ((T) >= 8 ? (b * SEQ + (KR0 + (((T) - 8) >> 1)) * GRIDW + 32 * (((T) - 8) & 1)) : (M + b * CTXL + 32 * (T)))
#define DMA(T, ST) do { const size_t go_ = (size_t)KEYBASE(T) * (NAW * 2) + dma_off; \
        __builtin_amdgcn_global_load_lds((const unsigned*)(kbase + go_), (LAS unsigned*)(ring + (ST) * A_STAGE + w * 1024), 16, 0, 0); \
        __builtin_amdgcn_global_load_lds((const unsigned*)(vbase + go_), (LAS unsigned*)(ring + (ST) * A_STAGE + 8192 + w * 1024), 16, 0, 0); } while (0)
    const unsigned kap = (j & 19) | ((j & 4) << 1) | ((j & 8) >> 1), ksw = ((kap & 3u) << 2) | ((kap >> 2) & 3u);
    unsigned ka[8];
#pragma unroll
    for (int kd = 0; kd < 8; ++kd) ka[kd] = 256u * kap + 16u * ((2u * kd + g) ^ ksw);
    const unsigned blk = (lane >> 4) & 1, q4 = (lane & 15) >> 2, p4 = lane & 3;
    unsigned va_[2][4];
#pragma unroll
    for (int t = 0; t < 2; ++t)
#pragma unroll
        for (int jb = 0; jb < 4; ++jb) { const unsigned row = 8u * g + 4u * t + q4, sw = ((row & 3u) << 2) | ((row >> 2) & 3u);
            va_[t][jb] = 8192u + 256u * row + 16u * ((4u * jb + 2u * blk + (p4 >> 1)) ^ sw) + 8u * (p4 & 1); }
    const size_t qtok = (size_t)b * SEQ + r * GRIDW + 32 * qblk + j;
    bf16x8 qf[8];
    { const GAS bf16x8* qp = (const GAS bf16x8*)(F.QB + qtok * NAW + HD * h + 8 * g);
#pragma unroll
      for (int kd = 0; kd < 8; ++kd) qf[kd] = __builtin_nontemporal_load(qp + 2 * kd); }
#pragma unroll
    for (int t = 0; t < A_NST - 1; ++t) DMA(t, t);
    f32x16 o0, o1, o2, o3;
#pragma unroll
    for (int v = 0; v < 16; ++v) { o0[v] = 0.f; o1[v] = 0.f; o2[v] = 0.f; o3[v] = 0.f; }
    float m_run = -__builtin_inff(), l_run = 0.f;
    int st = 0, stp = A_NST - 1;
    for (int t = 0; t < NT; ++t) {
        asm volatile("s_waitcnt vmcnt(%0)" :: "n"(2 * (A_NST - 2)) : "memory");
        __builtin_amdgcn_s_barrier();
        asm volatile("" ::: "memory");
        { const int tp = min(t + A_NST - 1, NT - 1); DMA(tp, stp); }
        const bool lat = t >= 8; const int kr = KR0 + ((t - 8) >> 1), kblk = (t - 8) & 1;
        const bool active = !lat || (kr >= rs && kr < rs + NAKH);
        if (active) {
            const LAS unsigned char* sb = ring + st * A_STAGE;
            f32x16 s;
#pragma unroll
            for (int v = 0; v < 16; ++v) s[v] = 0.f;
            { bf16x8 kf[8];
#pragma unroll
              for (int kd = 0; kd < 8; ++kd) kf[kd] = *(const LAS bf16x8*)(sb + ka[kd]);
#pragma unroll
              for (int kd = 0; kd < 8; ++kd) s = MFMA32(kf[kd], qf[kd], s); }
            s16x4 tv[2][2][4];
            { const unsigned sa = (unsigned)(size_t)sb;
#pragma unroll
              for (int t2 = 0; t2 < 2; ++t2)
#pragma unroll
                for (int jb = 0; jb < 4; ++jb) { asm volatile("ds_read_b64_tr_b16 %0, %1" : "=v"(tv[0][t2][jb]) : "v"(sa + va_[t2][jb]) : "memory");
                                                 asm volatile("ds_read_b64_tr_b16 %0, %1 offset:4096" : "=v"(tv[1][t2][jb]) : "v"(sa + va_[t2][jb]) : "memory"); } }
            if (lat) { int ml = mask_lane; asm volatile("" : "+v"(ml)); const LAS float* bp = rp + bias_lane + 31 * (kr - rs) + 32 * kblk;
                float bias[16];
#pragma unroll
                for (int v = 0; v < 16; ++v) bias[v] = bp[(v & 7) + 16 * (v >> 3)];
                asm volatile("" : "+v"(bias[0]), "+v"(bias[1]), "+v"(bias[2]), "+v"(bias[3]), "+v"(bias[4]), "+v"(bias[5]), "+v"(bias[6]), "+v"(bias[7]),
                             "+v"(bias[8]), "+v"(bias[9]), "+v"(bias[10]), "+v"(bias[11]), "+v"(bias[12]), "+v"(bias[13]), "+v"(bias[14]), "+v"(bias[15]));
                const int mk = ml + 32 * kblk;
#pragma unroll
                for (int v = 0; v < 16; ++v) { const int c = (v & 7) + 16 * (v >> 3); s[v] = ((unsigned)(c + mk) < 16u) ? s[v] + bias[v] : -__builtin_inff(); } }
            float mx = s[0];
#pragma unroll
            for (int v = 1; v < 16; ++v) mx = fmaxf(mx, s[v]);
            mx = fmaxf(mx, __shfl_xor(mx, 32));
            if (__builtin_amdgcn_ballot_w64(mx > m_run) != 0ull) {
                const float m_new = fmaxf(m_run, mx), alpha = __builtin_amdgcn_exp2f(m_run - m_new);
                l_run *= alpha; m_run = m_new;
#pragma unroll
                for (int v = 0; v < 16; ++v) { o0[v] *= alpha; o1[v] *= alpha; o2[v] *= alpha; o3[v] *= alpha; } }
            float ps = 0.f;
#pragma unroll
            for (int v = 0; v < 16; ++v) { s[v] = __builtin_amdgcn_exp2f(s[v] - m_run); ps += s[v]; }
            l_run += ps;
            bf16x8 pf0, pf1;
            { v4u t0, t1; t0.x = pkbf(s[0], s[1]); t0.y = pkbf(s[2], s[3]); t0.z = pkbf(s[4], s[5]); t0.w = pkbf(s[6], s[7]);
              t1.x = pkbf(s[8], s[9]); t1.y = pkbf(s[10], s[11]); t1.z = pkbf(s[12], s[13]); t1.w = pkbf(s[14], s[15]);
              pf0 = __builtin_bit_cast(bf16x8, t0); pf1 = __builtin_bit_cast(bf16x8, t1); }
            asm volatile("s_waitcnt lgkmcnt(0)" : "+v"(tv[0][0][0]), "+v"(tv[0][0][1]), "+v"(tv[0][0][2]), "+v"(tv[0][0][3]), "+v"(tv[0][1][0]), "+v"(tv[0][1][1]), "+v"(tv[0][1][2]), "+v"(tv[0][1][3]),
                         "+v"(tv[1][0][0]), "+v"(tv[1][0][1]), "+v"(tv[1][0][2]), "+v"(tv[1][0][3]), "+v"(tv[1][1][0]), "+v"(tv[1][1][1]), "+v"(tv[1][1][2]), "+v"(tv[1][1][3]) :: "memory");
#define VF(KS, JB) __builtin_shufflevector(tv[KS][0][JB], tv[KS][1][JB], 0, 1, 2, 3, 4, 5, 6, 7)
            o0 = MFMA32(VF(0, 0), pf0, o0); o1 = MFMA32(VF(0, 1), pf0, o1); o2 = MFMA32(VF(0, 2), pf0, o2); o3 = MFMA32(VF(0, 3), pf0, o3);
            o0 = MFMA32(VF(1, 0), pf1, o0); o1 = MFMA32(VF(1, 1), pf1, o1); o2 = MFMA32(VF(1, 2), pf1, o2); o3 = MFMA32(VF(1, 3), pf1, o3);
#undef VF
        }
        st = (st + 1 == A_NST) ? 0 : st + 1; stp = (stp + 1 == A_NST) ? 0 : stp + 1;
    }
#undef KEYBASE
#undef DMA
    asm volatile("s_waitcnt vmcnt(0)" ::: "memory");
    __builtin_amdgcn_s_barrier();
    asm volatile("" ::: "memory");
    const float l = l_run + __shfl_xor(l_run, 32), inv = 1.0f / l;
    GAS v2u* op = (GAS v2u*)(F.YB + qtok * D + HD * h);
    float sq = 0.f;
#define OST(JB, OV) do { _Pragma("unroll") for (int u = 0; u < 4; ++u) { const float a_ = OV[4 * u] * inv, b_ = OV[4 * u + 1] * inv, c_ = OV[4 * u + 2] * inv, d_ = OV[4 * u + 3] * inv; \
        sq += (a_ * a_ + b_ * b_) + (c_ * c_ + d_ * d_); v2u w_; w_.x = pkbf(a_, b_); w_.y = pkbf(c_, d_); op[8 * (JB) + 2 * u + g] = w_; } } while (0)
    OST(0, o0); OST(1, o1); OST(2, o2); OST(3, o3);
    sq += __shfl_xor(sq, 32);
    if (g == 0) atomicAdd(F.ssq + qtok, sq);
#undef OST
}
__device__ __forceinline__ void attn_phase(Frame& F) {
    LAS float* rp = (LAS float*)(F.lds + RING_OFF + 1024);
    for (int i = F.tid; i < NAH * 15 * 31; i += NWAVES * 64) rp[i] = F.in[I_RPB][i] * LOG2E;
    __syncthreads();
    for (int wu = F.vcu; wu < NB * NAH * 8; wu += F.G) { const int bh = wu >> 3, rg = wu & 7; attn_wg_unit(F, rp, bh >> 4, bh & 15, rg * 4); }
}

__device__ __forceinline__ void conv_row(Frame& F, int row) {
    unsigned lane = (unsigned)F.lane; const int t = row & (SEQ - 1);
    asm volatile("" : "+v"(lane) :: "memory");
    const GAS char* cw = (const GAS char*)F.in[I_CONVW];
    const GAS char* r0 = (const GAS char*)(F.CB + (size_t)row * 4096);
    const GAS char* rm = t > 0 ? r0 - 8192 : r0; const GAS char* rp = t < SEQ - 1 ? r0 + 8192 : r0;
    const float fm = t > 0 ? 1.f : 0.f, fp = t < SEQ - 1 ? 1.f : 0.f;
    const float ssa = F.ssq[row];
    float co[4][8]; float ss = 0.f;
#pragma unroll
    for (int q = 0; q < 4; ++q) { const unsigned vo = lane * 16u + q * 1024u, wo = lane * 32u + q * 2048u;
        const v4u c0v = *(const GAS v4u*)(r0 + vo), gb = __builtin_nontemporal_load((const GAS v4u*)(r0 + (vo + 4096u)));
        const v4u cm = *(const GAS v4u*)(rm + vo), cpl = *(const GAS v4u*)(rp + vo);
        const f32x4 wa0 = *(const GAS f32x4*)(cw + wo), wa1 = *(const GAS f32x4*)(cw + (wo + 16u)), wb0 = *(const GAS f32x4*)(cw + (wo + 8192u)), wb1 = *(const GAS f32x4*)(cw + (wo + 8208u)),
                    wc0 = *(const GAS f32x4*)(cw + (wo + 16384u)), wc1 = *(const GAS f32x4*)(cw + (wo + 16400u));
#pragma unroll
        for (int e = 0; e < 4; ++e) {
            const float k0l = (e < 2 ? wa0[(2 * e) & 3] : wa1[(2 * e) & 3]) * fm, k0h = (e < 2 ? wa0[(2 * e + 1) & 3] : wa1[(2 * e + 1) & 3]) * fm;
            const float k1l = e < 2 ? wb0[(2 * e) & 3] : wb1[(2 * e) & 3], k1h = e < 2 ? wb0[(2 * e + 1) & 3] : wb1[(2 * e + 1) & 3];
            const float k2l = (e < 2 ? wc0[(2 * e) & 3] : wc1[(2 * e) & 3]) * fp, k2h = (e < 2 ? wc0[(2 * e + 1) & 3] : wc1[(2 * e + 1) & 3]) * fp;
            const float vl = bflo(gb[e]) * (k0l * bflo(cm[e]) + k1l * bflo(c0v[e]) + k2l * bflo(cpl[e]));
            const float vh = bfhi(gb[e]) * (k0h * bfhi(cm[e]) + k1h * bfhi(c0v[e]) + k2h * bfhi(cpl[e]));
            co[q][2 * e] = vl; co[q][2 * e + 1] = vh; ss += vl * vl + vh * vh; } }
    const float sc = sqrtf(ssa * (1.0f / NAW) + EPS) / sqrtf(wave_sum(ss) * (1.0f / CVW) + EPS);
    GAS char* yp = (GAS char*)(F.YB + (size_t)row * D + NAW);
#pragma unroll
    for (int q = 0; q < 4; ++q) { v4u w;
        w.x = pkbf(co[q][0] * sc, co[q][1] * sc); w.y = pkbf(co[q][2] * sc, co[q][3] * sc); w.z = pkbf(co[q][4] * sc, co[q][5] * sc); w.w = pkbf(co[q][6] * sc, co[q][7] * sc);
        *(GAS v4u*)(yp + (lane * 16u + q * 1024u)) = w; }
}
__device__ __forceinline__ void final_norm_row(const float* xrow, const bf16* mrow, const bf16* frow, float* orow, const float* gain, int lane) {
    const GAS f32x4* xr = (const GAS f32x4*)xrow + lane; const GAS v2u* mr = (const GAS v2u*)mrow + lane; const GAS v2u* fr = (const GAS v2u*)frow + lane;
    const GAS f32x4* g4 = (const GAS f32x4*)gain + lane; GAS f32x4* o4 = (GAS f32x4*)orow + lane;
    f32x4 v[16]; float ss = 0.f;
#pragma unroll
    for (int j = 0; j < 16; ++j) { const f32x4 x = __builtin_nontemporal_load(xr + 64 * j); const v2u m = __builtin_nontemporal_load(mr + 64 * j), f = __builtin_nontemporal_load(fr + 64 * j);
        v[j] = (f32x4){x.x + bflo(m.x) + bflo(f.x), x.y + bfhi(m.x) + bfhi(f.x), x.z + bflo(m.y) + bflo(f.y), x.w + bfhi(m.y) + bfhi(f.y)};
        ss += (v[j].x * v[j].x + v[j].y * v[j].y) + (v[j].z * v[j].z + v[j].w * v[j].w); }
    const float rstd = 1.0f / sqrtf(wave_sum(ss) * (1.0f / D) + EPS);
#pragma unroll
    for (int j = 0; j < 16; ++j) __builtin_nontemporal_store(v[j] * rstd * g4[64 * j], o4 + 64 * j);
}

struct Args { const float* in[N_IN]; float* out; unsigned char* ws; int ph_lo, ph_hi; };
__global__ void __launch_bounds__(NWAVES * 64, 2) fwd_kernel(Args args) {
    extern __shared__ __attribute__((aligned(16))) unsigned char lds[];
    Frame F;
    F.lds = (LAS unsigned char*)lds;
    F.MISC = (volatile LAS unsigned*)(F.lds + MISC_OFF);
    F.tid = threadIdx.x; F.lane = F.tid & 63; F.wave = __builtin_amdgcn_readfirstlane(F.tid >> 6);
    F.G = gridDim.x; { const int bx = blockIdx.x; F.vcu = (F.G % 8 == 0) ? (bx % 8) * (F.G / 8) + bx / 8 : bx; }
    unsigned char* ws = args.ws;
    F.ctl = (gu32*)(ws + WS_CTL);
#pragma unroll
    for (int i = 0; i < N_IN; ++i) F.in[i] = args.in[i];
    F.out = args.out; F.mod = (float*)(ws + WS_MOD); F.rope = (float*)(ws + WS_ROPE);
    F.Win_t = (bf16*)(ws + WS_WIN); F.Wout_t = (bf16*)(ws + WS_WOUT); F.Wgu_t = (bf16*)(ws + WS_WGU); F.Wdn_t = (bf16*)(ws + WS_WDN);
    F.HB = (bf16*)(ws + WS_H); F.QB = (bf16*)(ws + WS_Q); F.KB = (bf16*)(ws + WS_K); F.VB = (bf16*)(ws + WS_V); F.CB = (bf16*)(ws + WS_C);
    F.ssq = (float*)(ws + WS_SSQ); F.YB = (bf16*)(ws + WS_Y); F.ACT = (bf16*)(ws + WS_ACT); F.MX = (bf16*)(ws + WS_X1); F.FX = (bf16*)(ws + WS_X1 + 64 * MiB);
    for (int u = F.tid; u < (LDS_BYTES - LDSCTL_OFF) / 4; u += NWAVES * 64) ((LAS unsigned*)(F.lds + LDSCTL_OFF))[u] = 0u;
    __syncthreads();
    XcdBarrier bar; bar.bar = (unsigned*)(F.ctl + CW_BAR); bar.x = 0; bar.st = nullptr;
    if (N_LAUNCHES == 1) bar = xcd_barrier_post((unsigned*)(F.ctl + CW_BAR), F.MISC + 8);
    const int lo = args.ph_lo, hi = args.ph_hi;
#define IN(k) (lo <= (k) && (k) < hi)
#if defined(PROBE_BAR2)
#define SEAM(k) do { if (IN(k) && IN((k) + 1)) { xcd_barrier(bar); xcd_barrier(bar); } } while (0)
#else
#define SEAM(k) do { if (IN(k) && IN((k) + 1)) xcd_barrier(bar); } while (0)
#endif
    const int gw = F.vcu * NWAVES + F.wave, NGW = F.G * NWAVES;
#ifndef PROBE_DUP
#define PROBE_DUP (-1)
#endif
#define DUP(k, body) do { body; if (PROBE_DUP == (k)) { xcd_barrier(bar); body; } } while (0)

    if (IN(0)) { p0_prologue(F, 1.0f); if (PROBE_DUP == 0) { xcd_barrier(bar); p0_prologue(F, 0.0f); } SEAM(0); }
    if (IN(1)) {
        DUP(1, for (int m = gw; m < MT; m += NGW) {
            const bool isctx = m >= M; const float* xrow = isctx ? F.in[I_CTX] + (size_t)(m - M) * D : F.in[I_X] + (size_t)m * D;
            const float* mrow = F.mod + (size_t)(isctx ? 4 : (m >> 11)) * NMODC;
            norm_mod_row(xrow, F.HB + (size_t)m * D, F.in[I_N1G], mrow, mrow + D, F.lane); });
        SEAM(1);
    }
#if defined(PROBE_IDLE_US)
    if (IN(2)) { const unsigned long long t0 = __builtin_amdgcn_s_memrealtime(); while (__builtin_amdgcn_s_memrealtime() - t0 < (unsigned long long)(PROBE_IDLE_US) * 100ull) __builtin_amdgcn_s_sleep(32); }
#endif
    if (IN(2)) {
        pg8::Gemm g{F.HB, F.Win_t, MT, INC, D}; pg8::InOrder S; S.init(F.G, (int)blockIdx.x);
        pg8::EpiIn E{F.QB, F.KB, F.VB, F.CB, F.rope, 0.08838834764831845f * LOG2E};
        DUP(2, (pg8::gemm_phase<pg8::EpiIn, pg8::InOrder, PG8_ALIGN, PG8_SP2>(F.lds + RING_OFF, g, S, E)));
        if (F.G == 256 && blockIdx.x >= 64) {
            LAS float* scr = (LAS float*)(F.lds + RING_OFF + F.wave * 16384); const int p = ((int)blockIdx.x - 64) * NWAVES + F.wave;
            transpose_items<3>(F.in[I_WOUT], D, D, F.Wout_t, scr, P0_OUT_ITEMS + p, 192 * NWAVES, IT_OUT, F.lane, F.in[I_GNG]);
            transpose_items<2>(F.in[I_WGU], D, 2 * FF, F.Wgu_t, scr, P0_GU_ITEMS + p, 192 * NWAVES, IT_GU, F.lane);
        } else if (F.G != 256) {
            LAS float* scr = (LAS float*)(F.lds + RING_OFF + F.wave * 16384);
            transpose_items<3>(F.in[I_WOUT], D, D, F.Wout_t, scr, P0_OUT_ITEMS + gw, NGW, IT_OUT, F.lane, F.in[I_GNG]);
            transpose_items<2>(F.in[I_WGU], D, 2 * FF, F.Wgu_t, scr, P0_GU_ITEMS + gw, NGW, IT_GU, F.lane);
        }
        SEAM(2);
    }
    if (IN(3)) { DUP(3, attn_phase(F)); SEAM(3); }
    if (IN(4)) { DUP(4, for (int m = gw; m < M; m += NGW) conv_row(F, m)); SEAM(4); }
    if (IN(5)) {
        pg8::Gemm g{F.YB, F.Wout_t, M, D, D}; pg8::StaticOrder S; S.init(M, D, F.G, (int)blockIdx.x);
        pg8::EpiGate<true> E{F.MX, D, F.mod + 2 * D, F.ssq};
        DUP(5, (pg8::gemm_phase<pg8::EpiGate<true>, pg8::StaticOrder, PG8_ALIGN, PG8_SP2>(F.lds + RING_OFF, g, S, E)));
        SEAM(5);
    }
    if (IN(6)) {
        DUP(6, for (int m = gw; m < M; m += NGW) { const float* mrow = F.mod + (size_t)(m >> 11) * NMODC;
            norm_mod_row_x1(F.in[I_X] + (size_t)m * D, F.MX + (size_t)m * D, F.HB + (size_t)m * D, F.in[I_N2G], mrow + 3 * D, mrow + 4 * D, F.lane); });
        SEAM(6);
    }
    if (IN(7)) {
        pg8::Gemm g{F.HB, F.Wgu_t, M, 2 * FF, D}; pg8::StaticOrder S; S.init(M, 2 * FF, F.G, (int)blockIdx.x);
        pg8::EpiSwiglu E{F.ACT, FF};
        DUP(7, (pg8::gemm_phase<pg8::EpiSwiglu, pg8::StaticOrder, PG8_ALIGN, PG8_SP2>(F.lds + RING_OFF, g, S, E)));
        if (F.G == 256 && blockIdx.x >= 192) {
            LAS float* scr = (LAS float*)(F.lds + RING_OFF + F.wave * 16384); const int p = ((int)blockIdx.x - 192) * NWAVES + F.wave;
            transpose_items<0>(F.in[I_WDN], FF, D, F.Wdn_t, scr, P0_DN_ITEMS + p, 64 * NWAVES, IT_DN, F.lane);
        } else if (F.G != 256) {
            LAS float* scr = (LAS float*)(F.lds + RING_OFF + F.wave * 16384);
            transpose_items<0>(F.in[I_WDN], FF, D, F.Wdn_t, scr, P0_DN_ITEMS + gw, NGW, IT_DN, F.lane);
        }
        SEAM(7);
    }
    if (IN(8)) {
        pg8::Gemm g{F.ACT, F.Wdn_t, M, D, FF}; pg8::StaticOrder S; S.init(M, D, F.G, (int)blockIdx.x);
        pg8::EpiGate<false> E{F.FX, D, F.mod + 5 * D, nullptr};
        DUP(8, (pg8::gemm_phase<pg8::EpiGate<false>, pg8::StaticOrder, PG8_ALIGN, PG8_SP2>(F.lds + RING_OFF, g, S, E)));
        SEAM(8);
    }
    if (IN(9)) { for (int m = gw; m < M; m += NGW) final_norm_row(F.in[I_X] + (size_t)m * D, F.MX + (size_t)m * D, F.FX + (size_t)m * D, F.out + (size_t)m * D, F.in[I_FNG], F.lane); }
#undef IN
#undef SEAM
}

extern "C" void kernel_launch(void* const* d_in, const int* in_sizes, int n_in, void* d_out, int out_size, void* d_ws, size_t ws_size, hipStream_t stream) {
    static int grid = 0;
    if (grid == 0) {
        if (n_in != N_IN || in_sizes[I_X] != M * D || out_size != M * D || ws_size < WS_END) { fprintf(stderr, "kernel_launch: shape / workspace mismatch (n_in %d, x %d, out %d, ws %zu); nothing launched\n", n_in, n_in > 0 ? in_sizes[0] : -1, out_size, ws_size); grid = -1; return; }
        int dev = 0, cus = 0, per_cu = 0;
        if (hipGetDevice(&dev) != hipSuccess || hipDeviceGetAttribute(&cus, hipDeviceAttributeMultiprocessorCount, dev) != hipSuccess) { fprintf(stderr, "kernel_launch: device query failed\n"); grid = -1; return; }
        if (hipFuncSetAttribute((const void*)fwd_kernel, hipFuncAttributeMaxDynamicSharedMemorySize, LDS_BYTES) != hipSuccess) { fprintf(stderr, "kernel_launch: hipFuncSetAttribute failed\n"); grid = -1; return; }
        if (hipOccupancyMaxActiveBlocksPerMultiprocessor(&per_cu, (const void*)fwd_kernel, NWAVES * 64, LDS_BYTES) != hipSuccess || per_cu < 1)
            fprintf(stderr, "kernel_launch: note: occupancy query reports %d workgroups per CU\n", per_cu);
        (void)hipGetLastError();
        grid = cus;
    }
    if (grid < 0) return;
    if (hipMemsetAsync((char*)d_ws + WS_CTL, 0, CTL_ZERO_BYTES, stream) != hipSuccess) { fprintf(stderr, "kernel_launch: memset failed\n"); return; }
    Args a{};
    for (int i = 0; i < N_IN; ++i) a.in[i] = (const float*)d_in[i];
    a.out = (float*)d_out; a.ws = (unsigned char*)d_ws;
    for (int li = 0; li < N_LAUNCHES; ++li) {
        a.ph_lo = (N_LAUNCHES == 1) ? 0 : li; a.ph_hi = (N_LAUNCHES == 1) ? N_PHASES : li + 1;
        hipLaunchKernelGGL(fwd_kernel, dim3(grid), dim3(NWAVES * 64), LDS_BYTES, stream, a);
        const hipError_t le = hipPeekAtLastError();
        if (le != hipSuccess) { fprintf(stderr, "kernel_launch: launch %d failed: %s\n", li, hipGetErrorName(le)); break; }
    }
}
```

```cpp
#include <hip/hip_runtime.h>
#include <cstdio>
#include <cstdint>
namespace pg8 {
#define PG8_LAS __attribute__((address_space(3)))
typedef unsigned short bf16_t;
typedef short bf16x8 __attribute__((ext_vector_type(8)));
typedef float f32x4 __attribute__((ext_vector_type(4)));
typedef unsigned u32x4 __attribute__((ext_vector_type(4)));
constexpr int BM = 256, BK = 64, HALF = 128, HTB = HALF * BK * 2  , STAGE_BYTES = 8 * HTB, NXCD = 8, WGM = 8;

__host__ __device__ __forceinline__ int lds_byte(int r, int c) { const int st = (r >> 4) * 2 + (c >> 5), rr = r & 15, cc = c & 31, ob = rr * 64 + cc * 2; return st * 1024 + (ob ^ (((ob >> 9) & 1) << 5)); }
__host__ __device__ __forceinline__ void stage_rc(int b, int& R, int& C) { const int st = b / 1024, sb = b % 1024, swz = sb ^ (((sb >> 9) & 1) << 5); R = (st >> 1) * 16 + swz / 64; C = (st & 1) * 32 + (swz % 64) / 2; }
__host__ __device__ __forceinline__ int perm32(int rho) { const int n = rho >> 4, i = rho & 15; return 8 * (i >> 2) + 4 * n + (i & 3); }

struct Unit { int pm, pn; };
struct Gemm { const bf16_t* A; const bf16_t* Bt; int M, N, K; };

struct StaticOrder {
    int nM, nN, nwg, G, c;
    __host__ __device__ void init(int M, int N, int G_, int c_) { nM = M / BM; nN = N / BM; nwg = nM * nN; G = G_; c = c_; }
    __host__ __device__ bool next(int i, Unit& u) const {
        const long L = (long)i * G + c; if (L >= nwg) return false;
        int wgid = (int)L; { const int q = nwg / NXCD, r = nwg % NXCD, xcd = wgid % NXCD, off = wgid / NXCD; wgid = (xcd < r ? xcd * (q + 1) : r * (q + 1) + (xcd - r) * q) + off; }
        const int nig = WGM * nN, gid = wgid / nig, fm = gid * WGM, gsz = (nM - fm) < WGM ? (nM - fm) : WGM;
        u.pm = fm + ((wgid % nig) % gsz); u.pn = (wgid % nig) / gsz; return true;
    }
    __device__ __forceinline__ void a_ready(const Unit&) const {}
    __device__ __forceinline__ void done(const Unit&) const {}
};

__device__ __forceinline__ unsigned cvt_pk_bf16(float lo, float hi) { unsigned r; asm volatile("v_cvt_pk_bf16_f32 %0, %1, %2" : "=v"(r) : "v"(lo), "v"(hi)); return r; }
typedef float f32x2 __attribute__((ext_vector_type(2)));
typedef int i32x4 __attribute__((ext_vector_type(4)));
__device__ __forceinline__ void mma16(f32x4& c, const bf16x8 b, const bf16x8 a) { c = __builtin_amdgcn_mfma_f32_16x16x32_bf16(b, a, c, 0, 0, 0); }
__device__ __forceinline__ void mma16(i32x4& c, const bf16x8 b, const bf16x8 a) { c = __builtin_amdgcn_mfma_i32_16x16x64_i8(__builtin_bit_cast(i32x4, b), __builtin_bit_cast(i32x4, a), c, 0, 0, 0); }
typedef __bf16 bf16v2 __attribute__((ext_vector_type(2)));
__device__ __forceinline__ unsigned pkbf(float lo, float hi) { f32x2 v = {lo, hi}; bf16v2 r = __builtin_convertvector(v, bf16v2); return __builtin_bit_cast(unsigned, r); }

struct EpiIn {
    typedef f32x4 acc_t;
    static constexpr bool PERM = true, AFTER_DRAIN = false;
    bf16_t *Q, *Kd, *Vd, *Cd; const float* rope; float qscale;
    __device__ __forceinline__ void operator()(const f32x4 (&acc)[2][2][4][2], const Unit& u, int wr, int wc, int fr, int fq) const {
        const int reg = u.pn >> 3;
        if (reg == 3 || reg == 4) {
            const int row0 = u.pm * BM + wr * 64 + fr, col0 = (u.pn - 24) * HALF + wc * 32 + 8 * fq;
#pragma unroll
            for (int ai = 0; ai < 2; ++ai)
#pragma unroll
                for (int m = 0; m < 4; ++m) { bf16_t* rowp = Cd + (size_t)(row0 + ai * HALF + m * 16) * 4096 + col0;
                    const f32x4 p0 = acc[ai][0][m][0] * acc[ai][1][m][0], p1 = acc[ai][0][m][1] * acc[ai][1][m][1];
                    u32x4 w; w.x = pkbf(p0[0], p0[1]); w.y = pkbf(p0[2], p0[3]); w.z = pkbf(p1[0], p1[1]); w.w = pkbf(p1[2], p1[3]);
                    *(u32x4*)rowp = w; }
            return; }
        bf16_t* base; int ldc, colt; bool rot = false; float sc = 1.f;
        if (reg == 0) { base = Q; ldc = 2048; colt = u.pn * BM; rot = true; sc = qscale; }
        else if (reg == 1) { base = Kd; ldc = 2048; colt = (u.pn - 8) * BM; rot = (u.pm < 32); }
        else if (reg == 2) { base = Vd; ldc = 2048; colt = (u.pn - 16) * BM; }
        else { base = Cd; ldc = 4096; colt = 2048 + (u.pn - 40) * BM; }
        const int row0 = u.pm * BM + wr * 64 + fr, col0 = colt + wc * 32 + 8 * fq;
        const int blk = wc >> 1, i0 = 4 * ((4 * wc + fq) & 7);
        f32x4 cs[2], sn[2];
        cs[0] = (f32x4){1.f, 1.f, 1.f, 1.f}; sn[0] = (f32x4){0.f, 0.f, 0.f, 0.f}; cs[1] = cs[0]; sn[1] = sn[0];
        if (rot) { const int t = row0 & 2047, pos = blk ? (t & 63) : (t >> 6); cs[0] = *(const f32x4*)(rope + pos * 32 + i0); sn[0] = *(const f32x4*)(rope + 2048 + pos * 32 + i0); }
#pragma unroll
        for (int gi = 0; gi < 8; ++gi) { const int ai = gi >> 2, m = gi & 3; const int r = row0 + ai * HALF + m * 16; bf16_t* rowp = base + (size_t)r * ldc + col0;
            if (gi < 7 && rot) { const int rn = row0 + ((gi + 1) >> 2) * HALF + ((gi + 1) & 3) * 16, t = rn & 2047, pos = blk ? (t & 63) : (t >> 6);
                cs[(gi + 1) & 1] = *(const f32x4*)(rope + pos * 32 + i0); sn[(gi + 1) & 1] = *(const f32x4*)(rope + 2048 + pos * 32 + i0); }
            const f32x4 cs4 = cs[gi & 1], sn4 = sn[gi & 1];
#pragma unroll
            for (int bj = 0; bj < 2; ++bj) { const f32x4 a = acc[ai][bj][m][0], b = acc[ai][bj][m][1];
                const f32x4 v0 = (a * cs4 - b * sn4) * sc, v1 = (a * sn4 + b * cs4) * sc;
                u32x4 w; w.x = pkbf(v0[0], v0[1]); w.y = pkbf(v0[2], v0[3]); w.z = pkbf(v1[0], v1[1]); w.w = pkbf(v1[2], v1[3]);
                *(u32x4*)(rowp + bj * HALF) = w; }
            asm volatile("" ::: "memory"); }
    }
};
#ifndef EPI_NT_GATE
#define EPI_NT_GATE 0
#endif
#ifndef EPI_NT_ACT
#define EPI_NT_ACT 1
#endif
#ifndef EPI_NT_FX
#define EPI_NT_FX 0
#endif
#if EPI_NT_GATE
#define EPI_GATE_STORE(v, p) __builtin_nontemporal_store((v), (p))
#else
#define EPI_GATE_STORE(v, p) (*(p) = (v))
#endif
#if EPI_NT_ACT
#define EPI_ACT_STORE(v, p) __builtin_nontemporal_store((v), (p))
#else
#define EPI_ACT_STORE(v, p) (*(p) = (v))
#endif
template <bool ROWSCALE> struct EpiGate {
    typedef f32x4 acc_t;
    static constexpr bool PERM = true, AFTER_DRAIN = false;
    bf16_t* O; int ldc; const float* gate; const float* ssq;
    __device__ __forceinline__ void operator()(const f32x4 (&acc)[2][2][4][2], const Unit& u, int wr, int wc, int fr, int fq) const {
        const int row0 = u.pm * BM + wr * 64 + fr, col0 = u.pn * BM + wc * 32 + 8 * fq;
        const float* gp = gate + (size_t)(u.pm >> 3) * 24576 + col0;
        f32x4 gv[2][2];
#pragma unroll
        for (int bj = 0; bj < 2; ++bj)
#pragma unroll
            for (int n = 0; n < 2; ++n) gv[bj][n] = *(const f32x4*)(gp + bj * HALF + 4 * n);
        float rs[8];
#pragma unroll
        for (int gi = 0; gi < 8; ++gi) rs[gi] = ROWSCALE ? ssq[row0 + (gi >> 2) * HALF + (gi & 3) * 16] : 1.0f;
#pragma unroll
        for (int ai = 0; ai < 2; ++ai)
#pragma unroll
            for (int m = 0; m < 4; ++m) { bf16_t* rowp = O + (size_t)(row0 + ai * HALF + m * 16) * ldc + col0;
                const float rsc = ROWSCALE ? 1.0f / sqrtf(rs[ai * 4 + m] * (1.0f / 2048.0f) + 1e-6f) : 1.0f;
#pragma unroll
                for (int bj = 0; bj < 2; ++bj) { const f32x4 v0 = acc[ai][bj][m][0] * gv[bj][0] * rsc, v1 = acc[ai][bj][m][1] * gv[bj][1] * rsc;
                    u32x4 w; w.x = pkbf(v0[0], v0[1]); w.y = pkbf(v0[2], v0[3]); w.z = pkbf(v1[0], v1[1]); w.w = pkbf(v1[2], v1[3]);
                    EPI_GATE_STORE(w, (u32x4*)(rowp + bj * HALF)); } }
    }
};
struct EpiSwiglu {
    typedef f32x4 acc_t;
    static constexpr bool PERM = true, AFTER_DRAIN = false;
    bf16_t* O; int ldc;
    __device__ __forceinline__ void operator()(const f32x4 (&acc)[2][2][4][2], const Unit& u, int wr, int wc, int fr, int fq) const {
        const int row0 = u.pm * BM + wr * 64 + fr, col0 = u.pn * HALF + wc * 32 + 8 * fq;
#pragma unroll
        for (int ai = 0; ai < 2; ++ai)
#pragma unroll
            for (int m = 0; m < 4; ++m) { bf16_t* rowp = O + (size_t)(row0 + ai * HALF + m * 16) * ldc + col0;
                float o[8];
#pragma unroll
                for (int n = 0; n < 2; ++n)
#pragma unroll
                    for (int j = 0; j < 4; ++j) { const float gt = acc[ai][0][m][n][j], up = acc[ai][1][m][n][j];
                        o[4 * n + j] = gt * __builtin_amdgcn_rcpf(1.0f + __builtin_amdgcn_exp2f(-1.44269504089f * gt)) * up; }
                u32x4 w; w.x = pkbf(o[0], o[1]); w.y = pkbf(o[2], o[3]); w.z = pkbf(o[4], o[5]); w.w = pkbf(o[6], o[7]);
                EPI_ACT_STORE(w, (u32x4*)rowp); }
    }
};
__device__ __forceinline__ void had32(float (&o)[8], int fq) {
#pragma unroll
    for (int s = 1; s < 8; s <<= 1)
#pragma unroll
        for (int i = 0; i < 8; ++i) if (!(i & s)) { const float a = o[i], b = o[i ^ s]; o[i] = a + b; o[i ^ s] = a - b; }
#pragma unroll
    for (int i = 0; i < 8; ++i) { const unsigned x = __builtin_bit_cast(unsigned, o[i]); const auto r = __builtin_amdgcn_permlane16_swap(x, x, false, false);
        const float p = __builtin_bit_cast(float, (fq & 1) ? r[0] : r[1]); o[i] = (fq & 1) ? p - o[i] : o[i] + p; }
#pragma unroll
    for (int i = 0; i < 8; ++i) { const unsigned x = __builtin_bit_cast(unsigned, o[i]); const auto r = __builtin_amdgcn_permlane32_swap(x, x, false, false);
        const float p = __builtin_bit_cast(float, (fq & 2) ? r[0] : r[1]); o[i] = ((fq & 2) ? p - o[i] : o[i] + p) * 0.17677669529663687f; }
}
struct EpiSwigluI8 {
    typedef i32x4 acc_t;
    static constexpr bool PERM = true, AFTER_DRAIN = false;
    bf16_t* O; int ldc; const float* rs; const float* cs;
    __device__ __forceinline__ void operator()(const i32x4 (&acc)[2][2][4][2], const Unit& u, int wr, int wc, int fr, int fq) const {
        const int row0 = u.pm * BM + wr * 64 + fr, col0 = u.pn * HALF + wc * 32 + 8 * fq, gcol0 = u.pn * BM + wc * 32 + 8 * fq;
        f32x4 cg[2], cu[2];
#pragma unroll
        for (int n = 0; n < 2; ++n) { cg[n] = *(const f32x4*)(cs + gcol0 + 4 * n); cu[n] = *(const f32x4*)(cs + gcol0 + HALF + 4 * n); }
        float rsv[8];
#pragma unroll
        for (int gi = 0; gi < 8; ++gi) rsv[gi] = rs[row0 + (gi >> 2) * HALF + (gi & 3) * 16];
#pragma unroll
        for (int ai = 0; ai < 2; ++ai)
#pragma unroll
            for (int m = 0; m < 4; ++m) { bf16_t* rowp = O + (size_t)(row0 + ai * HALF + m * 16) * ldc + col0; const float r = rsv[ai * 4 + m];
                float o[8];
#pragma unroll
                for (int n = 0; n < 2; ++n)
#pragma unroll
                    for (int j = 0; j < 4; ++j) { const float gt = (float)acc[ai][0][m][n][j] * (r * cg[n][j]), up = (float)acc[ai][1][m][n][j] * (r * cu[n][j]);
                        o[4 * n + j] = gt * __builtin_amdgcn_rcpf(1.0f + __builtin_amdgcn_exp2f(-1.44269504089f * gt)) * up; }
                had32(o, fq);
                u32x4 w; w.x = pkbf(o[0], o[1]); w.y = pkbf(o[2], o[3]); w.z = pkbf(o[4], o[5]); w.w = pkbf(o[6], o[7]);
                EPI_ACT_STORE(w, (u32x4*)rowp); }
    }
};
struct EpiGateI8 {
    typedef i32x4 acc_t;
    static constexpr bool PERM = true, AFTER_DRAIN = false;
    bf16_t* O; int ldc; const float* gate; const float* rs; const unsigned* cmax;
    __device__ __forceinline__ void operator()(const i32x4 (&acc)[2][2][4][2], const Unit& u, int wr, int wc, int fr, int fq) const {
        const int row0 = u.pm * BM + wr * 64 + fr, col0 = u.pn * BM + wc * 32 + 8 * fq;
        const float* gp = gate + (size_t)(u.pm >> 3) * 24576 + col0;
        f32x4 gv[2][2];
#pragma unroll
        for (int bj = 0; bj < 2; ++bj)
#pragma unroll
            for (int n = 0; n < 2; ++n) { const f32x4 g = *(const f32x4*)(gp + bj * HALF + 4 * n); const f32x4 cm = *(const f32x4*)((const float*)cmax + 4096 + col0 + bj * HALF + 4 * n);
                gv[bj][n] = g * cm; }
        float rsv[8];
#pragma unroll
        for (int gi = 0; gi < 8; ++gi) rsv[gi] = rs[row0 + (gi >> 2) * HALF + (gi & 3) * 16];
#pragma unroll
        for (int ai = 0; ai < 2; ++ai)
#pragma unroll
            for (int m = 0; m < 4; ++m) { bf16_t* rowp = O + (size_t)(row0 + ai * HALF + m * 16) * ldc + col0; const float r = rsv[ai * 4 + m];
#pragma unroll
                for (int bj = 0; bj < 2; ++bj) { const i32x4 a0 = acc[ai][bj][m][0], a1 = acc[ai][bj][m][1];
                    const f32x4 v0 = (f32x4){(float)a0.x, (float)a0.y, (float)a0.z, (float)a0.w} * gv[bj][0] * r, v1 = (f32x4){(float)a1.x, (float)a1.y, (float)a1.z, (float)a1.w} * gv[bj][1] * r;
                    u32x4 w; w.x = pkbf(v0[0], v0[1]); w.y = pkbf(v0[2], v0[3]); w.z = pkbf(v1[0], v1[1]); w.w = pkbf(v1[2], v1[3]);
                    if (EPI_NT_FX) __builtin_nontemporal_store(w, (u32x4*)(rowp + bj * HALF)); else *(u32x4*)(rowp + bj * HALF) = w; } }
    }
};
struct InOrder {
    StaticOrder so; int G, c;
    __host__ __device__ void init(int G_, int c_) { so.init(8192, 12288, G_, c_); G = G_; c = c_; }
    __host__ __device__ bool next(int i, Unit& u) const {
        const long L = (long)i * G + c; if (L >= 1600) return false;
        if (L < 1536) return so.next(i, u);
        const int e = (int)L - 1536; u.pm = 32 + (e & 3); u.pn = 8 + (e >> 2); return true;
    }
    __device__ __forceinline__ void a_ready(const Unit&) const {}
    __device__ __forceinline__ void done(const Unit&) const {}
};
template <class Epi, class Sched, bool ALIGN_EPI = false, bool SP2 = false>
__device__ __forceinline__ void gemm_phase(PG8_LAS unsigned char* lds, const Gemm g, const Sched& S, const Epi& E) {
    const int tid = threadIdx.x, wid = __builtin_amdgcn_readfirstlane(tid >> 6), lane = tid & 63, wr = wid >> 2, wc = wid & 3, fr = lane & 15, fq = lane >> 4;
    const int K = g.K, nt = K / BK;
    unsigned voffA[2], voffB[2];
#pragma unroll
    for (int i = 0; i < 2; ++i) { int R, C; stage_rc(tid * 16 + i * 8192, R, C); const int Rb = Epi::PERM ? ((R & ~31) + perm32(R & 31)) : R;
        voffA[i] = (unsigned)(R * K + C) * 2u; voffB[i] = (unsigned)(Rb * K + C) * 2u; }
    const size_t kstep = (size_t)(BK * 2);
    const size_t hstep = (size_t)HALF * K * 2;
    const size_t tstep = 2 * hstep;
    const unsigned ldsw = (unsigned)wid * 1024u;
    const int aoff = lds_byte(wr * 64 + fr, fq * 8), boff = lds_byte(wc * 32 + fr, fq * 8);
#define PG8_SA(b, h) (((b) * 2 + (h)) * HTB)
#define PG8_SB(b, h) ((4 + (b) * 2 + (h)) * HTB)
#define PG8_STAGE(bufoff, gbase, voff) do { _Pragma("unroll") for (int _i = 0; _i < 2; ++_i) \
        __builtin_amdgcn_global_load_lds((const unsigned*)((const char*)(gbase) + (voff)[_i]), (PG8_LAS unsigned*)(lds + (bufoff) + ldsw + _i * 8192), 16, 0, 0); } while (0)
#define PG8_LDA(dst, b, h) do { _Pragma("unroll") for (int m = 0; m < 4; ++m) _Pragma("unroll") for (int k = 0; k < 2; ++k) dst[m][k] = *(const PG8_LAS bf16x8*)(lds + PG8_SA(b, h) + aoff + m * 2048 + k * 1024); } while (0)
#define PG8_LDB(dst, b, h) do { _Pragma("unroll") for (int n = 0; n < 2; ++n) _Pragma("unroll") for (int k = 0; k < 2; ++k) dst[n][k] = *(const PG8_LAS bf16x8*)(lds + PG8_SB(b, h) + boff + n * 2048 + k * 1024); } while (0)
#ifndef MMA_ORDER
#define MMA_ORDER 0
#endif
#if MMA_ORDER == 0
#define PG8_MMA(ai, bj, At, Bt) do { __builtin_amdgcn_s_setprio(1); _Pragma("unroll") for (int m = 0; m < 4; ++m) _Pragma("unroll") for (int n = 0; n < 2; ++n) _Pragma("unroll") for (int k = 0; k < 2; ++k) \
        mma16(acc[ai][bj][m][n], Bt[n][k], At[m][k]); __builtin_amdgcn_s_setprio(0); } while (0)
#elif MMA_ORDER == 1
#define PG8_MMA(ai, bj, At, Bt) do { __builtin_amdgcn_s_setprio(1); _Pragma("unroll") for (int k = 0; k < 2; ++k) _Pragma("unroll") for (int n = 0; n < 2; ++n) _Pragma("unroll") for (int m = 0; m < 4; ++m) \
        mma16(acc[ai][bj][m][n], Bt[n][k], At[m][k]); __builtin_amdgcn_s_setprio(0); } while (0)
#elif MMA_ORDER == 3
#define PG8_MMA(ai, bj, At, Bt) do { __builtin_amdgcn_s_setprio(1); _Pragma("unroll") for (int m = 0; m < 4; ++m) _Pragma("unroll") for (int nn = 0; nn < 2; ++nn) _Pragma("unroll") for (int kk = 0; kk < 2; ++kk) { \
        const int n = (m & 1) ? 1 - nn : nn, k = ((nn + (m & 1)) & 1) ? 1 - kk : kk; \
        mma16(acc[ai][bj][m][n], Bt[n][k], At[m][k]); } __builtin_amdgcn_s_setprio(0); } while (0)
#elif MMA_ORDER == 4
#define PG8_MMA(ai, bj, At, Bt) do { __builtin_amdgcn_s_setprio(1); _Pragma("unroll") for (int n = 0; n < 2; ++n) _Pragma("unroll") for (int m = 0; m < 4; ++m) _Pragma("unroll") for (int k = 0; k < 2; ++k) \
        mma16(acc[ai][bj][m][n], Bt[n][k], At[m][k]); __builtin_amdgcn_s_setprio(0); } while (0)
#elif MMA_ORDER == 5
#define PG8_MMA(ai, bj, At, Bt) do { __builtin_amdgcn_s_setprio(1); _Pragma("unroll") for (int m = 0; m < 4; ++m) _Pragma("unroll") for (int k = 0; k < 2; ++k) _Pragma("unroll") for (int n = 0; n < 2; ++n) \
        mma16(acc[ai][bj][m][n], Bt[n][k], At[m][k]); __builtin_amdgcn_s_setprio(0); } while (0)
#else
#define PG8_MMA(ai, bj, At, Bt) do { __builtin_amdgcn_s_setprio(1); _Pragma("unroll") for (int k = 0; k < 2; ++k) _Pragma("unroll") for (int m = 0; m < 4; ++m) _Pragma("unroll") for (int n = 0; n < 2; ++n) \
        mma16(acc[ai][bj][m][n], Bt[n][k], At[m][k]); __builtin_amdgcn_s_setprio(0); } while (0)
#endif
#define PG8_WAIT_V(n) asm volatile("s_waitcnt vmcnt(" #n ")" ::: "memory")
#define PG8_WAIT_L(n) asm volatile("s_waitcnt lgkmcnt(" #n ")" ::: "memory")
#define PG8_BAR __builtin_amdgcn_s_barrier()
#define PG8_SCHED __builtin_amdgcn_sched_barrier(0)
    Unit cur, nxt; int ui = 0;
    if (!S.next(0, cur)) return;
    typedef typename Epi::acc_t acc_t;
    acc_t acc[2][2][4][2];
#pragma unroll
    for (int a = 0; a < 2; ++a)
#pragma unroll
        for (int b = 0; b < 2; ++b)
#pragma unroll
            for (int m = 0; m < 4; ++m)
#pragma unroll
                for (int n = 0; n < 2; ++n) acc[a][b][m][n] = (acc_t){0, 0, 0, 0};
    bf16x8 At[4][2], B0[2][2], B1[2][2];
    const char* cA = (const char*)g.A + (size_t)cur.pm * tstep; const char* cB = (const char*)g.Bt + (size_t)cur.pn * tstep;
    S.a_ready(cur);
    if constexpr (SP2) {
        PG8_STAGE(PG8_SB(0, 0), cB, voffB); PG8_STAGE(PG8_SB(0, 1), cB + hstep, voffB); PG8_STAGE(PG8_SA(0, 0), cA, voffA); PG8_STAGE(PG8_SA(0, 1), cA + hstep, voffA);
        if (wr == 1) PG8_BAR;
        PG8_WAIT_V(2); PG8_BAR;
        PG8_STAGE(PG8_SB(1, 0), cB + kstep, voffB); PG8_STAGE(PG8_SA(1, 0), cA + kstep, voffA); PG8_STAGE(PG8_SB(1, 1), cB + hstep + kstep, voffB);
        PG8_WAIT_V(6); PG8_BAR;
    } else {
        PG8_STAGE(PG8_SB(0, 0), cB, voffB); PG8_STAGE(PG8_SA(0, 0), cA, voffA); PG8_STAGE(PG8_SB(0, 1), cB + hstep, voffB); PG8_STAGE(PG8_SA(0, 1), cA + hstep, voffA);
        if (wr == 1) PG8_BAR;
        PG8_WAIT_V(4); PG8_BAR;
        PG8_STAGE(PG8_SB(1, 0), cB + kstep, voffB); PG8_STAGE(PG8_SA(1, 0), cA + kstep, voffA); PG8_STAGE(PG8_SB(1, 1), cB + hstep + kstep, voffB);
        PG8_WAIT_V(6); PG8_BAR;
    }
    for (;;) {
        const bool has_next = S.next(ui + 1, nxt);
        const char* nA = has_next ? (const char*)g.A + (size_t)nxt.pm * tstep : cA; const char* nB = has_next ? (const char*)g.Bt + (size_t)nxt.pn * tstep : cB;
        for (int t = 0; t < nt; t += 2) {
            const bool last = (t == nt - 2);
            const char* a1 = cA + (size_t)(t + 1) * kstep;
            const char* a2 = last ? nA : cA + (size_t)(t + 2) * kstep; const char* b2 = last ? nB : cB + (size_t)(t + 2) * kstep;
            const char* a3 = a2 + kstep; const char* b3 = b2 + kstep;
            if (last && has_next) S.a_ready(nxt);
            if constexpr (SP2) {
            PG8_LDB(B0, 0, 0); PG8_LDB(B1, 0, 1); PG8_SCHED; PG8_LDA(At, 0, 0); PG8_STAGE(PG8_SA(1, 1), a1 + hstep, voffA);
            PG8_WAIT_V(8); PG8_WAIT_L(0); PG8_BAR; PG8_MMA(0, 0, At, B0); PG8_MMA(0, 1, At, B1); PG8_BAR; PG8_SCHED;
            PG8_LDA(At, 0, 1); PG8_STAGE(PG8_SB(0, 0), b2, voffB); PG8_STAGE(PG8_SB(0, 1), b2 + hstep, voffB); PG8_STAGE(PG8_SA(0, 0), a2, voffA);
            PG8_WAIT_V(8); PG8_WAIT_L(0); PG8_BAR; PG8_MMA(1, 0, At, B0); PG8_MMA(1, 1, At, B1); PG8_BAR; PG8_SCHED;
            PG8_LDB(B0, 1, 0); PG8_LDB(B1, 1, 1); PG8_SCHED; PG8_LDA(At, 1, 0); PG8_STAGE(PG8_SA(0, 1), a2 + hstep, voffA);
            PG8_WAIT_V(8); PG8_WAIT_L(0); PG8_BAR; PG8_MMA(0, 0, At, B0); PG8_MMA(0, 1, At, B1); PG8_BAR; PG8_SCHED;
            PG8_LDA(At, 1, 1); PG8_STAGE(PG8_SB(1, 0), b3, voffB); PG8_STAGE(PG8_SB(1, 1), b3 + hstep, voffB); PG8_STAGE(PG8_SA(1, 0), a3, voffA);
            PG8_WAIT_V(8); PG8_WAIT_L(0); PG8_BAR; PG8_MMA(1, 0, At, B0); PG8_MMA(1, 1, At, B1); PG8_BAR; PG8_SCHED;
            } else {
            PG8_LDB(B0, 0, 0); PG8_SCHED; PG8_LDA(At, 0, 0); PG8_STAGE(PG8_SA(1, 1), a1 + hstep, voffA);
            PG8_WAIT_L(8); PG8_BAR; PG8_WAIT_L(0); PG8_MMA(0, 0, At, B0); PG8_BAR; PG8_SCHED;
            PG8_LDB(B1, 0, 1); PG8_STAGE(PG8_SB(0, 0), b2, voffB);
            PG8_BAR; PG8_WAIT_L(0); PG8_MMA(0, 1, At, B1); PG8_BAR;
            PG8_LDA(At, 0, 1); PG8_STAGE(PG8_SA(0, 0), a2, voffA);
            PG8_BAR; PG8_WAIT_L(0); PG8_MMA(1, 0, At, B0); PG8_BAR; PG8_SCHED;
            PG8_STAGE(PG8_SB(0, 1), b2 + hstep, voffB);
            PG8_WAIT_V(6); PG8_BAR; PG8_MMA(1, 1, At, B1); PG8_BAR;
            PG8_LDB(B0, 1, 0); PG8_SCHED; PG8_LDA(At, 1, 0); PG8_STAGE(PG8_SA(0, 1), a2 + hstep, voffA);
            PG8_WAIT_L(8); PG8_BAR; PG8_WAIT_L(0); PG8_MMA(0, 0, At, B0); PG8_BAR; PG8_SCHED;
            PG8_LDB(B1, 1, 1); PG8_STAGE(PG8_SB(1, 0), b3, voffB);
            PG8_BAR; PG8_WAIT_L(0); PG8_MMA(0, 1, At, B1); PG8_BAR;
            PG8_LDA(At, 1, 1); PG8_STAGE(PG8_SA(1, 0), a3, voffA);
            PG8_BAR; PG8_WAIT_L(0); PG8_MMA(1, 0, At, B0); PG8_BAR; PG8_SCHED;
            PG8_STAGE(PG8_SB(1, 1), b3 + hstep, voffB);
            PG8_WAIT_V(6); PG8_BAR; PG8_MMA(1, 1, At, B1); PG8_BAR;
            }
        }
        if constexpr (ALIGN_EPI) { if (wr == 0) PG8_BAR; }
        if constexpr (!Epi::AFTER_DRAIN) { E(acc, cur, wr, wc, fr, fq); S.done(cur); }
        if (!has_next) break;
#pragma unroll
        for (int a = 0; a < 2; ++a)
#pragma unroll
            for (int b = 0; b < 2; ++b)
#pragma unroll
                for (int m = 0; m < 4; ++m)
#pragma unroll
                    for (int n = 0; n < 2; ++n) acc[a][b][m][n] = (acc_t){0, 0, 0, 0};
        cur = nxt; cA = nA; cB = nB; ++ui;
        if constexpr (ALIGN_EPI) { if (wr == 1) PG8_BAR; }
    }
    PG8_WAIT_V(0);
    if constexpr (!ALIGN_EPI) { if (wr == 0) PG8_BAR; }
    PG8_BAR;
    if constexpr (Epi::AFTER_DRAIN) { E.fused(acc, cur, wr, wc, fr, fq, lds, wid, lane); S.done(cur); }
#undef PG8_SA
#undef PG8_SB
#undef PG8_STAGE
#undef PG8_LDA
#undef PG8_LDB
#undef PG8_MMA
#undef PG8_WAIT_V
#undef PG8_WAIT_L
#undef PG8_BAR
#undef PG8_SCHED
}
}
#ifndef PG8_SP2
#define PG8_SP2 true
#endif
#ifndef PG8_ALIGN
#define PG8_ALIGN true
#endif
constexpr int NWAVES = 8;
#ifndef MK_N_LAUNCHES
#define MK_N_LAUNCHES 1
#endif
constexpr int N_PHASES = 11;
constexpr int N_LAUNCHES = MK_N_LAUNCHES;

constexpr int D = 4096, NB = 4, SEQ = 2048, M = NB * SEQ, CTXL = 256, MC = NB * CTXL, MT = M + MC;
constexpr int HD = 128, NAH = 16, NAW = 2048, CVW = 2048, INC = 12288, FF = 11008, NMODC = 6 * D;
constexpr int GRIDW = 64, ROWS = 32, NAKH = 8, NAKW = 16;
constexpr float EPS = 1e-6f, LOG2E = 1.44269504089f;
enum { I_X = 0, I_C, I_CTX, I_CCTX, I_ADAW, I_ADAB, I_N1G, I_WIN, I_CONVW, I_RPB, I_GNG, I_WOUT, I_N2G, I_WGU, I_WDN, I_FNG, N_IN };

constexpr size_t MiB = 1u << 20;
constexpr size_t WS_CTL = 0, WS_MOD = 1 * MiB, CTL_ZERO_BYTES = 2 * MiB;
constexpr size_t WS_SSQ = 1536 * 1024;
constexpr size_t WS_CMAXD = 1600 * 1024;
constexpr size_t WS_ROPE = 2 * MiB;
constexpr size_t WS_RSA = 2 * MiB + 256 * 1024;
constexpr size_t WS_RSH = 2 * MiB + 64 * 1024, WS_CSW = 2 * MiB + 128 * 1024;
constexpr size_t WS_WIN = 4 * MiB, WS_WOUT = 100 * MiB, WS_WGU = 132 * MiB, WS_WDN = 304 * MiB;
constexpr size_t WS_H = 390 * MiB;
constexpr size_t WS_Q = 462 * MiB;
constexpr size_t WS_K = 494 * MiB;
constexpr size_t WS_V = 530 * MiB;
constexpr size_t WS_C = 566 * MiB;
constexpr size_t WS_AO = 662 * MiB;
constexpr size_t WS_Y = 694 * MiB;
constexpr size_t WS_X1 = 758 * MiB;
constexpr size_t WS_ACT = 886 * MiB;
constexpr size_t WS_END = 1058 * MiB;
static_assert(WS_WIN + (size_t)INC * D * 2 <= WS_WOUT && WS_WOUT + (size_t)D * D * 2 <= WS_WGU && WS_WGU + (size_t)2 * FF * D * 2 <= WS_WDN && WS_WDN + (size_t)D * FF * 2 <= WS_H, "ws map (weights)");
static_assert(WS_H + (size_t)MT * D * 2 <= WS_Q && WS_Q + (size_t)M * NAW * 2 <= WS_K && WS_K + (size_t)MT * NAW * 2 <= WS_V && WS_V + (size_t)MT * NAW * 2 <= WS_C && WS_C + (size_t)M * 6144 * 2 <= WS_AO, "ws map (acts 1)");
static_assert(WS_AO + (size_t)M * NAW * 2 <= WS_Y && WS_Y + (size_t)M * D * 2 <= WS_X1 && WS_X1 + (size_t)M * D * 4 <= WS_ACT && WS_ACT + (size_t)M * FF * 2 <= WS_END, "ws map (acts 2)");
constexpr int CW_XRANK = 1024;
constexpr int CW_BAR = 4096;

#ifndef P0_DN_ITEMS
#define P0_DN_ITEMS 8192
#endif
#ifndef P0_OUT_ITEMS
#define P0_OUT_ITEMS 0
#endif
#ifndef DNQ_COOP
#define DNQ_COOP 1
#endif
#ifndef TAIL2_DN_ITEMS
#define TAIL2_DN_ITEMS 22016
#endif
#ifndef P0_GUQ_BLOCKS
#define P0_GUQ_BLOCKS 0
#endif
#ifndef P0_GU_ITEMS
#define P0_GU_ITEMS 0
#endif
constexpr int RING_OFF = 0, RING_BYTES = 131072;
constexpr int LDSCTL_OFF = RING_BYTES, MISC_OFF = LDSCTL_OFF + 320;
constexpr int LDS_BYTES = 147456;
static_assert(MISC_OFF + 128 <= LDS_BYTES, "LDS map");

#define GAS __attribute__((address_space(1)))
#define LAS __attribute__((address_space(3)))
typedef unsigned short bf16;
typedef unsigned v4u __attribute__((ext_vector_type(4)));
typedef float f32x4 __attribute__((ext_vector_type(4)));
typedef short bf16x8 __attribute__((ext_vector_type(8)));
typedef GAS unsigned gu32;
typedef GAS unsigned long long gu64;
#define RLX_AGENT __ATOMIC_RELAXED, __HIP_MEMORY_SCOPE_AGENT
#define LDS_WAIT() asm volatile("s_waitcnt lgkmcnt(0)" ::: "memory")
#define VM_WAIT() asm volatile("s_waitcnt vmcnt(0)" ::: "memory")
__device__ __forceinline__ unsigned long long rt() { return __builtin_amdgcn_s_memrealtime(); }
__device__ __forceinline__ unsigned f2bf(float f) { unsigned u = __builtin_bit_cast(unsigned, f); return (u + 0x7fffu + ((u >> 16) & 1u)) >> 16; }
__device__ __forceinline__ unsigned pk2(float lo, float hi) { return f2bf(lo) | (f2bf(hi) << 16); }

#define XB_TMO      128
#define XB_XCNT(j)  (256  + 64 * (j))
#define XB_XSUB(j)  (1280 + 64 * (j))
#define XB_XGEN(j)  (2304 + 64 * (j))
#define XB_TOP      3328
#define XB_TOPGEN   3392
#define XCD_BAR_WORDS 3456
#define XB_SPIN_CAP (1u << 18)

__device__ __forceinline__ unsigned xb_ld(unsigned* p)              { return __hip_atomic_load(p, __ATOMIC_RELAXED, __HIP_MEMORY_SCOPE_AGENT); }
__device__ __forceinline__ unsigned xb_add(unsigned* p, unsigned v) { return __hip_atomic_fetch_add(p, v, __ATOMIC_RELAXED, __HIP_MEMORY_SCOPE_AGENT); }
__device__ __forceinline__ unsigned xb_xcc_id() { return (unsigned)__builtin_amdgcn_s_getreg((3 << 11) | 20) & 0xFu; }
#define XB_SPIN(cond, bar) do { unsigned _sp = 0; while (cond) { __builtin_amdgcn_s_sleep(1); \
    if ((++_sp & 255u) == 0u) { if (xb_ld(&(bar)[XB_TMO])) break; if (_sp > XB_SPIN_CAP) { atomicAdd(&(bar)[XB_TMO], 1u); break; } } } } while (0)

struct XcdBarrier {
    unsigned* bar; unsigned x;
    volatile LAS unsigned* st;
};

__device__ __forceinline__ XcdBarrier xcd_barrier_post(unsigned* bar, volatile LAS unsigned* st) {
    XcdBarrier b; b.bar = bar; b.x = xb_xcc_id(); b.st = st;
    if (threadIdx.x == 0) (void)xb_add(&bar[XB_XCNT(b.x)], 1u);
    return b;
}
__device__ __forceinline__ void xcd_barrier_complete(unsigned* bar, unsigned x, unsigned& nloc, unsigned& nx) {
    const unsigned G = gridDim.x * gridDim.y * gridDim.z;
    unsigned sum, cnt, mine, sp = 0u;
    for (;;) {
        sum = 0u; cnt = 0u; mine = 0u;
#pragma unroll
        for (unsigned j = 0; j < 16; ++j) { const unsigned c = xb_ld(&bar[XB_XCNT(j)]); sum += c; cnt += (c > 0u) ? 1u : 0u; mine = (j == x) ? c : mine; }
        if (sum == G) break;
        __builtin_amdgcn_s_sleep(1);
        if ((++sp & 255u) == 0u) { if (xb_ld(&bar[XB_TMO])) break; if (sp > XB_SPIN_CAP) { atomicAdd(&bar[XB_TMO], 1u); break; } }
    }
    nloc = mine > 0u ? mine : 1u; nx = cnt > 0u ? cnt : 1u;
}

__device__ __forceinline__ void xcd_barrier(const XcdBarrier& b) {
    asm volatile("s_waitcnt vmcnt(0)" ::: "memory");
    __syncthreads();
    if (threadIdx.x == 0) {
        unsigned* bar = b.bar;
        __builtin_amdgcn_s_waitcnt(0);
        unsigned nloc = b.st[0], nx = b.st[1];
        if (nloc == 0u) { xcd_barrier_complete(bar, b.x, nloc, nx); b.st[0] = nloc; b.st[1] = nx; }
        const unsigned old = xb_add(&bar[XB_XSUB(b.x)], 1u);
        const unsigned gen = old / nloc;
        if (old + 1u == (gen + 1u) * nloc) {
            __builtin_amdgcn_fence(__ATOMIC_RELEASE, "agent");
            asm volatile("s_waitcnt vmcnt(0)" ::: "memory");
            const unsigned og = xb_add(&bar[XB_TOP], 1u);
            const unsigned tg = og / nx;
            if (og + 1u == (tg + 1u) * nx) xb_add(&bar[XB_TOPGEN], 1u);
            else XB_SPIN(xb_ld(&bar[XB_TOPGEN]) == tg, bar);
            __builtin_amdgcn_fence(__ATOMIC_ACQUIRE, "agent");
            xb_add(&bar[XB_XGEN(b.x)], 1u);
            asm volatile("s_waitcnt vmcnt(0)" ::: "memory");
        } else {
            XB_SPIN(xb_ld(&bar[XB_XGEN(b.x)]) == gen, bar);
            __builtin_amdgcn_fence(__ATOMIC_ACQUIRE, "agent");
            asm volatile("s_waitcnt vmcnt(0)" ::: "memory");
        }
    }
    __syncthreads();
}

typedef float f32x16 __attribute__((ext_vector_type(16)));
typedef unsigned v2u __attribute__((ext_vector_type(2)));
struct Frame {
    LAS unsigned char* lds;
    volatile LAS unsigned* MISC;
    gu32* ctl;
    int tid, lane, wave, vcu, G;
    const float* in[N_IN]; float* out;
    float* mod; float* rope;
    bf16 *Win_t, *Wout_t, *Wgu_t, *Wdn_t;
    bf16 *HB, *QB, *KB, *VB, *CB, *YB, *ACT, *MX, *FX; float* ssq; signed char *HQ, *Wgu_q, *ACTQ, *Wdn_q; float *rsH, *csW, *rsA; unsigned* cmaxD;
};
template <int CTRL> __device__ __forceinline__ float dpp_add(float v) { return v + __builtin_bit_cast(float, __builtin_amdgcn_update_dpp(0, __builtin_bit_cast(int, v), CTRL, 0xf, 0xf, true)); }
__device__ __forceinline__ float wave_sum(float v) {
    v = dpp_add<0xB1>(v); v = dpp_add<0x4E>(v); v = dpp_add<0x141>(v); v = dpp_add<0x140>(v);
    v += __builtin_bit_cast(float, __builtin_amdgcn_ds_swizzle(__builtin_bit_cast(int, v), 0x401F));
    return __builtin_bit_cast(float, __builtin_amdgcn_readlane(__builtin_bit_cast(int, v), 0)) + __builtin_bit_cast(float, __builtin_amdgcn_readlane(__builtin_bit_cast(int, v), 32));
}
template <int CTRL> __device__ __forceinline__ float dpp_max(float v) { return fmaxf(v, __builtin_bit_cast(float, __builtin_amdgcn_update_dpp(0, __builtin_bit_cast(int, v), CTRL, 0xf, 0xf, true))); }
__device__ __forceinline__ float wave_max(float v) {
    v = dpp_max<0xB1>(v); v = dpp_max<0x4E>(v); v = dpp_max<0x141>(v); v = dpp_max<0x140>(v);
    v = fmaxf(v, __builtin_bit_cast(float, __builtin_amdgcn_ds_swizzle(__builtin_bit_cast(int, v), 0x401F)));
    return fmaxf(__builtin_bit_cast(float, __builtin_amdgcn_readlane(__builtin_bit_cast(int, v), 0)), __builtin_bit_cast(float, __builtin_amdgcn_readlane(__builtin_bit_cast(int, v), 32)));
}
__device__ __forceinline__ unsigned pkbf(float lo, float hi) { return pg8::pkbf(lo, hi); }
__device__ __forceinline__ unsigned pkq4(float a, float b, float c, float d) {
    a = fminf(fmaxf(a, -127.f), 127.f); b = fminf(fmaxf(b, -127.f), 127.f); c = fminf(fmaxf(c, -127.f), 127.f); d = fminf(fmaxf(d, -127.f), 127.f);
    const int ia = (int)__builtin_rintf(a), ib = (int)__builtin_rintf(b), ic = (int)__builtin_rintf(c), id = (int)__builtin_rintf(d);
    return (unsigned)(ia & 0xff) | ((unsigned)(ib & 0xff) << 8) | ((unsigned)(ic & 0xff) << 16) | ((unsigned)id << 24);
}
__device__ __forceinline__ float bflo(unsigned w) { return __builtin_bit_cast(float, w << 16); }
__device__ __forceinline__ float bfhi(unsigned w) { return __builtin_bit_cast(float, w & 0xffff0000u); }

__device__ __forceinline__ int map_in(int n) {
    if (n < 4096) { const int hd = n & ~127, d = n & 127, blk = d >> 6, e4 = (d >> 5) & 1, i = d & 31; return hd + 64 * blk + 8 * (i >> 2) + 4 * e4 + (i & 3); }
    if (n < 6144) return n;
    const int kind = (n - 6144) >> 11, c = (n - 6144) & 2047;
    if (kind == 1) return 10240 + c;
    return 6144 + 256 * (c >> 7) + (kind == 2 ? 128 : 0) + (c & 127);
}
__device__ __forceinline__ int map_gu(int n) { const int up = n >= FF ? 1 : 0, jx = up ? n - FF : n; return 256 * (jx >> 7) + 128 * up + (jx & 127); }
#ifndef TR_NT
#define TR_NT 1
#endif
#ifndef TR_NT_ST
#define TR_NT_ST 1
#endif
#if TR_NT
#define TR_LOAD(p) __builtin_nontemporal_load(p)
#else
#define TR_LOAD(p) (*(p))
#endif
#if TR_NT_ST
#define TR_STORE(v, p) __builtin_nontemporal_store((v), (p))
#else
#define TR_STORE(v, p) (*(p) = (v))
#endif
#ifndef W_DROP_BITS
#define W_DROP_BITS 0
#endif
__device__ __forceinline__ unsigned pkw(float lo, float hi) {
#if W_DROP_BITS > 0
    constexpr unsigned SH = 16 + W_DROP_BITS, HALF_ = (1u << (SH - 1)) - 1u, MASK = ~((1u << SH) - 1u);
    unsigned a = __builtin_bit_cast(unsigned, lo), b = __builtin_bit_cast(unsigned, hi);
    a = (a + HALF_ + ((a >> SH) & 1u)) & MASK; b = (b + HALF_ + ((b >> SH) & 1u)) & MASK;
    return (a >> 16) | (b & 0xffff0000u);
#else
    return pkbf(lo, hi);
#endif
}
template <int MAP> __device__ __forceinline__ void transpose_items(const float* W, int K, int N, bf16* WT, LAS float* scr, int first, int stride, int end, int lane, const float* kscale = nullptr) {
    const int nblk = N / 32;
    const GAS float* Wl = (const GAS float*)W + (size_t)(lane >> 3) * N + 4 * (lane & 7);
    LAS float* sw = scr + (lane >> 3) * 33 + 4 * (lane & 7);
    const int c = lane & 7;
    f32x4 v[8];
    int it = first;
    if (it < end) { const GAS float* Wg = Wl + (size_t)(64 * (it / nblk)) * N + 32 * (it % nblk);
#pragma unroll
        for (int i = 0; i < 8; ++i) v[i] = TR_LOAD((const GAS f32x4*)(Wg + (size_t)(8 * i) * N)); }
    while (it < end) {
        const int k0 = 64 * (it / nblk), n0 = 32 * (it % nblk);
#pragma unroll
        for (int i = 0; i < 8; ++i) { sw[(8 * i) * 33 + 0] = v[i].x; sw[(8 * i) * 33 + 1] = v[i].y; sw[(8 * i) * 33 + 2] = v[i].z; sw[(8 * i) * 33 + 3] = v[i].w; }
        const int nx = it + stride;
        if (nx < end) { const GAS float* Wg = Wl + (size_t)(64 * (nx / nblk)) * N + 32 * (nx % nblk);
#pragma unroll
            for (int i = 0; i < 8; ++i) v[i] = TR_LOAD((const GAS f32x4*)(Wg + (size_t)(8 * i) * N)); }
        LDS_WAIT(); asm volatile("" ::: "memory");
#pragma unroll
        for (int j = 0; j < 4; ++j) { const int n = (lane >> 3) + 8 * j; const LAS float* s = scr + (8 * c) * 33 + n;
            v4u o;
            if (MAP == 3) { const f32x4 g0 = *(const GAS f32x4*)(kscale + k0 + 8 * c), g1 = *(const GAS f32x4*)(kscale + k0 + 8 * c + 4);
                o.x = pkw(s[0 * 33] * g0.x, s[1 * 33] * g0.y); o.y = pkw(s[2 * 33] * g0.z, s[3 * 33] * g0.w); o.z = pkw(s[4 * 33] * g1.x, s[5 * 33] * g1.y); o.w = pkw(s[6 * 33] * g1.z, s[7 * 33] * g1.w); }
            else if (MAP == 6 || MAP == 7 || MAP == 8) { float t[8];
#pragma unroll
                for (int e = 0; e < 8; ++e) t[e] = s[e * 33];
#pragma unroll
                for (int st = 1; st < 8; st <<= 1)
#pragma unroll
                    for (int e = 0; e < 8; ++e) if (!(e & st)) { const float a = t[e], b = t[e ^ st]; t[e] = a + b; t[e ^ st] = a - b; }
#pragma unroll
                for (int e = 0; e < 8; ++e) { const float p = __builtin_bit_cast(float, __builtin_amdgcn_update_dpp(0, __builtin_bit_cast(int, t[e]), 0xB1, 0xf, 0xf, true)); t[e] = (c & 1) ? p - t[e] : t[e] + p; }
#pragma unroll
                for (int e = 0; e < 8; ++e) { const float p = __builtin_bit_cast(float, __builtin_amdgcn_update_dpp(0, __builtin_bit_cast(int, t[e]), 0x4E, 0xf, 0xf, true)); t[e] = ((c & 2) ? p - t[e] : t[e] + p) * 0.17677669529663687f; }
                if (MAP == 7) {
                    float a = 0.f;
#pragma unroll
                    for (int e = 0; e < 8; ++e) a = fmaxf(a, fabsf(t[e]));
                    a = dpp_max<0xB1>(a); a = dpp_max<0x4E>(a); a = dpp_max<0x141>(a);
                    if (c == 0) atomicMax((unsigned*)kscale + (n0 + n), __builtin_bit_cast(unsigned, a));
                    continue; }
                if (MAP == 8) {
                    const float am = __builtin_bit_cast(float, __hip_atomic_load((const GAS unsigned*)kscale + (n0 + n), __ATOMIC_RELAXED, __HIP_MEMORY_SCOPE_AGENT)), q = am > 0.f ? 127.0f / am : 0.f;
                    if (c == 0 && k0 == 0) ((GAS float*)kscale)[4096 + n0 + n] = am * (1.0f / 127.0f);
#if defined(FAKEQ_DN)
                    { const float dq = am * (1.0f / 127.0f);
#pragma unroll
                      for (int e = 0; e < 8; ++e) t[e] = __builtin_rintf(fminf(fmaxf(t[e] * q, -127.f), 127.f)) * dq;
                      o.x = pkw(t[0], t[1]); o.y = pkw(t[2], t[3]); o.z = pkw(t[4], t[5]); o.w = pkw(t[6], t[7]);
                      TR_STORE(o, (GAS v4u*)(WT + (size_t)(n0 + n) * K + k0 + 8 * c)); continue; }
#endif
                    v2u o8; o8.x = pkq4(t[0] * q, t[1] * q, t[2] * q, t[3] * q); o8.y = pkq4(t[4] * q, t[5] * q, t[6] * q, t[7] * q);
                    __builtin_nontemporal_store(o8, (GAS v2u*)((signed char*)WT + (size_t)(n0 + n) * K + k0 + 8 * c));
                    continue; }
                o.x = pkw(t[0], t[1]); o.y = pkw(t[2], t[3]); o.z = pkw(t[4], t[5]); o.w = pkw(t[6], t[7]); }
            else { o.x = pkw(s[0 * 33], s[1 * 33]); o.y = pkw(s[2 * 33], s[3 * 33]); o.z = pkw(s[4 * 33], s[5 * 33]); o.w = pkw(s[6 * 33], s[7 * 33]); }
            const int nsrc = n0 + n, nd = MAP == 1 ? map_in(nsrc) : (MAP == 2 ? map_gu(nsrc) : nsrc);
            TR_STORE(o, (GAS v4u*)(WT + (size_t)nd * K + k0 + 8 * c)); }
        LDS_WAIT(); asm volatile("" ::: "memory");
        it = nx;
    }
}
constexpr int IT_IN = (D / 64) * (INC / 32), IT_OUT = (D / 64) * (D / 32), IT_GU = (D / 64) * (2 * FF / 32), IT_DN = (FF / 64) * (D / 32);
__device__ __forceinline__ void quant_gu_block(Frame& F, int nb) {
    const int lane = F.lane, N = 2 * FF, nblk = N / 32, n0 = 32 * nb, K = D;
    LAS float* scr = (LAS float*)(F.lds + RING_OFF + F.wave * 16384);
    LAS float* red = (LAS float*)(F.lds + RING_OFF + 12288);
    const GAS float* Wl = (const GAS float*)F.in[I_WGU] + (size_t)(lane >> 3) * N + n0 + 4 * (lane & 7);
    f32x4 m4 = {0.f, 0.f, 0.f, 0.f};
    for (int kb = F.wave; kb < 64; kb += 8) { const GAS float* Wg = Wl + (size_t)(64 * kb) * N;
#pragma unroll
        for (int i = 0; i < 8; ++i) { const f32x4 v = *(const GAS f32x4*)(Wg + (size_t)(8 * i) * N);
            m4.x = fmaxf(m4.x, fabsf(v.x)); m4.y = fmaxf(m4.y, fabsf(v.y)); m4.z = fmaxf(m4.z, fabsf(v.z)); m4.w = fmaxf(m4.w, fabsf(v.w)); } }
#pragma unroll
    for (int o = 8; o < 64; o <<= 1) { m4.x = fmaxf(m4.x, __shfl_xor(m4.x, o)); m4.y = fmaxf(m4.y, __shfl_xor(m4.y, o)); m4.z = fmaxf(m4.z, __shfl_xor(m4.z, o)); m4.w = fmaxf(m4.w, __shfl_xor(m4.w, o)); }
    if (lane < 8) *(LAS f32x4*)(red + F.wave * 32 + 4 * lane) = m4;
    __syncthreads();
    float qinv[4];
#pragma unroll
    for (int j = 0; j < 4; ++j) { const int n = (lane >> 3) + 8 * j; float a = 0.f;
#pragma unroll
        for (int w = 0; w < 8; ++w) a = fmaxf(a, red[w * 32 + n]);
        qinv[j] = a > 0.f ? 127.0f / a : 0.f;
        if (F.wave == 0 && (lane & 7) == 0) F.csW[map_gu(n0 + n)] = a * (1.0f / 127.0f); }
    LAS float* sw = scr + (lane >> 3) * 33 + 4 * (lane & 7);
    const int c = lane & 7;
    f32x4 v[8];
    int kb = F.wave;
    { const GAS float* Wg = Wl + (size_t)(64 * kb) * N;
#pragma unroll
      for (int i = 0; i < 8; ++i) v[i] = *(const GAS f32x4*)(Wg + (size_t)(8 * i) * N); }
    while (kb < 64) {
        const int k0 = 64 * kb;
#pragma unroll
        for (int i = 0; i < 8; ++i) { sw[(8 * i) * 33 + 0] = v[i].x; sw[(8 * i) * 33 + 1] = v[i].y; sw[(8 * i) * 33 + 2] = v[i].z; sw[(8 * i) * 33 + 3] = v[i].w; }
        const int nx = kb + 8;
        if (nx < 64) { const GAS float* Wg = Wl + (size_t)(64 * nx) * N;
#pragma unroll
            for (int i = 0; i < 8; ++i) v[i] = *(const GAS f32x4*)(Wg + (size_t)(8 * i) * N); }
        LDS_WAIT(); asm volatile("" ::: "memory");
#pragma unroll
        for (int j = 0; j < 4; ++j) { const int n = (lane >> 3) + 8 * j; const LAS float* s = scr + (8 * c) * 33 + n; const float q = qinv[j];
            v2u o; o.x = pkq4(s[0 * 33] * q, s[1 * 33] * q, s[2 * 33] * q, s[3 * 33] * q); o.y = pkq4(s[4 * 33] * q, s[5 * 33] * q, s[6 * 33] * q, s[7 * 33] * q);
            __builtin_nontemporal_store(o, (GAS v2u*)(F.Wgu_q + (size_t)map_gu(n0 + n) * K + k0 + 8 * c)); }
        LDS_WAIT(); asm volatile("" ::: "memory");
        kb = nx;
    }
    __syncthreads();
}
#define QDN_LOAD(KB) do { const GAS float* Wg_ = Wl + (size_t)(64 * (KB)) * N; _Pragma("unroll") for (int i = 0; i < 8; ++i) v[i] = *(const GAS f32x4*)(Wg_ + (size_t)(8 * i) * N); } while (0)
#define QDN_TILE() do { _Pragma("unroll") for (int i = 0; i < 8; ++i) { sw[(8 * i) * 33 + 0] = v[i].x; sw[(8 * i) * 33 + 1] = v[i].y; sw[(8 * i) * 33 + 2] = v[i].z; sw[(8 * i) * 33 + 3] = v[i].w; } } while (0)
#define QDN_ROT(J) float t[8]; { const LAS float* s_ = scr + (8 * c) * 33 + (lane >> 3) + 8 * (J); \
        _Pragma("unroll") for (int e = 0; e < 8; ++e) t[e] = s_[e * 33]; \
        _Pragma("unroll") for (int st = 1; st < 8; st <<= 1) _Pragma("unroll") for (int e = 0; e < 8; ++e) if (!(e & st)) { const float a_ = t[e], b_ = t[e ^ st]; t[e] = a_ + b_; t[e ^ st] = a_ - b_; } \
        _Pragma("unroll") for (int e = 0; e < 8; ++e) { const float p_ = __builtin_bit_cast(float, __builtin_amdgcn_update_dpp(0, __builtin_bit_cast(int, t[e]), 0xB1, 0xf, 0xf, true)); t[e] = (c & 1) ? p_ - t[e] : t[e] + p_; } \
        _Pragma("unroll") for (int e = 0; e < 8; ++e) { const float p_ = __builtin_bit_cast(float, __builtin_amdgcn_update_dpp(0, __builtin_bit_cast(int, t[e]), 0x4E, 0xf, 0xf, true)); t[e] = ((c & 2) ? p_ - t[e] : t[e] + p_) * 0.17677669529663687f; } }
__device__ __forceinline__ void quant_dn_block(Frame& F, int nb) {
    const int lane = F.lane, N = D, K = FF, NKB = FF / 64, n0 = 32 * nb, c = lane & 7;
    LAS float* scr = (LAS float*)(F.lds + RING_OFF + F.wave * 16384);
    LAS float* red = (LAS float*)(F.lds + RING_OFF + 12288);
    LAS float* sw = scr + (lane >> 3) * 33 + 4 * (lane & 7);
    const GAS float* Wl = (const GAS float*)F.in[I_WDN] + (size_t)(lane >> 3) * N + n0 + 4 * (lane & 7);
    f32x4 v[8];
    float mx[4] = {0.f, 0.f, 0.f, 0.f};
    { int kb = F.wave; QDN_LOAD(kb);
      while (kb < NKB) { QDN_TILE(); const int nx = kb + 8; if (nx < NKB) QDN_LOAD(nx);
          LDS_WAIT(); asm volatile("" ::: "memory");
#pragma unroll
          for (int j = 0; j < 4; ++j) { QDN_ROT(j);
#pragma unroll
              for (int e = 0; e < 8; ++e) mx[j] = fmaxf(mx[j], fabsf(t[e])); }
          LDS_WAIT(); asm volatile("" ::: "memory"); kb = nx; } }
#pragma unroll
    for (int j = 0; j < 4; ++j) { float a = mx[j]; a = dpp_max<0xB1>(a); a = dpp_max<0x4E>(a); a = dpp_max<0x141>(a); if (c == 0) red[F.wave * 32 + (lane >> 3) + 8 * j] = a; }
    __syncthreads();
    float qinv[4];
#pragma unroll
    for (int j = 0; j < 4; ++j) { const int n = (lane >> 3) + 8 * j; float a = 0.f;
#pragma unroll
        for (int w = 0; w < 8; ++w) a = fmaxf(a, red[w * 32 + n]);
        qinv[j] = a > 0.f ? 127.0f / a : 0.f;
        if (F.wave == 0 && c == 0) ((float*)F.cmaxD)[4096 + n0 + n] = a * (1.0f / 127.0f); }
    { int kb = F.wave; QDN_LOAD(kb);
      while (kb < NKB) { const int k0 = 64 * kb; QDN_TILE(); const int nx = kb + 8; if (nx < NKB) QDN_LOAD(nx);
          LDS_WAIT(); asm volatile("" ::: "memory");
#pragma unroll
          for (int j = 0; j < 4; ++j) { QDN_ROT(j); const float q = qinv[j];
              v2u o8; o8.x = pkq4(t[0] * q, t[1] * q, t[2] * q, t[3] * q); o8.y = pkq4(t[4] * q, t[5] * q, t[6] * q, t[7] * q);
              __builtin_nontemporal_store(o8, (GAS v2u*)(F.Wdn_q + (size_t)(n0 + (lane >> 3) + 8 * j) * K + k0 + 8 * c)); }
          LDS_WAIT(); asm volatile("" ::: "memory"); kb = nx; } }
    __syncthreads();
}
#undef QDN_LOAD
#undef QDN_TILE
#undef QDN_ROT
__device__ __forceinline__ void p0_prologue(Frame& F, const float amul) {
    { const int gi = blockIdx.x * (NWAVES * 64) + F.tid;
      if (gi < 2048) { const int pos = gi >> 5, i = gi & 31; const float fr = exp2f(-(float)i * (13.287712379549449f / 32.0f)); const float ang = (float)pos * fr;
          F.rope[gi] = cosf(ang); F.rope[2048 + gi] = sinf(ang); } }
    { LAS float* sil = (LAS float*)(F.lds + RING_OFF);
      LAS float* red = (LAS float*)(F.lds + RING_OFF + 16384);
      const GAS float* aw = (const GAS float*)F.in[I_ADAW];
      for (int it = blockIdx.x; it < 768; it += F.G) {
          const int cs = it % 96, ks = it / 96, k0 = 512 * ks;
          for (int idx = F.tid; idx < 5 * 512; idx += NWAVES * 64) { const int bb = idx >> 9, kk = idx & 511;
              const float v = bb < 4 ? F.in[I_C][bb * D + k0 + kk] : F.in[I_CCTX][k0 + kk]; sil[idx] = v / (1.0f + __expf(-v)); }
          __syncthreads();
          f32x4 a0 = {0.f, 0.f, 0.f, 0.f}, a1 = a0, a2 = a0, a3 = a0, a4 = a0;
          const GAS float* wp = aw + (size_t)(k0 + F.wave) * NMODC + 256 * cs + 4 * F.lane;
#pragma unroll 8
          for (int i = 0; i < 64; ++i) { const f32x4 w = __builtin_nontemporal_load((const GAS f32x4*)(wp + (size_t)(8 * i) * NMODC)); const int k = F.wave + 8 * i;
              a0 += sil[k] * w; a1 += sil[512 + k] * w; a2 += sil[1024 + k] * w; a3 += sil[1536 + k] * w; a4 += sil[2048 + k] * w; }
          LAS f32x4* rw = (LAS f32x4*)(red + F.wave * 1280) + F.lane;
          rw[0] = a0; rw[64] = a1; rw[128] = a2; rw[192] = a3; rw[256] = a4;
          __syncthreads();
          for (int idx = F.tid; idx < 1280; idx += NWAVES * 64) { float s = 0.f;
#pragma unroll
              for (int w = 0; w < 8; ++w) s += red[w * 1280 + idx];
              const int bb = idx >> 8, cc = idx & 255, n = 256 * cs + cc;
              if (ks == 0) s += F.in[I_ADAB][n];
              atomicAdd(F.mod + bb * NMODC + n, s * amul); }
          __syncthreads();
      } }
    LAS float* scr = (LAS float*)(F.lds + RING_OFF + F.wave * 16384);
    const int gw = F.vcu * NWAVES + F.wave, NGW = F.G * NWAVES;
    transpose_items<1>(F.in[I_WIN], D, INC, F.Win_t, scr, gw, NGW, IT_IN, F.lane);
#if !DNQ_COOP
    transpose_items<7>(F.in[I_WDN], FF, D, F.Wdn_t, scr, gw, NGW, IT_DN, F.lane, (const float*)F.cmaxD);
#endif
    transpose_items<3>(F.in[I_WOUT], D, D, F.Wout_t, scr, gw, NGW, P0_OUT_ITEMS, F.lane, F.in[I_GNG]);
    if (P0_GUQ_BLOCKS > 0) { __syncthreads(); for (int nb = (int)blockIdx.x; nb < P0_GUQ_BLOCKS; nb += F.G) quant_gu_block(F, nb); }
}

__device__ __forceinline__ void norm_mod_row(const float* xrow, bf16* orow, const float* gain, const float* shift, const float* scale, int lane) {
    const GAS f32x4* xr = (const GAS f32x4*)xrow + lane;
    f32x4 v[16]; float ss = 0.f;
#pragma unroll
    for (int j = 0; j < 16; ++j) { v[j] = __builtin_nontemporal_load(xr + 64 * j); ss += (v[j].x * v[j].x + v[j].y * v[j].y) + (v[j].z * v[j].z + v[j].w * v[j].w); }
    const float rstd = 1.0f / sqrtf(wave_sum(ss) * (1.0f / D) + EPS);
    const GAS f32x4* g4 = (const GAS f32x4*)gain + lane; const GAS f32x4* sh4 = (const GAS f32x4*)shift + lane; const GAS f32x4* sc4 = (const GAS f32x4*)scale + lane;
    GAS v2u* o8 = (GAS v2u*)orow + lane;
#pragma unroll
    for (int j = 0; j < 16; ++j) { const f32x4 g = g4[64 * j], sh = sh4[64 * j], sc = sc4[64 * j];
        const f32x4 y = v[j] * rstd * g * (1.0f + sc) + sh; v2u w; w.x = pkbf(y.x, y.y); w.y = pkbf(y.z, y.w); o8[64 * j] = w; }
}

__device__ __forceinline__ void norm_mod_row_x1(const float* xrow, const bf16* mrow, bf16* orow, const float* gain, const float* shift, const float* scale, int lane) {
    const GAS f32x4* xr = (const GAS f32x4*)xrow + lane; const GAS v2u* mr = (const GAS v2u*)mrow + lane;
    f32x4 v[16]; float ss = 0.f;
#pragma unroll
    for (int j = 0; j < 16; ++j) { const f32x4 x = __builtin_nontemporal_load(xr + 64 * j); const v2u m = __builtin_nontemporal_load(mr + 64 * j);
        v[j] = (f32x4){x.x + bflo(m.x), x.y + bfhi(m.x), x.z + bflo(m.y), x.w + bfhi(m.y)};
        ss += (v[j].x * v[j].x + v[j].y * v[j].y) + (v[j].z * v[j].z + v[j].w * v[j].w); }
    const float rstd = 1.0f / sqrtf(wave_sum(ss) * (1.0f / D) + EPS);
    const GAS f32x4* g4 = (const GAS f32x4*)gain + lane; const GAS f32x4* sh4 = (const GAS f32x4*)shift + lane; const GAS f32x4* sc4 = (const GAS f32x4*)scale + lane;
    GAS v2u* o8 = (GAS v2u*)orow + lane;
#pragma unroll
    for (int j = 0; j < 16; ++j) { const f32x4 g = g4[64 * j], sh = sh4[64 * j], sc = sc4[64 * j];
        const f32x4 y = v[j] * rstd * g * (1.0f + sc) + sh; v2u w; w.x = pkbf(y.x, y.y); w.y = pkbf(y.z, y.w); o8[64 * j] = w; }
}

__device__ __forceinline__ void norm_mod_row_x1_q8(const float* xrow, const bf16* mrow, signed char* orow, float* rs_out, const float* gain, const float* shift, const float* scale, int lane) {
    const GAS f32x4* xr = (const GAS f32x4*)xrow + lane; const GAS v2u* mr = (const GAS v2u*)mrow + lane;
    f32x4 v[16]; float ss = 0.f;
#pragma unroll
    for (int j = 0; j < 16; ++j) { const f32x4 x = __builtin_nontemporal_load(xr + 64 * j); const v2u m = __builtin_nontemporal_load(mr + 64 * j);
        v[j] = (f32x4){x.x + bflo(m.x), x.y + bfhi(m.x), x.z + bflo(m.y), x.w + bfhi(m.y)};
        ss += (v[j].x * v[j].x + v[j].y * v[j].y) + (v[j].z * v[j].z + v[j].w * v[j].w); }
    const float rstd = 1.0f / sqrtf(wave_sum(ss) * (1.0f / D) + EPS);
    const GAS f32x4* g4 = (const GAS f32x4*)gain + lane; const GAS f32x4* sh4 = (const GAS f32x4*)shift + lane; const GAS f32x4* sc4 = (const GAS f32x4*)scale + lane;
    float am = 0.f;
#pragma unroll
    for (int j = 0; j < 16; ++j) { const f32x4 g = g4[64 * j], sh = sh4[64 * j], sc = sc4[64 * j];
        v[j] = v[j] * rstd * g * (1.0f + sc) + sh; am = fmaxf(fmaxf(am, fmaxf(fabsf(v[j].x), fabsf(v[j].y))), fmaxf(fabsf(v[j].z), fabsf(v[j].w))); }
    am = wave_max(am);
    const float qi = am > 0.f ? 127.0f / am : 0.f;
    GAS unsigned* o4 = (GAS unsigned*)orow + lane;
#pragma unroll
    for (int j = 0; j < 16; ++j) o4[64 * j] = pkq4(v[j].x * qi, v[j].y * qi, v[j].z * qi, v[j].w * qi);
    if (lane == 0) *rs_out = am * (1.0f / 127.0f);
}

__device__ __forceinline__ void quant_act_row(const bf16* arow, signed char* orow, float* rs_out, int lane) {
    const GAS v2u* ar = (const GAS v2u*)arow + lane;
    v2u a[43]; float am = 0.f;
#pragma unroll
    for (int q = 0; q < 43; ++q) { a[q] = __builtin_nontemporal_load(ar + 64 * q);
        am = fmaxf(fmaxf(am, fmaxf(fabsf(bflo(a[q].x)), fabsf(bfhi(a[q].x)))), fmaxf(fabsf(bflo(a[q].y)), fabsf(bfhi(a[q].y)))); }
    am = wave_max(am);
    const float qi = am > 0.f ? 127.0f / am : 0.f;
#if defined(FAKEQ_DN)
    { const float dq = am * (1.0f / 127.0f); GAS v2u* ob = (GAS v2u*)arow + lane;
#pragma unroll
      for (int q = 0; q < 43; ++q) { v2u w; w.x = pkbf(__builtin_rintf(bflo(a[q].x) * qi) * dq, __builtin_rintf(bfhi(a[q].x) * qi) * dq); w.y = pkbf(__builtin_rintf(bflo(a[q].y) * qi) * dq, __builtin_rintf(bfhi(a[q].y) * qi) * dq); ob[64 * q] = w; } }
#endif
    GAS unsigned* o4 = (GAS unsigned*)orow + lane;
#pragma unroll
    for (int q = 0; q < 43; ++q) o4[64 * q] = pkq4(bflo(a[q].x) * qi, bfhi(a[q].x) * qi, bflo(a[q].y) * qi, bfhi(a[q].y) * qi);
    if (lane == 0) *rs_out = am * (1.0f / 127.0f);
}


#define MFMA32(a, b, c) __builtin_amdgcn_mfma_f32_32x32x16_bf16((a), (b), (c), 0, 0, 0)
constexpr int A_NST = 6, A_STAGE = 16384, A_RING = 32768;
typedef short s16x4 __attribute__((ext_vector_type(4)));
__device__ __forceinline__ void attn_wg_unit(Frame& F, const LAS float* rp, int b, int h, int R0) {
    const int lane = F.lane, w = F.wave, j = lane & 31, g = lane >> 5;
    const int r = R0 + (w >> 1), qblk = w & 1;
    const int rs = min(max(r - NAKH / 2, 0), ROWS - NAKH);
    const int KR0 = min(max(R0 - NAKH / 2, 0), ROWS - NAKH), KR1 = min(max(R0 + 3 - NAKH / 2, 0), ROWS - NAKH) + NAKH - 1;
    const int NT = 8 + 2 * (KR1 - KR0 + 1);
    const int qc = 32 * qblk + j, cs = min(max(qc - NAKW / 2, 0), GRIDW - NAKW);
    const int bias_lane = (h * 15 + rs - r + NAKH - 1) * 31 + 8 * g - qc + NAKW - 1;
    const int mask_lane = 8 * g - cs;
    const unsigned drow = 4u * w + (lane >> 4), dsw = ((drow & 3u) << 2) | ((drow >> 2) & 3u);
    const unsigned dma_off = (drow * NAW + 8u * ((lane & 15u) ^ dsw)) * 2u;
    const char* kbase = (const char*)(F.KB + HD * h); const char* vbase = (const char*)(F.VB + HD * h);
    LAS unsigned char* ring = F.lds + RING_OFF + A_RING;
#define KEYBASE(T) ((T) >= 8 ? (b * SEQ + (KR0 + (((T) - 8) >> 1)) * GRIDW + 32 * (((T) - 8) & 1)) : (M + b * CTXL + 32 * (T)))
#define DMA(T, ST) do { const size_t go_ = (size_t)KEYBASE(T) * (NAW * 2) + dma_off; \
        __builtin_amdgcn_global_load_lds((const unsigned*)(kbase + go_), (LAS unsigned*)(ring + (ST) * A_STAGE + w * 1024), 16, 0, 0); \
        __builtin_amdgcn_global_load_lds((const unsigned*)(vbase + go_), (LAS unsigned*)(ring + (ST) * A_STAGE + 8192 + w * 1024), 16, 0, 0); } while (0)
    const unsigned kap = (j & 19) | ((j & 4) << 1) | ((j & 8) >> 1), ksw = ((kap & 3u) << 2) | ((kap >> 2) & 3u);
    unsigned ka[8];
#pragma unroll
    for (int kd = 0; kd < 8; ++kd) ka[kd] = 256u * kap + 16u * ((2u * kd + g) ^ ksw);
    const unsigned blk = (lane >> 4) & 1, q4 = (lane & 15) >> 2, p4 = lane & 3;
    unsigned va_[2][4];
#pragma unroll
    for (int t = 0; t < 2; ++t)
#pragma unroll
        for (int jb = 0; jb < 4; ++jb) { const unsigned row = 8u * g + 4u * t + q4, sw = ((row & 3u) << 2) | ((row >> 2) & 3u);
            va_[t][jb] = 8192u + 256u * row + 16u * ((4u * jb + 2u * blk + (p4 >> 1)) ^ sw) + 8u * (p4 & 1); }
    const size_t qtok = (size_t)b * SEQ + r * GRIDW + 32 * qblk + j;
    bf16x8 qf[8];
    { const GAS bf16x8* qp = (const GAS bf16x8*)(F.QB + qtok * NAW + HD * h + 8 * g);
#pragma unroll
      for (int kd = 0; kd < 8; ++kd) qf[kd] = __builtin_nontemporal_load(qp + 2 * kd); }
#pragma unroll
    for (int t = 0; t < A_NST - 1; ++t) DMA(t, t);
    f32x16 o0, o1, o2, o3;
#pragma unroll
    for (int v = 0; v < 16; ++v) { o0[v] = 0.f; o1[v] = 0.f; o2[v] = 0.f; o3[v] = 0.f; }
    float m_run = -__builtin_inff(), l_run = 0.f;
    int st = 0, stp = A_NST - 1;
    for (int t = 0; t < NT; ++t) {
        asm volatile("s_waitcnt vmcnt(%0)" :: "n"(2 * (A_NST - 2)) : "memory");
        __builtin_amdgcn_s_barrier();
        asm volatile("" ::: "memory");
        { const int tp = min(t + A_NST - 1, NT - 1); DMA(tp, stp); }
        const bool lat = t >= 8; const int kr = KR0 + ((t - 8) >> 1), kblk = (t - 8) & 1;
        const bool active = !lat || (kr >= rs && kr < rs + NAKH);
        if (active) {
            const LAS unsigned char* sb = ring + st * A_STAGE;
            f32x16 s;
#pragma unroll
            for (int v = 0; v < 16; ++v) s[v] = 0.f;
            { bf16x8 kf[8];
#pragma unroll
              for (int kd = 0; kd < 8; ++kd) kf[kd] = *(const LAS bf16x8*)(sb + ka[kd]);
#pragma unroll
              for (int kd = 0; kd < 8; ++kd) s = MFMA32(kf[kd], qf[kd], s); }
            s16x4 tv[2][2][4];
            { const unsigned sa = (unsigned)(size_t)sb;
#pragma unroll
              for (int t2 = 0; t2 < 2; ++t2)
#pragma unroll
                for (int jb = 0; jb < 4; ++jb) { asm volatile("ds_read_b64_tr_b16 %0, %1" : "=v"(tv[0][t2][jb]) : "v"(sa + va_[t2][jb]) : "memory");
                                                 asm volatile("ds_read_b64_tr_b16 %0, %1 offset:4096" : "=v"(tv[1][t2][jb]) : "v"(sa + va_[t2][jb]) : "memory"); } }
            if (lat) { int ml = mask_lane; asm volatile("" : "+v"(ml)); const LAS float* bp = rp + bias_lane + 31 * (kr - rs) + 32 * kblk;
                float bias[16];
#pragma unroll
                for (int v = 0; v < 16; ++v) bias[v] = bp[(v & 7) + 16 * (v >> 3)];
                asm volatile("" : "+v"(bias[0]), "+v"(bias[1]), "+v"(bias[2]), "+v"(bias[3]), "+v"(bias[4]), "+v"(bias[5]), "+v"(bias[6]), "+v"(bias[7]),
                             "+v"(bias[8]), "+v"(bias[9]), "+v"(bias[10]), "+v"(bias[11]), "+v"(bias[12]), "+v"(bias[13]), "+v"(bias[14]), "+v"(bias[15]));
                const int mk = ml + 32 * kblk;
#pragma unroll
                for (int v = 0; v < 16; ++v) { const int c = (v & 7) + 16 * (v >> 3); s[v] = ((unsigned)(c + mk) < 16u) ? s[v] + bias[v] : -__builtin_inff(); } }
            float mx = s[0];
#pragma unroll
            for (int v = 1; v < 16; ++v) mx = fmaxf(mx, s[v]);
            mx = fmaxf(mx, __shfl_xor(mx, 32));
            if (__builtin_amdgcn_ballot_w64(mx > m_run) != 0ull) {
                const float m_new = fmaxf(m_run, mx), alpha = __builtin_amdgcn_exp2f(m_run - m_new);
                l_run *= alpha; m_run = m_new;
#pragma unroll
                for (int v = 0; v < 16; ++v) { o0[v] *= alpha; o1[v] *= alpha; o2[v] *= alpha; o3[v] *= alpha; } }
            float ps = 0.f;
#pragma unroll
            for (int v = 0; v < 16; ++v) { s[v] = __builtin_amdgcn_exp2f(s[v] - m_run); ps += s[v]; }
            l_run += ps;
            bf16x8 pf0, pf1;
            { v4u t0, t1; t0.x = pkbf(s[0], s[1]); t0.y = pkbf(s[2], s[3]); t0.z = pkbf(s[4], s[5]); t0.w = pkbf(s[6], s[7]);
              t1.x = pkbf(s[8], s[9]); t1.y = pkbf(s[10], s[11]); t1.z = pkbf(s[12], s[13]); t1.w = pkbf(s[14], s[15]);
              pf0 = __builtin_bit_cast(bf16x8, t0); pf1 = __builtin_bit_cast(bf16x8, t1); }
            asm volatile("s_waitcnt lgkmcnt(0)" : "+v"(tv[0][0][0]), "+v"(tv[0][0][1]), "+v"(tv[0][0][2]), "+v"(tv[0][0][3]), "+v"(tv[0][1][0]), "+v"(tv[0][1][1]), "+v"(tv[0][1][2]), "+v"(tv[0][1][3]),
                         "+v"(tv[1][0][0]), "+v"(tv[1][0][1]), "+v"(tv[1][0][2]), "+v"(tv[1][0][3]), "+v"(tv[1][1][0]), "+v"(tv[1][1][1]), "+v"(tv[1][1][2]), "+v"(tv[1][1][3]) :: "memory");
#define VF(KS, JB) __builtin_shufflevector(tv[KS][0][JB], tv[KS][1][JB], 0, 1, 2, 3, 4, 5, 6, 7)
            o0 = MFMA32(VF(0, 0), pf0, o0); o1 = MFMA32(VF(0, 1), pf0, o1); o2 = MFMA32(VF(0, 2), pf0, o2); o3 = MFMA32(VF(0, 3), pf0, o3);
            o0 = MFMA32(VF(1, 0), pf1, o0); o1 = MFMA32(VF(1, 1), pf1, o1); o2 = MFMA32(VF(1, 2), pf1, o2); o3 = MFMA32(VF(1, 3), pf1, o3);
#undef VF
        }
        st = (st + 1 == A_NST) ? 0 : st + 1; stp = (stp + 1 == A_NST) ? 0 : stp + 1;
    }
#undef KEYBASE
#undef DMA
    asm volatile("s_waitcnt vmcnt(0)" ::: "memory");
    __builtin_amdgcn_s_barrier();
    asm volatile("" ::: "memory");
    const float l = l_run + __shfl_xor(l_run, 32), inv = 1.0f / l;
    GAS v2u* op = (GAS v2u*)(F.YB + qtok * D + HD * h);
    float sq = 0.f;
#define OST(JB, OV) do { _Pragma("unroll") for (int u = 0; u < 4; ++u) { const float a_ = OV[4 * u] * inv, b_ = OV[4 * u + 1] * inv, c_ = OV[4 * u + 2] * inv, d_ = OV[4 * u + 3] * inv; \
        sq += (a_ * a_ + b_ * b_) + (c_ * c_ + d_ * d_); v2u w_; w_.x = pkbf(a_, b_); w_.y = pkbf(c_, d_); op[8 * (JB) + 2 * u + g] = w_; } } while (0)
    OST(0, o0); OST(1, o1); OST(2, o2); OST(3, o3);
    sq += __shfl_xor(sq, 32);
    if (g == 0) atomicAdd(F.ssq + qtok, sq);
#undef OST
}
__device__ __forceinline__ void attn_phase(Frame& F) {
    LAS float* rp = (LAS float*)(F.lds + RING_OFF + 1024);
    for (int i = F.tid; i < NAH * 15 * 31; i += NWAVES * 64) rp[i] = F.in[I_RPB][i] * LOG2E;
    __syncthreads();
    for (int wu = F.vcu; wu < NB * NAH * 8; wu += F.G) { const int bh = wu >> 3, rg = wu & 7; attn_wg_unit(F, rp, bh >> 4, bh & 15, rg * 4); }
}

__device__ __forceinline__ void conv_row(Frame& F, int row) {
    unsigned lane = (unsigned)F.lane; const int t = row & (SEQ - 1);
    asm volatile("" : "+v"(lane) :: "memory");
    const GAS char* cw = (const GAS char*)F.in[I_CONVW];
    const GAS char* r0 = (const GAS char*)(F.CB + (size_t)row * 4096);
    const GAS char* rm = t > 0 ? r0 - 8192 : r0; const GAS char* rp = t < SEQ - 1 ? r0 + 8192 : r0;
    const float fm = t > 0 ? 1.f : 0.f, fp = t < SEQ - 1 ? 1.f : 0.f;
    const float ssa = F.ssq[row];
    float co[4][8]; float ss = 0.f;
#pragma unroll
    for (int q = 0; q < 4; ++q) { const unsigned vo = lane * 16u + q * 1024u, wo = lane * 32u + q * 2048u;
        const v4u c0v = *(const GAS v4u*)(r0 + vo), gb = __builtin_nontemporal_load((const GAS v4u*)(r0 + (vo + 4096u)));
        const v4u cm = *(const GAS v4u*)(rm + vo), cpl = *(const GAS v4u*)(rp + vo);
        const f32x4 wa0 = *(const GAS f32x4*)(cw + wo), wa1 = *(const GAS f32x4*)(cw + (wo + 16u)), wb0 = *(const GAS f32x4*)(cw + (wo + 8192u)), wb1 = *(const GAS f32x4*)(cw + (wo + 8208u)),
                    wc0 = *(const GAS f32x4*)(cw + (wo + 16384u)), wc1 = *(const GAS f32x4*)(cw + (wo + 16400u));
#pragma unroll
        for (int e = 0; e < 4; ++e) {
            const float k0l = (e < 2 ? wa0[(2 * e) & 3] : wa1[(2 * e) & 3]) * fm, k0h = (e < 2 ? wa0[(2 * e + 1) & 3] : wa1[(2 * e + 1) & 3]) * fm;
            const float k1l = e < 2 ? wb0[(2 * e) & 3] : wb1[(2 * e) & 3], k1h = e < 2 ? wb0[(2 * e + 1) & 3] : wb1[(2 * e + 1) & 3];
            const float k2l = (e < 2 ? wc0[(2 * e) & 3] : wc1[(2 * e) & 3]) * fp, k2h = (e < 2 ? wc0[(2 * e + 1) & 3] : wc1[(2 * e + 1) & 3]) * fp;
            const float vl = bflo(gb[e]) * (k0l * bflo(cm[e]) + k1l * bflo(c0v[e]) + k2l * bflo(cpl[e]));
            const float vh = bfhi(gb[e]) * (k0h * bfhi(cm[e]) + k1h * bfhi(c0v[e]) + k2h * bfhi(cpl[e]));
            co[q][2 * e] = vl; co[q][2 * e + 1] = vh; ss += vl * vl + vh * vh; } }
    const float sc = sqrtf(ssa * (1.0f / NAW) + EPS) / sqrtf(wave_sum(ss) * (1.0f / CVW) + EPS);
    GAS char* yp = (GAS char*)(F.YB + (size_t)row * D + NAW);
#pragma unroll
    for (int q = 0; q < 4; ++q) { v4u w;
        w.x = pkbf(co[q][0] * sc, co[q][1] * sc); w.y = pkbf(co[q][2] * sc, co[q][3] * sc); w.z = pkbf(co[q][4] * sc, co[q][5] * sc); w.w = pkbf(co[q][6] * sc, co[q][7] * sc);
        *(GAS v4u*)(yp + (lane * 16u + q * 1024u)) = w; }
}
__device__ __forceinline__ void final_norm_row(const float* xrow, const bf16* mrow, const bf16* frow, float* orow, const float* gain, int lane) {
    const GAS f32x4* xr = (const GAS f32x4*)xrow + lane; const GAS v2u* mr = (const GAS v2u*)mrow + lane; const GAS v2u* fr = (const GAS v2u*)frow + lane;
    const GAS f32x4* g4 = (const GAS f32x4*)gain + lane; GAS f32x4* o4 = (GAS f32x4*)orow + lane;
    f32x4 v[16]; float ss = 0.f;
#pragma unroll
    for (int j = 0; j < 16; ++j) { const f32x4 x = __builtin_nontemporal_load(xr + 64 * j); const v2u m = __builtin_nontemporal_load(mr + 64 * j), f = __builtin_nontemporal_load(fr + 64 * j);
        v[j] = (f32x4){x.x + bflo(m.x) + bflo(f.x), x.y + bfhi(m.x) + bfhi(f.x), x.z + bflo(m.y) + bflo(f.y), x.w + bfhi(m.y) + bfhi(f.y)};
        ss += (v[j].x * v[j].x + v[j].y * v[j].y) + (v[j].z * v[j].z + v[j].w * v[j].w); }
    const float rstd = 1.0f / sqrtf(wave_sum(ss) * (1.0f / D) + EPS);
#pragma unroll
    for (int j = 0; j < 16; ++j) __builtin_nontemporal_store(v[j] * rstd * g4[64 * j], o4 + 64 * j);
}

struct Args { const float* in[N_IN]; float* out; unsigned char* ws; int ph_lo, ph_hi; };
__global__ void __launch_bounds__(NWAVES * 64, 2) fwd_kernel(Args args) {
    extern __shared__ __attribute__((aligned(16))) unsigned char lds[];
    Frame F;
    F.lds = (LAS unsigned char*)lds;
    F.MISC = (volatile LAS unsigned*)(F.lds + MISC_OFF);
    F.tid = threadIdx.x; F.lane = F.tid & 63; F.wave = __builtin_amdgcn_readfirstlane(F.tid >> 6);
    F.G = gridDim.x; { const int bx = blockIdx.x; F.vcu = (F.G % 8 == 0) ? (bx % 8) * (F.G / 8) + bx / 8 : bx; }
    unsigned char* ws = args.ws;
    F.ctl = (gu32*)(ws + WS_CTL);
#pragma unroll
    for (int i = 0; i < N_IN; ++i) F.in[i] = args.in[i];
    F.out = args.out; F.mod = (float*)(ws + WS_MOD); F.rope = (float*)(ws + WS_ROPE);
    F.Win_t = (bf16*)(ws + WS_WIN); F.Wout_t = (bf16*)(ws + WS_WOUT); F.Wgu_t = (bf16*)(ws + WS_WGU); F.Wdn_t = (bf16*)(ws + WS_WDN);
    F.HB = (bf16*)(ws + WS_H); F.QB = (bf16*)(ws + WS_Q); F.KB = (bf16*)(ws + WS_K); F.VB = (bf16*)(ws + WS_V); F.CB = (bf16*)(ws + WS_C);
    F.ssq = (float*)(ws + WS_SSQ); F.HQ = (signed char*)(ws + WS_H); F.Wgu_q = (signed char*)(ws + WS_WGU); F.rsH = (float*)(ws + WS_RSH); F.csW = (float*)(ws + WS_CSW); F.ACTQ = (signed char*)(ws + WS_Q); F.Wdn_q = (signed char*)(ws + WS_WDN); F.rsA = (float*)(ws + WS_RSA); F.cmaxD = (unsigned*)(ws + WS_CMAXD); F.YB = (bf16*)(ws + WS_Y); F.ACT = (bf16*)(ws + WS_ACT); F.MX = (bf16*)(ws + WS_X1); F.FX = (bf16*)(ws + WS_X1 + 64 * MiB);
    for (int u = F.tid; u < (LDS_BYTES - LDSCTL_OFF) / 4; u += NWAVES * 64) ((LAS unsigned*)(F.lds + LDSCTL_OFF))[u] = 0u;
    __syncthreads();
    XcdBarrier bar; bar.bar = (unsigned*)(F.ctl + CW_BAR); bar.x = 0; bar.st = nullptr;
    if (N_LAUNCHES == 1) bar = xcd_barrier_post((unsigned*)(F.ctl + CW_BAR), F.MISC + 8);
    int cid = (int)blockIdx.x;
#if defined(XCC_PLACE)
    if (N_LAUNCHES == 1 && F.G == 256) {
        if (F.tid == 0) { const unsigned x = xb_xcc_id(); const unsigned r = __hip_atomic_fetch_add(F.ctl + CW_XRANK + 64 * x, 1u, RLX_AGENT);
            unsigned sp = 0; bool ok = false;
            for (;;) { unsigned sum = 0; bool even = true;
                for (unsigned j = 0; j < 16; ++j) { const unsigned c = __hip_atomic_load(F.ctl + CW_XRANK + 64 * j, RLX_AGENT); sum += c; if (j < 8 ? c != 32u : c != 0u) even = false; }
                if (sum == 256u) { ok = even; break; }
                __builtin_amdgcn_s_sleep(1); if (++sp > (1u << 16)) break; }
            F.MISC[12] = ok ? (8u * r + x) : (unsigned)blockIdx.x; }
        __syncthreads();
        cid = (int)F.MISC[12];
    }
#endif
#if defined(FAKEQ_DN)
#define DNQ_DST F.Wdn_t
#else
#define DNQ_DST (bf16*)F.Wdn_q
#endif
    const int lo = args.ph_lo, hi = args.ph_hi;
#define IN(k) (lo <= (k) && (k) < hi)
#if defined(PROBE_BAR2)
#define SEAM(k) do { if (IN(k) && IN((k) + 1)) { xcd_barrier(bar); xcd_barrier(bar); } } while (0)
#else
#define SEAM(k) do { if (IN(k) && IN((k) + 1)) xcd_barrier(bar); } while (0)
#endif
    const int gw = F.vcu * NWAVES + F.wave, NGW = F.G * NWAVES;
#ifndef PROBE_DUP
#define PROBE_DUP (-1)
#endif
#define DUP(k, body) do { body; if (PROBE_DUP == (k)) { xcd_barrier(bar); body; } } while (0)

    if (IN(0)) { p0_prologue(F, 1.0f); if (PROBE_DUP == 0) { xcd_barrier(bar); p0_prologue(F, 0.0f); } SEAM(0); }
    if (IN(1)) {
        DUP(1, for (int m = gw; m < MT; m += NGW) {
            const bool isctx = m >= M; const float* xrow = isctx ? F.in[I_CTX] + (size_t)(m - M) * D : F.in[I_X] + (size_t)m * D;
            const float* mrow = F.mod + (size_t)(isctx ? 4 : (m >> 11)) * NMODC;
            norm_mod_row(xrow, F.HB + (size_t)m * D, F.in[I_N1G], mrow, mrow + D, F.lane); });
        SEAM(1);
    }
#if defined(PROBE_IDLE_US)
    if (IN(2)) { const unsigned long long t0 = __builtin_amdgcn_s_memrealtime(); while (__builtin_amdgcn_s_memrealtime() - t0 < (unsigned long long)(PROBE_IDLE_US) * 100ull) __builtin_amdgcn_s_sleep(32); }
#endif
    if (IN(2)) {
        pg8::Gemm g{F.HB, F.Win_t, MT, INC, D}; pg8::InOrder S; S.init(F.G, cid);
        pg8::EpiIn E{F.QB, F.KB, F.VB, F.CB, F.rope, 0.08838834764831845f * LOG2E};
        DUP(2, (pg8::gemm_phase<pg8::EpiIn, pg8::InOrder, PG8_ALIGN, PG8_SP2>(F.lds + RING_OFF, g, S, E)));
        if (F.G == 256 && cid >= 64) {
            LAS float* scr = (LAS float*)(F.lds + RING_OFF + F.wave * 16384); const int p = (cid - 64) * NWAVES + F.wave, pw = cid - 64;
            transpose_items<3>(F.in[I_WOUT], D, D, F.Wout_t, scr, P0_OUT_ITEMS + p, 192 * NWAVES, IT_OUT, F.lane, F.in[I_GNG]);
#if DNQ_COOP
            __syncthreads();
            if (pw < 64) { quant_dn_block(F, pw); for (int nb = 576 + pw; nb < 2 * FF / 32; nb += 64) quant_gu_block(F, nb); }
            else { for (int nb = pw - 64; nb < 576; nb += 128) quant_gu_block(F, nb); }
#else
            for (int nb = P0_GUQ_BLOCKS + cid - 64; nb < 2 * FF / 32; nb += 192) quant_gu_block(F, nb);
            transpose_items<8>(F.in[I_WDN], FF, D, DNQ_DST, scr, p, 192 * NWAVES, TAIL2_DN_ITEMS, F.lane, (const float*)F.cmaxD);
#endif
        } else if (F.G != 256) {
            LAS float* scr = (LAS float*)(F.lds + RING_OFF + F.wave * 16384);
            transpose_items<3>(F.in[I_WOUT], D, D, F.Wout_t, scr, P0_OUT_ITEMS + gw, NGW, IT_OUT, F.lane, F.in[I_GNG]);
            __syncthreads();
            for (int nb = P0_GUQ_BLOCKS + (int)blockIdx.x; nb < 2 * FF / 32; nb += F.G) quant_gu_block(F, nb);
#if DNQ_COOP
            for (int nb = (int)blockIdx.x; nb < D / 32; nb += F.G) quant_dn_block(F, nb);
#else
            transpose_items<8>(F.in[I_WDN], FF, D, DNQ_DST, scr, gw, NGW, TAIL2_DN_ITEMS, F.lane, (const float*)F.cmaxD);
#endif
        }
        SEAM(2);
    }
    if (IN(3)) { DUP(3, attn_phase(F)); SEAM(3); }
    if (IN(4)) { DUP(4, for (int m = gw; m < M; m += NGW) conv_row(F, m)); SEAM(4); }
    if (IN(5)) {
        pg8::Gemm g{F.YB, F.Wout_t, M, D, D}; pg8::StaticOrder S; S.init(M, D, F.G, cid);
        pg8::EpiGate<true> E{F.MX, D, F.mod + 2 * D, F.ssq};
        DUP(5, (pg8::gemm_phase<pg8::EpiGate<true>, pg8::StaticOrder, PG8_ALIGN, PG8_SP2>(F.lds + RING_OFF, g, S, E)));
        SEAM(5);
    }
    if (IN(6)) {
        DUP(6, for (int m = gw; m < M; m += NGW) { const float* mrow = F.mod + (size_t)(m >> 11) * NMODC;
            norm_mod_row_x1_q8(F.in[I_X] + (size_t)m * D, F.MX + (size_t)m * D, F.HQ + (size_t)m * D, F.rsH + m, F.in[I_N2G], mrow + 3 * D, mrow + 4 * D, F.lane); });
        SEAM(6);
    }
    if (IN(7)) {
        pg8::Gemm g{(const bf16*)F.HQ, (const bf16*)F.Wgu_q, M, 2 * FF, D / 2}; pg8::StaticOrder S; S.init(M, 2 * FF, F.G, cid);
        pg8::EpiSwigluI8 E{F.ACT, FF, F.rsH, F.csW};
#if defined(PROBE_CLK_THR)
        const unsigned long long pc0 = __builtin_readcyclecounter(), pr0 = __builtin_amdgcn_s_memrealtime();
#endif
        DUP(7, (pg8::gemm_phase<pg8::EpiSwigluI8, pg8::StaticOrder, PG8_ALIGN, PG8_SP2>(F.lds + RING_OFF, g, S, E)));
#if defined(PROBE_CLK_THR)
        { const unsigned long long pc1 = __builtin_readcyclecounter(), pr1 = __builtin_amdgcn_s_memrealtime();
          const unsigned long long mhz = (pc1 - pc0) * 100ull / (pr1 - pr0 + 1ull);
          if (blockIdx.x == 0 && mhz < (unsigned long long)(PROBE_CLK_THR)) { const unsigned long long t0 = __builtin_amdgcn_s_memrealtime(); while (__builtin_amdgcn_s_memrealtime() - t0 < 50000ull) __builtin_amdgcn_s_sleep(32); } }
#endif
#if DNQ_COOP
        if (F.G == 256 && cid >= 192) quant_dn_block(F, 64 + cid - 192);
#else
        if (F.G == 256 && cid >= 192) {
            LAS float* scr = (LAS float*)(F.lds + RING_OFF + F.wave * 16384); const int p = (cid - 192) * NWAVES + F.wave;
            transpose_items<8>(F.in[I_WDN], FF, D, DNQ_DST, scr, TAIL2_DN_ITEMS + p, 64 * NWAVES, IT_DN, F.lane, (const float*)F.cmaxD);
        } else if (F.G != 256) {
            LAS float* scr = (LAS float*)(F.lds + RING_OFF + F.wave * 16384);
            transpose_items<8>(F.in[I_WDN], FF, D, DNQ_DST, scr, TAIL2_DN_ITEMS + gw, NGW, IT_DN, F.lane, (const float*)F.cmaxD);
        }
#endif
        SEAM(7);
    }
    if (IN(8)) { for (int m = gw; m < M; m += NGW) quant_act_row(F.ACT + (size_t)m * FF, F.ACTQ + (size_t)m * FF, F.rsA + m, F.lane); SEAM(8); }
    if (IN(9)) {
#if defined(FAKEQ_DN)
        pg8::Gemm g{F.ACT, F.Wdn_t, M, D, FF}; pg8::StaticOrder S; S.init(M, D, F.G, cid);
        pg8::EpiGate<false> E{F.FX, D, F.mod + 5 * D, nullptr};
        DUP(9, (pg8::gemm_phase<pg8::EpiGate<false>, pg8::StaticOrder, PG8_ALIGN, PG8_SP2>(F.lds + RING_OFF, g, S, E)));
#else
        pg8::Gemm g{(const bf16*)F.ACTQ, (const bf16*)F.Wdn_q, M, D, FF / 2}; pg8::StaticOrder S; S.init(M, D, F.G, cid);
        pg8::EpiGateI8 E{F.FX, D, F.mod + 5 * D, F.rsA, F.cmaxD};
        DUP(9, (pg8::gemm_phase<pg8::EpiGateI8, pg8::StaticOrder, PG8_ALIGN, PG8_SP2>(F.lds + RING_OFF, g, S, E)));
#endif
        SEAM(9);
    }
    if (IN(10)) { for (int m = gw; m < M; m += NGW) final_norm_row(F.in[I_X] + (size_t)m * D, F.MX + (size_t)m * D, F.FX + (size_t)m * D, F.out + (size_t)m * D, F.in[I_FNG], F.lane); }
#undef IN
#undef SEAM
}

extern "C" void kernel_launch(void* const* d_in, const int* in_sizes, int n_in, void* d_out, int out_size, void* d_ws, size_t ws_size, hipStream_t stream) {
    static int grid = 0;
    if (grid == 0) {
        if (n_in != N_IN || in_sizes[I_X] != M * D || out_size != M * D || ws_size < WS_END) { fprintf(stderr, "kernel_launch: shape / workspace mismatch (n_in %d, x %d, out %d, ws %zu); nothing launched\n", n_in, n_in > 0 ? in_sizes[0] : -1, out_size, ws_size); grid = -1; return; }
        int dev = 0, cus = 0, per_cu = 0;
        if (hipGetDevice(&dev) != hipSuccess || hipDeviceGetAttribute(&cus, hipDeviceAttributeMultiprocessorCount, dev) != hipSuccess) { fprintf(stderr, "kernel_launch: device query failed\n"); grid = -1; return; }
        if (hipFuncSetAttribute((const void*)fwd_kernel, hipFuncAttributeMaxDynamicSharedMemorySize, LDS_BYTES) != hipSuccess) { fprintf(stderr, "kernel_launch: hipFuncSetAttribute failed\n"); grid = -1; return; }
        if (hipOccupancyMaxActiveBlocksPerMultiprocessor(&per_cu, (const void*)fwd_kernel, NWAVES * 64, LDS_BYTES) != hipSuccess || per_cu < 1)
            fprintf(stderr, "kernel_launch: note: occupancy query reports %d workgroups per CU\n", per_cu);
        (void)hipGetLastError();
        grid = cus;
    }
    if (grid < 0) return;
    if (hipMemsetAsync((char*)d_ws + WS_CTL, 0, CTL_ZERO_BYTES, stream) != hipSuccess) { fprintf(stderr, "kernel_launch: memset failed\n"); return; }
    Args a{};
    for (int i = 0; i < N_IN; ++i) a.in[i] = (const float*)d_in[i];
    a.out = (float*)d_out; a.ws = (unsigned char*)d_ws;
    for (int li = 0; li < N_LAUNCHES; ++li) {
        a.ph_lo = (N_LAUNCHES == 1) ? 0 : li; a.ph_hi = (N_LAUNCHES == 1) ? N_PHASES : li + 1;
        hipLaunchKernelGGL(fwd_kernel, dim3(grid), dim3(NWAVES * 64), LDS_BYTES, stream, a);
        const hipError_t le = hipPeekAtLastError();
        if (le != hipSuccess) { fprintf(stderr, "kernel_launch: launch %d failed: %s\n", li, hipGetErrorName(le)); break; }
    }
}
```

```cpp
#include <hip/hip_runtime.h>
#include <cstdio>
#include <cstdint>
namespace pg8 {
#define PG8_LAS __attribute__((address_space(3)))
typedef unsigned short bf16_t;
typedef short bf16x8 __attribute__((ext_vector_type(8)));
typedef float f32x4 __attribute__((ext_vector_type(4)));
typedef unsigned u32x4 __attribute__((ext_vector_type(4)));
constexpr int BM = 256, BK = 64, HALF = 128, HTB = HALF * BK * 2  , STAGE_BYTES = 8 * HTB, NXCD = 8, WGM = 8;

__host__ __device__ __forceinline__ int lds_byte(int r, int c) { const int st = (r >> 4) * 2 + (c >> 5), rr = r & 15, cc = c & 31, ob = rr * 64 + cc * 2; return st * 1024 + (ob ^ (((ob >> 9) & 1) << 5)); }
__host__ __device__ __forceinline__ void stage_rc(int b, int& R, int& C) { const int st = b / 1024, sb = b % 1024, swz = sb ^ (((sb >> 9) & 1) << 5); R = (st >> 1) * 16 + swz / 64; C = (st & 1) * 32 + (swz % 64) / 2; }
__host__ __device__ __forceinline__ int perm32(int rho) { const int n = rho >> 4, i = rho & 15; return 8 * (i >> 2) + 4 * n + (i & 3); }

struct Unit { int pm, pn; };
struct Gemm { const bf16_t* A; const bf16_t* Bt; int M, N, K; };

struct StaticOrder {
    int nM, nN, nwg, G, c;
    __host__ __device__ void init(int M, int N, int G_, int c_) { nM = M / BM; nN = N / BM; nwg = nM * nN; G = G_; c = c_; }
    __host__ __device__ bool next(int i, Unit& u) const {
        const long L = (long)i * G + c; if (L >= nwg) return false;
        int wgid = (int)L; { const int q = nwg / NXCD, r = nwg % NXCD, xcd = wgid % NXCD, off = wgid / NXCD; wgid = (xcd < r ? xcd * (q + 1) : r * (q + 1) + (xcd - r) * q) + off; }
        const int nig = WGM * nN, gid = wgid / nig, fm = gid * WGM, gsz = (nM - fm) < WGM ? (nM - fm) : WGM;
        u.pm = fm + ((wgid % nig) % gsz); u.pn = (wgid % nig) / gsz; return true;
    }
    __device__ __forceinline__ void a_ready(const Unit&) const {}
    __device__ __forceinline__ void done(const Unit&) const {}
};

__device__ __forceinline__ unsigned cvt_pk_bf16(float lo, float hi) { unsigned r; asm volatile("v_cvt_pk_bf16_f32 %0, %1, %2" : "=v"(r) : "v"(lo), "v"(hi)); return r; }
typedef float f32x2 __attribute__((ext_vector_type(2)));
typedef int i32x4 __attribute__((ext_vector_type(4)));
__device__ __forceinline__ void mma16(f32x4& c, const bf16x8 b, const bf16x8 a) { c = __builtin_amdgcn_mfma_f32_16x16x32_bf16(b, a, c, 0, 0, 0); }
__device__ __forceinline__ void mma16(i32x4& c, const bf16x8 b, const bf16x8 a) { c = __builtin_amdgcn_mfma_i32_16x16x64_i8(__builtin_bit_cast(i32x4, b), __builtin_bit_cast(i32x4, a), c, 0, 0, 0); }
typedef __bf16 bf16v2 __attribute__((ext_vector_type(2)));
__device__ __forceinline__ unsigned pkbf(float lo, float hi) { f32x2 v = {lo, hi}; bf16v2 r = __builtin_convertvector(v, bf16v2); return __builtin_bit_cast(unsigned, r); }

struct EpiIn {
    typedef f32x4 acc_t;
    static constexpr bool PERM = true, AFTER_DRAIN = false;
    bf16_t *Q, *Kd, *Vd, *Cd; const float* rope; float qscale;
    __device__ __forceinline__ void operator()(const f32x4 (&acc)[2][2][4][2], const Unit& u, int wr, int wc, int fr, int fq) const {
        const int reg = u.pn >> 3;
        if (reg == 3 || reg == 4) {
            const int row0 = u.pm * BM + wr * 64 + fr, col0 = (u.pn - 24) * HALF + wc * 32 + 8 * fq;
#pragma unroll
            for (int ai = 0; ai < 2; ++ai)
#pragma unroll
                for (int m = 0; m < 4; ++m) { bf16_t* rowp = Cd + (size_t)(row0 + ai * HALF + m * 16) * 4096 + col0;
                    const f32x4 p0 = acc[ai][0][m][0] * acc[ai][1][m][0], p1 = acc[ai][0][m][1] * acc[ai][1][m][1];
                    u32x4 w; w.x = pkbf(p0[0], p0[1]); w.y = pkbf(p0[2], p0[3]); w.z = pkbf(p1[0], p1[1]); w.w = pkbf(p1[2], p1[3]);
                    *(u32x4*)rowp = w; }
            return; }
        bf16_t* base; int ldc, colt; bool rot = false; float sc = 1.f;
        if (reg == 0) { base = Q; ldc = 2048; colt = u.pn * BM; rot = true; sc = qscale; }
        else if (reg == 1) { base = Kd; ldc = 2048; colt = (u.pn - 8) * BM; rot = (u.pm < 32); }
        else if (reg == 2) { base = Vd; ldc = 2048; colt = (u.pn - 16) * BM; }
        else { base = Cd; ldc = 4096; colt = 2048 + (u.pn - 40) * BM; }
        const int row0 = u.pm * BM + wr * 64 + fr, col0 = colt + wc * 32 + 8 * fq;
        const int blk = wc >> 1, i0 = 4 * ((4 * wc + fq) & 7);
        f32x4 cs[2], sn[2];
        cs[0] = (f32x4){1.f, 1.f, 1.f, 1.f}; sn[0] = (f32x4){0.f, 0.f, 0.f, 0.f}; cs[1] = cs[0]; sn[1] = sn[0];
        if (rot) { const int t = row0 & 2047, pos = blk ? (t & 63) : (t >> 6); cs[0] = *(const f32x4*)(rope + pos * 32 + i0); sn[0] = *(const f32x4*)(rope + 2048 + pos * 32 + i0); }
#pragma unroll
        for (int gi = 0; gi < 8; ++gi) { const int ai = gi >> 2, m = gi & 3; const int r = row0 + ai * HALF + m * 16; bf16_t* rowp = base + (size_t)r * ldc + col0;
            if (gi < 7 && rot) { const int rn = row0 + ((gi + 1) >> 2) * HALF + ((gi + 1) & 3) * 16, t = rn & 2047, pos = blk ? (t & 63) : (t >> 6);
                cs[(gi + 1) & 1] = *(const f32x4*)(rope + pos * 32 + i0); sn[(gi + 1) & 1] = *(const f32x4*)(rope + 2048 + pos * 32 + i0); }
            const f32x4 cs4 = cs[gi & 1], sn4 = sn[gi & 1];
#pragma unroll
            for (int bj = 0; bj < 2; ++bj) { const f32x4 a = acc[ai][bj][m][0], b = acc[ai][bj][m][1];
                const f32x4 v0 = (a * cs4 - b * sn4) * sc, v1 = (a * sn4 + b * cs4) * sc;
                u32x4 w; w.x = pkbf(v0[0], v0[1]); w.y = pkbf(v0[2], v0[3]); w.z = pkbf(v1[0], v1[1]); w.w = pkbf(v1[2], v1[3]);
                *(u32x4*)(rowp + bj * HALF) = w; }
            asm volatile("" ::: "memory"); }
    }
};
#ifndef EPI_NT_GATE
#define EPI_NT_GATE 0
#endif
#ifndef EPI_NT_ACT
#define EPI_NT_ACT 1
#endif
#ifndef EPI_NT_FX
#define EPI_NT_FX 0
#endif
#if EPI_NT_GATE
#define EPI_GATE_STORE(v, p) __builtin_nontemporal_store((v), (p))
#else
#define EPI_GATE_STORE(v, p) (*(p) = (v))
#endif
#if EPI_NT_ACT
#define EPI_ACT_STORE(v, p) __builtin_nontemporal_store((v), (p))
#else
#define EPI_ACT_STORE(v, p) (*(p) = (v))
#endif
template <bool ROWSCALE> struct EpiGate {
    typedef f32x4 acc_t;
    static constexpr bool PERM = true, AFTER_DRAIN = false;
    bf16_t* O; int ldc; const float* gate; const float* ssq;
    __device__ __forceinline__ void operator()(const f32x4 (&acc)[2][2][4][2], const Unit& u, int wr, int wc, int fr, int fq) const {
        const int row0 = u.pm * BM + wr * 64 + fr, col0 = u.pn * BM + wc * 32 + 8 * fq;
        const float* gp = gate + (size_t)(u.pm >> 3) * 24576 + col0;
        f32x4 gv[2][2];
#pragma unroll
        for (int bj = 0; bj < 2; ++bj)
#pragma unroll
            for (int n = 0; n < 2; ++n) gv[bj][n] = *(const f32x4*)(gp + bj * HALF + 4 * n);
        float rs[8];
#pragma unroll
        for (int gi = 0; gi < 8; ++gi) rs[gi] = ROWSCALE ? ssq[row0 + (gi >> 2) * HALF + (gi & 3) * 16] : 1.0f;
#pragma unroll
        for (int ai = 0; ai < 2; ++ai)
#pragma unroll
            for (int m = 0; m < 4; ++m) { bf16_t* rowp = O + (size_t)(row0 + ai * HALF + m * 16) * ldc + col0;
                const float rsc = ROWSCALE ? 1.0f / sqrtf(rs[ai * 4 + m] * (1.0f / 2048.0f) + 1e-6f) : 1.0f;
#pragma unroll
                for (int bj = 0; bj < 2; ++bj) { const f32x4 v0 = acc[ai][bj][m][0] * gv[bj][0] * rsc, v1 = acc[ai][bj][m][1] * gv[bj][1] * rsc;
                    u32x4 w; w.x = pkbf(v0[0], v0[1]); w.y = pkbf(v0[2], v0[3]); w.z = pkbf(v1[0], v1[1]); w.w = pkbf(v1[2], v1[3]);
                    EPI_GATE_STORE(w, (u32x4*)(rowp + bj * HALF)); } }
    }
};
struct EpiSwiglu {
    typedef f32x4 acc_t;
    static constexpr bool PERM = true, AFTER_DRAIN = false;
    bf16_t* O; int ldc;
    __device__ __forceinline__ void operator()(const f32x4 (&acc)[2][2][4][2], const Unit& u, int wr, int wc, int fr, int fq) const {
        const int row0 = u.pm * BM + wr * 64 + fr, col0 = u.pn * HALF + wc * 32 + 8 * fq;
#pragma unroll
        for (int ai = 0; ai < 2; ++ai)
#pragma unroll
            for (int m = 0; m < 4; ++m) { bf16_t* rowp = O + (size_t)(row0 + ai * HALF + m * 16) * ldc + col0;
                float o[8];
#pragma unroll
                for (int n = 0; n < 2; ++n)
#pragma unroll
                    for (int j = 0; j < 4; ++j) { const float gt = acc[ai][0][m][n][j], up = acc[ai][1][m][n][j];
                        o[4 * n + j] = gt * __builtin_amdgcn_rcpf(1.0f + __builtin_amdgcn_exp2f(-1.44269504089f * gt)) * up; }
                u32x4 w; w.x = pkbf(o[0], o[1]); w.y = pkbf(o[2], o[3]); w.z = pkbf(o[4], o[5]); w.w = pkbf(o[6], o[7]);
                EPI_ACT_STORE(w, (u32x4*)rowp); }
    }
};
__device__ __forceinline__ void had32(float (&o)[8], int fq) {
#pragma unroll
    for (int s = 1; s < 8; s <<= 1)
#pragma unroll
        for (int i = 0; i < 8; ++i) if (!(i & s)) { const float a = o[i], b = o[i ^ s]; o[i] = a + b; o[i ^ s] = a - b; }
#pragma unroll
    for (int i = 0; i < 8; ++i) { const unsigned x = __builtin_bit_cast(unsigned, o[i]); const auto r = __builtin_amdgcn_permlane16_swap(x, x, false, false);
        const float p = __builtin_bit_cast(float, (fq & 1) ? r[0] : r[1]); o[i] = (fq & 1) ? p - o[i] : o[i] + p; }
#pragma unroll
    for (int i = 0; i < 8; ++i) { const unsigned x = __builtin_bit_cast(unsigned, o[i]); const auto r = __builtin_amdgcn_permlane32_swap(x, x, false, false);
        const float p = __builtin_bit_cast(float, (fq & 2) ? r[0] : r[1]); o[i] = ((fq & 2) ? p - o[i] : o[i] + p) * 0.17677669529663687f; }
}
struct EpiSwigluI8 {
    typedef i32x4 acc_t;
    static constexpr bool PERM = true, AFTER_DRAIN = false;
    bf16_t* O; int ldc; const float* rs; const float* cs;
    __device__ __forceinline__ void operator()(const i32x4 (&acc)[2][2][4][2], const Unit& u, int wr, int wc, int fr, int fq) const {
        const int row0 = u.pm * BM + wr * 64 + fr, col0 = u.pn * HALF + wc * 32 + 8 * fq, gcol0 = u.pn * BM + wc * 32 + 8 * fq;
        f32x4 cg[2], cu[2];
#pragma unroll
        for (int n = 0; n < 2; ++n) { cg[n] = *(const f32x4*)(cs + gcol0 + 4 * n); cu[n] = *(const f32x4*)(cs + gcol0 + HALF + 4 * n); }
        float rsv[8];
#pragma unroll
        for (int gi = 0; gi < 8; ++gi) rsv[gi] = rs[row0 + (gi >> 2) * HALF + (gi & 3) * 16];
#pragma unroll
        for (int ai = 0; ai < 2; ++ai)
#pragma unroll
            for (int m = 0; m < 4; ++m) { bf16_t* rowp = O + (size_t)(row0 + ai * HALF + m * 16) * ldc + col0; const float r = rsv[ai * 4 + m];
                float o[8];
#pragma unroll
                for (int n = 0; n < 2; ++n)
#pragma unroll
                    for (int j = 0; j < 4; ++j) { const float gt = (float)acc[ai][0][m][n][j] * (r * cg[n][j]), up = (float)acc[ai][1][m][n][j] * (r * cu[n][j]);
                        o[4 * n + j] = gt * __builtin_amdgcn_rcpf(1.0f + __builtin_amdgcn_exp2f(-1.44269504089f * gt)) * up; }
                had32(o, fq);
                u32x4 w; w.x = pkbf(o[0], o[1]); w.y = pkbf(o[2], o[3]); w.z = pkbf(o[4], o[5]); w.w = pkbf(o[6], o[7]);
                EPI_ACT_STORE(w, (u32x4*)rowp); }
    }
};
struct EpiGateI8 {
    typedef i32x4 acc_t;
    static constexpr bool PERM = true, AFTER_DRAIN = false;
    bf16_t* O; int ldc; const float* gate; const float* rs; const unsigned* cmax;
    __device__ __forceinline__ void operator()(const i32x4 (&acc)[2][2][4][2], const Unit& u, int wr, int wc, int fr, int fq) const {
        const int row0 = u.pm * BM + wr * 64 + fr, col0 = u.pn * BM + wc * 32 + 8 * fq;
        const float* gp = gate + (size_t)(u.pm >> 3) * 24576 + col0;
        f32x4 gv[2][2];
#pragma unroll
        for (int bj = 0; bj < 2; ++bj)
#pragma unroll
            for (int n = 0; n < 2; ++n) { const f32x4 g = *(const f32x4*)(gp + bj * HALF + 4 * n); const f32x4 cm = *(const f32x4*)((const float*)cmax + 4096 + col0 + bj * HALF + 4 * n);
                gv[bj][n] = g * cm; }
        float rsv[8];
#pragma unroll
        for (int gi = 0; gi < 8; ++gi) rsv[gi] = rs[row0 + (gi >> 2) * HALF + (gi & 3) * 16];
#pragma unroll
        for (int ai = 0; ai < 2; ++ai)
#pragma unroll
            for (int m = 0; m < 4; ++m) { bf16_t* rowp = O + (size_t)(row0 + ai * HALF + m * 16) * ldc + col0; const float r = rsv[ai * 4 + m];
#pragma unroll
                for (int bj = 0; bj < 2; ++bj) { const i32x4 a0 = acc[ai][bj][m][0], a1 = acc[ai][bj][m][1];
                    const f32x4 v0 = (f32x4){(float)a0.x, (float)a0.y, (float)a0.z, (float)a0.w} * gv[bj][0] * r, v1 = (f32x4){(float)a1.x, (float)a1.y, (float)a1.z, (float)a1.w} * gv[bj][1] * r;
                    u32x4 w; w.x = pkbf(v0[0], v0[1]); w.y = pkbf(v0[2], v0[3]); w.z = pkbf(v1[0], v1[1]); w.w = pkbf(v1[2], v1[3]);
                    if (EPI_NT_FX) __builtin_nontemporal_store(w, (u32x4*)(rowp + bj * HALF)); else *(u32x4*)(rowp + bj * HALF) = w; } }
    }
};
struct InOrder {
    StaticOrder so; int G, c;
    __host__ __device__ void init(int G_, int c_) { so.init(8192, 12288, G_, c_); G = G_; c = c_; }
    __host__ __device__ bool next(int i, Unit& u) const {
        const long L = (long)i * G + c; if (L >= 1600) return false;
        if (L < 1536) return so.next(i, u);
        const int e = (int)L - 1536; u.pm = 32 + (e & 3); u.pn = 8 + (e >> 2); return true;
    }
    __device__ __forceinline__ void a_ready(const Unit&) const {}
    __device__ __forceinline__ void done(const Unit&) const {}
};
template <class Epi, class Sched, bool ALIGN_EPI = false, bool SP2 = false>
__device__ __forceinline__ void gemm_phase(PG8_LAS unsigned char* lds, const Gemm g, const Sched& S, const Epi& E) {
    const int tid = threadIdx.x, wid = __builtin_amdgcn_readfirstlane(tid >> 6), lane = tid & 63, wr = wid >> 2, wc = wid & 3, fr = lane & 15, fq = lane >> 4;
    const int K = g.K, nt = K / BK;
    unsigned voffA[2], voffB[2];
#pragma unroll
    for (int i = 0; i < 2; ++i) { int R, C; stage_rc(tid * 16 + i * 8192, R, C); const int Rb = Epi::PERM ? ((R & ~31) + perm32(R & 31)) : R;
        voffA[i] = (unsigned)(R * K + C) * 2u; voffB[i] = (unsigned)(Rb * K + C) * 2u; }
    const size_t kstep = (size_t)(BK * 2);
    const size_t hstep = (size_t)HALF * K * 2;
    const size_t tstep = 2 * hstep;
    const unsigned ldsw = (unsigned)wid * 1024u;
    const int aoff = lds_byte(wr * 64 + fr, fq * 8), boff = lds_byte(wc * 32 + fr, fq * 8);
#define PG8_SA(b, h) (((b) * 2 + (h)) * HTB)
#define PG8_SB(b, h) ((4 + (b) * 2 + (h)) * HTB)
#ifndef PG8_AUX_A
#define PG8_AUX_A 0
#endif
#ifndef PG8_AUX_B
#define PG8_AUX_B 0
#endif
#define PG8_STAGE(bufoff, gbase, voff) do { _Pragma("unroll") for (int _i = 0; _i < 2; ++_i) \
        __builtin_amdgcn_global_load_lds((const unsigned*)((const char*)(gbase) + (voff)[_i]), (PG8_LAS unsigned*)(lds + (bufoff) + ldsw + _i * 8192), 16, 0, ((bufoff) >= 4 * HTB) ? PG8_AUX_B : PG8_AUX_A); } while (0)
#define PG8_LDA(dst, b, h) do { _Pragma("unroll") for (int m = 0; m < 4; ++m) _Pragma("unroll") for (int k = 0; k < 2; ++k) dst[m][k] = *(const PG8_LAS bf16x8*)(lds + PG8_SA(b, h) + aoff + m * 2048 + k * 1024); } while (0)
#define PG8_LDB(dst, b, h) do { _Pragma("unroll") for (int n = 0; n < 2; ++n) _Pragma("unroll") for (int k = 0; k < 2; ++k) dst[n][k] = *(const PG8_LAS bf16x8*)(lds + PG8_SB(b, h) + boff + n * 2048 + k * 1024); } while (0)
#ifndef MMA_ORDER
#define MMA_ORDER 0
#endif
#if MMA_ORDER == 0
#define PG8_MMA(ai, bj, At, Bt) do { __builtin_amdgcn_s_setprio(1); _Pragma("unroll") for (int m = 0; m < 4; ++m) _Pragma("unroll") for (int n = 0; n < 2; ++n) _Pragma("unroll") for (int k = 0; k < 2; ++k) \
        mma16(acc[ai][bj][m][n], Bt[n][k], At[m][k]); __builtin_amdgcn_s_setprio(0); } while (0)
#elif MMA_ORDER == 1
#define PG8_MMA(ai, bj, At, Bt) do { __builtin_amdgcn_s_setprio(1); _Pragma("unroll") for (int k = 0; k < 2; ++k) _Pragma("unroll") for (int n = 0; n < 2; ++n) _Pragma("unroll") for (int m = 0; m < 4; ++m) \
        mma16(acc[ai][bj][m][n], Bt[n][k], At[m][k]); __builtin_amdgcn_s_setprio(0); } while (0)
#elif MMA_ORDER == 3
#define PG8_MMA(ai, bj, At, Bt) do { __builtin_amdgcn_s_setprio(1); _Pragma("unroll") for (int m = 0; m < 4; ++m) _Pragma("unroll") for (int nn = 0; nn < 2; ++nn) _Pragma("unroll") for (int kk = 0; kk < 2; ++kk) { \
        const int n = (m & 1) ? 1 - nn : nn, k = ((nn + (m & 1)) & 1) ? 1 - kk : kk; \
        mma16(acc[ai][bj][m][n], Bt[n][k], At[m][k]); } __builtin_amdgcn_s_setprio(0); } while (0)
#elif MMA_ORDER == 4
#define PG8_MMA(ai, bj, At, Bt) do { __builtin_amdgcn_s_setprio(1); _Pragma("unroll") for (int n = 0; n < 2; ++n) _Pragma("unroll") for (int m = 0; m < 4; ++m) _Pragma("unroll") for (int k = 0; k < 2; ++k) \
        mma16(acc[ai][bj][m][n], Bt[n][k], At[m][k]); __builtin_amdgcn_s_setprio(0); } while (0)
#elif MMA_ORDER == 5
#define PG8_MMA(ai, bj, At, Bt) do { __builtin_amdgcn_s_setprio(1); _Pragma("unroll") for (int m = 0; m < 4; ++m) _Pragma("unroll") for (int k = 0; k < 2; ++k) _Pragma("unroll") for (int n = 0; n < 2; ++n) \
        mma16(acc[ai][bj][m][n], Bt[n][k], At[m][k]); __builtin_amdgcn_s_setprio(0); } while (0)
#else
#define PG8_MMA(ai, bj, At, Bt) do { __builtin_amdgcn_s_setprio(1); _Pragma("unroll") for (int k = 0; k < 2; ++k) _Pragma("unroll") for (int m = 0; m < 4; ++m) _Pragma("unroll") for (int n = 0; n < 2; ++n) \
        mma16(acc[ai][bj][m][n], Bt[n][k], At[m][k]); __builtin_amdgcn_s_setprio(0); } while (0)
#endif
#define PG8_WAIT_V(n) asm volatile("s_waitcnt vmcnt(" #n ")" ::: "memory")
#define PG8_WAIT_L(n) asm volatile("s_waitcnt lgkmcnt(" #n ")" ::: "memory")
#define PG8_BAR __builtin_amdgcn_s_barrier()
#define PG8_SCHED __builtin_amdgcn_sched_barrier(0)
    Unit cur, nxt; int ui = 0;
    if (!S.next(0, cur)) return;
    typedef typename Epi::acc_t acc_t;
    acc_t acc[2][2][4][2];
#pragma unroll
    for (int a = 0; a < 2; ++a)
#pragma unroll
        for (int b = 0; b < 2; ++b)
#pragma unroll
            for (int m = 0; m < 4; ++m)
#pragma unroll
                for (int n = 0; n < 2; ++n) acc[a][b][m][n] = (acc_t){0, 0, 0, 0};
    bf16x8 At[4][2], B0[2][2], B1[2][2];
    const char* cA = (const char*)g.A + (size_t)cur.pm * tstep; const char* cB = (const char*)g.Bt + (size_t)cur.pn * tstep;
    S.a_ready(cur);
    if constexpr (SP2) {
        PG8_STAGE(PG8_SB(0, 0), cB, voffB); PG8_STAGE(PG8_SB(0, 1), cB + hstep, voffB); PG8_STAGE(PG8_SA(0, 0), cA, voffA); PG8_STAGE(PG8_SA(0, 1), cA + hstep, voffA);
        if (wr == 1) PG8_BAR;
        PG8_WAIT_V(2); PG8_BAR;
        PG8_STAGE(PG8_SB(1, 0), cB + kstep, voffB); PG8_STAGE(PG8_SA(1, 0), cA + kstep, voffA); PG8_STAGE(PG8_SB(1, 1), cB + hstep + kstep, voffB);
        PG8_WAIT_V(6); PG8_BAR;
    } else {
        PG8_STAGE(PG8_SB(0, 0), cB, voffB); PG8_STAGE(PG8_SA(0, 0), cA, voffA); PG8_STAGE(PG8_SB(0, 1), cB + hstep, voffB); PG8_STAGE(PG8_SA(0, 1), cA + hstep, voffA);
        if (wr == 1) PG8_BAR;
        PG8_WAIT_V(4); PG8_BAR;
        PG8_STAGE(PG8_SB(1, 0), cB + kstep, voffB); PG8_STAGE(PG8_SA(1, 0), cA + kstep, voffA); PG8_STAGE(PG8_SB(1, 1), cB + hstep + kstep, voffB);
        PG8_WAIT_V(6); PG8_BAR;
    }
    for (;;) {
        const bool has_next = S.next(ui + 1, nxt);
        const char* nA = has_next ? (const char*)g.A + (size_t)nxt.pm * tstep : cA; const char* nB = has_next ? (const char*)g.Bt + (size_t)nxt.pn * tstep : cB;
        for (int t = 0; t < nt; t += 2) {
            const bool last = (t == nt - 2);
            const char* a1 = cA + (size_t)(t + 1) * kstep;
            const char* a2 = last ? nA : cA + (size_t)(t + 2) * kstep; const char* b2 = last ? nB : cB + (size_t)(t + 2) * kstep;
            const char* a3 = a2 + kstep; const char* b3 = b2 + kstep;
            if (last && has_next) S.a_ready(nxt);
            if constexpr (SP2) {
            PG8_LDB(B0, 0, 0); PG8_LDB(B1, 0, 1); PG8_SCHED; PG8_LDA(At, 0, 0); PG8_STAGE(PG8_SA(1, 1), a1 + hstep, voffA);
            PG8_WAIT_V(8); PG8_WAIT_L(0); PG8_BAR; PG8_MMA(0, 0, At, B0); PG8_MMA(0, 1, At, B1); PG8_BAR; PG8_SCHED;
            PG8_LDA(At, 0, 1); PG8_STAGE(PG8_SB(0, 0), b2, voffB); PG8_STAGE(PG8_SB(0, 1), b2 + hstep, voffB); PG8_STAGE(PG8_SA(0, 0), a2, voffA);
            PG8_WAIT_V(8); PG8_WAIT_L(0); PG8_BAR; PG8_MMA(1, 0, At, B0); PG8_MMA(1, 1, At, B1); PG8_BAR; PG8_SCHED;
            PG8_LDB(B0, 1, 0); PG8_LDB(B1, 1, 1); PG8_SCHED; PG8_LDA(At, 1, 0); PG8_STAGE(PG8_SA(0, 1), a2 + hstep, voffA);
            PG8_WAIT_V(8); PG8_WAIT_L(0); PG8_BAR; PG8_MMA(0, 0, At, B0); PG8_MMA(0, 1, At, B1); PG8_BAR; PG8_SCHED;
            PG8_LDA(At, 1, 1); PG8_STAGE(PG8_SB(1, 0), b3, voffB); PG8_STAGE(PG8_SB(1, 1), b3 + hstep, voffB); PG8_STAGE(PG8_SA(1, 0), a3, voffA);
            PG8_WAIT_V(8); PG8_WAIT_L(0); PG8_BAR; PG8_MMA(1, 0, At, B0); PG8_MMA(1, 1, At, B1); PG8_BAR; PG8_SCHED;
            } else {
            PG8_LDB(B0, 0, 0); PG8_SCHED; PG8_LDA(At, 0, 0); PG8_STAGE(PG8_SA(1, 1), a1 + hstep, voffA);
            PG8_WAIT_L(8); PG8_BAR; PG8_WAIT_L(0); PG8_MMA(0, 0, At, B0); PG8_BAR; PG8_SCHED;
            PG8_LDB(B1, 0, 1); PG8_STAGE(PG8_SB(0, 0), b2, voffB);
            PG8_BAR; PG8_WAIT_L(0); PG8_MMA(0, 1, At, B1); PG8_BAR;
            PG8_LDA(At, 0, 1); PG8_STAGE(PG8_SA(0, 0), a2, voffA);
            PG8_BAR; PG8_WAIT_L(0); PG8_MMA(1, 0, At, B0); PG8_BAR; PG8_SCHED;
            PG8_STAGE(PG8_SB(0, 1), b2 + hstep, voffB);
            PG8_WAIT_V(6); PG8_BAR; PG8_MMA(1, 1, At, B1); PG8_BAR;
            PG8_LDB(B0, 1, 0); PG8_SCHED; PG8_LDA(At, 1, 0); PG8_STAGE(PG8_SA(0, 1), a2 + hstep, voffA);
            PG8_WAIT_L(8); PG8_BAR; PG8_WAIT_L(0); PG8_MMA(0, 0, At, B0); PG8_BAR; PG8_SCHED;
            PG8_LDB(B1, 1, 1); PG8_STAGE(PG8_SB(1, 0), b3, voffB);
            PG8_BAR; PG8_WAIT_L(0); PG8_MMA(0, 1, At, B1); PG8_BAR;
            PG8_LDA(At, 1, 1); PG8_STAGE(PG8_SA(1, 0), a3, voffA);
            PG8_BAR; PG8_WAIT_L(0); PG8_MMA(1, 0, At, B0); PG8_BAR; PG8_SCHED;
            PG8_STAGE(PG8_SB(1, 1), b3 + hstep, voffB);
            PG8_WAIT_V(6); PG8_BAR; PG8_MMA(1, 1, At, B1); PG8_BAR;
            }
        }
        if constexpr (ALIGN_EPI) { if (wr == 0) PG8_BAR; }
        if constexpr (!Epi::AFTER_DRAIN) { E(acc, cur, wr, wc, fr, fq); S.done(cur); }
        if (!has_next) break;
#pragma unroll
        for (int a = 0; a < 2; ++a)
#pragma unroll
            for (int b = 0; b < 2; ++b)
#pragma unroll
                for (int m = 0; m < 4; ++m)
#pragma unroll
                    for (int n = 0; n < 2; ++n) acc[a][b][m][n] = (acc_t){0, 0, 0, 0};
        cur = nxt; cA = nA; cB = nB; ++ui;
        if constexpr (ALIGN_EPI) { if (wr == 1) PG8_BAR; }
    }
    PG8_WAIT_V(0);
    if constexpr (!ALIGN_EPI) { if (wr == 0) PG8_BAR; }
    PG8_BAR;
    if constexpr (Epi::AFTER_DRAIN) { E.fused(acc, cur, wr, wc, fr, fq, lds, wid, lane); S.done(cur); }
#undef PG8_SA
#undef PG8_SB
#undef PG8_STAGE
#undef PG8_LDA
#undef PG8_LDB
#undef PG8_MMA
#undef PG8_WAIT_V
#undef PG8_WAIT_L
#undef PG8_BAR
#undef PG8_SCHED
}
}
#ifndef PG8_SP2
#define PG8_SP2 true
#endif
#ifndef PG8_ALIGN
#define PG8_ALIGN true
#endif
constexpr int NWAVES = 8;
#ifndef MK_N_LAUNCHES
#define MK_N_LAUNCHES 1
#endif
constexpr int N_PHASES = 11;
constexpr int N_LAUNCHES = MK_N_LAUNCHES;

constexpr int D = 4096, NB = 4, SEQ = 2048, M = NB * SEQ, CTXL = 256, MC = NB * CTXL, MT = M + MC;
constexpr int HD = 128, NAH = 16, NAW = 2048, CVW = 2048, INC = 12288, FF = 11008, NMODC = 6 * D;
constexpr int GRIDW = 64, ROWS = 32, NAKH = 8, NAKW = 16;
constexpr float EPS = 1e-6f, LOG2E = 1.44269504089f;
enum { I_X = 0, I_C, I_CTX, I_CCTX, I_ADAW, I_ADAB, I_N1G, I_WIN, I_CONVW, I_RPB, I_GNG, I_WOUT, I_N2G, I_WGU, I_WDN, I_FNG, N_IN };

constexpr size_t MiB = 1u << 20;
constexpr size_t WS_CTL = 0, WS_MOD = 1 * MiB, CTL_ZERO_BYTES = 2 * MiB;
constexpr size_t WS_SSQ = 1536 * 1024;
constexpr size_t WS_CMAXD = 1600 * 1024;
constexpr size_t WS_ROPE = 2 * MiB;
constexpr size_t WS_RSA = 2 * MiB + 256 * 1024;
constexpr size_t WS_RSH = 2 * MiB + 64 * 1024, WS_CSW = 2 * MiB + 128 * 1024;
constexpr size_t WS_WIN = 4 * MiB, WS_WOUT = 100 * MiB, WS_WGU = 132 * MiB, WS_WDN = 304 * MiB;
constexpr size_t WS_H = 390 * MiB;
constexpr size_t WS_Q = 462 * MiB;
constexpr size_t WS_K = 494 * MiB;
constexpr size_t WS_V = 530 * MiB;
constexpr size_t WS_C = 566 * MiB;
constexpr size_t WS_AO = 662 * MiB;
constexpr size_t WS_Y = 694 * MiB;
constexpr size_t WS_X1 = 758 * MiB;
constexpr size_t WS_ACT = 886 * MiB;
constexpr size_t WS_END = 1058 * MiB;
static_assert(WS_WIN + (size_t)INC * D * 2 <= WS_WOUT && WS_WOUT + (size_t)D * D * 2 <= WS_WGU && WS_WGU + (size_t)2 * FF * D * 2 <= WS_WDN && WS_WDN + (size_t)D * FF * 2 <= WS_H, "ws map (weights)");
static_assert(WS_H + (size_t)MT * D * 2 <= WS_Q && WS_Q + (size_t)M * NAW * 2 <= WS_K && WS_K + (size_t)MT * NAW * 2 <= WS_V && WS_V + (size_t)MT * NAW * 2 <= WS_C && WS_C + (size_t)M * 6144 * 2 <= WS_AO, "ws map (acts 1)");
static_assert(WS_AO + (size_t)M * NAW * 2 <= WS_Y && WS_Y + (size_t)M * D * 2 <= WS_X1 && WS_X1 + (size_t)M * D * 4 <= WS_ACT && WS_ACT + (size_t)M * FF * 2 <= WS_END, "ws map (acts 2)");
constexpr int CW_XRANK = 1024;
constexpr int CW_BAR = 4096;

#ifndef P0_DN_ITEMS
#define P0_DN_ITEMS 8192
#endif
#ifndef P0_OUT_ITEMS
#define P0_OUT_ITEMS 0
#endif
#ifndef DNQ_COOP
#define DNQ_COOP 1
#endif
#ifndef TAIL2_DN_ITEMS
#define TAIL2_DN_ITEMS 22016
#endif
#ifndef P0_GUQ_BLOCKS
#define P0_GUQ_BLOCKS 0
#endif
#ifndef P0_GU_ITEMS
#define P0_GU_ITEMS 0
#endif
constexpr int RING_OFF = 0, RING_BYTES = 131072;
constexpr int LDSCTL_OFF = RING_BYTES, MISC_OFF = LDSCTL_OFF + 320;
constexpr int LDS_BYTES = 147456;
static_assert(MISC_OFF + 128 <= LDS_BYTES, "LDS map");

#define GAS __attribute__((address_space(1)))
#define LAS __attribute__((address_space(3)))
typedef unsigned short bf16;
typedef unsigned v4u __attribute__((ext_vector_type(4)));
typedef float f32x4 __attribute__((ext_vector_type(4)));
typedef short bf16x8 __attribute__((ext_vector_type(8)));
typedef GAS unsigned gu32;
typedef GAS unsigned long long gu64;
#define RLX_AGENT __ATOMIC_RELAXED, __HIP_MEMORY_SCOPE_AGENT
#define LDS_WAIT() asm volatile("s_waitcnt lgkmcnt(0)" ::: "memory")
#define VM_WAIT() asm volatile("s_waitcnt vmcnt(0)" ::: "memory")
__device__ __forceinline__ unsigned long long rt() { return __builtin_amdgcn_s_memrealtime(); }
__device__ __forceinline__ unsigned f2bf(float f) { unsigned u = __builtin_bit_cast(unsigned, f); return (u + 0x7fffu + ((u >> 16) & 1u)) >> 16; }
__device__ __forceinline__ unsigned pk2(float lo, float hi) { return f2bf(lo) | (f2bf(hi) << 16); }

#define XB_TMO      128
#define XB_XCNT(j)  (256  + 64 * (j))
#define XB_XSUB(j)  (1280 + 64 * (j))
#define XB_XGEN(j)  (2304 + 64 * (j))
#define XB_TOP      3328
#define XB_TOPGEN   3392
#define XCD_BAR_WORDS 3456
#define XB_SPIN_CAP (1u << 18)

__device__ __forceinline__ unsigned xb_ld(unsigned* p)              { return __hip_atomic_load(p, __ATOMIC_RELAXED, __HIP_MEMORY_SCOPE_AGENT); }
__device__ __forceinline__ unsigned xb_add(unsigned* p, unsigned v) { return __hip_atomic_fetch_add(p, v, __ATOMIC_RELAXED, __HIP_MEMORY_SCOPE_AGENT); }
__device__ __forceinline__ unsigned xb_xcc_id() { return (unsigned)__builtin_amdgcn_s_getreg((3 << 11) | 20) & 0xFu; }
#define XB_SPIN(cond, bar) do { unsigned _sp = 0; while (cond) { __builtin_amdgcn_s_sleep(1); \
    if ((++_sp & 255u) == 0u) { if (xb_ld(&(bar)[XB_TMO])) break; if (_sp > XB_SPIN_CAP) { atomicAdd(&(bar)[XB_TMO], 1u); break; } } } } while (0)

struct XcdBarrier {
    unsigned* bar; unsigned x;
    volatile LAS unsigned* st;
};

__device__ __forceinline__ XcdBarrier xcd_barrier_post(unsigned* bar, volatile LAS unsigned* st) {
    XcdBarrier b; b.bar = bar; b.x = xb_xcc_id(); b.st = st;
    if (threadIdx.x == 0) (void)xb_add(&bar[XB_XCNT(b.x)], 1u);
    return b;
}
__device__ __forceinline__ void xcd_barrier_complete(unsigned* bar, unsigned x, unsigned& nloc, unsigned& nx) {
    const unsigned G = gridDim.x * gridDim.y * gridDim.z;
    unsigned sum, cnt, mine, sp = 0u;
    for (;;) {
        sum = 0u; cnt = 0u; mine = 0u;
#pragma unroll
        for (unsigned j = 0; j < 16; ++j) { const unsigned c = xb_ld(&bar[XB_XCNT(j)]); sum += c; cnt += (c > 0u) ? 1u : 0u; mine = (j == x) ? c : mine; }
        if (sum == G) break;
        __builtin_amdgcn_s_sleep(1);
        if ((++sp & 255u) == 0u) { if (xb_ld(&bar[XB_TMO])) break; if (sp > XB_SPIN_CAP) { atomicAdd(&bar[XB_TMO], 1u); break; } }
    }
    nloc = mine > 0u ? mine : 1u; nx = cnt > 0u ? cnt : 1u;
}

__device__ __forceinline__ void xcd_barrier(const XcdBarrier& b) {
    asm volatile("s_waitcnt vmcnt(0)" ::: "memory");
    __syncthreads();
    if (threadIdx.x == 0) {
        unsigned* bar = b.bar;
        __builtin_amdgcn_s_waitcnt(0);
        unsigned nloc = b.st[0], nx = b.st[1];
        if (nloc == 0u) { xcd_barrier_complete(bar, b.x, nloc, nx); b.st[0] = nloc; b.st[1] = nx; }
        const unsigned old = xb_add(&bar[XB_XSUB(b.x)], 1u);
        const unsigned gen = old / nloc;
        if (old + 1u == (gen + 1u) * nloc) {
            __builtin_amdgcn_fence(__ATOMIC_RELEASE, "agent");
            asm volatile("s_waitcnt vmcnt(0)" ::: "memory");
            const unsigned og = xb_add(&bar[XB_TOP], 1u);
            const unsigned tg = og / nx;
            if (og + 1u == (tg + 1u) * nx) xb_add(&bar[XB_TOPGEN], 1u);
            else XB_SPIN(xb_ld(&bar[XB_TOPGEN]) == tg, bar);
            __builtin_amdgcn_fence(__ATOMIC_ACQUIRE, "agent");
            xb_add(&bar[XB_XGEN(b.x)], 1u);
            asm volatile("s_waitcnt vmcnt(0)" ::: "memory");
        } else {
            XB_SPIN(xb_ld(&bar[XB_XGEN(b.x)]) == gen, bar);
            __builtin_amdgcn_fence(__ATOMIC_ACQUIRE, "agent");
            asm volatile("s_waitcnt vmcnt(0)" ::: "memory");
        }
    }
    __syncthreads();
}

typedef float f32x16 __attribute__((ext_vector_type(16)));
typedef unsigned v2u __attribute__((ext_vector_type(2)));
struct Frame {
    LAS unsigned char* lds;
    volatile LAS unsigned* MISC;
    gu32* ctl;
    int tid, lane, wave, vcu, G;
    const float* in[N_IN]; float* out;
    float* mod; float* rope;
    bf16 *Win_t, *Wout_t, *Wgu_t, *Wdn_t;
    bf16 *HB, *QB, *KB, *VB, *CB, *YB, *ACT, *MX, *FX; float* ssq; signed char *HQ, *Wgu_q, *ACTQ, *Wdn_q; float *rsH, *csW, *rsA; unsigned* cmaxD;
};
template <int CTRL> __device__ __forceinline__ float dpp_add(float v) { return v + __builtin_bit_cast(float, __builtin_amdgcn_update_dpp(0, __builtin_bit_cast(int, v), CTRL, 0xf, 0xf, true)); }
__device__ __forceinline__ float wave_sum(float v) {
    v = dpp_add<0xB1>(v); v = dpp_add<0x4E>(v); v = dpp_add<0x141>(v); v = dpp_add<0x140>(v);
    v += __builtin_bit_cast(float, __builtin_amdgcn_ds_swizzle(__builtin_bit_cast(int, v), 0x401F));
    return __builtin_bit_cast(float, __builtin_amdgcn_readlane(__builtin_bit_cast(int, v), 0)) + __builtin_bit_cast(float, __builtin_amdgcn_readlane(__builtin_bit_cast(int, v), 32));
}
template <int CTRL> __device__ __forceinline__ float dpp_max(float v) { return fmaxf(v, __builtin_bit_cast(float, __builtin_amdgcn_update_dpp(0, __builtin_bit_cast(int, v), CTRL, 0xf, 0xf, true))); }
__device__ __forceinline__ float wave_max(float v) {
    v = dpp_max<0xB1>(v); v = dpp_max<0x4E>(v); v = dpp_max<0x141>(v); v = dpp_max<0x140>(v);
    v = fmaxf(v, __builtin_bit_cast(float, __builtin_amdgcn_ds_swizzle(__builtin_bit_cast(int, v), 0x401F)));
    return fmaxf(__builtin_bit_cast(float, __builtin_amdgcn_readlane(__builtin_bit_cast(int, v), 0)), __builtin_bit_cast(float, __builtin_amdgcn_readlane(__builtin_bit_cast(int, v), 32)));
}
__device__ __forceinline__ unsigned pkbf(float lo, float hi) { return pg8::pkbf(lo, hi); }
__device__ __forceinline__ unsigned pkq4(float a, float b, float c, float d) {
    a = fminf(fmaxf(a, -127.f), 127.f); b = fminf(fmaxf(b, -127.f), 127.f); c = fminf(fmaxf(c, -127.f), 127.f); d = fminf(fmaxf(d, -127.f), 127.f);
    const int ia = (int)__builtin_rintf(a), ib = (int)__builtin_rintf(b), ic = (int)__builtin_rintf(c), id = (int)__builtin_rintf(d);
    return (unsigned)(ia & 0xff) | ((unsigned)(ib & 0xff) << 8) | ((unsigned)(ic & 0xff) << 16) | ((unsigned)id << 24);
}
__device__ __forceinline__ float bflo(unsigned w) { return __builtin_bit_cast(float, w << 16); }
__device__ __forceinline__ float bfhi(unsigned w) { return __builtin_bit_cast(float, w & 0xffff0000u); }

__device__ __forceinline__ int map_in(int n) {
    if (n < 4096) { const int hd = n & ~127, d = n & 127, blk = d >> 6, e4 = (d >> 5) & 1, i = d & 31; return hd + 64 * blk + 8 * (i >> 2) + 4 * e4 + (i & 3); }
    if (n < 6144) return n;
    const int kind = (n - 6144) >> 11, c = (n - 6144) & 2047;
    if (kind == 1) return 10240 + c;
    return 6144 + 256 * (c >> 7) + (kind == 2 ? 128 : 0) + (c & 127);
}
__device__ __forceinline__ int map_gu(int n) { const int up = n >= FF ? 1 : 0, jx = up ? n - FF : n; return 256 * (jx >> 7) + 128 * up + (jx & 127); }
#ifndef TR_NT
#define TR_NT 1
#endif
#ifndef TR_NT_ST
#define TR_NT_ST 1
#endif
#if TR_NT
#define TR_LOAD(p) __builtin_nontemporal_load(p)
#else
#define TR_LOAD(p) (*(p))
#endif
#if TR_NT_ST
#define TR_STORE(v, p) __builtin_nontemporal_store((v), (p))
#else
#define TR_STORE(v, p) (*(p) = (v))
#endif
#ifndef W_DROP_BITS
#define W_DROP_BITS 0
#endif
__device__ __forceinline__ unsigned pkw(float lo, float hi) {
#if W_DROP_BITS > 0
    constexpr unsigned SH = 16 + W_DROP_BITS, HALF_ = (1u << (SH - 1)) - 1u, MASK = ~((1u << SH) - 1u);
    unsigned a = __builtin_bit_cast(unsigned, lo), b = __builtin_bit_cast(unsigned, hi);
    a = (a + HALF_ + ((a >> SH) & 1u)) & MASK; b = (b + HALF_ + ((b >> SH) & 1u)) & MASK;
    return (a >> 16) | (b & 0xffff0000u);
#else
    return pkbf(lo, hi);
#endif
}
template <int MAP> __device__ __forceinline__ void transpose_items(const float* W, int K, int N, bf16* WT, LAS float* scr, int first, int stride, int end, int lane, const float* kscale = nullptr) {
    const int nblk = N / 32;
    const GAS float* Wl = (const GAS float*)W + (size_t)(lane >> 3) * N + 4 * (lane & 7);
    LAS float* sw = scr + (lane >> 3) * 33 + 4 * (lane & 7);
    const int c = lane & 7;
    f32x4 v[8];
    int it = first;
    if (it < end) { const GAS float* Wg = Wl + (size_t)(64 * (it / nblk)) * N + 32 * (it % nblk);
#pragma unroll
        for (int i = 0; i < 8; ++i) v[i] = TR_LOAD((const GAS f32x4*)(Wg + (size_t)(8 * i) * N)); }
    while (it < end) {
        const int k0 = 64 * (it / nblk), n0 = 32 * (it % nblk);
#pragma unroll
        for (int i = 0; i < 8; ++i) { sw[(8 * i) * 33 + 0] = v[i].x; sw[(8 * i) * 33 + 1] = v[i].y; sw[(8 * i) * 33 + 2] = v[i].z; sw[(8 * i) * 33 + 3] = v[i].w; }
        const int nx = it + stride;
        if (nx < end) { const GAS float* Wg = Wl + (size_t)(64 * (nx / nblk)) * N + 32 * (nx % nblk);
#pragma unroll
            for (int i = 0; i < 8; ++i) v[i] = TR_LOAD((const GAS f32x4*)(Wg + (size_t)(8 * i) * N)); }
        LDS_WAIT(); asm volatile("" ::: "memory");
#pragma unroll
        for (int j = 0; j < 4; ++j) { const int n = (lane >> 3) + 8 * j; const LAS float* s = scr + (8 * c) * 33 + n;
            v4u o;
            if (MAP == 3) { const f32x4 g0 = *(const GAS f32x4*)(kscale + k0 + 8 * c), g1 = *(const GAS f32x4*)(kscale + k0 + 8 * c + 4);
                o.x = pkw(s[0 * 33] * g0.x, s[1 * 33] * g0.y); o.y = pkw(s[2 * 33] * g0.z, s[3 * 33] * g0.w); o.z = pkw(s[4 * 33] * g1.x, s[5 * 33] * g1.y); o.w = pkw(s[6 * 33] * g1.z, s[7 * 33] * g1.w); }
            else if (MAP == 6 || MAP == 7 || MAP == 8) { float t[8];
#pragma unroll
                for (int e = 0; e < 8; ++e) t[e] = s[e * 33];
#pragma unroll
                for (int st = 1; st < 8; st <<= 1)
#pragma unroll
                    for (int e = 0; e < 8; ++e) if (!(e & st)) { const float a = t[e], b = t[e ^ st]; t[e] = a + b; t[e ^ st] = a - b; }
#pragma unroll
                for (int e = 0; e < 8; ++e) { const float p = __builtin_bit_cast(float, __builtin_amdgcn_update_dpp(0, __builtin_bit_cast(int, t[e]), 0xB1, 0xf, 0xf, true)); t[e] = (c & 1) ? p - t[e] : t[e] + p; }
#pragma unroll
                for (int e = 0; e < 8; ++e) { const float p = __builtin_bit_cast(float, __builtin_amdgcn_update_dpp(0, __builtin_bit_cast(int, t[e]), 0x4E, 0xf, 0xf, true)); t[e] = ((c & 2) ? p - t[e] : t[e] + p) * 0.17677669529663687f; }
                if (MAP == 7) {
                    float a = 0.f;
#pragma unroll
                    for (int e = 0; e < 8; ++e) a = fmaxf(a, fabsf(t[e]));
                    a = dpp_max<0xB1>(a); a = dpp_max<0x4E>(a); a = dpp_max<0x141>(a);
                    if (c == 0) atomicMax((unsigned*)kscale + (n0 + n), __builtin_bit_cast(unsigned, a));
                    continue; }
                if (MAP == 8) {
                    const float am = __builtin_bit_cast(float, __hip_atomic_load((const GAS unsigned*)kscale + (n0 + n), __ATOMIC_RELAXED, __HIP_MEMORY_SCOPE_AGENT)), q = am > 0.f ? 127.0f / am : 0.f;
                    if (c == 0 && k0 == 0) ((GAS float*)kscale)[4096 + n0 + n] = am * (1.0f / 127.0f);
#if defined(FAKEQ_DN)
                    { const float dq = am * (1.0f / 127.0f);
#pragma unroll
                      for (int e = 0; e < 8; ++e) t[e] = __builtin_rintf(fminf(fmaxf(t[e] * q, -127.f), 127.f)) * dq;
                      o.x = pkw(t[0], t[1]); o.y = pkw(t[2], t[3]); o.z = pkw(t[4], t[5]); o.w = pkw(t[6], t[7]);
                      TR_STORE(o, (GAS v4u*)(WT + (size_t)(n0 + n) * K + k0 + 8 * c)); continue; }
#endif
                    v2u o8; o8.x = pkq4(t[0] * q, t[1] * q, t[2] * q, t[3] * q); o8.y = pkq4(t[4] * q, t[5] * q, t[6] * q, t[7] * q);
                    __builtin_nontemporal_store(o8, (GAS v2u*)((signed char*)WT + (size_t)(n0 + n) * K + k0 + 8 * c));
                    continue; }
                o.x = pkw(t[0], t[1]); o.y = pkw(t[2], t[3]); o.z = pkw(t[4], t[5]); o.w = pkw(t[6], t[7]); }
            else { o.x = pkw(s[0 * 33], s[1 * 33]); o.y = pkw(s[2 * 33], s[3 * 33]); o.z = pkw(s[4 * 33], s[5 * 33]); o.w = pkw(s[6 * 33], s[7 * 33]); }
            const int nsrc = n0 + n, nd = MAP == 1 ? map_in(nsrc) : (MAP == 2 ? map_gu(nsrc) : nsrc);
            TR_STORE(o, (GAS v4u*)(WT + (size_t)nd * K + k0 + 8 * c)); }
        LDS_WAIT(); asm volatile("" ::: "memory");
        it = nx;
    }
}
constexpr int IT_IN = (D / 64) * (INC / 32), IT_OUT = (D / 64) * (D / 32), IT_GU = (D / 64) * (2 * FF / 32), IT_DN = (FF / 64) * (D / 32);
__device__ __forceinline__ void quant_gu_block(Frame& F, int nb) {
    const int lane = F.lane, N = 2 * FF, nblk = N / 32, n0 = 32 * nb, K = D;
    LAS float* scr = (LAS float*)(F.lds + RING_OFF + F.wave * 16384);
    LAS float* red = (LAS float*)(F.lds + RING_OFF + 12288);
    const GAS float* Wl = (const GAS float*)F.in[I_WGU] + (size_t)(lane >> 3) * N + n0 + 4 * (lane & 7);
    f32x4 m4 = {0.f, 0.f, 0.f, 0.f};
    for (int kb = F.wave; kb < 64; kb += 8) { const GAS float* Wg = Wl + (size_t)(64 * kb) * N;
#pragma unroll
        for (int i = 0; i < 8; ++i) { const f32x4 v = *(const GAS f32x4*)(Wg + (size_t)(8 * i) * N);
            m4.x = fmaxf(m4.x, fabsf(v.x)); m4.y = fmaxf(m4.y, fabsf(v.y)); m4.z = fmaxf(m4.z, fabsf(v.z)); m4.w = fmaxf(m4.w, fabsf(v.w)); } }
#pragma unroll
    for (int o = 8; o < 64; o <<= 1) { m4.x = fmaxf(m4.x, __shfl_xor(m4.x, o)); m4.y = fmaxf(m4.y, __shfl_xor(m4.y, o)); m4.z = fmaxf(m4.z, __shfl_xor(m4.z, o)); m4.w = fmaxf(m4.w, __shfl_xor(m4.w, o)); }
    if (lane < 8) *(LAS f32x4*)(red + F.wave * 32 + 4 * lane) = m4;
    __syncthreads();
    float qinv[4];
#pragma unroll
    for (int j = 0; j < 4; ++j) { const int n = (lane >> 3) + 8 * j; float a = 0.f;
#pragma unroll
        for (int w = 0; w < 8; ++w) a = fmaxf(a, red[w * 32 + n]);
        qinv[j] = a > 0.f ? 127.0f / a : 0.f;
        if (F.wave == 0 && (lane & 7) == 0) F.csW[map_gu(n0 + n)] = a * (1.0f / 127.0f); }
    LAS float* sw = scr + (lane >> 3) * 33 + 4 * (lane & 7);
    const int c = lane & 7;
    f32x4 v[8];
    int kb = F.wave;
    { const GAS float* Wg = Wl + (size_t)(64 * kb) * N;
#pragma unroll
      for (int i = 0; i < 8; ++i) v[i] = *(const GAS f32x4*)(Wg + (size_t)(8 * i) * N); }
    while (kb < 64) {
        const int k0 = 64 * kb;
#pragma unroll
        for (int i = 0; i < 8; ++i) { sw[(8 * i) * 33 + 0] = v[i].x; sw[(8 * i) * 33 + 1] = v[i].y; sw[(8 * i) * 33 + 2] = v[i].z; sw[(8 * i) * 33 + 3] = v[i].w; }
        const int nx = kb + 8;
        if (nx < 64) { const GAS float* Wg = Wl + (size_t)(64 * nx) * N;
#pragma unroll
            for (int i = 0; i < 8; ++i) v[i] = *(const GAS f32x4*)(Wg + (size_t)(8 * i) * N); }
        LDS_WAIT(); asm volatile("" ::: "memory");
#pragma unroll
        for (int j = 0; j < 4; ++j) { const int n = (lane >> 3) + 8 * j; const LAS float* s = scr + (8 * c) * 33 + n; const float q = qinv[j];
            v2u o; o.x = pkq4(s[0 * 33] * q, s[1 * 33] * q, s[2 * 33] * q, s[3 * 33] * q); o.y = pkq4(s[4 * 33] * q, s[5 * 33] * q, s[6 * 33] * q, s[7 * 33] * q);
            __builtin_nontemporal_store(o, (GAS v2u*)(F.Wgu_q + (size_t)map_gu(n0 + n) * K + k0 + 8 * c)); }
        LDS_WAIT(); asm volatile("" ::: "memory");
        kb = nx;
    }
    __syncthreads();
}
#define QDN_LOAD(KB) do { const GAS float* Wg_ = Wl + (size_t)(64 * (KB)) * N; _Pragma("unroll") for (int i = 0; i < 8; ++i) v[i] = *(const GAS f32x4*)(Wg_ + (size_t)(8 * i) * N); } while (0)
#define QDN_TILE() do { _Pragma("unroll") for (int i = 0; i < 8; ++i) { sw[(8 * i) * 33 + 0] = v[i].x; sw[(8 * i) * 33 + 1] = v[i].y; sw[(8 * i) * 33 + 2] = v[i].z; sw[(8 * i) * 33 + 3] = v[i].w; } } while (0)
#define QDN_ROT(J) float t[8]; { const LAS float* s_ = scr + (8 * c) * 33 + (lane >> 3) + 8 * (J); \
        _Pragma("unroll") for (int e = 0; e < 8; ++e) t[e] = s_[e * 33]; \
        _Pragma("unroll") for (int st = 1; st < 8; st <<= 1) _Pragma("unroll") for (int e = 0; e < 8; ++e) if (!(e & st)) { const float a_ = t[e], b_ = t[e ^ st]; t[e] = a_ + b_; t[e ^ st] = a_ - b_; } \
        _Pragma("unroll") for (int e = 0; e < 8; ++e) { const float p_ = __builtin_bit_cast(float, __builtin_amdgcn_update_dpp(0, __builtin_bit_cast(int, t[e]), 0xB1, 0xf, 0xf, true)); t[e] = (c & 1) ? p_ - t[e] : t[e] + p_; } \
        _Pragma("unroll") for (int e = 0; e < 8; ++e) { const float p_ = __builtin_bit_cast(float, __builtin_amdgcn_update_dpp(0, __builtin_bit_cast(int, t[e]), 0x4E, 0xf, 0xf, true)); t[e] = ((c & 2) ? p_ - t[e] : t[e] + p_) * 0.17677669529663687f; } }
__device__ __forceinline__ void quant_dn_block(Frame& F, int nb) {
    const int lane = F.lane, N = D, K = FF, NKB = FF / 64, n0 = 32 * nb, c = lane & 7;
    LAS float* scr = (LAS float*)(F.lds + RING_OFF + F.wave * 16384);
    LAS float* red = (LAS float*)(F.lds + RING_OFF + 12288);
    LAS float* sw = scr + (lane >> 3) * 33 + 4 * (lane & 7);
    const GAS float* Wl = (const GAS float*)F.in[I_WDN] + (size_t)(lane >> 3) * N + n0 + 4 * (lane & 7);
    f32x4 v[8];
    float mx[4] = {0.f, 0.f, 0.f, 0.f};
    { int kb = F.wave; QDN_LOAD(kb);
      while (kb < NKB) { QDN_TILE(); const int nx = kb + 8; if (nx < NKB) QDN_LOAD(nx);
          LDS_WAIT(); asm volatile("" ::: "memory");
#pragma unroll
          for (int j = 0; j < 4; ++j) { QDN_ROT(j);
#pragma unroll
              for (int e = 0; e < 8; ++e) mx[j] = fmaxf(mx[j], fabsf(t[e])); }
          LDS_WAIT(); asm volatile("" ::: "memory"); kb = nx; } }
#pragma unroll
    for (int j = 0; j < 4; ++j) { float a = mx[j]; a = dpp_max<0xB1>(a); a = dpp_max<0x4E>(a); a = dpp_max<0x141>(a); if (c == 0) red[F.wave * 32 + (lane >> 3) + 8 * j] = a; }
    __syncthreads();
    float qinv[4];
#pragma unroll
    for (int j = 0; j < 4; ++j) { const int n = (lane >> 3) + 8 * j; float a = 0.f;
#pragma unroll
        for (int w = 0; w < 8; ++w) a = fmaxf(a, red[w * 32 + n]);
        qinv[j] = a > 0.f ? 127.0f / a : 0.f;
        if (F.wave == 0 && c == 0) ((float*)F.cmaxD)[4096 + n0 + n] = a * (1.0f / 127.0f); }
    { int kb = F.wave; QDN_LOAD(kb);
      while (kb < NKB) { const int k0 = 64 * kb; QDN_TILE(); const int nx = kb + 8; if (nx < NKB) QDN_LOAD(nx);
          LDS_WAIT(); asm volatile("" ::: "memory");
#pragma unroll
          for (int j = 0; j < 4; ++j) { QDN_ROT(j); const float q = qinv[j];
              v2u o8; o8.x = pkq4(t[0] * q, t[1] * q, t[2] * q, t[3] * q); o8.y = pkq4(t[4] * q, t[5] * q, t[6] * q, t[7] * q);
              __builtin_nontemporal_store(o8, (GAS v2u*)(F.Wdn_q + (size_t)(n0 + (lane >> 3) + 8 * j) * K + k0 + 8 * c)); }
          LDS_WAIT(); asm volatile("" ::: "memory"); kb = nx; } }
    __syncthreads();
}
#undef QDN_LOAD
#undef QDN_TILE
#undef QDN_ROT
__device__ __forceinline__ void p0_prologue(Frame& F, const float amul) {
    { const int gi = blockIdx.x * (NWAVES * 64) + F.tid;
      if (gi < 2048) { const int pos = gi >> 5, i = gi & 31; const float fr = exp2f(-(float)i * (13.287712379549449f / 32.0f)); const float ang = (float)pos * fr;
          F.rope[gi] = cosf(ang); F.rope[2048 + gi] = sinf(ang); } }
    { LAS float* sil = (LAS float*)(F.lds + RING_OFF);
      LAS float* red = (LAS float*)(F.lds + RING_OFF + 16384);
      const GAS float* aw = (const GAS float*)F.in[I_ADAW];
      for (int it = blockIdx.x; it < 768; it += F.G) {
          const int cs = it % 96, ks = it / 96, k0 = 512 * ks;
          for (int idx = F.tid; idx < 5 * 512; idx += NWAVES * 64) { const int bb = idx >> 9, kk = idx & 511;
              const float v = bb < 4 ? F.in[I_C][bb * D + k0 + kk] : F.in[I_CCTX][k0 + kk]; sil[idx] = v / (1.0f + __expf(-v)); }
          __syncthreads();
          f32x4 a0 = {0.f, 0.f, 0.f, 0.f}, a1 = a0, a2 = a0, a3 = a0, a4 = a0;
          const GAS float* wp = aw + (size_t)(k0 + F.wave) * NMODC + 256 * cs + 4 * F.lane;
#pragma unroll 8
          for (int i = 0; i < 64; ++i) { const f32x4 w = __builtin_nontemporal_load((const GAS f32x4*)(wp + (size_t)(8 * i) * NMODC)); const int k = F.wave + 8 * i;
              a0 += sil[k] * w; a1 += sil[512 + k] * w; a2 += sil[1024 + k] * w; a3 += sil[1536 + k] * w; a4 += sil[2048 + k] * w; }
          LAS f32x4* rw = (LAS f32x4*)(red + F.wave * 1280) + F.lane;
          rw[0] = a0; rw[64] = a1; rw[128] = a2; rw[192] = a3; rw[256] = a4;
          __syncthreads();
          for (int idx = F.tid; idx < 1280; idx += NWAVES * 64) { float s = 0.f;
#pragma unroll
              for (int w = 0; w < 8; ++w) s += red[w * 1280 + idx];
              const int bb = idx >> 8, cc = idx & 255, n = 256 * cs + cc;
              if (ks == 0) s += F.in[I_ADAB][n];
              atomicAdd(F.mod + bb * NMODC + n, s * amul); }
          __syncthreads();
      } }
    LAS float* scr = (LAS float*)(F.lds + RING_OFF + F.wave * 16384);
    const int gw = F.vcu * NWAVES + F.wave, NGW = F.G * NWAVES;
    transpose_items<1>(F.in[I_WIN], D, INC, F.Win_t, scr, gw, NGW, IT_IN, F.lane);
#if !DNQ_COOP
    transpose_items<7>(F.in[I_WDN], FF, D, F.Wdn_t, scr, gw, NGW, IT_DN, F.lane, (const float*)F.cmaxD);
#endif
    transpose_items<3>(F.in[I_WOUT], D, D, F.Wout_t, scr, gw, NGW, P0_OUT_ITEMS, F.lane, F.in[I_GNG]);
    if (P0_GUQ_BLOCKS > 0) { __syncthreads(); for (int nb = (int)blockIdx.x; nb < P0_GUQ_BLOCKS; nb += F.G) quant_gu_block(F, nb); }
}

__device__ __forceinline__ void norm_mod_row(const float* xrow, bf16* orow, const float* gain, const float* shift, const float* scale, int lane) {
    const GAS f32x4* xr = (const GAS f32x4*)xrow + lane;
    f32x4 v[16]; float ss = 0.f;
#pragma unroll
    for (int j = 0; j < 16; ++j) { v[j] = __builtin_nontemporal_load(xr + 64 * j); ss += (v[j].x * v[j].x + v[j].y * v[j].y) + (v[j].z * v[j].z + v[j].w * v[j].w); }
    const float rstd = 1.0f / sqrtf(wave_sum(ss) * (1.0f / D) + EPS);
    const GAS f32x4* g4 = (const GAS f32x4*)gain + lane; const GAS f32x4* sh4 = (const GAS f32x4*)shift + lane; const GAS f32x4* sc4 = (const GAS f32x4*)scale + lane;
    GAS v2u* o8 = (GAS v2u*)orow + lane;
#pragma unroll
    for (int j = 0; j < 16; ++j) { const f32x4 g = g4[64 * j], sh = sh4[64 * j], sc = sc4[64 * j];
        const f32x4 y = v[j] * rstd * g * (1.0f + sc) + sh; v2u w; w.x = pkbf(y.x, y.y); w.y = pkbf(y.z, y.w); o8[64 * j] = w; }
}

__device__ __forceinline__ void norm_mod_row_x1(const float* xrow, const bf16* mrow, bf16* orow, const float* gain, const float* shift, const float* scale, int lane) {
    const GAS f32x4* xr = (const GAS f32x4*)xrow + lane; const GAS v2u* mr = (const GAS v2u*)mrow + lane;
    f32x4 v[16]; float ss = 0.f;
#pragma unroll
    for (int j = 0; j < 16; ++j) { const f32x4 x = __builtin_nontemporal_load(xr + 64 * j); const v2u m = __builtin_nontemporal_load(mr + 64 * j);
        v[j] = (f32x4){x.x + bflo(m.x), x.y + bfhi(m.x), x.z + bflo(m.y), x.w + bfhi(m.y)};
        ss += (v[j].x * v[j].x + v[j].y * v[j].y) + (v[j].z * v[j].z + v[j].w * v[j].w); }
    const float rstd = 1.0f / sqrtf(wave_sum(ss) * (1.0f / D) + EPS);
    const GAS f32x4* g4 = (const GAS f32x4*)gain + lane; const GAS f32x4* sh4 = (const GAS f32x4*)shift + lane; const GAS f32x4* sc4 = (const GAS f32x4*)scale + lane;
    GAS v2u* o8 = (GAS v2u*)orow + lane;
#pragma unroll
    for (int j = 0; j < 16; ++j) { const f32x4 g = g4[64 * j], sh = sh4[64 * j], sc = sc4[64 * j];
        const f32x4 y = v[j] * rstd * g * (1.0f + sc) + sh; v2u w; w.x = pkbf(y.x, y.y); w.y = pkbf(y.z, y.w); o8[64 * j] = w; }
}

__device__ __forceinline__ void norm_mod_row_x1_q8(const float* xrow, const bf16* mrow, signed char* orow, float* rs_out, const float* gain, const float* shift, const float* scale, int lane) {
    const GAS f32x4* xr = (const GAS f32x4*)xrow + lane; const GAS v2u* mr = (const GAS v2u*)mrow + lane;
    f32x4 v[16]; float ss = 0.f;
#pragma unroll
    for (int j = 0; j < 16; ++j) { const f32x4 x = __builtin_nontemporal_load(xr + 64 * j); const v2u m = __builtin_nontemporal_load(mr + 64 * j);
        v[j] = (f32x4){x.x + bflo(m.x), x.y + bfhi(m.x), x.z + bflo(m.y), x.w + bfhi(m.y)};
        ss += (v[j].x * v[j].x + v[j].y * v[j].y) + (v[j].z * v[j].z + v[j].w * v[j].w); }
    const float rstd = 1.0f / sqrtf(wave_sum(ss) * (1.0f / D) + EPS);
    const GAS f32x4* g4 = (const GAS f32x4*)gain + lane; const GAS f32x4* sh4 = (const GAS f32x4*)shift + lane; const GAS f32x4* sc4 = (const GAS f32x4*)scale + lane;
    float am = 0.f;
#pragma unroll
    for (int j = 0; j < 16; ++j) { const f32x4 g = g4[64 * j], sh = sh4[64 * j], sc = sc4[64 * j];
        v[j] = v[j] * rstd * g * (1.0f + sc) + sh; am = fmaxf(fmaxf(am, fmaxf(fabsf(v[j].x), fabsf(v[j].y))), fmaxf(fabsf(v[j].z), fabsf(v[j].w))); }
    am = wave_max(am);
    const float qi = am > 0.f ? 127.0f / am : 0.f;
    GAS unsigned* o4 = (GAS unsigned*)orow + lane;
#pragma unroll
    for (int j = 0; j < 16; ++j) o4[64 * j] = pkq4(v[j].x * qi, v[j].y * qi, v[j].z * qi, v[j].w * qi);
    if (lane == 0) *rs_out = am * (1.0f / 127.0f);
}

__device__ __forceinline__ void quant_act_row(const bf16* arow, signed char* orow, float* rs_out, int lane) {
    const GAS v2u* ar = (const GAS v2u*)arow + lane;
    v2u a[43]; float am = 0.f;
#pragma unroll
    for (int q = 0; q < 43; ++q) { a[q] = __builtin_nontemporal_load(ar + 64 * q);
        am = fmaxf(fmaxf(am, fmaxf(fabsf(bflo(a[q].x)), fabsf(bfhi(a[q].x)))), fmaxf(fabsf(bflo(a[q].y)), fabsf(bfhi(a[q].y)))); }
    am = wave_max(am);
    const float qi = am > 0.f ? 127.0f / am : 0.f;
#if defined(FAKEQ_DN)
    { const float dq = am * (1.0f / 127.0f); GAS v2u* ob = (GAS v2u*)arow + lane;
#pragma unroll
      for (int q = 0; q < 43; ++q) { v2u w; w.x = pkbf(__builtin_rintf(bflo(a[q].x) * qi) * dq, __builtin_rintf(bfhi(a[q].x) * qi) * dq); w.y = pkbf(__builtin_rintf(bflo(a[q].y) * qi) * dq, __builtin_rintf(bfhi(a[q].y) * qi) * dq); ob[64 * q] = w; } }
#endif
    GAS unsigned* o4 = (GAS unsigned*)orow + lane;
#pragma unroll
    for (int q = 0; q < 43; ++q) o4[64 * q] = pkq4(bflo(a[q].x) * qi, bfhi(a[q].x) * qi, bflo(a[q].y) * qi, bfhi(a[q].y) * qi);
    if (lane == 0) *rs_out = am * (1.0f / 127.0f);
}


__device__ __forceinline__ void stage_mod(Frame& F, const float* gain, const float* shift, const float* scale) {
    LAS float* Gs = (LAS float*)(F.lds + RING_OFF); LAS float* Ss = Gs + D;
    for (int i = F.tid; i < D; i += NWAVES * 64) { Gs[i] = gain[i] * (1.0f + scale[i]); Ss[i] = shift[i]; }
    __syncthreads();
}
__device__ __forceinline__ void p6_row_lds(Frame& F, int m) {
    const int lane = F.lane;
    const LAS f32x4* G4 = (const LAS f32x4*)(F.lds + RING_OFF) + lane; const LAS f32x4* S4 = G4 + D / 4;
    const GAS f32x4* xr = (const GAS f32x4*)(F.in[I_X] + (size_t)m * D) + lane; const GAS v2u* mr = (const GAS v2u*)(F.MX + (size_t)m * D) + lane;
    f32x4 v[16]; float ss = 0.f;
#pragma unroll
    for (int j = 0; j < 16; ++j) { const f32x4 x = __builtin_nontemporal_load(xr + 64 * j); const v2u mm = __builtin_nontemporal_load(mr + 64 * j);
        v[j] = (f32x4){x.x + bflo(mm.x), x.y + bfhi(mm.x), x.z + bflo(mm.y), x.w + bfhi(mm.y)};
        ss += (v[j].x * v[j].x + v[j].y * v[j].y) + (v[j].z * v[j].z + v[j].w * v[j].w); }
    const float rstd = 1.0f / sqrtf(wave_sum(ss) * (1.0f / D) + EPS);
    float am = 0.f;
#pragma unroll
    for (int j = 0; j < 16; ++j) { v[j] = v[j] * rstd * G4[64 * j] + S4[64 * j]; am = fmaxf(fmaxf(am, fmaxf(fabsf(v[j].x), fabsf(v[j].y))), fmaxf(fabsf(v[j].z), fabsf(v[j].w))); }
    am = wave_max(am);
    const float qi = am > 0.f ? 127.0f / am : 0.f;
    GAS unsigned* o4 = (GAS unsigned*)(F.HQ + (size_t)m * D) + lane;
#pragma unroll
    for (int j = 0; j < 16; ++j) o4[64 * j] = pkq4(v[j].x * qi, v[j].y * qi, v[j].z * qi, v[j].w * qi);
    if (lane == 0) F.rsH[m] = am * (1.0f / 127.0f);
}
__device__ __forceinline__ void p1_row_lds(Frame& F, int m) {
    const int lane = F.lane;
    const LAS f32x4* G4 = (const LAS f32x4*)(F.lds + RING_OFF) + lane; const LAS f32x4* S4 = G4 + D / 4;
    const GAS f32x4* xr = (const GAS f32x4*)(F.in[I_X] + (size_t)m * D) + lane;
    f32x4 v[16]; float ss = 0.f;
#pragma unroll
    for (int j = 0; j < 16; ++j) { v[j] = __builtin_nontemporal_load(xr + 64 * j); ss += (v[j].x * v[j].x + v[j].y * v[j].y) + (v[j].z * v[j].z + v[j].w * v[j].w); }
    const float rstd = 1.0f / sqrtf(wave_sum(ss) * (1.0f / D) + EPS);
    GAS v2u* o8 = (GAS v2u*)(F.HB + (size_t)m * D) + lane;
#pragma unroll
    for (int j = 0; j < 16; ++j) { const f32x4 y = v[j] * rstd * G4[64 * j] + S4[64 * j]; v2u w; w.x = pkbf(y.x, y.y); w.y = pkbf(y.z, y.w); o8[64 * j] = w; }
}

#define MFMA32(a, b, c) __builtin_amdgcn_mfma_f32_32x32x16_bf16((a), (b), (c), 0, 0, 0)
constexpr int A_NST = 6, A_STAGE = 16384, A_RING = 32768;
typedef short s16x4 __attribute__((ext_vector_type(4)));
__device__ __forceinline__ void attn_wg_unit(Frame& F, const LAS float* rp, int b, int h, int R0) {
    const int lane = F.lane, w = F.wave, j = lane & 31, g = lane >> 5;
    const int r = R0 + (w >> 1), qblk = w & 1;
    const int rs = min(max(r - NAKH / 2, 0), ROWS - NAKH);
    const int KR0 = min(max(R0 - NAKH / 2, 0), ROWS - NAKH), KR1 = min(max(R0 + 3 - NAKH / 2, 0), ROWS - NAKH) + NAKH - 1;
    const int NT = 8 + 2 * (KR1 - KR0 + 1);
    const int qc = 32 * qblk + j, cs = min(max(qc - NAKW / 2, 0), GRIDW - NAKW);
    const int bias_lane = (h * 15 + rs - r + NAKH - 1) * 31 + 8 * g - qc + NAKW - 1;
    const int mask_lane = 8 * g - cs;
    const unsigned drow = 4u * w + (lane >> 4), dsw = ((drow & 3u) << 2) | ((drow >> 2) & 3u);
    const unsigned dma_off = (drow * NAW + 8u * ((lane & 15u) ^ dsw)) * 2u;
    const char* kbase = (const char*)(F.KB + HD * h); const char* vbase = (const char*)(F.VB + HD * h);
    LAS unsigned char* ring = F.lds + RING_OFF + A_RING;
#define KEYBASE(T) ((T) >= 8 ? (b * SEQ + (KR0 + (((T) - 8) >> 1)) * GRIDW + 32 * (((T) - 8) & 1)) : (M + b * CTXL + 32 * (T)))
#define DMA(T, ST) do { const size_t go_ = (size_t)KEYBASE(T) * (NAW * 2) + dma_off; \
        __builtin_amdgcn_global_load_lds((const unsigned*)(kbase + go_), (LAS unsigned*)(ring + (ST) * A_STAGE + w * 1024), 16, 0, 0); \
        __builtin_amdgcn_global_load_lds((const unsigned*)(vbase + go_), (LAS unsigned*)(ring + (ST) * A_STAGE + 8192 + w * 1024), 16, 0, 0); } while (0)
    const unsigned kap = (j & 19) | ((j & 4) << 1) | ((j & 8) >> 1), ksw = ((kap & 3u) << 2) | ((kap >> 2) & 3u);
    unsigned ka[8];
#pragma unroll
    for (int kd = 0; kd < 8; ++kd) ka[kd] = 256u * kap + 16u * ((2u * kd + g) ^ ksw);
    const unsigned blk = (lane >> 4) & 1, q4 = (lane & 15) >> 2, p4 = lane & 3;
    unsigned va_[2][4];
#pragma unroll
    for (int t = 0; t < 2; ++t)
#pragma unroll
        for (int jb = 0; jb < 4; ++jb) { const unsigned row = 8u * g + 4u * t + q4, sw = ((row & 3u) << 2) | ((row >> 2) & 3u);
            va_[t][jb] = 8192u + 256u * row + 16u * ((4u * jb + 2u * blk + (p4 >> 1)) ^ sw) + 8u * (p4 & 1); }
    const size_t qtok = (size_t)b * SEQ + r * GRIDW + 32 * qblk + j;
    bf16x8 qf[8];
    { const GAS bf16x8* qp = (const GAS bf16x8*)(F.QB + qtok * NAW + HD * h + 8 * g);
#pragma unroll
      for (int kd = 0; kd < 8; ++kd) qf[kd] = __builtin_nontemporal_load(qp + 2 * kd); }
#pragma unroll
    for (int t = 0; t < A_NST - 1; ++t) DMA(t, t);
    f32x16 o0, o1, o2, o3;
#pragma unroll
    for (int v = 0; v < 16; ++v) { o0[v] = 0.f; o1[v] = 0.f; o2[v] = 0.f; o3[v] = 0.f; }
    float m_run = -__builtin_inff(), l_run = 0.f;
    int st = 0, stp = A_NST - 1;
    for (int t = 0; t < NT; ++t) {
        asm volatile("s_waitcnt vmcnt(%0)" :: "n"(2 * (A_NST - 2)) : "memory");
        __builtin_amdgcn_s_barrier();
        asm volatile("" ::: "memory");
        { const int tp = min(t + A_NST - 1, NT - 1); DMA(tp, stp); }
        const bool lat = t >= 8; const int kr = KR0 + ((t - 8) >> 1), kblk = (t - 8) & 1;
        const bool active = !lat || (kr >= rs && kr < rs + NAKH);
        if (active) {
            const LAS unsigned char* sb = ring + st * A_STAGE;
            f32x16 s;
#pragma unroll
            for (int v = 0; v < 16; ++v) s[v] = 0.f;
            { bf16x8 kf[8];
#pragma unroll
              for (int kd = 0; kd < 8; ++kd) kf[kd] = *(const LAS bf16x8*)(sb + ka[kd]);
#pragma unroll
              for (int kd = 0; kd < 8; ++kd) s = MFMA32(kf[kd], qf[kd], s); }
            s16x4 tv[2][2][4];
            { const unsigned sa = (unsigned)(size_t)sb;
#pragma unroll
              for (int t2 = 0; t2 < 2; ++t2)
#pragma unroll
                for (int jb = 0; jb < 4; ++jb) { asm volatile("ds_read_b64_tr_b16 %0, %1" : "=v"(tv[0][t2][jb]) : "v"(sa + va_[t2][jb]) : "memory");
                                                 asm volatile("ds_read_b64_tr_b16 %0, %1 offset:4096" : "=v"(tv[1][t2][jb]) : "v"(sa + va_[t2][jb]) : "memory"); } }
            if (lat) { int ml = mask_lane; asm volatile("" : "+v"(ml)); const LAS float* bp = rp + bias_lane + 31 * (kr - rs) + 32 * kblk;
                float bias[16];
#pragma unroll
                for (int v = 0; v < 16; ++v) bias[v] = bp[(v & 7) + 16 * (v >> 3)];
                asm volatile("" : "+v"(bias[0]), "+v"(bias[1]), "+v"(bias[2]), "+v"(bias[3]), "+v"(bias[4]), "+v"(bias[5]), "+v"(bias[6]), "+v"(bias[7]),
                             "+v"(bias[8]), "+v"(bias[9]), "+v"(bias[10]), "+v"(bias[11]), "+v"(bias[12]), "+v"(bias[13]), "+v"(bias[14]), "+v"(bias[15]));
                const int mk = ml + 32 * kblk;
#pragma unroll
                for (int v = 0; v < 16; ++v) { const int c = (v & 7) + 16 * (v >> 3); s[v] = ((unsigned)(c + mk) < 16u) ? s[v] + bias[v] : -__builtin_inff(); } }
            float mx = s[0];
#pragma unroll
            for (int v = 1; v < 16; ++v) mx = fmaxf(mx, s[v]);
            mx = fmaxf(mx, __shfl_xor(mx, 32));
            if (__builtin_amdgcn_ballot_w64(mx > m_run) != 0ull) {
                const float m_new = fmaxf(m_run, mx), alpha = __builtin_amdgcn_exp2f(m_run - m_new);
                l_run *= alpha; m_run = m_new;
#pragma unroll
                for (int v = 0; v < 16; ++v) { o0[v] *= alpha; o1[v] *= alpha; o2[v] *= alpha; o3[v] *= alpha; } }
            float ps = 0.f;
#pragma unroll
            for (int v = 0; v < 16; ++v) { s[v] = __builtin_amdgcn_exp2f(s[v] - m_run); ps += s[v]; }
            l_run += ps;
            bf16x8 pf0, pf1;
            { v4u t0, t1; t0.x = pkbf(s[0], s[1]); t0.y = pkbf(s[2], s[3]); t0.z = pkbf(s[4], s[5]); t0.w = pkbf(s[6], s[7]);
              t1.x = pkbf(s[8], s[9]); t1.y = pkbf(s[10], s[11]); t1.z = pkbf(s[12], s[13]); t1.w = pkbf(s[14], s[15]);
              pf0 = __builtin_bit_cast(bf16x8, t0); pf1 = __builtin_bit_cast(bf16x8, t1); }
            asm volatile("s_waitcnt lgkmcnt(0)" : "+v"(tv[0][0][0]), "+v"(tv[0][0][1]), "+v"(tv[0][0][2]), "+v"(tv[0][0][3]), "+v"(tv[0][1][0]), "+v"(tv[0][1][1]), "+v"(tv[0][1][2]), "+v"(tv[0][1][3]),
                         "+v"(tv[1][0][0]), "+v"(tv[1][0][1]), "+v"(tv[1][0][2]), "+v"(tv[1][0][3]), "+v"(tv[1][1][0]), "+v"(tv[1][1][1]), "+v"(tv[1][1][2]), "+v"(tv[1][1][3]) :: "memory");
#define VF(KS, JB) __builtin_shufflevector(tv[KS][0][JB], tv[KS][1][JB], 0, 1, 2, 3, 4, 5, 6, 7)
            o0 = MFMA32(VF(0, 0), pf0, o0); o1 = MFMA32(VF(0, 1), pf0, o1); o2 = MFMA32(VF(0, 2), pf0, o2); o3 = MFMA32(VF(0, 3), pf0, o3);
            o0 = MFMA32(VF(1, 0), pf1, o0); o1 = MFMA32(VF(1, 1), pf1, o1); o2 = MFMA32(VF(1, 2), pf1, o2); o3 = MFMA32(VF(1, 3), pf1, o3);
#undef VF
        }
        st = (st + 1 == A_NST) ? 0 : st + 1; stp = (stp + 1 == A_NST) ? 0 : stp + 1;
    }
#undef KEYBASE
#undef DMA
    asm volatile("s_waitcnt vmcnt(0)" ::: "memory");
    __builtin_amdgcn_s_barrier();
    asm volatile("" ::: "memory");
    const float l = l_run + __shfl_xor(l_run, 32), inv = 1.0f / l;
    GAS v2u* op = (GAS v2u*)(F.YB + qtok * D + HD * h);
    float sq = 0.f;
#define OST(JB, OV) do { _Pragma("unroll") for (int u = 0; u < 4; ++u) { const float a_ = OV[4 * u] * inv, b_ = OV[4 * u + 1] * inv, c_ = OV[4 * u + 2] * inv, d_ = OV[4 * u + 3] * inv; \
        sq += (a_ * a_ + b_ * b_) + (c_ * c_ + d_ * d_); v2u w_; w_.x = pkbf(a_, b_); w_.y = pkbf(c_, d_); op[8 * (JB) + 2 * u + g] = w_; } } while (0)
    OST(0, o0); OST(1, o1); OST(2, o2); OST(3, o3);
    sq += __shfl_xor(sq, 32);
    if (g == 0) atomicAdd(F.ssq + qtok, sq);
#undef OST
}
__device__ __forceinline__ void attn_phase(Frame& F) {
    LAS float* rp = (LAS float*)(F.lds + RING_OFF + 1024);
    for (int i = F.tid; i < NAH * 15 * 31; i += NWAVES * 64) rp[i] = F.in[I_RPB][i] * LOG2E;
    __syncthreads();
    for (int wu = F.vcu; wu < NB * NAH * 8; wu += F.G) { const int bh = wu >> 3, rg = wu & 7; attn_wg_unit(F, rp, bh >> 4, bh & 15, rg * 4); }
}

__device__ __forceinline__ void conv_row(Frame& F, int row) {
    unsigned lane = (unsigned)F.lane; const int t = row & (SEQ - 1);
    asm volatile("" : "+v"(lane) :: "memory");
    const GAS char* cw = (const GAS char*)F.in[I_CONVW];
    const GAS char* r0 = (const GAS char*)(F.CB + (size_t)row * 4096);
    const GAS char* rm = t > 0 ? r0 - 8192 : r0; const GAS char* rp = t < SEQ - 1 ? r0 + 8192 : r0;
    const float fm = t > 0 ? 1.f : 0.f, fp = t < SEQ - 1 ? 1.f : 0.f;
    const float ssa = F.ssq[row];
    float co[4][8]; float ss = 0.f;
#pragma unroll
    for (int q = 0; q < 4; ++q) { const unsigned vo = lane * 16u + q * 1024u, wo = lane * 32u + q * 2048u;
        const v4u c0v = *(const GAS v4u*)(r0 + vo), gb = __builtin_nontemporal_load((const GAS v4u*)(r0 + (vo + 4096u)));
        const v4u cm = *(const GAS v4u*)(rm + vo), cpl = *(const GAS v4u*)(rp + vo);
        const f32x4 wa0 = *(const GAS f32x4*)(cw + wo), wa1 = *(const GAS f32x4*)(cw + (wo + 16u)), wb0 = *(const GAS f32x4*)(cw + (wo + 8192u)), wb1 = *(const GAS f32x4*)(cw + (wo + 8208u)),
                    wc0 = *(const GAS f32x4*)(cw + (wo + 16384u)), wc1 = *(const GAS f32x4*)(cw + (wo + 16400u));
#pragma unroll
        for (int e = 0; e < 4; ++e) {
            const float k0l = (e < 2 ? wa0[(2 * e) & 3] : wa1[(2 * e) & 3]) * fm, k0h = (e < 2 ? wa0[(2 * e + 1) & 3] : wa1[(2 * e + 1) & 3]) * fm;
            const float k1l = e < 2 ? wb0[(2 * e) & 3] : wb1[(2 * e) & 3], k1h = e < 2 ? wb0[(2 * e + 1) & 3] : wb1[(2 * e + 1) & 3];
            const float k2l = (e < 2 ? wc0[(2 * e) & 3] : wc1[(2 * e) & 3]) * fp, k2h = (e < 2 ? wc0[(2 * e + 1) & 3] : wc1[(2 * e + 1) & 3]) * fp;
            const float vl = bflo(gb[e]) * (k0l * bflo(cm[e]) + k1l * bflo(c0v[e]) + k2l * bflo(cpl[e]));
            const float vh = bfhi(gb[e]) * (k0h * bfhi(cm[e]) + k1h * bfhi(c0v[e]) + k2h * bfhi(cpl[e]));
            co[q][2 * e] = vl; co[q][2 * e + 1] = vh; ss += vl * vl + vh * vh; } }
    const float sc = sqrtf(ssa * (1.0f / NAW) + EPS) / sqrtf(wave_sum(ss) * (1.0f / CVW) + EPS);
    GAS char* yp = (GAS char*)(F.YB + (size_t)row * D + NAW);
#pragma unroll
    for (int q = 0; q < 4; ++q) { v4u w;
        w.x = pkbf(co[q][0] * sc, co[q][1] * sc); w.y = pkbf(co[q][2] * sc, co[q][3] * sc); w.z = pkbf(co[q][4] * sc, co[q][5] * sc); w.w = pkbf(co[q][6] * sc, co[q][7] * sc);
        *(GAS v4u*)(yp + (lane * 16u + q * 1024u)) = w; }
}
__device__ __forceinline__ void final_norm_row(const float* xrow, const bf16* mrow, const bf16* frow, float* orow, const float* gain, int lane) {
    const GAS f32x4* xr = (const GAS f32x4*)xrow + lane; const GAS v2u* mr = (const GAS v2u*)mrow + lane; const GAS v2u* fr = (const GAS v2u*)frow + lane;
    const GAS f32x4* g4 = (const GAS f32x4*)gain + lane; GAS f32x4* o4 = (GAS f32x4*)orow + lane;
    f32x4 v[16]; float ss = 0.f;
#pragma unroll
    for (int j = 0; j < 16; ++j) { const f32x4 x = __builtin_nontemporal_load(xr + 64 * j); const v2u m = __builtin_nontemporal_load(mr + 64 * j), f = __builtin_nontemporal_load(fr + 64 * j);
        v[j] = (f32x4){x.x + bflo(m.x) + bflo(f.x), x.y + bfhi(m.x) + bfhi(f.x), x.z + bflo(m.y) + bflo(f.y), x.w + bfhi(m.y) + bfhi(f.y)};
        ss += (v[j].x * v[j].x + v[j].y * v[j].y) + (v[j].z * v[j].z + v[j].w * v[j].w); }
    const float rstd = 1.0f / sqrtf(wave_sum(ss) * (1.0f / D) + EPS);
#pragma unroll
    for (int j = 0; j < 16; ++j) __builtin_nontemporal_store(v[j] * rstd * g4[64 * j], o4 + 64 * j);
}

struct Args { const float* in[N_IN]; float* out; unsigned char* ws; int ph_lo, ph_hi; };
__global__ void __launch_bounds__(NWAVES * 64, 2) fwd_kernel(Args args) {
    extern __shared__ __attribute__((aligned(16))) unsigned char lds[];
    Frame F;
    F.lds = (LAS unsigned char*)lds;
    F.MISC = (volatile LAS unsigned*)(F.lds + MISC_OFF);
    F.tid = threadIdx.x; F.lane = F.tid & 63; F.wave = __builtin_amdgcn_readfirstlane(F.tid >> 6);
    F.G = gridDim.x; { const int bx = blockIdx.x; F.vcu = (F.G % 8 == 0) ? (bx % 8) * (F.G / 8) + bx / 8 : bx; }
    unsigned char* ws = args.ws;
    F.ctl = (gu32*)(ws + WS_CTL);
#pragma unroll
    for (int i = 0; i < N_IN; ++i) F.in[i] = args.in[i];
    F.out = args.out; F.mod = (float*)(ws + WS_MOD); F.rope = (float*)(ws + WS_ROPE);
    F.Win_t = (bf16*)(ws + WS_WIN); F.Wout_t = (bf16*)(ws + WS_WOUT); F.Wgu_t = (bf16*)(ws + WS_WGU); F.Wdn_t = (bf16*)(ws + WS_WDN);
    F.HB = (bf16*)(ws + WS_H); F.QB = (bf16*)(ws + WS_Q); F.KB = (bf16*)(ws + WS_K); F.VB = (bf16*)(ws + WS_V); F.CB = (bf16*)(ws + WS_C);
    F.ssq = (float*)(ws + WS_SSQ); F.HQ = (signed char*)(ws + WS_H); F.Wgu_q = (signed char*)(ws + WS_WGU); F.rsH = (float*)(ws + WS_RSH); F.csW = (float*)(ws + WS_CSW); F.ACTQ = (signed char*)(ws + WS_Q); F.Wdn_q = (signed char*)(ws + WS_WDN); F.rsA = (float*)(ws + WS_RSA); F.cmaxD = (unsigned*)(ws + WS_CMAXD); F.YB = (bf16*)(ws + WS_Y); F.ACT = (bf16*)(ws + WS_ACT); F.MX = (bf16*)(ws + WS_X1); F.FX = (bf16*)(ws + WS_X1 + 64 * MiB);
    for (int u = F.tid; u < (LDS_BYTES - LDSCTL_OFF) / 4; u += NWAVES * 64) ((LAS unsigned*)(F.lds + LDSCTL_OFF))[u] = 0u;
    __syncthreads();
    XcdBarrier bar; bar.bar = (unsigned*)(F.ctl + CW_BAR); bar.x = 0; bar.st = nullptr;
    if (N_LAUNCHES == 1) bar = xcd_barrier_post((unsigned*)(F.ctl + CW_BAR), F.MISC + 8);
    int cid = (int)blockIdx.x;
#if defined(XCC_PLACE)
    if (N_LAUNCHES == 1 && F.G == 256) {
        if (F.tid == 0) { const unsigned x = xb_xcc_id(); const unsigned r = __hip_atomic_fetch_add(F.ctl + CW_XRANK + 64 * x, 1u, RLX_AGENT);
            unsigned sp = 0; bool ok = false;
            for (;;) { unsigned sum = 0; bool even = true;
                for (unsigned j = 0; j < 16; ++j) { const unsigned c = __hip_atomic_load(F.ctl + CW_XRANK + 64 * j, RLX_AGENT); sum += c; if (j < 8 ? c != 32u : c != 0u) even = false; }
                if (sum == 256u) { ok = even; break; }
                __builtin_amdgcn_s_sleep(1); if (++sp > (1u << 16)) break; }
            F.MISC[12] = ok ? (8u * r + x) : (unsigned)blockIdx.x; }
        __syncthreads();
        cid = (int)F.MISC[12];
    }
#endif
#if defined(FAKEQ_DN)
#define DNQ_DST F.Wdn_t
#else
#define DNQ_DST (bf16*)F.Wdn_q
#endif
    const int lo = args.ph_lo, hi = args.ph_hi;
#define IN(k) (lo <= (k) && (k) < hi)
#if defined(PROBE_BAR2)
#define SEAM(k) do { if (IN(k) && IN((k) + 1)) { xcd_barrier(bar); xcd_barrier(bar); } } while (0)
#else
#define SEAM(k) do { if (IN(k) && IN((k) + 1)) xcd_barrier(bar); } while (0)
#endif
    const int gw = F.vcu * NWAVES + F.wave, NGW = F.G * NWAVES;
#ifndef PROBE_DUP
#define PROBE_DUP (-1)
#endif
#define DUP(k, body) do { body; if (PROBE_DUP == (k)) { xcd_barrier(bar); body; } } while (0)

    if (IN(0)) { p0_prologue(F, 1.0f); if (PROBE_DUP == 0) { xcd_barrier(bar); p0_prologue(F, 0.0f); } SEAM(0); }
    if (IN(1)) {
        if (F.G == 256) {
            const int b0 = (int)blockIdx.x * 32; const float* mrow = F.mod + (size_t)(b0 >> 11) * NMODC;
            stage_mod(F, F.in[I_N1G], mrow, mrow + D);
#pragma unroll 1
            for (int r = F.wave; r < 32; r += NWAVES) { p1_row_lds(F, b0 + r); asm volatile("" ::: "memory"); }
            if (F.wave < 4) { const int mc = M + (int)blockIdx.x * 4 + F.wave; const float* mr4 = F.mod + (size_t)4 * NMODC;
                norm_mod_row(F.in[I_CTX] + (size_t)(mc - M) * D, F.HB + (size_t)mc * D, F.in[I_N1G], mr4, mr4 + D, F.lane); }
        } else
        DUP(1, for (int m = gw; m < MT; m += NGW) {
            const bool isctx = m >= M; const float* xrow = isctx ? F.in[I_CTX] + (size_t)(m - M) * D : F.in[I_X] + (size_t)m * D;
            const float* mrow = F.mod + (size_t)(isctx ? 4 : (m >> 11)) * NMODC;
            norm_mod_row(xrow, F.HB + (size_t)m * D, F.in[I_N1G], mrow, mrow + D, F.lane); });
        SEAM(1);
    }
#if defined(PROBE_IDLE_US)
    if (IN(2)) { const unsigned long long t0 = __builtin_amdgcn_s_memrealtime(); while (__builtin_amdgcn_s_memrealtime() - t0 < (unsigned long long)(PROBE_IDLE_US) * 100ull) __builtin_amdgcn_s_sleep(32); }
#endif
    if (IN(2)) {
        pg8::Gemm g{F.HB, F.Win_t, MT, INC, D}; pg8::InOrder S; S.init(F.G, cid);
        pg8::EpiIn E{F.QB, F.KB, F.VB, F.CB, F.rope, 0.08838834764831845f * LOG2E};
        DUP(2, (pg8::gemm_phase<pg8::EpiIn, pg8::InOrder, PG8_ALIGN, PG8_SP2>(F.lds + RING_OFF, g, S, E)));
        if (F.G == 256 && cid >= 64) {
            LAS float* scr = (LAS float*)(F.lds + RING_OFF + F.wave * 16384); const int p = (cid - 64) * NWAVES + F.wave, pw = cid - 64;
            transpose_items<3>(F.in[I_WOUT], D, D, F.Wout_t, scr, P0_OUT_ITEMS + p, 192 * NWAVES, IT_OUT, F.lane, F.in[I_GNG]);
#if DNQ_COOP
            __syncthreads();
            if (pw < 64) { quant_dn_block(F, pw); for (int nb = 576 + pw; nb < 2 * FF / 32; nb += 64) quant_gu_block(F, nb); }
            else { for (int nb = pw - 64; nb < 576; nb += 128) quant_gu_block(F, nb); }
#else
            for (int nb = P0_GUQ_BLOCKS + cid - 64; nb < 2 * FF / 32; nb += 192) quant_gu_block(F, nb);
            transpose_items<8>(F.in[I_WDN], FF, D, DNQ_DST, scr, p, 192 * NWAVES, TAIL2_DN_ITEMS, F.lane, (const float*)F.cmaxD);
#endif
        } else if (F.G != 256) {
            LAS float* scr = (LAS float*)(F.lds + RING_OFF + F.wave * 16384);
            transpose_items<3>(F.in[I_WOUT], D, D, F.Wout_t, scr, P0_OUT_ITEMS + gw, NGW, IT_OUT, F.lane, F.in[I_GNG]);
            __syncthreads();
            for (int nb = P0_GUQ_BLOCKS + (int)blockIdx.x; nb < 2 * FF / 32; nb += F.G) quant_gu_block(F, nb);
#if DNQ_COOP
            for (int nb = (int)blockIdx.x; nb < D / 32; nb += F.G) quant_dn_block(F, nb);
#else
            transpose_items<8>(F.in[I_WDN], FF, D, DNQ_DST, scr, gw, NGW, TAIL2_DN_ITEMS, F.lane, (const float*)F.cmaxD);
#endif
        }
        SEAM(2);
    }
    if (IN(3)) { DUP(3, attn_phase(F)); SEAM(3); }
    if (IN(4)) { DUP(4, for (int m = gw; m < M; m += NGW) conv_row(F, m)); SEAM(4); }
    if (IN(5)) {
        pg8::Gemm g{F.YB, F.Wout_t, M, D, D}; pg8::StaticOrder S; S.init(M, D, F.G, cid);
        pg8::EpiGate<true> E{F.MX, D, F.mod + 2 * D, F.ssq};
        DUP(5, (pg8::gemm_phase<pg8::EpiGate<true>, pg8::StaticOrder, PG8_ALIGN, PG8_SP2>(F.lds + RING_OFF, g, S, E)));
        SEAM(5);
    }
    if (IN(6)) {
        if (F.G == 256) { const int b0 = (int)blockIdx.x * 32; const float* mrow = F.mod + (size_t)(b0 >> 11) * NMODC;
            stage_mod(F, F.in[I_N2G], mrow + 3 * D, mrow + 4 * D);
#pragma unroll 1
            for (int r = F.wave; r < 32; r += NWAVES) { p6_row_lds(F, b0 + r); asm volatile("" ::: "memory"); }
        } else
        DUP(6, for (int m = gw; m < M; m += NGW) { const float* mrow = F.mod + (size_t)(m >> 11) * NMODC;
            norm_mod_row_x1_q8(F.in[I_X] + (size_t)m * D, F.MX + (size_t)m * D, F.HQ + (size_t)m * D, F.rsH + m, F.in[I_N2G], mrow + 3 * D, mrow + 4 * D, F.lane); });
        SEAM(6);
    }
    if (IN(7)) {
        pg8::Gemm g{(const bf16*)F.HQ, (const bf16*)F.Wgu_q, M, 2 * FF, D / 2}; pg8::StaticOrder S; S.init(M, 2 * FF, F.G, cid);
        pg8::EpiSwigluI8 E{F.ACT, FF, F.rsH, F.csW};
#if defined(PROBE_CLK_THR)
        const unsigned long long pc0 = __builtin_readcyclecounter(), pr0 = __builtin_amdgcn_s_memrealtime();
#endif
        DUP(7, (pg8::gemm_phase<pg8::EpiSwigluI8, pg8::StaticOrder, PG8_ALIGN, PG8_SP2>(F.lds + RING_OFF, g, S, E)));
#if defined(PROBE_CLK_THR)
        { const unsigned long long pc1 = __builtin_readcyclecounter(), pr1 = __builtin_amdgcn_s_memrealtime();
          const unsigned long long mhz = (pc1 - pc0) * 100ull / (pr1 - pr0 + 1ull);
          if (blockIdx.x == 0 && mhz < (unsigned long long)(PROBE_CLK_THR)) { const unsigned long long t0 = __builtin_amdgcn_s_memrealtime(); while (__builtin_amdgcn_s_memrealtime() - t0 < 50000ull) __builtin_amdgcn_s_sleep(32); } }
#endif
#if DNQ_COOP
        if (F.G == 256 && cid >= 192) quant_dn_block(F, 64 + cid - 192);
#else
        if (F.G == 256 && cid >= 192) {
            LAS float* scr = (LAS float*)(F.lds + RING_OFF + F.wave * 16384); const int p = (cid - 192) * NWAVES + F.wave;
            transpose_items<8>(F.in[I_WDN], FF, D, DNQ_DST, scr, TAIL2_DN_ITEMS + p, 64 * NWAVES, IT_DN, F.lane, (const float*)F.cmaxD);
        } else if (F.G != 256) {
            LAS float* scr = (LAS float*)(F.lds + RING_OFF + F.wave * 16384);
            transpose_items<8>(F.in[I_WDN], FF, D, DNQ_DST, scr, TAIL2_DN_ITEMS + gw, NGW, IT_DN, F.lane, (const float*)F.cmaxD);
        }
#endif
        SEAM(7);
    }
    if (IN(8)) { for (int m = gw; m < M; m += NGW) quant_act_row(F.ACT + (size_t)m * FF, F.ACTQ + (size_t)m * FF, F.rsA + m, F.lane); SEAM(8); }
    if (IN(9)) {
#if defined(FAKEQ_DN)
        pg8::Gemm g{F.ACT, F.Wdn_t, M, D, FF}; pg8::StaticOrder S; S.init(M, D, F.G, cid);
        pg8::EpiGate<false> E{F.FX, D, F.mod + 5 * D, nullptr};
        DUP(9, (pg8::gemm_phase<pg8::EpiGate<false>, pg8::StaticOrder, PG8_ALIGN, PG8_SP2>(F.lds + RING_OFF, g, S, E)));
#else
        pg8::Gemm g{(const bf16*)F.ACTQ, (const bf16*)F.Wdn_q, M, D, FF / 2}; pg8::StaticOrder S; S.init(M, D, F.G, cid);
        pg8::EpiGateI8 E{F.FX, D, F.mod + 5 * D, F.rsA, F.cmaxD};
        DUP(9, (pg8::gemm_phase<pg8::EpiGateI8, pg8::StaticOrder, PG8_ALIGN, PG8_SP2>(F.lds + RING_OFF, g, S, E)));
#endif
        SEAM(9);
    }
    if (IN(10)) { for (int m = gw; m < M; m += NGW) final_norm_row(F.in[I_X] + (size_t)m * D, F.MX + (size_t)m * D, F.FX + (size_t)m * D, F.out + (size_t)m * D, F.in[I_FNG], F.lane); }
#undef IN
#undef SEAM
}

extern "C" void kernel_launch(void* const* d_in, const int* in_sizes, int n_in, void* d_out, int out_size, void* d_ws, size_t ws_size, hipStream_t stream) {
    static int grid = 0;
    if (grid == 0) {
        if (n_in != N_IN || in_sizes[I_X] != M * D || out_size != M * D || ws_size < WS_END) { fprintf(stderr, "kernel_launch: shape / workspace mismatch (n_in %d, x %d, out %d, ws %zu); nothing launched\n", n_in, n_in > 0 ? in_sizes[0] : -1, out_size, ws_size); grid = -1; return; }
        int dev = 0, cus = 0, per_cu = 0;
        if (hipGetDevice(&dev) != hipSuccess || hipDeviceGetAttribute(&cus, hipDeviceAttributeMultiprocessorCount, dev) != hipSuccess) { fprintf(stderr, "kernel_launch: device query failed\n"); grid = -1; return; }
        if (hipFuncSetAttribute((const void*)fwd_kernel, hipFuncAttributeMaxDynamicSharedMemorySize, LDS_BYTES) != hipSuccess) { fprintf(stderr, "kernel_launch: hipFuncSetAttribute failed\n"); grid = -1; return; }
        if (hipOccupancyMaxActiveBlocksPerMultiprocessor(&per_cu, (const void*)fwd_kernel, NWAVES * 64, LDS_BYTES) != hipSuccess || per_cu < 1)
            fprintf(stderr, "kernel_launch: note: occupancy query reports %d workgroups per CU\n", per_cu);
        (void)hipGetLastError();
        grid = cus;
    }
    if (grid < 0) return;
    if (hipMemsetAsync((char*)d_ws + WS_CTL, 0, CTL_ZERO_BYTES, stream) != hipSuccess) { fprintf(stderr, "kernel_launch: memset failed\n"); return; }
    Args a{};
    for (int i = 0; i < N_IN; ++i) a.in[i] = (const float*)d_in[i];
    a.out = (float*)d_out; a.ws = (unsigned char*)d_ws;
    for (int li = 0; li < N_LAUNCHES; ++li) {
        a.ph_lo = (N_LAUNCHES == 1) ? 0 : li; a.ph_hi = (N_LAUNCHES == 1) ? N_PHASES : li + 1;
        hipLaunchKernelGGL(fwd_kernel, dim3(grid), dim3(NWAVES * 64), LDS_BYTES, stream, a);
        const hipError_t le = hipPeekAtLastError();
        if (le != hipSuccess) { fprintf(stderr, "kernel_launch: launch %d failed: %s\n", li, hipGetErrorName(le)); break; }
    }
}
```

```cpp
#include <hip/hip_runtime.h>
#include <cstdio>
#include <cstdint>
namespace pg8 {
#define PG8_LAS __attribute__((address_space(3)))
typedef unsigned short bf16_t;
typedef short bf16x8 __attribute__((ext_vector_type(8)));
typedef float f32x4 __attribute__((ext_vector_type(4)));
typedef unsigned u32x4 __attribute__((ext_vector_type(4)));
constexpr int BM = 256, BK = 64, HALF = 128, HTB = HALF * BK * 2  , STAGE_BYTES = 8 * HTB, NXCD = 8, WGM = 8;

__host__ __device__ __forceinline__ int lds_byte(int r, int c) { const int st = (r >> 4) * 2 + (c >> 5), rr = r & 15, cc = c & 31, ob = rr * 64 + cc * 2; return st * 1024 + (ob ^ (((ob >> 9) & 1) << 5)); }
__host__ __device__ __forceinline__ void stage_rc(int b, int& R, int& C) { const int st = b / 1024, sb = b % 1024, swz = sb ^ (((sb >> 9) & 1) << 5); R = (st >> 1) * 16 + swz / 64; C = (st & 1) * 32 + (swz % 64) / 2; }
__host__ __device__ __forceinline__ int perm32(int rho) { const int n = rho >> 4, i = rho & 15; return 8 * (i >> 2) + 4 * n + (i & 3); }

struct Unit { int pm, pn; };
struct Gemm { const bf16_t* A; const bf16_t* Bt; int M, N, K; };

struct StaticOrder {
    int nM, nN, nwg, G, c;
    __host__ __device__ void init(int M, int N, int G_, int c_) { nM = M / BM; nN = N / BM; nwg = nM * nN; G = G_; c = c_; }
    __host__ __device__ bool next(int i, Unit& u) const {
        const long L = (long)i * G + c; if (L >= nwg) return false;
        int wgid = (int)L; { const int q = nwg / NXCD, r = nwg % NXCD, xcd = wgid % NXCD, off = wgid / NXCD; wgid = (xcd < r ? xcd * (q + 1) : r * (q + 1) + (xcd - r) * q) + off; }
        const int nig = WGM * nN, gid = wgid / nig, fm = gid * WGM, gsz = (nM - fm) < WGM ? (nM - fm) : WGM;
        u.pm = fm + ((wgid % nig) % gsz); u.pn = (wgid % nig) / gsz; return true;
    }
    __device__ __forceinline__ void a_ready(const Unit&) const {}
    __device__ __forceinline__ void done(const Unit&) const {}
};

__device__ __forceinline__ unsigned cvt_pk_bf16(float lo, float hi) { unsigned r; asm volatile("v_cvt_pk_bf16_f32 %0, %1, %2" : "=v"(r) : "v"(lo), "v"(hi)); return r; }
typedef float f32x2 __attribute__((ext_vector_type(2)));
typedef int i32x4 __attribute__((ext_vector_type(4)));
__device__ __forceinline__ void mma16(f32x4& c, const bf16x8 b, const bf16x8 a) { c = __builtin_amdgcn_mfma_f32_16x16x32_bf16(b, a, c, 0, 0, 0); }
__device__ __forceinline__ void mma16(i32x4& c, const bf16x8 b, const bf16x8 a) { c = __builtin_amdgcn_mfma_i32_16x16x64_i8(__builtin_bit_cast(i32x4, b), __builtin_bit_cast(i32x4, a), c, 0, 0, 0); }
typedef __bf16 bf16v2 __attribute__((ext_vector_type(2)));
__device__ __forceinline__ unsigned pkbf(float lo, float hi) { f32x2 v = {lo, hi}; bf16v2 r = __builtin_convertvector(v, bf16v2); return __builtin_bit_cast(unsigned, r); }

struct EpiIn {
    typedef f32x4 acc_t;
    static constexpr bool PERM = true, AFTER_DRAIN = false;
    bf16_t *Q, *Kd, *Vd, *Cd; const float* rope; float qscale;
    __device__ __forceinline__ void operator()(const f32x4 (&acc)[2][2][4][2], const Unit& u, int wr, int wc, int fr, int fq) const {
        const int reg = u.pn >> 3;
        if (reg == 3 || reg == 4) {
            const int row0 = u.pm * BM + wr * 64 + fr, col0 = (u.pn - 24) * HALF + wc * 32 + 8 * fq;
#pragma unroll
            for (int ai = 0; ai < 2; ++ai)
#pragma unroll
                for (int m = 0; m < 4; ++m) { bf16_t* rowp = Cd + (size_t)(row0 + ai * HALF + m * 16) * 4096 + col0;
                    const f32x4 p0 = acc[ai][0][m][0] * acc[ai][1][m][0], p1 = acc[ai][0][m][1] * acc[ai][1][m][1];
                    u32x4 w; w.x = pkbf(p0[0], p0[1]); w.y = pkbf(p0[2], p0[3]); w.z = pkbf(p1[0], p1[1]); w.w = pkbf(p1[2], p1[3]);
                    *(u32x4*)rowp = w; }
            return; }
        bf16_t* base; int ldc, colt; bool rot = false; float sc = 1.f;
        if (reg == 0) { base = Q; ldc = 2048; colt = u.pn * BM; rot = true; sc = qscale; }
        else if (reg == 1) { base = Kd; ldc = 2048; colt = (u.pn - 8) * BM; rot = (u.pm < 32); }
        else if (reg == 2) { base = Vd; ldc = 2048; colt = (u.pn - 16) * BM; }
        else { base = Cd; ldc = 4096; colt = 2048 + (u.pn - 40) * BM; }
        const int row0 = u.pm * BM + wr * 64 + fr, col0 = colt + wc * 32 + 8 * fq;
        const int blk = wc >> 1, i0 = 4 * ((4 * wc + fq) & 7);
        f32x4 cs[2], sn[2];
        cs[0] = (f32x4){1.f, 1.f, 1.f, 1.f}; sn[0] = (f32x4){0.f, 0.f, 0.f, 0.f}; cs[1] = cs[0]; sn[1] = sn[0];
        if (rot) { const int t = row0 & 2047, pos = blk ? (t & 63) : (t >> 6); cs[0] = *(const f32x4*)(rope + pos * 32 + i0); sn[0] = *(const f32x4*)(rope + 2048 + pos * 32 + i0); }
#pragma unroll
        for (int gi = 0; gi < 8; ++gi) { const int ai = gi >> 2, m = gi & 3; const int r = row0 + ai * HALF + m * 16; bf16_t* rowp = base + (size_t)r * ldc + col0;
            if (gi < 7 && rot) { const int rn = row0 + ((gi + 1) >> 2) * HALF + ((gi + 1) & 3) * 16, t = rn & 2047, pos = blk ? (t & 63) : (t >> 6);
                cs[(gi + 1) & 1] = *(const f32x4*)(rope + pos * 32 + i0); sn[(gi + 1) & 1] = *(const f32x4*)(rope + 2048 + pos * 32 + i0); }
            const f32x4 cs4 = cs[gi & 1], sn4 = sn[gi & 1];
#pragma unroll
            for (int bj = 0; bj < 2; ++bj) { const f32x4 a = acc[ai][bj][m][0], b = acc[ai][bj][m][1];
                const f32x4 v0 = (a * cs4 - b * sn4) * sc, v1 = (a * sn4 + b * cs4) * sc;
                u32x4 w; w.x = pkbf(v0[0], v0[1]); w.y = pkbf(v0[2], v0[3]); w.z = pkbf(v1[0], v1[1]); w.w = pkbf(v1[2], v1[3]);
                *(u32x4*)(rowp + bj * HALF) = w; }
            asm volatile("" ::: "memory"); }
    }
};
#ifndef EPI_NT_GATE
#define EPI_NT_GATE 0
#endif
#ifndef EPI_NT_ACT
#define EPI_NT_ACT 1
#endif
#ifndef EPI_NT_FX
#define EPI_NT_FX 0
#endif
#if EPI_NT_GATE
#define EPI_GATE_STORE(v, p) __builtin_nontemporal_store((v), (p))
#else
#define EPI_GATE_STORE(v, p) (*(p) = (v))
#endif
#if EPI_NT_ACT
#define EPI_ACT_STORE(v, p) __builtin_nontemporal_store((v), (p))
#else
#define EPI_ACT_STORE(v, p) (*(p) = (v))
#endif
template <bool ROWSCALE> struct EpiGate {
    typedef f32x4 acc_t;
    static constexpr bool PERM = true, AFTER_DRAIN = false;
    bf16_t* O; int ldc; const float* gate; const float* ssq;
    __device__ __forceinline__ void operator()(const f32x4 (&acc)[2][2][4][2], const Unit& u, int wr, int wc, int fr, int fq) const {
        const int row0 = u.pm * BM + wr * 64 + fr, col0 = u.pn * BM + wc * 32 + 8 * fq;
        const float* gp = gate + (size_t)(u.pm >> 3) * 24576 + col0;
        f32x4 gv[2][2];
#pragma unroll
        for (int bj = 0; bj < 2; ++bj)
#pragma unroll
            for (int n = 0; n < 2; ++n) gv[bj][n] = *(const f32x4*)(gp + bj * HALF + 4 * n);
        float rs[8];
#pragma unroll
        for (int gi = 0; gi < 8; ++gi) rs[gi] = ROWSCALE ? ssq[row0 + (gi >> 2) * HALF + (gi & 3) * 16] : 1.0f;
#pragma unroll
        for (int ai = 0; ai < 2; ++ai)
#pragma unroll
            for (int m = 0; m < 4; ++m) { bf16_t* rowp = O + (size_t)(row0 + ai * HALF + m * 16) * ldc + col0;
                const float rsc = ROWSCALE ? 1.0f / sqrtf(rs[ai * 4 + m] * (1.0f / 2048.0f) + 1e-6f) : 1.0f;
#pragma unroll
                for (int bj = 0; bj < 2; ++bj) { const f32x4 v0 = acc[ai][bj][m][0] * gv[bj][0] * rsc, v1 = acc[ai][bj][m][1] * gv[bj][1] * rsc;
                    u32x4 w; w.x = pkbf(v0[0], v0[1]); w.y = pkbf(v0[2], v0[3]); w.z = pkbf(v1[0], v1[1]); w.w = pkbf(v1[2], v1[3]);
                    EPI_GATE_STORE(w, (u32x4*)(rowp + bj * HALF)); } }
    }
};
struct EpiSwiglu {
    typedef f32x4 acc_t;
    static constexpr bool PERM = true, AFTER_DRAIN = false;
    bf16_t* O; int ldc;
    __device__ __forceinline__ void operator()(const f32x4 (&acc)[2][2][4][2], const Unit& u, int wr, int wc, int fr, int fq) const {
        const int row0 = u.pm * BM + wr * 64 + fr, col0 = u.pn * HALF + wc * 32 + 8 * fq;
#pragma unroll
        for (int ai = 0; ai < 2; ++ai)
#pragma unroll
            for (int m = 0; m < 4; ++m) { bf16_t* rowp = O + (size_t)(row0 + ai * HALF + m * 16) * ldc + col0;
                float o[8];
#pragma unroll
                for (int n = 0; n < 2; ++n)
#pragma unroll
                    for (int j = 0; j < 4; ++j) { const float gt = acc[ai][0][m][n][j], up = acc[ai][1][m][n][j];
                        o[4 * n + j] = gt * __builtin_amdgcn_rcpf(1.0f + __builtin_amdgcn_exp2f(-1.44269504089f * gt)) * up; }
                u32x4 w; w.x = pkbf(o[0], o[1]); w.y = pkbf(o[2], o[3]); w.z = pkbf(o[4], o[5]); w.w = pkbf(o[6], o[7]);
                EPI_ACT_STORE(w, (u32x4*)rowp); }
    }
};
__device__ __forceinline__ void had32(float (&o)[8], int fq) {
#pragma unroll
    for (int s = 1; s < 8; s <<= 1)
#pragma unroll
        for (int i = 0; i < 8; ++i) if (!(i & s)) { const float a = o[i], b = o[i ^ s]; o[i] = a + b; o[i ^ s] = a - b; }
#pragma unroll
    for (int i = 0; i < 8; ++i) { const unsigned x = __builtin_bit_cast(unsigned, o[i]); const auto r = __builtin_amdgcn_permlane16_swap(x, x, false, false);
        const float p = __builtin_bit_cast(float, (fq & 1) ? r[0] : r[1]); o[i] = (fq & 1) ? p - o[i] : o[i] + p; }
#pragma unroll
    for (int i = 0; i < 8; ++i) { const unsigned x = __builtin_bit_cast(unsigned, o[i]); const auto r = __builtin_amdgcn_permlane32_swap(x, x, false, false);
        const float p = __builtin_bit_cast(float, (fq & 2) ? r[0] : r[1]); o[i] = ((fq & 2) ? p - o[i] : o[i] + p) * 0.17677669529663687f; }
}
struct EpiSwigluI8 {
    typedef i32x4 acc_t;
    static constexpr bool PERM = true, AFTER_DRAIN = false;
    bf16_t* O; int ldc; const float* rs; const float* cs;
    __device__ __forceinline__ void operator()(const i32x4 (&acc)[2][2][4][2], const Unit& u, int wr, int wc, int fr, int fq) const {
        const int row0 = u.pm * BM + wr * 64 + fr, col0 = u.pn * HALF + wc * 32 + 8 * fq, gcol0 = u.pn * BM + wc * 32 + 8 * fq;
        f32x4 cg[2], cu[2];
#pragma unroll
        for (int n = 0; n < 2; ++n) { cg[n] = *(const f32x4*)(cs + gcol0 + 4 * n); cu[n] = *(const f32x4*)(cs + gcol0 + HALF + 4 * n); }
        float rsv[8];
#pragma unroll
        for (int gi = 0; gi < 8; ++gi) rsv[gi] = rs[row0 + (gi >> 2) * HALF + (gi & 3) * 16];
#pragma unroll
        for (int ai = 0; ai < 2; ++ai)
#pragma unroll
            for (int m = 0; m < 4; ++m) { bf16_t* rowp = O + (size_t)(row0 + ai * HALF + m * 16) * ldc + col0; const float r = rsv[ai * 4 + m];
                float o[8];
#pragma unroll
                for (int n = 0; n < 2; ++n)
#pragma unroll
                    for (int j = 0; j < 4; ++j) { const float gt = (float)acc[ai][0][m][n][j] * (r * cg[n][j]), up = (float)acc[ai][1][m][n][j] * (r * cu[n][j]);
                        o[4 * n + j] = gt * __builtin_amdgcn_rcpf(1.0f + __builtin_amdgcn_exp2f(-1.44269504089f * gt)) * up; }
                had32(o, fq);
                u32x4 w; w.x = pkbf(o[0], o[1]); w.y = pkbf(o[2], o[3]); w.z = pkbf(o[4], o[5]); w.w = pkbf(o[6], o[7]);
                EPI_ACT_STORE(w, (u32x4*)rowp); }
    }
};
struct EpiGateI8 {
    typedef i32x4 acc_t;
    static constexpr bool PERM = true, AFTER_DRAIN = false;
    bf16_t* O; int ldc; const float* gate; const float* rs; const unsigned* cmax;
    __device__ __forceinline__ void operator()(const i32x4 (&acc)[2][2][4][2], const Unit& u, int wr, int wc, int fr, int fq) const {
        const int row0 = u.pm * BM + wr * 64 + fr, col0 = u.pn * BM + wc * 32 + 8 * fq;
        const float* gp = gate + (size_t)(u.pm >> 3) * 24576 + col0;
        f32x4 gv[2][2];
#pragma unroll
        for (int bj = 0; bj < 2; ++bj)
#pragma unroll
            for (int n = 0; n < 2; ++n) { const f32x4 g = *(const f32x4*)(gp + bj * HALF + 4 * n); const f32x4 cm = *(const f32x4*)((const float*)cmax + 4096 + col0 + bj * HALF + 4 * n);
                gv[bj][n] = g * cm; }
        float rsv[8];
#pragma unroll
        for (int gi = 0; gi < 8; ++gi) rsv[gi] = rs[row0 + (gi >> 2) * HALF + (gi & 3) * 16];
#pragma unroll
        for (int ai = 0; ai < 2; ++ai)
#pragma unroll
            for (int m = 0; m < 4; ++m) { bf16_t* rowp = O + (size_t)(row0 + ai * HALF + m * 16) * ldc + col0; const float r = rsv[ai * 4 + m];
#pragma unroll
                for (int bj = 0; bj < 2; ++bj) { const i32x4 a0 = acc[ai][bj][m][0], a1 = acc[ai][bj][m][1];
                    const f32x4 v0 = (f32x4){(float)a0.x, (float)a0.y, (float)a0.z, (float)a0.w} * gv[bj][0] * r, v1 = (f32x4){(float)a1.x, (float)a1.y, (float)a1.z, (float)a1.w} * gv[bj][1] * r;
                    u32x4 w; w.x = pkbf(v0[0], v0[1]); w.y = pkbf(v0[2], v0[3]); w.z = pkbf(v1[0], v1[1]); w.w = pkbf(v1[2], v1[3]);
                    if (EPI_NT_FX) __builtin_nontemporal_store(w, (u32x4*)(rowp + bj * HALF)); else *(u32x4*)(rowp + bj * HALF) = w; } }
    }
};
struct InOrder {
    StaticOrder so; int G, c;
    __host__ __device__ void init(int G_, int c_) { so.init(8192, 12288, G_, c_); G = G_; c = c_; }
    __host__ __device__ bool next(int i, Unit& u) const {
        const long L = (long)i * G + c; if (L >= 1600) return false;
        if (L < 1536) return so.next(i, u);
        const int e = (int)L - 1536; u.pm = 32 + (e & 3); u.pn = 8 + (e >> 2); return true;
    }
    __device__ __forceinline__ void a_ready(const Unit&) const {}
    __device__ __forceinline__ void done(const Unit&) const {}
};
template <class Epi, class Sched, bool ALIGN_EPI = false, bool SP2 = false>
__device__ __forceinline__ void gemm_phase(PG8_LAS unsigned char* lds, const Gemm g, const Sched& S, const Epi& E) {
    const int tid = threadIdx.x, wid = __builtin_amdgcn_readfirstlane(tid >> 6), lane = tid & 63, wr = wid >> 2, wc = wid & 3, fr = lane & 15, fq = lane >> 4;
    const int K = g.K, nt = K / BK;
    unsigned voffA[2], voffB[2];
#pragma unroll
    for (int i = 0; i < 2; ++i) { int R, C; stage_rc(tid * 16 + i * 8192, R, C); const int Rb = Epi::PERM ? ((R & ~31) + perm32(R & 31)) : R;
        voffA[i] = (unsigned)(R * K + C) * 2u; voffB[i] = (unsigned)(Rb * K + C) * 2u; }
    const size_t kstep = (size_t)(BK * 2);
    const size_t hstep = (size_t)HALF * K * 2;
    const size_t tstep = 2 * hstep;
    const unsigned ldsw = (unsigned)wid * 1024u;
    const int aoff = lds_byte(wr * 64 + fr, fq * 8), boff = lds_byte(wc * 32 + fr, fq * 8);
#define PG8_SA(b, h) (((b) * 2 + (h)) * HTB)
#define PG8_SB(b, h) ((4 + (b) * 2 + (h)) * HTB)
#ifndef PG8_AUX_A
#define PG8_AUX_A 0
#endif
#ifndef PG8_AUX_B
#define PG8_AUX_B 0
#endif
#define PG8_STAGE(bufoff, gbase, voff) do { _Pragma("unroll") for (int _i = 0; _i < 2; ++_i) \
        __builtin_amdgcn_global_load_lds((const unsigned*)((const char*)(gbase) + (voff)[_i]), (PG8_LAS unsigned*)(lds + (bufoff) + ldsw + _i * 8192), 16, 0, ((bufoff) >= 4 * HTB) ? PG8_AUX_B : PG8_AUX_A); } while (0)
#define PG8_LDA(dst, b, h) do { _Pragma("unroll") for (int m = 0; m < 4; ++m) _Pragma("unroll") for (int k = 0; k < 2; ++k) dst[m][k] = *(const PG8_LAS bf16x8*)(lds + PG8_SA(b, h) + aoff + m * 2048 + k * 1024); } while (0)
#define PG8_LDB(dst, b, h) do { _Pragma("unroll") for (int n = 0; n < 2; ++n) _Pragma("unroll") for (int k = 0; k < 2; ++k) dst[n][k] = *(const PG8_LAS bf16x8*)(lds + PG8_SB(b, h) + boff + n * 2048 + k * 1024); } while (0)
#ifndef MMA_ORDER
#define MMA_ORDER 0
#endif
#if MMA_ORDER == 0
#define PG8_MMA(ai, bj, At, Bt) do { __builtin_amdgcn_s_setprio(1); _Pragma("unroll") for (int m = 0; m < 4; ++m) _Pragma("unroll") for (int n = 0; n < 2; ++n) _Pragma("unroll") for (int k = 0; k < 2; ++k) \
        mma16(acc[ai][bj][m][n], Bt[n][k], At[m][k]); __builtin_amdgcn_s_setprio(0); } while (0)
#elif MMA_ORDER == 1
#define PG8_MMA(ai, bj, At, Bt) do { __builtin_amdgcn_s_setprio(1); _Pragma("unroll") for (int k = 0; k < 2; ++k) _Pragma("unroll") for (int n = 0; n < 2; ++n) _Pragma("unroll") for (int m = 0; m < 4; ++m) \
        mma16(acc[ai][bj][m][n], Bt[n][k], At[m][k]); __builtin_amdgcn_s_setprio(0); } while (0)
#elif MMA_ORDER == 3
#define PG8_MMA(ai, bj, At, Bt) do { __builtin_amdgcn_s_setprio(1); _Pragma("unroll") for (int m = 0; m < 4; ++m) _Pragma("unroll") for (int nn = 0; nn < 2; ++nn) _Pragma("unroll") for (int kk = 0; kk < 2; ++kk) { \
        const int n = (m & 1) ? 1 - nn : nn, k = ((nn + (m & 1)) & 1) ? 1 - kk : kk; \
        mma16(acc[ai][bj][m][n], Bt[n][k], At[m][k]); } __builtin_amdgcn_s_setprio(0); } while (0)
#elif MMA_ORDER == 4
#define PG8_MMA(ai, bj, At, Bt) do { __builtin_amdgcn_s_setprio(1); _Pragma("unroll") for (int n = 0; n < 2; ++n) _Pragma("unroll") for (int m = 0; m < 4; ++m) _Pragma("unroll") for (int k = 0; k < 2; ++k) \
        mma16(acc[ai][bj][m][n], Bt[n][k], At[m][k]); __builtin_amdgcn_s_setprio(0); } while (0)
#elif MMA_ORDER == 5
#define PG8_MMA(ai, bj, At, Bt) do { __builtin_amdgcn_s_setprio(1); _Pragma("unroll") for (int m = 0; m < 4; ++m) _Pragma("unroll") for (int k = 0; k < 2; ++k) _Pragma("unroll") for (int n = 0; n < 2; ++n) \
        mma16(acc[ai][bj][m][n], Bt[n][k], At[m][k]); __builtin_amdgcn_s_setprio(0); } while (0)
#else
#define PG8_MMA(ai, bj, At, Bt) do { __builtin_amdgcn_s_setprio(1); _Pragma("unroll") for (int k = 0; k < 2; ++k) _Pragma("unroll") for (int m = 0; m < 4; ++m) _Pragma("unroll") for (int n = 0; n < 2; ++n) \
        mma16(acc[ai][bj][m][n], Bt[n][k], At[m][k]); __builtin_amdgcn_s_setprio(0); } while (0)
#endif
#define PG8_WAIT_V(n) asm volatile("s_waitcnt vmcnt(" #n ")" ::: "memory")
#define PG8_WAIT_L(n) asm volatile("s_waitcnt lgkmcnt(" #n ")" ::: "memory")
#define PG8_BAR __builtin_amdgcn_s_barrier()
#define PG8_SCHED __builtin_amdgcn_sched_barrier(0)
    Unit cur, nxt; int ui = 0;
    if (!S.next(0, cur)) return;
    typedef typename Epi::acc_t acc_t;
    acc_t acc[2][2][4][2];
#pragma unroll
    for (int a = 0; a < 2; ++a)
#pragma unroll
        for (int b = 0; b < 2; ++b)
#pragma unroll
            for (int m = 0; m < 4; ++m)
#pragma unroll
                for (int n = 0; n < 2; ++n) acc[a][b][m][n] = (acc_t){0, 0, 0, 0};
    bf16x8 At[4][2], B0[2][2], B1[2][2];
    const char* cA = (const char*)g.A + (size_t)cur.pm * tstep; const char* cB = (const char*)g.Bt + (size_t)cur.pn * tstep;
    S.a_ready(cur);
    if constexpr (SP2) {
        PG8_STAGE(PG8_SB(0, 0), cB, voffB); PG8_STAGE(PG8_SB(0, 1), cB + hstep, voffB); PG8_STAGE(PG8_SA(0, 0), cA, voffA); PG8_STAGE(PG8_SA(0, 1), cA + hstep, voffA);
        if (wr == 1) PG8_BAR;
        PG8_WAIT_V(2); PG8_BAR;
        PG8_STAGE(PG8_SB(1, 0), cB + kstep, voffB); PG8_STAGE(PG8_SA(1, 0), cA + kstep, voffA); PG8_STAGE(PG8_SB(1, 1), cB + hstep + kstep, voffB);
        PG8_WAIT_V(6); PG8_BAR;
    } else {
        PG8_STAGE(PG8_SB(0, 0), cB, voffB); PG8_STAGE(PG8_SA(0, 0), cA, voffA); PG8_STAGE(PG8_SB(0, 1), cB + hstep, voffB); PG8_STAGE(PG8_SA(0, 1), cA + hstep, voffA);
        if (wr == 1) PG8_BAR;
        PG8_WAIT_V(4); PG8_BAR;
        PG8_STAGE(PG8_SB(1, 0), cB + kstep, voffB); PG8_STAGE(PG8_SA(1, 0), cA + kstep, voffA); PG8_STAGE(PG8_SB(1, 1), cB + hstep + kstep, voffB);
        PG8_WAIT_V(6); PG8_BAR;
    }
    for (;;) {
        const bool has_next = S.next(ui + 1, nxt);
        const char* nA = has_next ? (const char*)g.A + (size_t)nxt.pm * tstep : cA; const char* nB = has_next ? (const char*)g.Bt + (size_t)nxt.pn * tstep : cB;
        for (int t = 0; t < nt; t += 2) {
            const bool last = (t == nt - 2);
            const char* a1 = cA + (size_t)(t + 1) * kstep;
            const char* a2 = last ? nA : cA + (size_t)(t + 2) * kstep; const char* b2 = last ? nB : cB + (size_t)(t + 2) * kstep;
            const char* a3 = a2 + kstep; const char* b3 = b2 + kstep;
            if (last && has_next) S.a_ready(nxt);
            if constexpr (SP2) {
            PG8_LDB(B0, 0, 0); PG8_LDB(B1, 0, 1); PG8_SCHED; PG8_LDA(At, 0, 0); PG8_STAGE(PG8_SA(1, 1), a1 + hstep, voffA);
            PG8_WAIT_V(8); PG8_WAIT_L(0); PG8_BAR; PG8_MMA(0, 0, At, B0); PG8_MMA(0, 1, At, B1); PG8_BAR; PG8_SCHED;
            PG8_LDA(At, 0, 1); PG8_STAGE(PG8_SB(0, 0), b2, voffB); PG8_STAGE(PG8_SB(0, 1), b2 + hstep, voffB); PG8_STAGE(PG8_SA(0, 0), a2, voffA);
            PG8_WAIT_V(8); PG8_WAIT_L(0); PG8_BAR; PG8_MMA(1, 0, At, B0); PG8_MMA(1, 1, At, B1); PG8_BAR; PG8_SCHED;
            PG8_LDB(B0, 1, 0); PG8_LDB(B1, 1, 1); PG8_SCHED; PG8_LDA(At, 1, 0); PG8_STAGE(PG8_SA(0, 1), a2 + hstep, voffA);
            PG8_WAIT_V(8); PG8_WAIT_L(0); PG8_BAR; PG8_MMA(0, 0, At, B0); PG8_MMA(0, 1, At, B1); PG8_BAR; PG8_SCHED;
            PG8_LDA(At, 1, 1); PG8_STAGE(PG8_SB(1, 0), b3, voffB); PG8_STAGE(PG8_SB(1, 1), b3 + hstep, voffB); PG8_STAGE(PG8_SA(1, 0), a3, voffA);
            PG8_WAIT_V(8); PG8_WAIT_L(0); PG8_BAR; PG8_MMA(1, 0, At, B0); PG8_MMA(1, 1, At, B1); PG8_BAR; PG8_SCHED;
            } else {
            PG8_LDB(B0, 0, 0); PG8_SCHED; PG8_LDA(At, 0, 0); PG8_STAGE(PG8_SA(1, 1), a1 + hstep, voffA);
            PG8_WAIT_L(8); PG8_BAR; PG8_WAIT_L(0); PG8_MMA(0, 0, At, B0); PG8_BAR; PG8_SCHED;
            PG8_LDB(B1, 0, 1); PG8_STAGE(PG8_SB(0, 0), b2, voffB);
            PG8_BAR; PG8_WAIT_L(0); PG8_MMA(0, 1, At, B1); PG8_BAR;
            PG8_LDA(At, 0, 1); PG8_STAGE(PG8_SA(0, 0), a2, voffA);
            PG8_BAR; PG8_WAIT_L(0); PG8_MMA(1, 0, At, B0); PG8_BAR; PG8_SCHED;
            PG8_STAGE(PG8_SB(0, 1), b2 + hstep, voffB);
            PG8_WAIT_V(6); PG8_BAR; PG8_MMA(1, 1, At, B1); PG8_BAR;
            PG8_LDB(B0, 1, 0); PG8_SCHED; PG8_LDA(At, 1, 0); PG8_STAGE(PG8_SA(0, 1), a2 + hstep, voffA);
            PG8_WAIT_L(8); PG8_BAR; PG8_WAIT_L(0); PG8_MMA(0, 0, At, B0); PG8_BAR; PG8_SCHED;
            PG8_LDB(B1, 1, 1); PG8_STAGE(PG8_SB(1, 0), b3, voffB);
            PG8_BAR; PG8_WAIT_L(0); PG8_MMA(0, 1, At, B1); PG8_BAR;
            PG8_LDA(At, 1, 1); PG8_STAGE(PG8_SA(1, 0), a3, voffA);
            PG8_BAR; PG8_WAIT_L(0); PG8_MMA(1, 0, At, B0); PG8_BAR; PG8_SCHED;
            PG8_STAGE(PG8_SB(1, 1), b3 + hstep, voffB);
            PG8_WAIT_V(6); PG8_BAR; PG8_MMA(1, 1, At, B1); PG8_BAR;
            }
        }
        if constexpr (ALIGN_EPI) { if (wr == 0) PG8_BAR; }
        if constexpr (!Epi::AFTER_DRAIN) { E(acc, cur, wr, wc, fr, fq); S.done(cur); }
        if (!has_next) break;
#pragma unroll
        for (int a = 0; a < 2; ++a)
#pragma unroll
            for (int b = 0; b < 2; ++b)
#pragma unroll
                for (int m = 0; m < 4; ++m)
#pragma unroll
                    for (int n = 0; n < 2; ++n) acc[a][b][m][n] = (acc_t){0, 0, 0, 0};
        cur = nxt; cA = nA; cB = nB; ++ui;
        if constexpr (ALIGN_EPI) { if (wr == 1) PG8_BAR; }
    }
    PG8_WAIT_V(0);
    if constexpr (!ALIGN_EPI) { if (wr == 0) PG8_BAR; }
    PG8_BAR;
    if constexpr (Epi::AFTER_DRAIN) { E.fused(acc, cur, wr, wc, fr, fq, lds, wid, lane); S.done(cur); }
#undef PG8_SA
#undef PG8_SB
#undef PG8_STAGE
#undef PG8_LDA
#undef PG8_LDB
#undef PG8_MMA
#undef PG8_WAIT_V
#undef PG8_WAIT_L
#undef PG8_BAR
#undef PG8_SCHED
}
}
#ifndef PG8_SP2
#define PG8_SP2 true
#endif
#ifndef PG8_ALIGN
#define PG8_ALIGN true
#endif
constexpr int NWAVES = 8;
#ifndef MK_N_LAUNCHES
#define MK_N_LAUNCHES 1
#endif
constexpr int N_PHASES = 11;
constexpr int N_LAUNCHES = MK_N_LAUNCHES;

constexpr int D = 4096, NB = 4, SEQ = 2048, M = NB * SEQ, CTXL = 256, MC = NB * CTXL, MT = M + MC;
constexpr int HD = 128, NAH = 16, NAW = 2048, CVW = 2048, INC = 12288, FF = 11008, NMODC = 6 * D;
constexpr int GRIDW = 64, ROWS = 32, NAKH = 8, NAKW = 16;
constexpr float EPS = 1e-6f, LOG2E = 1.44269504089f;
enum { I_X = 0, I_C, I_CTX, I_CCTX, I_ADAW, I_ADAB, I_N1G, I_WIN, I_CONVW, I_RPB, I_GNG, I_WOUT, I_N2G, I_WGU, I_WDN, I_FNG, N_IN };

constexpr size_t MiB = 1u << 20;
constexpr size_t WS_CTL = 0, WS_MOD = 1 * MiB, CTL_ZERO_BYTES = 2 * MiB;
constexpr size_t WS_SSQ = 1536 * 1024;
constexpr size_t WS_CMAXD = 1600 * 1024;
constexpr size_t WS_ROPE = 2 * MiB;
constexpr size_t WS_RSA = 2 * MiB + 256 * 1024;
constexpr size_t WS_RSH = 2 * MiB + 64 * 1024, WS_CSW = 2 * MiB + 128 * 1024;
constexpr size_t WS_WIN = 4 * MiB, WS_WOUT = 100 * MiB, WS_WGU = 132 * MiB, WS_WDN = 304 * MiB;
constexpr size_t WS_H = 390 * MiB;
constexpr size_t WS_Q = 462 * MiB;
constexpr size_t WS_K = 494 * MiB;
constexpr size_t WS_V = 530 * MiB;
constexpr size_t WS_C = 566 * MiB;
constexpr size_t WS_AO = 662 * MiB;
constexpr size_t WS_Y = 694 * MiB;
constexpr size_t WS_X1 = 758 * MiB;
constexpr size_t WS_ACT = 886 * MiB;
constexpr size_t WS_END = 1058 * MiB;
static_assert(WS_WIN + (size_t)INC * D * 2 <= WS_WOUT && WS_WOUT + (size_t)D * D * 2 <= WS_WGU && WS_WGU + (size_t)2 * FF * D * 2 <= WS_WDN && WS_WDN + (size_t)D * FF * 2 <= WS_H, "ws map (weights)");
static_assert(WS_H + (size_t)MT * D * 2 <= WS_Q && WS_Q + (size_t)M * NAW * 2 <= WS_K && WS_K + (size_t)MT * NAW * 2 <= WS_V && WS_V + (size_t)MT * NAW * 2 <= WS_C && WS_C + (size_t)M * 6144 * 2 <= WS_AO, "ws map (acts 1)");
static_assert(WS_AO + (size_t)M * NAW * 2 <= WS_Y && WS_Y + (size_t)M * D * 2 <= WS_X1 && WS_X1 + (size_t)M * D * 4 <= WS_ACT && WS_ACT + (size_t)M * FF * 2 <= WS_END, "ws map (acts 2)");
constexpr int CW_XRANK = 1024;
constexpr int CW_BAR = 4096;

#ifndef P0_DN_ITEMS
#define P0_DN_ITEMS 8192
#endif
#ifndef P0_OUT_ITEMS
#define P0_OUT_ITEMS 0
#endif
#ifndef DNQ_COOP
#define DNQ_COOP 1
#endif
#ifndef TAIL2_DN_ITEMS
#define TAIL2_DN_ITEMS 22016
#endif
#ifndef P0_GUQ_BLOCKS
#define P0_GUQ_BLOCKS 0
#endif
#ifndef P0_GU_ITEMS
#define P0_GU_ITEMS 0
#endif
constexpr int RING_OFF = 0, RING_BYTES = 131072;
constexpr int LDSCTL_OFF = RING_BYTES, MISC_OFF = LDSCTL_OFF + 320;
constexpr int LDS_BYTES = 147456;
static_assert(MISC_OFF + 128 <= LDS_BYTES, "LDS map");

#define GAS __attribute__((address_space(1)))
#define LAS __attribute__((address_space(3)))
typedef unsigned short bf16;
typedef unsigned v4u __attribute__((ext_vector_type(4)));
typedef float f32x4 __attribute__((ext_vector_type(4)));
typedef short bf16x8 __attribute__((ext_vector_type(8)));
typedef GAS unsigned gu32;
typedef GAS unsigned long long gu64;
#define RLX_AGENT __ATOMIC_RELAXED, __HIP_MEMORY_SCOPE_AGENT
#define LDS_WAIT() asm volatile("s_waitcnt lgkmcnt(0)" ::: "memory")
#define VM_WAIT() asm volatile("s_waitcnt vmcnt(0)" ::: "memory")
__device__ __forceinline__ unsigned long long rt() { return __builtin_amdgcn_s_memrealtime(); }
__device__ __forceinline__ unsigned f2bf(float f) { unsigned u = __builtin_bit_cast(unsigned, f); return (u + 0x7fffu + ((u >> 16) & 1u)) >> 16; }
__device__ __forceinline__ unsigned pk2(float lo, float hi) { return f2bf(lo) | (f2bf(hi) << 16); }

#define XB_TMO      128
#define XB_XCNT(j)  (256  + 64 * (j))
#define XB_XSUB(j)  (1280 + 64 * (j))
#define XB_XGEN(j)  (2304 + 64 * (j))
#define XB_TOP      3328
#define XB_TOPGEN   3392
#define XCD_BAR_WORDS 3456
#define XB_SPIN_CAP (1u << 18)

__device__ __forceinline__ unsigned xb_ld(unsigned* p)              { return __hip_atomic_load(p, __ATOMIC_RELAXED, __HIP_MEMORY_SCOPE_AGENT); }
__device__ __forceinline__ unsigned xb_add(unsigned* p, unsigned v) { return __hip_atomic_fetch_add(p, v, __ATOMIC_RELAXED, __HIP_MEMORY_SCOPE_AGENT); }
__device__ __forceinline__ unsigned xb_xcc_id() { return (unsigned)__builtin_amdgcn_s_getreg((3 << 11) | 20) & 0xFu; }
#define XB_SPIN(cond, bar) do { unsigned _sp = 0; while (cond) { __builtin_amdgcn_s_sleep(1); \
    if ((++_sp & 255u) == 0u) { if (xb_ld(&(bar)[XB_TMO])) break; if (_sp > XB_SPIN_CAP) { atomicAdd(&(bar)[XB_TMO], 1u); break; } } } } while (0)

struct XcdBarrier {
    unsigned* bar; unsigned x;
    volatile LAS unsigned* st;
};

__device__ __forceinline__ XcdBarrier xcd_barrier_post(unsigned* bar, volatile LAS unsigned* st) {
    XcdBarrier b; b.bar = bar; b.x = xb_xcc_id(); b.st = st;
    if (threadIdx.x == 0) (void)xb_add(&bar[XB_XCNT(b.x)], 1u);
    return b;
}
__device__ __forceinline__ void xcd_barrier_complete(unsigned* bar, unsigned x, unsigned& nloc, unsigned& nx) {
    const unsigned G = gridDim.x * gridDim.y * gridDim.z;
    unsigned sum, cnt, mine, sp = 0u;
    for (;;) {
        sum = 0u; cnt = 0u; mine = 0u;
#pragma unroll
        for (unsigned j = 0; j < 16; ++j) { const unsigned c = xb_ld(&bar[XB_XCNT(j)]); sum += c; cnt += (c > 0u) ? 1u : 0u; mine = (j == x) ? c : mine; }
        if (sum == G) break;
        __builtin_amdgcn_s_sleep(1);
        if ((++sp & 255u) == 0u) { if (xb_ld(&bar[XB_TMO])) break; if (sp > XB_SPIN_CAP) { atomicAdd(&bar[XB_TMO], 1u); break; } }
    }
    nloc = mine > 0u ? mine : 1u; nx = cnt > 0u ? cnt : 1u;
}

__device__ __forceinline__ void xcd_barrier(const XcdBarrier& b) {
    asm volatile("s_waitcnt vmcnt(0)" ::: "memory");
    __syncthreads();
    if (threadIdx.x == 0) {
        unsigned* bar = b.bar;
        __builtin_amdgcn_s_waitcnt(0);
        unsigned nloc = b.st[0], nx = b.st[1];
        if (nloc == 0u) { xcd_barrier_complete(bar, b.x, nloc, nx); b.st[0] = nloc; b.st[1] = nx; }
        const unsigned old = xb_add(&bar[XB_XSUB(b.x)], 1u);
        const unsigned gen = old / nloc;
        if (old + 1u == (gen + 1u) * nloc) {
            __builtin_amdgcn_fence(__ATOMIC_RELEASE, "agent");
            asm volatile("s_waitcnt vmcnt(0)" ::: "memory");
            const unsigned og = xb_add(&bar[XB_TOP], 1u);
            const unsigned tg = og / nx;
            if (og + 1u == (tg + 1u) * nx) xb_add(&bar[XB_TOPGEN], 1u);
            else XB_SPIN(xb_ld(&bar[XB_TOPGEN]) == tg, bar);
            __builtin_amdgcn_fence(__ATOMIC_ACQUIRE, "agent");
            xb_add(&bar[XB_XGEN(b.x)], 1u);
            asm volatile("s_waitcnt vmcnt(0)" ::: "memory");
        } else {
            XB_SPIN(xb_ld(&bar[XB_XGEN(b.x)]) == gen, bar);
            __builtin_amdgcn_fence(__ATOMIC_ACQUIRE, "agent");
            asm volatile("s_waitcnt vmcnt(0)" ::: "memory");
        }
    }
    __syncthreads();
}

typedef float f32x16 __attribute__((ext_vector_type(16)));
typedef unsigned v2u __attribute__((ext_vector_type(2)));
struct Frame {
    LAS unsigned char* lds;
    volatile LAS unsigned* MISC;
    gu32* ctl;
    int tid, lane, wave, vcu, G;
    const float* in[N_IN]; float* out;
    float* mod; float* rope;
    bf16 *Win_t, *Wout_t, *Wgu_t, *Wdn_t;
    bf16 *HB, *QB, *KB, *VB, *CB, *YB, *ACT, *MX, *FX; float* ssq; signed char *HQ, *Wgu_q, *ACTQ, *Wdn_q; float *rsH, *csW, *rsA; unsigned* cmaxD;
};
template <int CTRL> __device__ __forceinline__ float dpp_add(float v) { return v + __builtin_bit_cast(float, __builtin_amdgcn_update_dpp(0, __builtin_bit_cast(int, v), CTRL, 0xf, 0xf, true)); }
__device__ __forceinline__ float wave_sum(float v) {
    v = dpp_add<0xB1>(v); v = dpp_add<0x4E>(v); v = dpp_add<0x141>(v); v = dpp_add<0x140>(v);
    v += __builtin_bit_cast(float, __builtin_amdgcn_ds_swizzle(__builtin_bit_cast(int, v), 0x401F));
    return __builtin_bit_cast(float, __builtin_amdgcn_readlane(__builtin_bit_cast(int, v), 0)) + __builtin_bit_cast(float, __builtin_amdgcn_readlane(__builtin_bit_cast(int, v), 32));
}
template <int CTRL> __device__ __forceinline__ float dpp_max(float v) { return fmaxf(v, __builtin_bit_cast(float, __builtin_amdgcn_update_dpp(0, __builtin_bit_cast(int, v), CTRL, 0xf, 0xf, true))); }
__device__ __forceinline__ float wave_max(float v) {
    v = dpp_max<0xB1>(v); v = dpp_max<0x4E>(v); v = dpp_max<0x141>(v); v = dpp_max<0x140>(v);
    v = fmaxf(v, __builtin_bit_cast(float, __builtin_amdgcn_ds_swizzle(__builtin_bit_cast(int, v), 0x401F)));
    return fmaxf(__builtin_bit_cast(float, __builtin_amdgcn_readlane(__builtin_bit_cast(int, v), 0)), __builtin_bit_cast(float, __builtin_amdgcn_readlane(__builtin_bit_cast(int, v), 32)));
}
__device__ __forceinline__ unsigned pkbf(float lo, float hi) { return pg8::pkbf(lo, hi); }
__device__ __forceinline__ unsigned pkq4(float a, float b, float c, float d) {
    a = fminf(fmaxf(a, -127.f), 127.f); b = fminf(fmaxf(b, -127.f), 127.f); c = fminf(fmaxf(c, -127.f), 127.f); d = fminf(fmaxf(d, -127.f), 127.f);
    const int ia = (int)__builtin_rintf(a), ib = (int)__builtin_rintf(b), ic = (int)__builtin_rintf(c), id = (int)__builtin_rintf(d);
    return (unsigned)(ia & 0xff) | ((unsigned)(ib & 0xff) << 8) | ((unsigned)(ic & 0xff) << 16) | ((unsigned)id << 24);
}
__device__ __forceinline__ float bflo(unsigned w) { return __builtin_bit_cast(float, w << 16); }
__device__ __forceinline__ float bfhi(unsigned w) { return __builtin_bit_cast(float, w & 0xffff0000u); }

__device__ __forceinline__ int map_in(int n) {
    if (n < 4096) { const int hd = n & ~127, d = n & 127, blk = d >> 6, e4 = (d >> 5) & 1, i = d & 31; return hd + 64 * blk + 8 * (i >> 2) + 4 * e4 + (i & 3); }
    if (n < 6144) return n;
    const int kind = (n - 6144) >> 11, c = (n - 6144) & 2047;
    if (kind == 1) return 10240 + c;
    return 6144 + 256 * (c >> 7) + (kind == 2 ? 128 : 0) + (c & 127);
}
__device__ __forceinline__ int map_gu(int n) { const int up = n >= FF ? 1 : 0, jx = up ? n - FF : n; return 256 * (jx >> 7) + 128 * up + (jx & 127); }
#ifndef TR_NT
#define TR_NT 1
#endif
#ifndef TR_NT_ST
#define TR_NT_ST 1
#endif
#if TR_NT
#define TR_LOAD(p) __builtin_nontemporal_load(p)
#else
#define TR_LOAD(p) (*(p))
#endif
#if TR_NT_ST
#define TR_STORE(v, p) __builtin_nontemporal_store((v), (p))
#else
#define TR_STORE(v, p) (*(p) = (v))
#endif
#ifndef W_DROP_BITS
#define W_DROP_BITS 0
#endif
__device__ __forceinline__ unsigned pkw(float lo, float hi) {
#if W_DROP_BITS > 0
    constexpr unsigned SH = 16 + W_DROP_BITS, HALF_ = (1u << (SH - 1)) - 1u, MASK = ~((1u << SH) - 1u);
    unsigned a = __builtin_bit_cast(unsigned, lo), b = __builtin_bit_cast(unsigned, hi);
    a = (a + HALF_ + ((a >> SH) & 1u)) & MASK; b = (b + HALF_ + ((b >> SH) & 1u)) & MASK;
    return (a >> 16) | (b & 0xffff0000u);
#else
    return pkbf(lo, hi);
#endif
}
template <int MAP> __device__ __forceinline__ void transpose_items(const float* W, int K, int N, bf16* WT, LAS float* scr, int first, int stride, int end, int lane, const float* kscale = nullptr) {
    const int nblk = N / 32;
    const GAS float* Wl = (const GAS float*)W + (size_t)(lane >> 3) * N + 4 * (lane & 7);
    LAS float* sw = scr + (lane >> 3) * 33 + 4 * (lane & 7);
    const int c = lane & 7;
    f32x4 v[8];
    int it = first;
    if (it < end) { const GAS float* Wg = Wl + (size_t)(64 * (it / nblk)) * N + 32 * (it % nblk);
#pragma unroll
        for (int i = 0; i < 8; ++i) v[i] = TR_LOAD((const GAS f32x4*)(Wg + (size_t)(8 * i) * N)); }
    while (it < end) {
        const int k0 = 64 * (it / nblk), n0 = 32 * (it % nblk);
#pragma unroll
        for (int i = 0; i < 8; ++i) { sw[(8 * i) * 33 + 0] = v[i].x; sw[(8 * i) * 33 + 1] = v[i].y; sw[(8 * i) * 33 + 2] = v[i].z; sw[(8 * i) * 33 + 3] = v[i].w; }
        const int nx = it + stride;
        if (nx < end) { const GAS float* Wg = Wl + (size_t)(64 * (nx / nblk)) * N + 32 * (nx % nblk);
#pragma unroll
            for (int i = 0; i < 8; ++i) v[i] = TR_LOAD((const GAS f32x4*)(Wg + (size_t)(8 * i) * N)); }
        LDS_WAIT(); asm volatile("" ::: "memory");
#pragma unroll
        for (int j = 0; j < 4; ++j) { const int n = (lane >> 3) + 8 * j; const LAS float* s = scr + (8 * c) * 33 + n;
            v4u o;
            if (MAP == 3) { const f32x4 g0 = *(const GAS f32x4*)(kscale + k0 + 8 * c), g1 = *(const GAS f32x4*)(kscale + k0 + 8 * c + 4);
                o.x = pkw(s[0 * 33] * g0.x, s[1 * 33] * g0.y); o.y = pkw(s[2 * 33] * g0.z, s[3 * 33] * g0.w); o.z = pkw(s[4 * 33] * g1.x, s[5 * 33] * g1.y); o.w = pkw(s[6 * 33] * g1.z, s[7 * 33] * g1.w); }
            else if (MAP == 6 || MAP == 7 || MAP == 8) { float t[8];
#pragma unroll
                for (int e = 0; e < 8; ++e) t[e] = s[e * 33];
#pragma unroll
                for (int st = 1; st < 8; st <<= 1)
#pragma unroll
                    for (int e = 0; e < 8; ++e) if (!(e & st)) { const float a = t[e], b = t[e ^ st]; t[e] = a + b; t[e ^ st] = a - b; }
#pragma unroll
                for (int e = 0; e < 8; ++e) { const float p = __builtin_bit_cast(float, __builtin_amdgcn_update_dpp(0, __builtin_bit_cast(int, t[e]), 0xB1, 0xf, 0xf, true)); t[e] = (c & 1) ? p - t[e] : t[e] + p; }
#pragma unroll
                for (int e = 0; e < 8; ++e) { const float p = __builtin_bit_cast(float, __builtin_amdgcn_update_dpp(0, __builtin_bit_cast(int, t[e]), 0x4E, 0xf, 0xf, true)); t[e] = ((c & 2) ? p - t[e] : t[e] + p) * 0.17677669529663687f; }
                if (MAP == 7) {
                    float a = 0.f;
#pragma unroll
                    for (int e = 0; e < 8; ++e) a = fmaxf(a, fabsf(t[e]));
                    a = dpp_max<0xB1>(a); a = dpp_max<0x4E>(a); a = dpp_max<0x141>(a);
                    if (c == 0) atomicMax((unsigned*)kscale + (n0 + n), __builtin_bit_cast(unsigned, a));
                    continue; }
                if (MAP == 8) {
                    const float am = __builtin_bit_cast(float, __hip_atomic_load((const GAS unsigned*)kscale + (n0 + n), __ATOMIC_RELAXED, __HIP_MEMORY_SCOPE_AGENT)), q = am > 0.f ? 127.0f / am : 0.f;
                    if (c == 0 && k0 == 0) ((GAS float*)kscale)[4096 + n0 + n] = am * (1.0f / 127.0f);
#if defined(FAKEQ_DN)
                    { const float dq = am * (1.0f / 127.0f);
#pragma unroll
                      for (int e = 0; e < 8; ++e) t[e] = __builtin_rintf(fminf(fmaxf(t[e] * q, -127.f), 127.f)) * dq;
                      o.x = pkw(t[0], t[1]); o.y = pkw(t[2], t[3]); o.z = pkw(t[4], t[5]); o.w = pkw(t[6], t[7]);
                      TR_STORE(o, (GAS v4u*)(WT + (size_t)(n0 + n) * K + k0 + 8 * c)); continue; }
#endif
                    v2u o8; o8.x = pkq4(t[0] * q, t[1] * q, t[2] * q, t[3] * q); o8.y = pkq4(t[4] * q, t[5] * q, t[6] * q, t[7] * q);
                    __builtin_nontemporal_store(o8, (GAS v2u*)((signed char*)WT + (size_t)(n0 + n) * K + k0 + 8 * c));
                    continue; }
                o.x = pkw(t[0], t[1]); o.y = pkw(t[2], t[3]); o.z = pkw(t[4], t[5]); o.w = pkw(t[6], t[7]); }
            else { o.x = pkw(s[0 * 33], s[1 * 33]); o.y = pkw(s[2 * 33], s[3 * 33]); o.z = pkw(s[4 * 33], s[5 * 33]); o.w = pkw(s[6 * 33], s[7 * 33]); }
            const int nsrc = n0 + n, nd = MAP == 1 ? map_in(nsrc) : (MAP == 2 ? map_gu(nsrc) : nsrc);
            TR_STORE(o, (GAS v4u*)(WT + (size_t)nd * K + k0 + 8 * c)); }
        LDS_WAIT(); asm volatile("" ::: "memory");
        it = nx;
    }
}
constexpr int IT_IN = (D / 64) * (INC / 32), IT_OUT = (D / 64) * (D / 32), IT_GU = (D / 64) * (2 * FF / 32), IT_DN = (FF / 64) * (D / 32);
__device__ __forceinline__ void quant_gu_block(Frame& F, int nb) {
    const int lane = F.lane, N = 2 * FF, nblk = N / 32, n0 = 32 * nb, K = D;
    LAS float* scr = (LAS float*)(F.lds + RING_OFF + F.wave * 16384);
    LAS float* red = (LAS float*)(F.lds + RING_OFF + 12288);
    const GAS float* Wl = (const GAS float*)F.in[I_WGU] + (size_t)(lane >> 3) * N + n0 + 4 * (lane & 7);
    f32x4 m4 = {0.f, 0.f, 0.f, 0.f};
    for (int kb = F.wave; kb < 64; kb += 8) { const GAS float* Wg = Wl + (size_t)(64 * kb) * N;
#pragma unroll
        for (int i = 0; i < 8; ++i) { const f32x4 v = *(const GAS f32x4*)(Wg + (size_t)(8 * i) * N);
            m4.x = fmaxf(m4.x, fabsf(v.x)); m4.y = fmaxf(m4.y, fabsf(v.y)); m4.z = fmaxf(m4.z, fabsf(v.z)); m4.w = fmaxf(m4.w, fabsf(v.w)); } }
#pragma unroll
    for (int o = 8; o < 64; o <<= 1) { m4.x = fmaxf(m4.x, __shfl_xor(m4.x, o)); m4.y = fmaxf(m4.y, __shfl_xor(m4.y, o)); m4.z = fmaxf(m4.z, __shfl_xor(m4.z, o)); m4.w = fmaxf(m4.w, __shfl_xor(m4.w, o)); }
    if (lane < 8) *(LAS f32x4*)(red + F.wave * 32 + 4 * lane) = m4;
    __syncthreads();
    float qinv[4];
#pragma unroll
    for (int j = 0; j < 4; ++j) { const int n = (lane >> 3) + 8 * j; float a = 0.f;
#pragma unroll
        for (int w = 0; w < 8; ++w) a = fmaxf(a, red[w * 32 + n]);
        qinv[j] = a > 0.f ? 127.0f / a : 0.f;
        if (F.wave == 0 && (lane & 7) == 0) F.csW[map_gu(n0 + n)] = a * (1.0f / 127.0f); }
    LAS float* sw = scr + (lane >> 3) * 33 + 4 * (lane & 7);
    const int c = lane & 7;
    f32x4 v[8];
    int kb = F.wave;
    { const GAS float* Wg = Wl + (size_t)(64 * kb) * N;
#pragma unroll
      for (int i = 0; i < 8; ++i) v[i] = *(const GAS f32x4*)(Wg + (size_t)(8 * i) * N); }
    while (kb < 64) {
        const int k0 = 64 * kb;
#pragma unroll
        for (int i = 0; i < 8; ++i) { sw[(8 * i) * 33 + 0] = v[i].x; sw[(8 * i) * 33 + 1] = v[i].y; sw[(8 * i) * 33 + 2] = v[i].z; sw[(8 * i) * 33 + 3] = v[i].w; }
        const int nx = kb + 8;
        if (nx < 64) { const GAS float* Wg = Wl + (size_t)(64 * nx) * N;
#pragma unroll
            for (int i = 0; i < 8; ++i) v[i] = *(const GAS f32x4*)(Wg + (size_t)(8 * i) * N); }
        LDS_WAIT(); asm volatile("" ::: "memory");
#pragma unroll
        for (int j = 0; j < 4; ++j) { const int n = (lane >> 3) + 8 * j; const LAS float* s = scr + (8 * c) * 33 + n; const float q = qinv[j];
            v2u o; o.x = pkq4(s[0 * 33] * q, s[1 * 33] * q, s[2 * 33] * q, s[3 * 33] * q); o.y = pkq4(s[4 * 33] * q, s[5 * 33] * q, s[6 * 33] * q, s[7 * 33] * q);
            __builtin_nontemporal_store(o, (GAS v2u*)(F.Wgu_q + (size_t)map_gu(n0 + n) * K + k0 + 8 * c)); }
        LDS_WAIT(); asm volatile("" ::: "memory");
        kb = nx;
    }
    __syncthreads();
}
#define QDN_LOAD(KB) do { const GAS float* Wg_ = Wl + (size_t)(64 * (KB)) * N; _Pragma("unroll") for (int i = 0; i < 8; ++i) v[i] = *(const GAS f32x4*)(Wg_ + (size_t)(8 * i) * N); } while (0)
#define QDN_TILE() do { _Pragma("unroll") for (int i = 0; i < 8; ++i) { sw[(8 * i) * 33 + 0] = v[i].x; sw[(8 * i) * 33 + 1] = v[i].y; sw[(8 * i) * 33 + 2] = v[i].z; sw[(8 * i) * 33 + 3] = v[i].w; } } while (0)
#define QDN_ROT(J) float t[8]; { const LAS float* s_ = scr + (8 * c) * 33 + (lane >> 3) + 8 * (J); \
        _Pragma("unroll") for (int e = 0; e < 8; ++e) t[e] = s_[e * 33]; \
        _Pragma("unroll") for (int st = 1; st < 8; st <<= 1) _Pragma("unroll") for (int e = 0; e < 8; ++e) if (!(e & st)) { const float a_ = t[e], b_ = t[e ^ st]; t[e] = a_ + b_; t[e ^ st] = a_ - b_; } \
        _Pragma("unroll") for (int e = 0; e < 8; ++e) { const float p_ = __builtin_bit_cast(float, __builtin_amdgcn_update_dpp(0, __builtin_bit_cast(int, t[e]), 0xB1, 0xf, 0xf, true)); t[e] = (c & 1) ? p_ - t[e] : t[e] + p_; } \
        _Pragma("unroll") for (int e = 0; e < 8; ++e) { const float p_ = __builtin_bit_cast(float, __builtin_amdgcn_update_dpp(0, __builtin_bit_cast(int, t[e]), 0x4E, 0xf, 0xf, true)); t[e] = ((c & 2) ? p_ - t[e] : t[e] + p_) * 0.17677669529663687f; } }
__device__ __forceinline__ void quant_dn_block(Frame& F, int nb) {
    const int lane = F.lane, N = D, K = FF, NKB = FF / 64, n0 = 32 * nb, c = lane & 7;
    LAS float* scr = (LAS float*)(F.lds + RING_OFF + F.wave * 16384);
    LAS float* red = (LAS float*)(F.lds + RING_OFF + 12288);
    LAS float* sw = scr + (lane >> 3) * 33 + 4 * (lane & 7);
    const GAS float* Wl = (const GAS float*)F.in[I_WDN] + (size_t)(lane >> 3) * N + n0 + 4 * (lane & 7);
    f32x4 v[8];
    float mx[4] = {0.f, 0.f, 0.f, 0.f};
    { int kb = F.wave; QDN_LOAD(kb);
      while (kb < NKB) { QDN_TILE(); const int nx = kb + 8; if (nx < NKB) QDN_LOAD(nx);
          LDS_WAIT(); asm volatile("" ::: "memory");
#pragma unroll
          for (int j = 0; j < 4; ++j) { QDN_ROT(j);
#pragma unroll
              for (int e = 0; e < 8; ++e) mx[j] = fmaxf(mx[j], fabsf(t[e])); }
          LDS_WAIT(); asm volatile("" ::: "memory"); kb = nx; } }
#pragma unroll
    for (int j = 0; j < 4; ++j) { float a = mx[j]; a = dpp_max<0xB1>(a); a = dpp_max<0x4E>(a); a = dpp_max<0x141>(a); if (c == 0) red[F.wave * 32 + (lane >> 3) + 8 * j] = a; }
    __syncthreads();
    float qinv[4];
#pragma unroll
    for (int j = 0; j < 4; ++j) { const int n = (lane >> 3) + 8 * j; float a = 0.f;
#pragma unroll
        for (int w = 0; w < 8; ++w) a = fmaxf(a, red[w * 32 + n]);
        qinv[j] = a > 0.f ? 127.0f / a : 0.f;
        if (F.wave == 0 && c == 0) ((float*)F.cmaxD)[4096 + n0 + n] = a * (1.0f / 127.0f); }
    { int kb = F.wave; QDN_LOAD(kb);
      while (kb < NKB) { const int k0 = 64 * kb; QDN_TILE(); const int nx = kb + 8; if (nx < NKB) QDN_LOAD(nx);
          LDS_WAIT(); asm volatile("" ::: "memory");
#pragma unroll
          for (int j = 0; j < 4; ++j) { QDN_ROT(j); const float q = qinv[j];
              v2u o8; o8.x = pkq4(t[0] * q, t[1] * q, t[2] * q, t[3] * q); o8.y = pkq4(t[4] * q, t[5] * q, t[6] * q, t[7] * q);
              __builtin_nontemporal_store(o8, (GAS v2u*)(F.Wdn_q + (size_t)(n0 + (lane >> 3) + 8 * j) * K + k0 + 8 * c)); }
          LDS_WAIT(); asm volatile("" ::: "memory"); kb = nx; } }
    __syncthreads();
}
#undef QDN_LOAD
#undef QDN_TILE
#undef QDN_ROT
__device__ __forceinline__ void p0_prologue(Frame& F, const float amul) {
    { const int gi = blockIdx.x * (NWAVES * 64) + F.tid;
      if (gi < 2048) { const int pos = gi >> 5, i = gi & 31; const float fr = exp2f(-(float)i * (13.287712379549449f / 32.0f)); const float ang = (float)pos * fr;
          F.rope[gi] = cosf(ang); F.rope[2048 + gi] = sinf(ang); } }
    { LAS float* sil = (LAS float*)(F.lds + RING_OFF);
      LAS float* red = (LAS float*)(F.lds + RING_OFF + 16384);
      const GAS float* aw = (const GAS float*)F.in[I_ADAW];
      for (int it = blockIdx.x; it < 768; it += F.G) {
          const int cs = it % 96, ks = it / 96, k0 = 512 * ks;
          for (int idx = F.tid; idx < 5 * 512; idx += NWAVES * 64) { const int bb = idx >> 9, kk = idx & 511;
              const float v = bb < 4 ? F.in[I_C][bb * D + k0 + kk] : F.in[I_CCTX][k0 + kk]; sil[idx] = v / (1.0f + __expf(-v)); }
          __syncthreads();
          f32x4 a0 = {0.f, 0.f, 0.f, 0.f}, a1 = a0, a2 = a0, a3 = a0, a4 = a0;
          const GAS float* wp = aw + (size_t)(k0 + F.wave) * NMODC + 256 * cs + 4 * F.lane;
#pragma unroll 8
          for (int i = 0; i < 64; ++i) { const f32x4 w = __builtin_nontemporal_load((const GAS f32x4*)(wp + (size_t)(8 * i) * NMODC)); const int k = F.wave + 8 * i;
              a0 += sil[k] * w; a1 += sil[512 + k] * w; a2 += sil[1024 + k] * w; a3 += sil[1536 + k] * w; a4 += sil[2048 + k] * w; }
          LAS f32x4* rw = (LAS f32x4*)(red + F.wave * 1280) + F.lane;
          rw[0] = a0; rw[64] = a1; rw[128] = a2; rw[192] = a3; rw[256] = a4;
          __syncthreads();
          for (int idx = F.tid; idx < 1280; idx += NWAVES * 64) { float s = 0.f;
#pragma unroll
              for (int w = 0; w < 8; ++w) s += red[w * 1280 + idx];
              const int bb = idx >> 8, cc = idx & 255, n = 256 * cs + cc;
              if (ks == 0) s += F.in[I_ADAB][n];
              atomicAdd(F.mod + bb * NMODC + n, s * amul); }
          __syncthreads();
      } }
    LAS float* scr = (LAS float*)(F.lds + RING_OFF + F.wave * 16384);
    const int gw = F.vcu * NWAVES + F.wave, NGW = F.G * NWAVES;
    transpose_items<1>(F.in[I_WIN], D, INC, F.Win_t, scr, gw, NGW, IT_IN, F.lane);
#if !DNQ_COOP
    transpose_items<7>(F.in[I_WDN], FF, D, F.Wdn_t, scr, gw, NGW, IT_DN, F.lane, (const float*)F.cmaxD);
#endif
    transpose_items<3>(F.in[I_WOUT], D, D, F.Wout_t, scr, gw, NGW, P0_OUT_ITEMS, F.lane, F.in[I_GNG]);
    if (P0_GUQ_BLOCKS > 0) { __syncthreads(); for (int nb = (int)blockIdx.x; nb < P0_GUQ_BLOCKS; nb += F.G) quant_gu_block(F, nb); }
}

__device__ __forceinline__ void norm_mod_row(const float* xrow, bf16* orow, const float* gain, const float* shift, const float* scale, int lane) {
    const GAS f32x4* xr = (const GAS f32x4*)xrow + lane;
    f32x4 v[16]; float ss = 0.f;
#pragma unroll
    for (int j = 0; j < 16; ++j) { v[j] = __builtin_nontemporal_load(xr + 64 * j); ss += (v[j].x * v[j].x + v[j].y * v[j].y) + (v[j].z * v[j].z + v[j].w * v[j].w); }
    const float rstd = 1.0f / sqrtf(wave_sum(ss) * (1.0f / D) + EPS);
    const GAS f32x4* g4 = (const GAS f32x4*)gain + lane; const GAS f32x4* sh4 = (const GAS f32x4*)shift + lane; const GAS f32x4* sc4 = (const GAS f32x4*)scale + lane;
    GAS v2u* o8 = (GAS v2u*)orow + lane;
#pragma unroll
    for (int j = 0; j < 16; ++j) { const f32x4 g = g4[64 * j], sh = sh4[64 * j], sc = sc4[64 * j];
        const f32x4 y = v[j] * rstd * g * (1.0f + sc) + sh; v2u w; w.x = pkbf(y.x, y.y); w.y = pkbf(y.z, y.w); o8[64 * j] = w; }
}

__device__ __forceinline__ void norm_mod_row_x1(const float* xrow, const bf16* mrow, bf16* orow, const float* gain, const float* shift, const float* scale, int lane) {
    const GAS f32x4* xr = (const GAS f32x4*)xrow + lane; const GAS v2u* mr = (const GAS v2u*)mrow + lane;
    f32x4 v[16]; float ss = 0.f;
#pragma unroll
    for (int j = 0; j < 16; ++j) { const f32x4 x = __builtin_nontemporal_load(xr + 64 * j); const v2u m = __builtin_nontemporal_load(mr + 64 * j);
        v[j] = (f32x4){x.x + bflo(m.x), x.y + bfhi(m.x), x.z + bflo(m.y), x.w + bfhi(m.y)};
        ss += (v[j].x * v[j].x + v[j].y * v[j].y) + (v[j].z * v[j].z + v[j].w * v[j].w); }
    const float rstd = 1.0f / sqrtf(wave_sum(ss) * (1.0f / D) + EPS);
    const GAS f32x4* g4 = (const GAS f32x4*)gain + lane; const GAS f32x4* sh4 = (const GAS f32x4*)shift + lane; const GAS f32x4* sc4 = (const GAS f32x4*)scale + lane;
    GAS v2u* o8 = (GAS v2u*)orow + lane;
#pragma unroll
    for (int j = 0; j < 16; ++j) { const f32x4 g = g4[64 * j], sh = sh4[64 * j], sc = sc4[64 * j];
        const f32x4 y = v[j] * rstd * g * (1.0f + sc) + sh; v2u w; w.x = pkbf(y.x, y.y); w.y = pkbf(y.z, y.w); o8[64 * j] = w; }
}

__device__ __forceinline__ void norm_mod_row_x1_q8(const float* xrow, const bf16* mrow, signed char* orow, float* rs_out, const float* gain, const float* shift, const float* scale, int lane) {
    const GAS f32x4* xr = (const GAS f32x4*)xrow + lane; const GAS v2u* mr = (const GAS v2u*)mrow + lane;
    f32x4 v[16]; float ss = 0.f;
#pragma unroll
    for (int j = 0; j < 16; ++j) { const f32x4 x = __builtin_nontemporal_load(xr + 64 * j); const v2u m = __builtin_nontemporal_load(mr + 64 * j);
        v[j] = (f32x4){x.x + bflo(m.x), x.y + bfhi(m.x), x.z + bflo(m.y), x.w + bfhi(m.y)};
        ss += (v[j].x * v[j].x + v[j].y * v[j].y) + (v[j].z * v[j].z + v[j].w * v[j].w); }
    const float rstd = 1.0f / sqrtf(wave_sum(ss) * (1.0f / D) + EPS);
    const GAS f32x4* g4 = (const GAS f32x4*)gain + lane; const GAS f32x4* sh4 = (const GAS f32x4*)shift + lane; const GAS f32x4* sc4 = (const GAS f32x4*)scale + lane;
    float am = 0.f;
#pragma unroll
    for (int j = 0; j < 16; ++j) { const f32x4 g = g4[64 * j], sh = sh4[64 * j], sc = sc4[64 * j];
        v[j] = v[j] * rstd * g * (1.0f + sc) + sh; am = fmaxf(fmaxf(am, fmaxf(fabsf(v[j].x), fabsf(v[j].y))), fmaxf(fabsf(v[j].z), fabsf(v[j].w))); }
    am = wave_max(am);
    const float qi = am > 0.f ? 127.0f / am : 0.f;
    GAS unsigned* o4 = (GAS unsigned*)orow + lane;
#pragma unroll
    for (int j = 0; j < 16; ++j) o4[64 * j] = pkq4(v[j].x * qi, v[j].y * qi, v[j].z * qi, v[j].w * qi);
    if (lane == 0) *rs_out = am * (1.0f / 127.0f);
}

__device__ __forceinline__ void quant_act_row(const bf16* arow, signed char* orow, float* rs_out, int lane) {
    const GAS v2u* ar = (const GAS v2u*)arow + lane;
    v2u a[43]; float am = 0.f;
#pragma unroll
    for (int q = 0; q < 43; ++q) { a[q] = __builtin_nontemporal_load(ar + 64 * q);
        am = fmaxf(fmaxf(am, fmaxf(fabsf(bflo(a[q].x)), fabsf(bfhi(a[q].x)))), fmaxf(fabsf(bflo(a[q].y)), fabsf(bfhi(a[q].y)))); }
    am = wave_max(am);
    const float qi = am > 0.f ? 127.0f / am : 0.f;
#if defined(FAKEQ_DN)
    { const float dq = am * (1.0f / 127.0f); GAS v2u* ob = (GAS v2u*)arow + lane;
#pragma unroll
      for (int q = 0; q < 43; ++q) { v2u w; w.x = pkbf(__builtin_rintf(bflo(a[q].x) * qi) * dq, __builtin_rintf(bfhi(a[q].x) * qi) * dq); w.y = pkbf(__builtin_rintf(bflo(a[q].y) * qi) * dq, __builtin_rintf(bfhi(a[q].y) * qi) * dq); ob[64 * q] = w; } }
#endif
    GAS unsigned* o4 = (GAS unsigned*)orow + lane;
#pragma unroll
    for (int q = 0; q < 43; ++q) o4[64 * q] = pkq4(bflo(a[q].x) * qi, bfhi(a[q].x) * qi, bflo(a[q].y) * qi, bfhi(a[q].y) * qi);
    if (lane == 0) *rs_out = am * (1.0f / 127.0f);
}


__device__ __forceinline__ void stage_mod(Frame& F, const float* gain, const float* shift, const float* scale) {
    LAS float* Gs = (LAS float*)(F.lds + RING_OFF); LAS float* Ss = Gs + D;
    int t0 = F.tid; asm volatile("" : "+v"(t0));
    for (int i = t0; i < D; i += NWAVES * 64) { Gs[i] = gain[i] * (1.0f + scale[i]); Ss[i] = shift[i]; }
    __syncthreads();
}
__device__ __forceinline__ void p6_row_lds(Frame& F, int m) {
    const int lane = F.lane;
    const LAS f32x4* G4 = (const LAS f32x4*)(F.lds + RING_OFF) + lane; const LAS f32x4* S4 = G4 + D / 4;
    const GAS f32x4* xr = (const GAS f32x4*)(F.in[I_X] + (size_t)m * D) + lane; const GAS v2u* mr = (const GAS v2u*)(F.MX + (size_t)m * D) + lane;
    f32x4 v[16]; float ss = 0.f;
#pragma unroll
    for (int j = 0; j < 16; ++j) { const f32x4 x = __builtin_nontemporal_load(xr + 64 * j); const v2u mm = __builtin_nontemporal_load(mr + 64 * j);
        v[j] = (f32x4){x.x + bflo(mm.x), x.y + bfhi(mm.x), x.z + bflo(mm.y), x.w + bfhi(mm.y)};
        ss += (v[j].x * v[j].x + v[j].y * v[j].y) + (v[j].z * v[j].z + v[j].w * v[j].w); }
    const float rstd = 1.0f / sqrtf(wave_sum(ss) * (1.0f / D) + EPS);
    float am = 0.f;
#pragma unroll
    for (int j = 0; j < 16; ++j) { v[j] = v[j] * rstd * G4[64 * j] + S4[64 * j]; am = fmaxf(fmaxf(am, fmaxf(fabsf(v[j].x), fabsf(v[j].y))), fmaxf(fabsf(v[j].z), fabsf(v[j].w))); }
    am = wave_max(am);
    const float qi = am > 0.f ? 127.0f / am : 0.f;
    GAS unsigned* o4 = (GAS unsigned*)(F.HQ + (size_t)m * D) + lane;
#pragma unroll
    for (int j = 0; j < 16; ++j) o4[64 * j] = pkq4(v[j].x * qi, v[j].y * qi, v[j].z * qi, v[j].w * qi);
    if (lane == 0) F.rsH[m] = am * (1.0f / 127.0f);
}
__device__ __forceinline__ void p1_row_lds(Frame& F, int m) {
    const int lane = F.lane;
    const LAS f32x4* G4 = (const LAS f32x4*)(F.lds + RING_OFF) + lane; const LAS f32x4* S4 = G4 + D / 4;
    const GAS f32x4* xr = (const GAS f32x4*)(F.in[I_X] + (size_t)m * D) + lane;
    f32x4 v[16]; float ss = 0.f;
#pragma unroll
    for (int j = 0; j < 16; ++j) { v[j] = __builtin_nontemporal_load(xr + 64 * j); ss += (v[j].x * v[j].x + v[j].y * v[j].y) + (v[j].z * v[j].z + v[j].w * v[j].w); }
    const float rstd = 1.0f / sqrtf(wave_sum(ss) * (1.0f / D) + EPS);
    GAS v2u* o8 = (GAS v2u*)(F.HB + (size_t)m * D) + lane;
#pragma unroll
    for (int j = 0; j < 16; ++j) { const f32x4 y = v[j] * rstd * G4[64 * j] + S4[64 * j]; v2u w; w.x = pkbf(y.x, y.y); w.y = pkbf(y.z, y.w); o8[64 * j] = w; }
}

#define MFMA32(a, b, c) __builtin_amdgcn_mfma_f32_32x32x16_bf16((a), (b), (c), 0, 0, 0)
constexpr int A_NST = 6, A_STAGE = 16384, A_RING = 32768;
typedef short s16x4 __attribute__((ext_vector_type(4)));
__device__ __forceinline__ void attn_wg_unit(Frame& F, const LAS float* rp, int b, int h, int R0) {
    const int lane = F.lane, w = F.wave, j = lane & 31, g = lane >> 5;
    const int r = R0 + (w >> 1), qblk = w & 1;
    const int rs = min(max(r - NAKH / 2, 0), ROWS - NAKH);
    const int KR0 = min(max(R0 - NAKH / 2, 0), ROWS - NAKH), KR1 = min(max(R0 + 3 - NAKH / 2, 0), ROWS - NAKH) + NAKH - 1;
    const int NT = 8 + 2 * (KR1 - KR0 + 1);
    const int qc = 32 * qblk + j, cs = min(max(qc - NAKW / 2, 0), GRIDW - NAKW);
    const int bias_lane = (h * 15 + rs - r + NAKH - 1) * 31 + 8 * g - qc + NAKW - 1;
    const int mask_lane = 8 * g - cs;
    const unsigned drow = 4u * w + (lane >> 4), dsw = ((drow & 3u) << 2) | ((drow >> 2) & 3u);
    const unsigned dma_off = (drow * NAW + 8u * ((lane & 15u) ^ dsw)) * 2u;
    const char* kbase = (const char*)(F.KB + HD * h); const char* vbase = (const char*)(F.VB + HD * h);
    LAS unsigned char* ring = F.lds + RING_OFF + A_RING;
#define KEYBASE(T) ((T) >= 8 ? (b * SEQ + (KR0 + (((T) - 8) >> 1)) * GRIDW + 32 * (((T) - 8) & 1)) : (M + b * CTXL + 32 * (T)))
#define DMA(T, ST) do { const size_t go_ = (size_t)KEYBASE(T) * (NAW * 2) + dma_off; \
        __builtin_amdgcn_global_load_lds((const unsigned*)(kbase + go_), (LAS unsigned*)(ring + (ST) * A_STAGE + w * 1024), 16, 0, 0); \
        __builtin_amdgcn_global_load_lds((const unsigned*)(vbase + go_), (LAS unsigned*)(ring + (ST) * A_STAGE + 8192 + w * 1024), 16, 0, 0); } while (0)
    const unsigned kap = (j & 19) | ((j & 4) << 1) | ((j & 8) >> 1), ksw = ((kap & 3u) << 2) | ((kap >> 2) & 3u);
    unsigned ka[8];
#pragma unroll
    for (int kd = 0; kd < 8; ++kd) ka[kd] = 256u * kap + 16u * ((2u * kd + g) ^ ksw);
    const unsigned blk = (lane >> 4) & 1, q4 = (lane & 15) >> 2, p4 = lane & 3;
    unsigned va_[2][4];
#pragma unroll
    for (int t = 0; t < 2; ++t)
#pragma unroll
        for (int jb = 0; jb < 4; ++jb) { const unsigned row = 8u * g + 4u * t + q4, sw = ((row & 3u) << 2) | ((row >> 2) & 3u);
            va_[t][jb] = 8192u + 256u * row + 16u * ((4u * jb + 2u * blk + (p4 >> 1)) ^ sw) + 8u * (p4 & 1); }
    const size_t qtok = (size_t)b * SEQ + r * GRIDW + 32 * qblk + j;
    bf16x8 qf[8];
    { const GAS bf16x8* qp = (const GAS bf16x8*)(F.QB + qtok * NAW + HD * h + 8 * g);
#pragma unroll
      for (int kd = 0; kd < 8; ++kd) qf[kd] = __builtin_nontemporal_load(qp + 2 * kd); }
#pragma unroll
    for (int t = 0; t < A_NST - 1; ++t) DMA(t, t);
    f32x16 o0, o1, o2, o3;
#pragma unroll
    for (int v = 0; v < 16; ++v) { o0[v] = 0.f; o1[v] = 0.f; o2[v] = 0.f; o3[v] = 0.f; }
    float m_run = -__builtin_inff(), l_run = 0.f;
    int st = 0, stp = A_NST - 1;
    for (int t = 0; t < NT; ++t) {
        asm volatile("s_waitcnt vmcnt(%0)" :: "n"(2 * (A_NST - 2)) : "memory");
        __builtin_amdgcn_s_barrier();
        asm volatile("" ::: "memory");
        { const int tp = min(t + A_NST - 1, NT - 1); DMA(tp, stp); }
        const bool lat = t >= 8; const int kr = KR0 + ((t - 8) >> 1), kblk = (t - 8) & 1;
        const bool active = !lat || (kr >= rs && kr < rs + NAKH);
        if (active) {
            const LAS unsigned char* sb = ring + st * A_STAGE;
            f32x16 s;
#pragma unroll
            for (int v = 0; v < 16; ++v) s[v] = 0.f;
            { bf16x8 kf[8];
#pragma unroll
              for (int kd = 0; kd < 8; ++kd) kf[kd] = *(const LAS bf16x8*)(sb + ka[kd]);
#pragma unroll
              for (int kd = 0; kd < 8; ++kd) s = MFMA32(kf[kd], qf[kd], s); }
            s16x4 tv[2][2][4];
            { const unsigned sa = (unsigned)(size_t)sb;
#pragma unroll
              for (int t2 = 0; t2 < 2; ++t2)
#pragma unroll
                for (int jb = 0; jb < 4; ++jb) { asm volatile("ds_read_b64_tr_b16 %0, %1" : "=v"(tv[0][t2][jb]) : "v"(sa + va_[t2][jb]) : "memory");
                                                 asm volatile("ds_read_b64_tr_b16 %0, %1 offset:4096" : "=v"(tv[1][t2][jb]) : "v"(sa + va_[t2][jb]) : "memory"); } }
            if (lat) { int ml = mask_lane; asm volatile("" : "+v"(ml)); const LAS float* bp = rp + bias_lane + 31 * (kr - rs) + 32 * kblk;
                float bias[16];
#pragma unroll
                for (int v = 0; v < 16; ++v) bias[v] = bp[(v & 7) + 16 * (v >> 3)];
                asm volatile("" : "+v"(bias[0]), "+v"(bias[1]), "+v"(bias[2]), "+v"(bias[3]), "+v"(bias[4]), "+v"(bias[5]), "+v"(bias[6]), "+v"(bias[7]),
                             "+v"(bias[8]), "+v"(bias[9]), "+v"(bias[10]), "+v"(bias[11]), "+v"(bias[12]), "+v"(bias[13]), "+v"(bias[14]), "+v"(bias[15]));
                const int mk = ml + 32 * kblk;
#pragma unroll
                for (int v = 0; v < 16; ++v) { const int c = (v & 7) + 16 * (v >> 3); s[v] = ((unsigned)(c + mk) < 16u) ? s[v] + bias[v] : -__builtin_inff(); } }
            float mx = s[0];
#pragma unroll
            for (int v = 1; v < 16; ++v) mx = fmaxf(mx, s[v]);
            mx = fmaxf(mx, __shfl_xor(mx, 32));
            if (__builtin_amdgcn_ballot_w64(mx > m_run) != 0ull) {
                const float m_new = fmaxf(m_run, mx), alpha = __builtin_amdgcn_exp2f(m_run - m_new);
                l_run *= alpha; m_run = m_new;
#pragma unroll
                for (int v = 0; v < 16; ++v) { o0[v] *= alpha; o1[v] *= alpha; o2[v] *= alpha; o3[v] *= alpha; } }
            float ps = 0.f;
#pragma unroll
            for (int v = 0; v < 16; ++v) { s[v] = __builtin_amdgcn_exp2f(s[v] - m_run); ps += s[v]; }
            l_run += ps;
            bf16x8 pf0, pf1;
            { v4u t0, t1; t0.x = pkbf(s[0], s[1]); t0.y = pkbf(s[2], s[3]); t0.z = pkbf(s[4], s[5]); t0.w = pkbf(s[6], s[7]);
              t1.x = pkbf(s[8], s[9]); t1.y = pkbf(s[10], s[11]); t1.z = pkbf(s[12], s[13]); t1.w = pkbf(s[14], s[15]);
              pf0 = __builtin_bit_cast(bf16x8, t0); pf1 = __builtin_bit_cast(bf16x8, t1); }
            asm volatile("s_waitcnt lgkmcnt(0)" : "+v"(tv[0][0][0]), "+v"(tv[0][0][1]), "+v"(tv[0][0][2]), "+v"(tv[0][0][3]), "+v"(tv[0][1][0]), "+v"(tv[0][1][1]), "+v"(tv[0][1][2]), "+v"(tv[0][1][3]),
                         "+v"(tv[1][0][0]), "+v"(tv[1][0][1]), "+v"(tv[1][0][2]), "+v"(tv[1][0][3]), "+v"(tv[1][1][0]), "+v"(tv[1][1][1]), "+v"(tv[1][1][2]), "+v"(tv[1][1][3]) :: "memory");
#define VF(KS, JB) __builtin_shufflevector(tv[KS][0][JB], tv[KS][1][JB], 0, 1, 2, 3, 4, 5, 6, 7)
            o0 = MFMA32(VF(0, 0), pf0, o0); o1 = MFMA32(VF(0, 1), pf0, o1); o2 = MFMA32(VF(0, 2), pf0, o2); o3 = MFMA32(VF(0, 3), pf0, o3);
            o0 = MFMA32(VF(1, 0), pf1, o0); o1 = MFMA32(VF(1, 1), pf1, o1); o2 = MFMA32(VF(1, 2), pf1, o2); o3 = MFMA32(VF(1, 3), pf1, o3);
#undef VF
        }
        st = (st + 1 == A_NST) ? 0 : st + 1; stp = (stp + 1 == A_NST) ? 0 : stp + 1;
    }
#undef KEYBASE
#undef DMA
    asm volatile("s_waitcnt vmcnt(0)" ::: "memory");
    __builtin_amdgcn_s_barrier();
    asm volatile("" ::: "memory");
    const float l = l_run + __shfl_xor(l_run, 32), inv = 1.0f / l;
    GAS v2u* op = (GAS v2u*)(F.YB + qtok * D + HD * h);
    float sq = 0.f;
#define OST(JB, OV) do { _Pragma("unroll") for (int u = 0; u < 4; ++u) { const float a_ = OV[4 * u] * inv, b_ = OV[4 * u + 1] * inv, c_ = OV[4 * u + 2] * inv, d_ = OV[4 * u + 3] * inv; \
        sq += (a_ * a_ + b_ * b_) + (c_ * c_ + d_ * d_); v2u w_; w_.x = pkbf(a_, b_); w_.y = pkbf(c_, d_); op[8 * (JB) + 2 * u + g] = w_; } } while (0)
    OST(0, o0); OST(1, o1); OST(2, o2); OST(3, o3);
    sq += __shfl_xor(sq, 32);
    if (g == 0) atomicAdd(F.ssq + qtok, sq);
#undef OST
}
__device__ __forceinline__ void attn_phase(Frame& F) {
    LAS float* rp = (LAS float*)(F.lds + RING_OFF + 1024);
    for (int i = F.tid; i < NAH * 15 * 31; i += NWAVES * 64) rp[i] = F.in[I_RPB][i] * LOG2E;
    __syncthreads();
    for (int wu = F.vcu; wu < NB * NAH * 8; wu += F.G) { const int bh = wu >> 3, rg = wu & 7; attn_wg_unit(F, rp, bh >> 4, bh & 15, rg * 4); }
}

template <bool LDSW> __device__ __forceinline__ void conv_row(Frame& F, int row) {
    unsigned lane = (unsigned)F.lane; const int t = row & (SEQ - 1);
    asm volatile("" : "+v"(lane) :: "memory");
    const GAS char* cw = (const GAS char*)F.in[I_CONVW];
    const GAS char* r0 = (const GAS char*)(F.CB + (size_t)row * 4096);
    const GAS char* rm = t > 0 ? r0 - 8192 : r0; const GAS char* rp = t < SEQ - 1 ? r0 + 8192 : r0;
    const float fm = t > 0 ? 1.f : 0.f, fp = t < SEQ - 1 ? 1.f : 0.f;
    const float ssa = F.ssq[row];
    float co[4][8]; float ss = 0.f;
#pragma unroll
    for (int q = 0; q < 4; ++q) { const unsigned vo = lane * 16u + q * 1024u, wo = lane * 32u + q * 2048u;
        const v4u c0v = *(const GAS v4u*)(r0 + vo), gb = __builtin_nontemporal_load((const GAS v4u*)(r0 + (vo + 4096u)));
        const v4u cm = *(const GAS v4u*)(rm + vo), cpl = *(const GAS v4u*)(rp + vo);
        f32x4 wa0, wa1, wb0, wb1, wc0, wc1;
        if (LDSW) { const LAS f32x4* wl = (const LAS f32x4*)(F.lds + RING_OFF) + (lane + 64u * q);
            wa0 = wl[0]; wa1 = wl[256]; wb0 = wl[512]; wb1 = wl[768]; wc0 = wl[1024]; wc1 = wl[1280]; }
        else { wa0 = *(const GAS f32x4*)(cw + wo); wa1 = *(const GAS f32x4*)(cw + (wo + 16u)); wb0 = *(const GAS f32x4*)(cw + (wo + 8192u)); wb1 = *(const GAS f32x4*)(cw + (wo + 8208u));
               wc0 = *(const GAS f32x4*)(cw + (wo + 16384u)); wc1 = *(const GAS f32x4*)(cw + (wo + 16400u)); }
#pragma unroll
        for (int e = 0; e < 4; ++e) {
            const float k0l = (e < 2 ? wa0[(2 * e) & 3] : wa1[(2 * e) & 3]) * fm, k0h = (e < 2 ? wa0[(2 * e + 1) & 3] : wa1[(2 * e + 1) & 3]) * fm;
            const float k1l = e < 2 ? wb0[(2 * e) & 3] : wb1[(2 * e) & 3], k1h = e < 2 ? wb0[(2 * e + 1) & 3] : wb1[(2 * e + 1) & 3];
            const float k2l = (e < 2 ? wc0[(2 * e) & 3] : wc1[(2 * e) & 3]) * fp, k2h = (e < 2 ? wc0[(2 * e + 1) & 3] : wc1[(2 * e + 1) & 3]) * fp;
            const float vl = bflo(gb[e]) * (k0l * bflo(cm[e]) + k1l * bflo(c0v[e]) + k2l * bflo(cpl[e]));
            const float vh = bfhi(gb[e]) * (k0h * bfhi(cm[e]) + k1h * bfhi(c0v[e]) + k2h * bfhi(cpl[e]));
            co[q][2 * e] = vl; co[q][2 * e + 1] = vh; ss += vl * vl + vh * vh; } }
    const float sc = sqrtf(ssa * (1.0f / NAW) + EPS) / sqrtf(wave_sum(ss) * (1.0f / CVW) + EPS);
    GAS char* yp = (GAS char*)(F.YB + (size_t)row * D + NAW);
#pragma unroll
    for (int q = 0; q < 4; ++q) { v4u w;
        w.x = pkbf(co[q][0] * sc, co[q][1] * sc); w.y = pkbf(co[q][2] * sc, co[q][3] * sc); w.z = pkbf(co[q][4] * sc, co[q][5] * sc); w.w = pkbf(co[q][6] * sc, co[q][7] * sc);
        *(GAS v4u*)(yp + (lane * 16u + q * 1024u)) = w; }
}
__device__ __forceinline__ void final_norm_row(const float* xrow, const bf16* mrow, const bf16* frow, float* orow, const float* gain, int lane) {
    const GAS f32x4* xr = (const GAS f32x4*)xrow + lane; const GAS v2u* mr = (const GAS v2u*)mrow + lane; const GAS v2u* fr = (const GAS v2u*)frow + lane;
    const GAS f32x4* g4 = (const GAS f32x4*)gain + lane; GAS f32x4* o4 = (GAS f32x4*)orow + lane;
    f32x4 v[16]; float ss = 0.f;
#pragma unroll
    for (int j = 0; j < 16; ++j) { const f32x4 x = __builtin_nontemporal_load(xr + 64 * j); const v2u m = __builtin_nontemporal_load(mr + 64 * j), f = __builtin_nontemporal_load(fr + 64 * j);
        v[j] = (f32x4){x.x + bflo(m.x) + bflo(f.x), x.y + bfhi(m.x) + bfhi(f.x), x.z + bflo(m.y) + bflo(f.y), x.w + bfhi(m.y) + bfhi(f.y)};
        ss += (v[j].x * v[j].x + v[j].y * v[j].y) + (v[j].z * v[j].z + v[j].w * v[j].w); }
    const float rstd = 1.0f / sqrtf(wave_sum(ss) * (1.0f / D) + EPS);
#pragma unroll
    for (int j = 0; j < 16; ++j) __builtin_nontemporal_store(v[j] * rstd * g4[64 * j], o4 + 64 * j);
}

__device__ __forceinline__ void final_norm_row_lds(Frame& F, int m) {
    const int lane = F.lane;
    const GAS f32x4* xr = (const GAS f32x4*)(F.in[I_X] + (size_t)m * D) + lane; const GAS v2u* mr = (const GAS v2u*)(F.MX + (size_t)m * D) + lane; const GAS v2u* fr = (const GAS v2u*)(F.FX + (size_t)m * D) + lane;
    const LAS f32x4* g4 = (const LAS f32x4*)(F.lds + RING_OFF) + lane; GAS f32x4* o4 = (GAS f32x4*)(F.out + (size_t)m * D) + lane;
    f32x4 v[16]; float ss = 0.f;
#pragma unroll
    for (int j = 0; j < 16; ++j) { const f32x4 x = __builtin_nontemporal_load(xr + 64 * j); const v2u mm = __builtin_nontemporal_load(mr + 64 * j), f = __builtin_nontemporal_load(fr + 64 * j);
        v[j] = (f32x4){x.x + bflo(mm.x) + bflo(f.x), x.y + bfhi(mm.x) + bfhi(f.x), x.z + bflo(mm.y) + bflo(f.y), x.w + bfhi(mm.y) + bfhi(f.y)};
        ss += (v[j].x * v[j].x + v[j].y * v[j].y) + (v[j].z * v[j].z + v[j].w * v[j].w); }
    const float rstd = 1.0f / sqrtf(wave_sum(ss) * (1.0f / D) + EPS);
#pragma unroll
    for (int j = 0; j < 16; ++j) __builtin_nontemporal_store(v[j] * rstd * g4[64 * j], o4 + 64 * j);
}

struct Args { const float* in[N_IN]; float* out; unsigned char* ws; int ph_lo, ph_hi; };
__global__ void __launch_bounds__(NWAVES * 64, 2) fwd_kernel(Args args) {
    extern __shared__ __attribute__((aligned(16))) unsigned char lds[];
    Frame F;
    F.lds = (LAS unsigned char*)lds;
    F.MISC = (volatile LAS unsigned*)(F.lds + MISC_OFF);
    F.tid = threadIdx.x; F.lane = F.tid & 63; F.wave = __builtin_amdgcn_readfirstlane(F.tid >> 6);
    F.G = gridDim.x; { const int bx = blockIdx.x; F.vcu = (F.G % 8 == 0) ? (bx % 8) * (F.G / 8) + bx / 8 : bx; }
    unsigned char* ws = args.ws;
    F.ctl = (gu32*)(ws + WS_CTL);
#pragma unroll
    for (int i = 0; i < N_IN; ++i) F.in[i] = args.in[i];
    F.out = args.out; F.mod = (float*)(ws + WS_MOD); F.rope = (float*)(ws + WS_ROPE);
    F.Win_t = (bf16*)(ws + WS_WIN); F.Wout_t = (bf16*)(ws + WS_WOUT); F.Wgu_t = (bf16*)(ws + WS_WGU); F.Wdn_t = (bf16*)(ws + WS_WDN);
    F.HB = (bf16*)(ws + WS_H); F.QB = (bf16*)(ws + WS_Q); F.KB = (bf16*)(ws + WS_K); F.VB = (bf16*)(ws + WS_V); F.CB = (bf16*)(ws + WS_C);
    F.ssq = (float*)(ws + WS_SSQ); F.HQ = (signed char*)(ws + WS_H); F.Wgu_q = (signed char*)(ws + WS_WGU); F.rsH = (float*)(ws + WS_RSH); F.csW = (float*)(ws + WS_CSW); F.ACTQ = (signed char*)(ws + WS_Q); F.Wdn_q = (signed char*)(ws + WS_WDN); F.rsA = (float*)(ws + WS_RSA); F.cmaxD = (unsigned*)(ws + WS_CMAXD); F.YB = (bf16*)(ws + WS_Y); F.ACT = (bf16*)(ws + WS_ACT); F.MX = (bf16*)(ws + WS_X1); F.FX = (bf16*)(ws + WS_X1 + 64 * MiB);
    for (int u = F.tid; u < (LDS_BYTES - LDSCTL_OFF) / 4; u += NWAVES * 64) ((LAS unsigned*)(F.lds + LDSCTL_OFF))[u] = 0u;
    __syncthreads();
    XcdBarrier bar; bar.bar = (unsigned*)(F.ctl + CW_BAR); bar.x = 0; bar.st = nullptr;
    if (N_LAUNCHES == 1) bar = xcd_barrier_post((unsigned*)(F.ctl + CW_BAR), F.MISC + 8);
    int cid = (int)blockIdx.x;
#if defined(XCC_PLACE)
    if (N_LAUNCHES == 1 && F.G == 256) {
        if (F.tid == 0) { const unsigned x = xb_xcc_id(); const unsigned r = __hip_atomic_fetch_add(F.ctl + CW_XRANK + 64 * x, 1u, RLX_AGENT);
            unsigned sp = 0; bool ok = false;
            for (;;) { unsigned sum = 0; bool even = true;
                for (unsigned j = 0; j < 16; ++j) { const unsigned c = __hip_atomic_load(F.ctl + CW_XRANK + 64 * j, RLX_AGENT); sum += c; if (j < 8 ? c != 32u : c != 0u) even = false; }
                if (sum == 256u) { ok = even; break; }
                __builtin_amdgcn_s_sleep(1); if (++sp > (1u << 16)) break; }
            F.MISC[12] = ok ? (8u * r + x) : (unsigned)blockIdx.x; }
        __syncthreads();
        cid = (int)F.MISC[12];
    }
#endif
#if defined(FAKEQ_DN)
#define DNQ_DST F.Wdn_t
#else
#define DNQ_DST (bf16*)F.Wdn_q
#endif
    const int lo = args.ph_lo, hi = args.ph_hi;
#define IN(k) (lo <= (k) && (k) < hi)
#if defined(PROBE_BAR2)
#define SEAM(k) do { if (IN(k) && IN((k) + 1)) { xcd_barrier(bar); xcd_barrier(bar); } } while (0)
#else
#define SEAM(k) do { if (IN(k) && IN((k) + 1)) xcd_barrier(bar); } while (0)
#endif
    const int gw = F.vcu * NWAVES + F.wave, NGW = F.G * NWAVES;
#ifndef PROBE_DUP
#define PROBE_DUP (-1)
#endif
#define DUP(k, body) do { body; if (PROBE_DUP == (k)) { xcd_barrier(bar); body; } } while (0)

    if (IN(0)) { p0_prologue(F, 1.0f); if (PROBE_DUP == 0) { xcd_barrier(bar); p0_prologue(F, 0.0f); } SEAM(0); }
    if (IN(1)) {
        if (F.G == 256) {
            const int b0 = (int)blockIdx.x * 32; const float* mrow = F.mod + (size_t)(b0 >> 11) * NMODC;
            stage_mod(F, F.in[I_N1G], mrow, mrow + D);
#pragma unroll 1
            for (int r = F.wave; r < 32; r += NWAVES) { p1_row_lds(F, b0 + r); asm volatile("" ::: "memory"); }
            if (F.wave < 4) { const int mc = M + (int)blockIdx.x * 4 + F.wave; const float* mr4 = F.mod + (size_t)4 * NMODC;
                norm_mod_row(F.in[I_CTX] + (size_t)(mc - M) * D, F.HB + (size_t)mc * D, F.in[I_N1G], mr4, mr4 + D, F.lane); }
        } else
        DUP(1, for (int m = gw; m < MT; m += NGW) {
            const bool isctx = m >= M; const float* xrow = isctx ? F.in[I_CTX] + (size_t)(m - M) * D : F.in[I_X] + (size_t)m * D;
            const float* mrow = F.mod + (size_t)(isctx ? 4 : (m >> 11)) * NMODC;
            norm_mod_row(xrow, F.HB + (size_t)m * D, F.in[I_N1G], mrow, mrow + D, F.lane); });
        SEAM(1);
    }
#if defined(PROBE_IDLE_US)
    if (IN(2)) { const unsigned long long t0 = __builtin_amdgcn_s_memrealtime(); while (__builtin_amdgcn_s_memrealtime() - t0 < (unsigned long long)(PROBE_IDLE_US) * 100ull) __builtin_amdgcn_s_sleep(32); }
#endif
    if (IN(2)) {
        pg8::Gemm g{F.HB, F.Win_t, MT, INC, D}; pg8::InOrder S; S.init(F.G, cid);
        pg8::EpiIn E{F.QB, F.KB, F.VB, F.CB, F.rope, 0.08838834764831845f * LOG2E};
        DUP(2, (pg8::gemm_phase<pg8::EpiIn, pg8::InOrder, PG8_ALIGN, PG8_SP2>(F.lds + RING_OFF, g, S, E)));
        if (F.G == 256 && cid >= 64) {
            LAS float* scr = (LAS float*)(F.lds + RING_OFF + F.wave * 16384); const int p = (cid - 64) * NWAVES + F.wave, pw = cid - 64;
            transpose_items<3>(F.in[I_WOUT], D, D, F.Wout_t, scr, P0_OUT_ITEMS + p, 192 * NWAVES, IT_OUT, F.lane, F.in[I_GNG]);
#if DNQ_COOP
            __syncthreads();
            if (pw < 64) { quant_dn_block(F, pw); for (int nb = 576 + pw; nb < 2 * FF / 32; nb += 64) quant_gu_block(F, nb); }
            else { for (int nb = pw - 64; nb < 576; nb += 128) quant_gu_block(F, nb); }
#else
            for (int nb = P0_GUQ_BLOCKS + cid - 64; nb < 2 * FF / 32; nb += 192) quant_gu_block(F, nb);
            transpose_items<8>(F.in[I_WDN], FF, D, DNQ_DST, scr, p, 192 * NWAVES, TAIL2_DN_ITEMS, F.lane, (const float*)F.cmaxD);
#endif
        } else if (F.G != 256) {
            LAS float* scr = (LAS float*)(F.lds + RING_OFF + F.wave * 16384);
            transpose_items<3>(F.in[I_WOUT], D, D, F.Wout_t, scr, P0_OUT_ITEMS + gw, NGW, IT_OUT, F.lane, F.in[I_GNG]);
            __syncthreads();
            for (int nb = P0_GUQ_BLOCKS + (int)blockIdx.x; nb < 2 * FF / 32; nb += F.G) quant_gu_block(F, nb);
#if DNQ_COOP
            for (int nb = (int)blockIdx.x; nb < D / 32; nb += F.G) quant_dn_block(F, nb);
#else
            transpose_items<8>(F.in[I_WDN], FF, D, DNQ_DST, scr, gw, NGW, TAIL2_DN_ITEMS, F.lane, (const float*)F.cmaxD);
#endif
        }
        SEAM(2);
    }
    if (IN(3)) { DUP(3, attn_phase(F)); SEAM(3); }
    if (IN(4)) {
        if (F.G == 256) {
            { LAS float* wl = (LAS float*)(F.lds + RING_OFF); const float* cw = F.in[I_CONVW];
              int t0 = F.tid; asm volatile("" : "+v"(t0));
              for (int i = t0; i < 3 * CVW; i += NWAVES * 64) { const int k = i / CVW, ch = i % CVW, chunk = ch >> 3, half = (ch >> 2) & 1, e = ch & 3; wl[((k * 2 + half) * 256 + chunk) * 4 + e] = cw[i]; }
              __syncthreads(); }
#pragma unroll 1
            for (int r = F.wave; r < 32; r += NWAVES) { conv_row<true>(F, (int)blockIdx.x * 32 + r); asm volatile("" ::: "memory"); }
        } else
        DUP(4, for (int m = gw; m < M; m += NGW) conv_row<false>(F, m));
        SEAM(4); }
    if (IN(5)) {
        pg8::Gemm g{F.YB, F.Wout_t, M, D, D}; pg8::StaticOrder S; S.init(M, D, F.G, cid);
        pg8::EpiGate<true> E{F.MX, D, F.mod + 2 * D, F.ssq};
        DUP(5, (pg8::gemm_phase<pg8::EpiGate<true>, pg8::StaticOrder, PG8_ALIGN, PG8_SP2>(F.lds + RING_OFF, g, S, E)));
        SEAM(5);
    }
    if (IN(6)) {
        if (F.G == 256) { const int b0 = (int)blockIdx.x * 32; const float* mrow = F.mod + (size_t)(b0 >> 11) * NMODC;
            stage_mod(F, F.in[I_N2G], mrow + 3 * D, mrow + 4 * D);
#pragma unroll 1
            for (int r = F.wave; r < 32; r += NWAVES) { p6_row_lds(F, b0 + r); asm volatile("" ::: "memory"); }
        } else
        DUP(6, for (int m = gw; m < M; m += NGW) { const float* mrow = F.mod + (size_t)(m >> 11) * NMODC;
            norm_mod_row_x1_q8(F.in[I_X] + (size_t)m * D, F.MX + (size_t)m * D, F.HQ + (size_t)m * D, F.rsH + m, F.in[I_N2G], mrow + 3 * D, mrow + 4 * D, F.lane); });
        SEAM(6);
    }
    if (IN(7)) {
        pg8::Gemm g{(const bf16*)F.HQ, (const bf16*)F.Wgu_q, M, 2 * FF, D / 2}; pg8::StaticOrder S; S.init(M, 2 * FF, F.G, cid);
        pg8::EpiSwigluI8 E{F.ACT, FF, F.rsH, F.csW};
#if defined(PROBE_CLK_THR)
        const unsigned long long pc0 = __builtin_readcyclecounter(), pr0 = __builtin_amdgcn_s_memrealtime();
#endif
        DUP(7, (pg8::gemm_phase<pg8::EpiSwigluI8, pg8::StaticOrder, PG8_ALIGN, PG8_SP2>(F.lds + RING_OFF, g, S, E)));
#if defined(PROBE_CLK_THR)
        { const unsigned long long pc1 = __builtin_readcyclecounter(), pr1 = __builtin_amdgcn_s_memrealtime();
          const unsigned long long mhz = (pc1 - pc0) * 100ull / (pr1 - pr0 + 1ull);
          if (blockIdx.x == 0 && mhz < (unsigned long long)(PROBE_CLK_THR)) { const unsigned long long t0 = __builtin_amdgcn_s_memrealtime(); while (__builtin_amdgcn_s_memrealtime() - t0 < 50000ull) __builtin_amdgcn_s_sleep(32); } }
#endif
#if DNQ_COOP
        if (F.G == 256 && cid >= 192) quant_dn_block(F, 64 + cid - 192);
#else
        if (F.G == 256 && cid >= 192) {
            LAS float* scr = (LAS float*)(F.lds + RING_OFF + F.wave * 16384); const int p = (cid - 192) * NWAVES + F.wave;
            transpose_items<8>(F.in[I_WDN], FF, D, DNQ_DST, scr, TAIL2_DN_ITEMS + p, 64 * NWAVES, IT_DN, F.lane, (const float*)F.cmaxD);
        } else if (F.G != 256) {
            LAS float* scr = (LAS float*)(F.lds + RING_OFF + F.wave * 16384);
            transpose_items<8>(F.in[I_WDN], FF, D, DNQ_DST, scr, TAIL2_DN_ITEMS + gw, NGW, IT_DN, F.lane, (const float*)F.cmaxD);
        }
#endif
        SEAM(7);
    }
    if (IN(8)) { for (int m = gw; m < M; m += NGW) quant_act_row(F.ACT + (size_t)m * FF, F.ACTQ + (size_t)m * FF, F.rsA + m, F.lane); SEAM(8); }
    if (IN(9)) {
#if defined(FAKEQ_DN)
        pg8::Gemm g{F.ACT, F.Wdn_t, M, D, FF}; pg8::StaticOrder S; S.init(M, D, F.G, cid);
        pg8::EpiGate<false> E{F.FX, D, F.mod + 5 * D, nullptr};
        DUP(9, (pg8::gemm_phase<pg8::EpiGate<false>, pg8::StaticOrder, PG8_ALIGN, PG8_SP2>(F.lds + RING_OFF, g, S, E)));
#else
        pg8::Gemm g{(const bf16*)F.ACTQ, (const bf16*)F.Wdn_q, M, D, FF / 2}; pg8::StaticOrder S; S.init(M, D, F.G, cid);
        pg8::EpiGateI8 E{F.FX, D, F.mod + 5 * D, F.rsA, F.cmaxD};
        DUP(9, (pg8::gemm_phase<pg8::EpiGateI8, pg8::StaticOrder, PG8_ALIGN, PG8_SP2>(F.lds + RING_OFF, g, S, E)));
#endif
        SEAM(9);
    }
    if (IN(10)) {
        if (F.G == 256) { LAS float* gl = (LAS float*)(F.lds + RING_OFF); int t0 = F.tid; asm volatile("" : "+v"(t0));
            for (int i = t0; i < D; i += NWAVES * 64) gl[i] = F.in[I_FNG][i]; __syncthreads();
#pragma unroll 1
            for (int r = F.wave; r < 32; r += NWAVES) { final_norm_row_lds(F, (int)blockIdx.x * 32 + r); asm volatile("" ::: "memory"); }
        } else
        for (int m = gw; m < M; m += NGW) final_norm_row(F.in[I_X] + (size_t)m * D, F.MX + (size_t)m * D, F.FX + (size_t)m * D, F.out + (size_t)m * D, F.in[I_FNG], F.lane); }
#undef IN
#undef SEAM
}

extern "C" void kernel_launch(void* const* d_in, const int* in_sizes, int n_in, void* d_out, int out_size, void* d_ws, size_t ws_size, hipStream_t stream) {
    static int grid = 0;
    if (grid == 0) {
        if (n_in != N_IN || in_sizes[I_X] != M * D || out_size != M * D || ws_size < WS_END) { fprintf(stderr, "kernel_launch: shape / workspace mismatch (n_in %d, x %d, out %d, ws %zu); nothing launched\n", n_in, n_in > 0 ? in_sizes[0] : -1, out_size, ws_size); grid = -1; return; }
        int dev = 0, cus = 0, per_cu = 0;
        if (hipGetDevice(&dev) != hipSuccess || hipDeviceGetAttribute(&cus, hipDeviceAttributeMultiprocessorCount, dev) != hipSuccess) { fprintf(stderr, "kernel_launch: device query failed\n"); grid = -1; return; }
        if (hipFuncSetAttribute((const void*)fwd_kernel, hipFuncAttributeMaxDynamicSharedMemorySize, LDS_BYTES) != hipSuccess) { fprintf(stderr, "kernel_launch: hipFuncSetAttribute failed\n"); grid = -1; return; }
        if (hipOccupancyMaxActiveBlocksPerMultiprocessor(&per_cu, (const void*)fwd_kernel, NWAVES * 64, LDS_BYTES) != hipSuccess || per_cu < 1)
            fprintf(stderr, "kernel_launch: note: occupancy query reports %d workgroups per CU\n", per_cu);
        (void)hipGetLastError();
        grid = cus;
    }
    if (grid < 0) return;
    if (hipMemsetAsync((char*)d_ws + WS_CTL, 0, CTL_ZERO_BYTES, stream) != hipSuccess) { fprintf(stderr, "kernel_launch: memset failed\n"); return; }
    Args a{};
    for (int i = 0; i < N_IN; ++i) a.in[i] = (const float*)d_in[i];
    a.out = (float*)d_out; a.ws = (unsigned char*)d_ws;
    for (int li = 0; li < N_LAUNCHES; ++li) {
        a.ph_lo = (N_LAUNCHES == 1) ? 0 : li; a.ph_hi = (N_LAUNCHES == 1) ? N_PHASES : li + 1;
        hipLaunchKernelGGL(fwd_kernel, dim3(grid), dim3(NWAVES * 64), LDS_BYTES, stream, a);
        const hipError_t le = hipPeekAtLastError();
        if (le != hipSuccess) { fprintf(stderr, "kernel_launch: launch %d failed: %s\n", li, hipGetErrorName(le)); break; }
    }
}
```
